# Optimizing an MI355X kernel written in HIP

```python
import math
import jax, jax.numpy as jnp
from jax import lax
import numpy as np

D_MODEL = 1024
BATCH = 2
SEQ = 8192
DEPTH = 2

HEAD_DIM = 64
DIFF_HEADS = 4
FOX_HEADS = 8
DIFF_QK_WIDTH = 2 * DIFF_HEADS * HEAD_DIM
DIFF_V_WIDTH = DIFF_HEADS * 2 * HEAD_DIM
FOX_WIDTH = FOX_HEADS * HEAD_DIM
ROT_DIM = HEAD_DIM // 4
ROPE_THETA = 500000.0
Q_BLOCK = 128
N_GROUPS = 4
EXPERTS_PER_GROUP = 8
EXPERT_FF = 512
TOP_K_INNER = 2
EPS = 1e-6
SPLIT_SIZES = (DIFF_QK_WIDTH, DIFF_QK_WIDTH, DIFF_V_WIDTH, FOX_WIDTH, FOX_WIDTH, FOX_WIDTH, FOX_HEADS, 2 * D_MODEL)
IN_COLS = sum(SPLIT_SIZES)

kernel_name = "hybrid_diffattn_fox_hmoe_block"


def rms_norm(x, g):
    xf = x.astype(jnp.float32)
    y = xf * lax.rsqrt(jnp.mean(xf * xf, axis=-1, keepdims=True) + EPS)
    return (y * g.astype(jnp.float32)).astype(x.dtype)


def split_heads(t, n_heads):
    b, s, w = t.shape
    return t.reshape(b, s, n_heads, w // n_heads).transpose(0, 2, 1, 3)


def merge_heads(t):
    b, h, s, d = t.shape
    return t.transpose(0, 2, 1, 3).reshape(b, s, h * d)


def rotary_tables(positions, dtype):
    inv_freq = ROPE_THETA ** (-jnp.arange(0, ROT_DIM, 2, dtype=jnp.float32) / ROT_DIM)
    ang = positions.astype(jnp.float32)[..., None] * inv_freq
    return jnp.cos(ang)[:, None].astype(dtype), jnp.sin(ang)[:, None].astype(dtype)


def partial_rotary(t, cos, sin):
    half = ROT_DIM // 2
    t1, t2, rest = t[..., :half], t[..., half:ROT_DIM], t[..., ROT_DIM:]
    return jnp.concatenate([t1 * cos - t2 * sin, t2 * cos + t1 * sin, rest], axis=-1)


def causal_block_attention(q, k, v, q_bias=None, k_bias=None):
    b, h, s, dk = q.shape
    dv = v.shape[-1]
    scale = dk ** -0.5
    k_pos = jnp.arange(s)

    def one_block(i):
        start = i * Q_BLOCK
        qb = lax.dynamic_slice_in_dim(q, start, Q_BLOCK, axis=2)
        logits = jnp.einsum('bhqd,bhkd->bhqk', qb, k).astype(jnp.float32) * scale
        if q_bias is not None:
            qbb = lax.dynamic_slice_in_dim(q_bias, start, Q_BLOCK, axis=2)
            logits = logits + qbb[..., :, None] + k_bias[..., None, :]
        q_pos = start + jnp.arange(Q_BLOCK)
        mask = k_pos[None, :] <= q_pos[:, None]
        logits = jnp.where(mask, logits, -jnp.inf)
        p = jax.nn.softmax(logits, axis=-1).astype(v.dtype)
        return jnp.einsum('bhqk,bhkv->bhqv', p, v)

    out = lax.map(one_block, jnp.arange(s // Q_BLOCK))
    return out.transpose(1, 2, 0, 3, 4).reshape(b, h, s, dv)


def hierarchical_moe(h, w_rg, b_rg, w_re, b_re, w_gate, w_up, w_down):
    t = h.shape[0]
    p_group = jax.nn.softmax((h @ w_rg + b_rg).astype(jnp.float32), axis=-1)
    p_g_top, g_idx = lax.top_k(p_group, 1)
    lg_exp = (h @ w_re + b_re).astype(jnp.float32).reshape(t, N_GROUPS, EXPERTS_PER_GROUP)
    lg_sel = jnp.take_along_axis(lg_exp, g_idx[:, :, None], axis=1)[:, 0]
    p_exp = jax.nn.softmax(lg_sel, axis=-1)
    p_e_top, e_idx = lax.top_k(p_exp, TOP_K_INNER)
    p_e_top = p_e_top / jnp.sum(p_e_top, axis=-1, keepdims=True)
    w_inner = jnp.sum(jax.nn.one_hot(e_idx, EXPERTS_PER_GROUP, dtype=jnp.float32) * p_e_top[..., None], axis=1)
    gate = (jax.nn.one_hot(g_idx[:, 0], N_GROUPS, dtype=jnp.float32)[:, :, None]
            * (p_g_top[:, 0, None, None] * w_inner[:, None, :])).astype(h.dtype)
    out = jnp.zeros_like(h)
    for g in range(N_GROUPS):
        a = jnp.einsum('td,edf->tef', h, w_gate[g])
        u = jnp.einsum('td,edf->tef', h, w_up[g])
        hid = jax.nn.silu(a) * u * gate[:, g, :, None]
        out = out + jnp.einsum('tef,efd->td', hid, w_down[g])
    return out


def setup_inputs(seed: int = 0) -> dict:
    key = jax.random.key(seed)
    ks = jax.random.split(key, 26)
    f32 = jnp.float32
    L, D, d = DEPTH, D_MODEL, HEAD_DIM
    G, E, F = N_GROUPS, EXPERTS_PER_GROUP, EXPERT_FF

    def nrm(k, shape, scale):
        return jax.random.normal(k, shape, f32) * scale

    def gain(k, shape):
        return 1.0 + 0.05 * jax.random.normal(k, shape, f32)

    return {
        "x": jax.random.normal(ks[0], (BATCH, SEQ, D), f32),
        "positions": jnp.broadcast_to(jnp.arange(SEQ, dtype=jnp.int32), (BATCH, SEQ)),
        "ln1_g": gain(ks[1], (L, D)),
        "w_in": nrm(ks[2], (L, D, IN_COLS), D ** -0.5),
        "b_forget": 2.0 + 0.5 * jax.random.normal(ks[3], (L, FOX_HEADS), f32),
        "q_norm_diff_g": gain(ks[4], (L, d)),
        "k_norm_diff_g": gain(ks[5], (L, d)),
        "lam_q1": nrm(ks[6], (L, d), 0.1),
        "lam_k1": nrm(ks[7], (L, d), 0.1),
        "lam_q2": nrm(ks[8], (L, d), 0.1),
        "lam_k2": nrm(ks[9], (L, d), 0.1),
        "subln_g": gain(ks[10], (L, 2 * d)),
        "q_norm_fox_g": gain(ks[11], (L, d)),
        "k_norm_fox_g": gain(ks[12], (L, d)),
        "w_diff_out": nrm(ks[13], (L, DIFF_V_WIDTH, D), DIFF_V_WIDTH ** -0.5),
        "w_fox_out": nrm(ks[14], (L, FOX_WIDTH, D), FOX_WIDTH ** -0.5),
        "w_o": nrm(ks[15], (L, D, D), D ** -0.5),
        "ln2_g": gain(ks[16], (L, D)),
        "w_router_group": nrm(ks[17], (L, D, G), D ** -0.5),
        "b_router_group": nrm(ks[18], (L, G), 0.01),
        "w_router_expert": nrm(ks[19], (L, D, G * E), D ** -0.5),
        "b_router_expert": nrm(ks[20], (L, G * E), 0.01),
        "w_exp_gate": nrm(ks[21], (L, G, E, D, F), D ** -0.5),
        "w_exp_up": nrm(ks[22], (L, G, E, D, F), D ** -0.5),
        "w_exp_down": nrm(ks[23], (L, G, E, F, D), F ** -0.5),
    }


def reference(x, positions, ln1_g, w_in, b_forget, q_norm_diff_g, k_norm_diff_g, lam_q1, lam_k1, lam_q2, lam_k2,
              subln_g, q_norm_fox_g, k_norm_fox_g, w_diff_out, w_fox_out, w_o, ln2_g, w_router_group,
              b_router_group, w_router_expert, b_router_expert, w_exp_gate, w_exp_up, w_exp_down):
    b, s, dm = x.shape
    cos, sin = rotary_tables(positions, x.dtype)
    split_points = [int(v) for v in np.cumsum(SPLIT_SIZES)[:-1]]
    for l in range(DEPTH):
        lambda_init = 0.8 - 0.6 * math.exp(-0.3 * l)
        h = rms_norm(x, ln1_g[l])
        proj = h @ w_in[l]
        qa, ka, va, qf, kf, vf, fz, gz = jnp.split(proj, split_points, axis=-1)

        qa = partial_rotary(rms_norm(split_heads(qa, 2 * DIFF_HEADS), q_norm_diff_g[l]), cos, sin)
        ka = partial_rotary(rms_norm(split_heads(ka, 2 * DIFF_HEADS), k_norm_diff_g[l]), cos, sin)
        va = split_heads(va, DIFF_HEADS)
        oa = causal_block_attention(qa, ka, jnp.concatenate([va, va], axis=1))
        lam = (jnp.exp(jnp.sum(lam_q1[l].astype(jnp.float32) * lam_k1[l].astype(jnp.float32)))
               - jnp.exp(jnp.sum(lam_q2[l].astype(jnp.float32) * lam_k2[l].astype(jnp.float32)))
               + lambda_init)
        oa = oa[:, :DIFF_HEADS] - lam.astype(oa.dtype) * oa[:, DIFF_HEADS:]
        oa = rms_norm(oa, subln_g[l]) * (1.0 - lambda_init)
        ya = merge_heads(oa) @ w_diff_out[l]

        qf = rms_norm(split_heads(qf, FOX_HEADS), q_norm_fox_g[l])
        kf = rms_norm(split_heads(kf, FOX_HEADS), k_norm_fox_g[l])
        vf = split_heads(vf, FOX_HEADS)
        log_f = jax.nn.log_sigmoid(fz.astype(jnp.float32) + b_forget[l].astype(jnp.float32))
        cum = jnp.cumsum(log_f, axis=1).transpose(0, 2, 1)
        of = causal_block_attention(qf, kf, vf, cum, -cum)
        yf = merge_heads(of) @ w_fox_out[l]

        gates = jax.nn.sigmoid(gz.astype(jnp.float32)).astype(x.dtype)
        g_a, g_f = gates[..., :dm], gates[..., dm:]
        x = x + (g_a * ya + g_f * yf) @ w_o[l]

        h2 = rms_norm(x, ln2_g[l]).reshape(b * s, dm)
        y = hierarchical_moe(h2, w_router_group[l], b_router_group[l], w_router_expert[l], b_router_expert[l],
                             w_exp_gate[l], w_exp_up[l], w_exp_down[l])
        x = x + y.reshape(b, s, dm)
    return x
```

```cpp
#define BUILD_ORACLE 0
#define ONE_LAUNCH 1
#include <hip/hip_runtime.h>
#include <cstdio>
#include <cstdint>

constexpr int D = 1024, BATCH = 2, SEQ = 8192, T = BATCH * SEQ, DEPTH = 2;
constexpr int HD = 64, NEXP = 32, FF = 512;
constexpr int INC = 5128;
constexpr int NP = 5120;
constexpr int C_QA = 0, C_KA = 512, C_VA = 1024, C_QF = 1536, C_KF = 2048, C_VF = 2560, C_GA = 3072, C_GF = 4096;
constexpr float EPS = 1e-6f;
constexpr float LOG2E = 1.4426950408889634f;
constexpr float C2 = 0.125f * 1.4426950408889634f;
constexpr int HID_ROWS = 2 * T + NEXP * 256;

constexpr size_t MiB = 1u << 20;
constexpr size_t WS_CTL = 0, CTL_ZERO_BYTES = 128 * 1024;
constexpr size_t WS_FZT = 1 * MiB;
constexpr size_t WS_WRT = 1 * MiB + 128 * 1024;
constexpr size_t WS_GT = 1 * MiB + 640 * 1024;
constexpr size_t WS_LOGF = 2 * MiB;
constexpr size_t WS_CUM = 2 * MiB + 512 * 1024;
constexpr size_t WS_COSSIN = 3 * MiB;
constexpr size_t WS_GWT = 4 * MiB;
constexpr size_t WS_LIST = 5 * MiB;
constexpr size_t WS_WIN = 8 * MiB;
constexpr size_t WS_WD = 28 * MiB;
constexpr size_t WS_WF = 30 * MiB;
constexpr size_t WS_WO = 32 * MiB;
constexpr size_t WS_WGU = 36 * MiB;
constexpr size_t WS_WDN = 164 * MiB;
constexpr size_t WS_QKVG = 228 * MiB;
constexpr size_t WS_HID = 228 * MiB;
constexpr size_t WS_Y = 280 * MiB;
constexpr size_t WS_HN = 388 * MiB;
constexpr size_t WS_AD = 388 * MiB;
constexpr size_t WS_OA = 420 * MiB;
constexpr size_t WS_Z = 420 * MiB;
constexpr size_t WS_OF = 452 * MiB;
constexpr size_t WS_SUMS = 468 * MiB;
constexpr size_t WS_RSTD = 4 * MiB + 256 * 1024;
constexpr size_t WS_END = 484 * MiB;
static_assert(WS_HID + (size_t)HID_ROWS * FF * 2 <= WS_Y && WS_Y + (size_t)2 * T * D * 2 <= WS_HN, "ws map");
constexpr int CW_TMO = 0;
constexpr int CW_CNT = 16384, CNT_STRIDE = 64;
constexpr int CW_BAR = 4096;
constexpr int CW_FOXQ = 128;
static_assert((16384 + 2 * 32 * 64) * 4 <= (int)CTL_ZERO_BYTES, "control words inside the memset");
constexpr int CW_DCNT = 24576, DCNT_STRIDE = 16;
static_assert(CW_DCNT + DEPTH * BATCH * 4 * 32 * DCNT_STRIDE <= (int)(CTL_ZERO_BYTES / 4), "pair counters inside the memset");
constexpr int CW_TCNT = 8192, TCNT_STRIDE = 16, MAX_TILES = HID_ROWS / 256;

typedef unsigned short bf16;
typedef unsigned v4u __attribute__((ext_vector_type(4)));
typedef unsigned v2u __attribute__((ext_vector_type(2)));
typedef float f32x4 __attribute__((ext_vector_type(4)));
#define LAS __attribute__((address_space(3)))
#define GAS __attribute__((address_space(1)))
#define LDS_WAIT() asm volatile("s_waitcnt lgkmcnt(0)" ::: "memory")
#define VM_WAIT() asm volatile("s_waitcnt vmcnt(0)" ::: "memory")

__device__ __forceinline__ unsigned f2bf(float f) { unsigned u = __builtin_bit_cast(unsigned, f); return (u + 0x7fffu + ((u >> 16) & 1u)) >> 16; }
__device__ __forceinline__ unsigned pk2(float lo, float hi) { return f2bf(lo) | (f2bf(hi) << 16); }
__device__ __forceinline__ float bflo(unsigned w) { return __uint_as_float(w << 16); }
__device__ __forceinline__ float bfhi(unsigned w) { return __uint_as_float(w & 0xffff0000u); }
__device__ __forceinline__ float bf2f(bf16 b) { return __uint_as_float((unsigned)b << 16); }
__device__ __forceinline__ float shx(float v, int mask, int lane) { return __int_as_float(__builtin_amdgcn_ds_bpermute((lane ^ mask) << 2, __float_as_int(v))); }
__device__ __forceinline__ float shl_(float v, int src) { return __int_as_float(__builtin_amdgcn_ds_bpermute(src << 2, __float_as_int(v))); }
__device__ __forceinline__ double shx_d(double v, int mask, int lane) { const long long b = __builtin_bit_cast(long long, v); const int lo = __builtin_amdgcn_ds_bpermute((lane ^ mask) << 2, (int)b), hi = __builtin_amdgcn_ds_bpermute((lane ^ mask) << 2, (int)(b >> 32));
    return __builtin_bit_cast(double, ((long long)hi << 32) | (unsigned)lo); }
__device__ __forceinline__ float wave_sum(float v, int lane) {
#pragma unroll
    for (int o = 1; o < 64; o <<= 1) v += shx(v, o, lane);
    return v;
}
__device__ __forceinline__ int fresh_lane() { unsigned m = ~0u; asm volatile("" : "+s"(m)); return (int)__builtin_amdgcn_mbcnt_hi(m, __builtin_amdgcn_mbcnt_lo(m, 0u)); }
__device__ __forceinline__ int fresh_tid(int wave0) { int w = wave0; asm volatile("" : "+s"(w)); return w * 64 + fresh_lane(); }
__device__ __forceinline__ int pi32(int n) { return n < 4 ? n : (n < 8 ? n + 4 : (n < 12 ? n - 4 : n)); }
__host__ __device__ constexpr float lambda_init_of(int l) { return l == 0 ? 0.2f : 0.35550906759f; }

struct Args { const void* in[25]; float* out; unsigned char* ws; int ph_lo, ph_hi; };
enum { I_X = 0, I_POS, I_LN1, I_WIN, I_BF, I_QND, I_KND, I_LQ1, I_LK1, I_LQ2, I_LK2, I_SUBLN, I_QNF, I_KNF, I_WDO, I_WFO, I_WO, I_LN2, I_WRG, I_BRG, I_WRE, I_BRE, I_WEG, I_WEU, I_WED };
#ifndef MOE_BARRIER
#define MOE_BARRIER 0
#endif
constexpr int PH_PRO = 0, PH_PER_LAYER = 10, PH_FINAL = 1 + PH_PER_LAYER * DEPTH, N_PHASES = PH_FINAL + 1;
enum { K_NORM1 = 0, K_CUMSUM, K_INPROJ, K_ATTN, K_DIFFC, K_YZ, K_WO, K_ROUTER, K_GATEUP, K_DOWN };
constexpr int NWAVES = 8;
constexpr int RING_OFF = 0, RING_BYTES = 131072;
constexpr int LDSCTL_OFF = RING_BYTES, MISC_OFF = LDSCTL_OFF + 320;
constexpr int LDS_BYTES = 147456;
struct Frame {
    LAS unsigned char* lds;
    volatile LAS unsigned* MISC;
    unsigned* ctl;
    int tid, lane, wave, vcu, G, wave0, bx;
    const void* const* in;
    float* out; unsigned char* ws;
};

__device__ __forceinline__ void p0_transpose_item(const float* W, int ld, int k0, int n0src, bf16* WT, int Kd, int drow0, bool swz, LAS float* scr, int lane) {
#pragma unroll 8
    for (int i = 0; i < 32; ++i) { const int kk = 2 * i + (lane >> 5); scr[kk * 33 + (lane & 31)] = __builtin_nontemporal_load(W + (size_t)(k0 + kk) * ld + n0src + (lane & 31)); }
    LDS_WAIT(); asm volatile("" ::: "memory");
    const int c = lane & 7;
#pragma unroll
    for (int j = 0; j < 4; ++j) { const int n = (lane >> 3) + 8 * j; const LAS float* s = scr + (8 * c) * 33 + n;
        v4u o; o.x = pk2(s[0 * 33], s[1 * 33]); o.y = pk2(s[2 * 33], s[3 * 33]); o.z = pk2(s[4 * 33], s[5 * 33]); o.w = pk2(s[6 * 33], s[7 * 33]);
        const int nd = swz ? pi32(n) : n;
        __builtin_nontemporal_store(o, (v4u*)(WT + (size_t)(drow0 + nd) * Kd + k0 + 8 * c)); }
    LDS_WAIT(); asm volatile("" ::: "memory");
}
__device__ __forceinline__ void phase_prologue(Frame& F) {
    LAS float* scr = (LAS float*)(F.lds + RING_OFF + F.wave * 16384);
    const int gw = F.vcu * NWAVES + F.wave, NGW = F.G * NWAVES;
    const float* w_in = (const float*)F.in[I_WIN]; const float* wdo = (const float*)F.in[I_WDO]; const float* wfo = (const float*)F.in[I_WFO]; const float* wo = (const float*)F.in[I_WO];
    const float* weg = (const float*)F.in[I_WEG]; const float* weu = (const float*)F.in[I_WEU]; const float* wed = (const float*)F.in[I_WED];
    bf16* WIN = (bf16*)(F.ws + WS_WIN); bf16* WD = (bf16*)(F.ws + WS_WD); bf16* WF = (bf16*)(F.ws + WS_WF); bf16* WO = (bf16*)(F.ws + WS_WO);
    bf16* WGU = (bf16*)(F.ws + WS_WGU); bf16* WDN = (bf16*)(F.ws + WS_WDN);
    constexpr int I_IN = 16 * 160 * DEPTH;
    constexpr int I_DF = 8 * 32 * DEPTH;
    constexpr int I_O = 16 * 32 * DEPTH;
    constexpr int I_GU = 16 * 16 * 64 * 2;
    constexpr int I_DN = 8 * 32 * 64;
    constexpr int NITEMS = I_IN + 2 * I_DF + I_O + I_GU + I_DN;
    for (int it = gw; it < NITEMS; it += NGW) {
        int r = it;
        if (r < I_GU) {
            const int nb = r & 15, kb = (r >> 4) & 15, which = (r >> 8) & 1, lge = r >> 9;
            const float* src = (which ? weu : weg) + (size_t)lge * D * FF;
            const int n0 = 32 * nb, drow = (n0 >> 7) * 256 + (n0 & 127) + which * 128;
            p0_transpose_item(src, FF, 64 * kb, n0, WGU + (size_t)lge * 1024 * 1024, D, drow, false, scr, F.lane); continue; }
        r -= I_GU;
        if (r < I_DN) {
            const int nb = r & 31, kb = (r >> 5) & 7, lge = r >> 8;
            p0_transpose_item(wed + (size_t)lge * FF * D, D, 64 * kb, 32 * nb, WDN + (size_t)lge * 1024 * 512, FF, 32 * nb, false, scr, F.lane); continue; }
        r -= I_DN;
        if (r < I_IN) {
            const int l = r / 2560, q = r % 2560, kb = q / 160, nb = q % 160;
            const int nsrc = nb < 96 ? 32 * nb : 32 * nb + 8;
            const bool swz = (nb < 32) && ((nb & 1) == 0);
            p0_transpose_item(w_in + (size_t)l * D * INC, INC, 64 * kb, nsrc, WIN + (size_t)l * NP * D, D, 32 * nb, swz, scr, F.lane); continue; }
        r -= I_IN;
        if (r < 2 * I_DF) {
            const int nb = r & 31, kb = (r >> 5) & 7, l = (r >> 8) & 1, which = r >> 9;
            p0_transpose_item((which ? wfo : wdo) + (size_t)l * 512 * D, D, 64 * kb, 32 * nb, (which ? WF : WD) + (size_t)l * D * 512, 512, 32 * nb, false, scr, F.lane); continue; }
        r -= 2 * I_DF;
        { const int nb = r & 31, kb = (r >> 5) & 15, l = r >> 9;
          p0_transpose_item(wo + (size_t)l * D * D, D, 64 * kb, 32 * nb, WO + (size_t)l * D * D, D, 32 * nb, false, scr, F.lane); }
    }
    const int gt = (F.vcu * NWAVES + F.wave) * 64 + F.lane, NGT = F.G * NWAVES * 64;
    bf16* FZT = (bf16*)(F.ws + WS_FZT); bf16* WRT = (bf16*)(F.ws + WS_WRT); float* CS = (float*)(F.ws + WS_COSSIN);
    const float* ln1 = (const float*)F.in[I_LN1]; const float* ln2 = (const float*)F.in[I_LN2];
    for (int i = gt; i < DEPTH * 16 * D; i += NGT) { const int l = i / (16 * D), q = i % (16 * D), j = q / D, k = q % D;
        const float w = j < 8 ? w_in[(size_t)l * D * INC + (size_t)k * INC + 3072 + j] * ln1[l * D + k] : 0.f;
        const unsigned h = f2bf(w); const float r = w - __uint_as_float(h << 16);
        FZT[(size_t)l * 2 * 16 * D + q] = (bf16)h; FZT[(size_t)l * 2 * 16 * D + 16 * D + q] = (bf16)f2bf(r); }
    const float* wrg = (const float*)F.in[I_WRG]; const float* wre = (const float*)F.in[I_WRE];
    for (int i = gt; i < DEPTH * 48 * D; i += NGT) { const int l = i / (48 * D), q = i % (48 * D), j = q / D, k = q % D;
        const float w = (j < 4 ? wrg[(size_t)l * D * 4 + k * 4 + j] : (j < 36 ? wre[(size_t)l * D * 32 + k * 32 + (j - 4)] : 0.f)) * ln2[l * D + k];
        const unsigned h = f2bf(w); const float r = w - __uint_as_float(h << 16);
        WRT[(size_t)l * 2 * 48 * D + q] = (bf16)h; WRT[(size_t)l * 2 * 48 * D + 48 * D + q] = (bf16)f2bf(r); }
    { float* GT = (float*)(F.ws + WS_GT);
      for (int i = gt; i < DEPTH * 4 * 64; i += NGT) { const int l = i >> 8, q = (i >> 6) & 3, d = i & 63;
          const float* src = (const float*)F.in[q == 0 ? I_QND : (q == 1 ? I_KND : (q == 2 ? I_QNF : I_KNF))];
          GT[i] = src[l * 64 + d] * ((q & 1) ? 1.0f : C2); } }
    const int* pos = (const int*)F.in[I_POS];
    for (int i = gt; i < T * 8; i += NGT) { const int t = i >> 3, f = i & 7;
        const double inv = exp2(-(double)f * (1.0 / 8.0) * 18.931568569324174);
        const double ang = (double)pos[t] * (double)(float)inv;
        CS[t * 16 + f] = (float)cos(ang); CS[t * 16 + 8 + f] = (float)sin(ang); }
}

typedef short bf16x8n __attribute__((ext_vector_type(8)));
typedef float f32x4m __attribute__((ext_vector_type(4)));
template <int KIND, int VAR = 0> __device__ __forceinline__ void phase_normgemm(Frame& F, int l) {
    constexpr int NB = KIND == 0 ? 1 : 3;
    constexpr int NR = NB * 16;
    constexpr int PW = 49, XP = 136;
    LAS bf16* XH = (LAS bf16*)(F.lds + RING_OFF);
    LAS bf16* XL = XH + 64 * XP;
    LAS bf16* WH = XL + 64 * XP;
    LAS bf16* WL = WH + 48 * XP;
    LAS float* part = (LAS float*)(WL + 48 * XP);
    LAS float* rsv = part + 2 * 64 * PW;
    const float* xsrc = (KIND == 0 && l == 0) ? (const float*)F.in[I_X] : F.out;
    const bool addy = (KIND == 0 && l > 0);
    const float* gn = (const float*)F.in[KIND == 0 ? I_LN1 : I_LN2] + (size_t)l * D;
    const bf16* WT = (const bf16*)(F.ws + (KIND == 0 ? WS_FZT : WS_WRT)) + (size_t)l * 2 * NR * D;
    const bf16* Y = (const bf16*)(F.ws + WS_Y); bf16* HN = (bf16*)(F.ws + WS_HN);
    const int lane = F.lane, wave = F.wave, tid = F.tid;
    for (int bt = F.vcu; bt < T / 64; bt += F.G) {
        const int row0 = bt * 64;
        f32x4 v_[8][4];
#pragma unroll
        for (int hh = 0; hh < 2; ++hh) {
#pragma unroll
            for (int r4 = 0; r4 < 4; ++r4) { const int rr = hh * 4 + r4, row = row0 + wave * 8 + rr;
#pragma unroll
                for (int j = 0; j < 4; ++j) v_[rr][j] = *(const f32x4*)(xsrc + (size_t)row * D + lane * 4 + 256 * j);
                if (addy) {
#pragma unroll
                    for (int j = 0; j < 4; ++j) { const v2u a = __builtin_nontemporal_load((const v2u*)(Y + (size_t)row * D + lane * 4 + 256 * j)), b = __builtin_nontemporal_load((const v2u*)(Y + (size_t)T * D + (size_t)row * D + lane * 4 + 256 * j));
                        v_[rr][j].x += bflo(a.x) + bflo(b.x); v_[rr][j].y += bfhi(a.x) + bfhi(b.x); v_[rr][j].z += bflo(a.y) + bflo(b.y); v_[rr][j].w += bfhi(a.y) + bfhi(b.y); }
                }
            }
            if (addy) asm volatile("" ::: "memory");
        }
#pragma unroll
        for (int rr = 0; rr < 8; ++rr) { const int rl = wave * 8 + rr, row = row0 + rl; float ss = 0.f;
#pragma unroll
            for (int j = 0; j < 4; ++j) { const f32x4 x = v_[rr][j]; if (KIND == 0 && l > 0) *(f32x4*)(F.out + (size_t)row * D + lane * 4 + 256 * j) = x; ss += (x.x * x.x + x.y * x.y) + (x.z * x.z + x.w * x.w); }
            const float r = 1.0f / sqrtf(wave_sum(ss, lane) * (1.0f / D) + EPS);
            if (lane == 0) rsv[rl] = r;
        }
        f32x4m acc[NB];
#pragma unroll
        for (int nb = 0; nb < NB; ++nb) acc[nb] = (f32x4m){0.f, 0.f, 0.f, 0.f};
        constexpr int NPZ = (2 * NR * 16 + NWAVES * 64 - 1) / (NWAVES * 64);
        v4u wreg[NPZ];
#define NG_WLOAD(hc_) _Pragma("unroll") for (int pi = 0; pi < NPZ; ++pi) { const int pz = tid + pi * NWAVES * 64; if (pz < 2 * NR * 16) { const int tb = pz / (NR * 16), q = pz % (NR * 16), n = q >> 4, c8 = q & 15; \
            wreg[pi] = *(const v4u*)(WT + (size_t)tb * NR * D + (size_t)n * D + (hc_) * 128 + c8 * 8); } }
        if (!(VAR & 2)) {
        NG_WLOAD(0)
#pragma unroll
        for (int hc = 0; hc < 8; ++hc) {
            if ((lane >> 5) == (hc & 1)) {
#pragma unroll
                for (int rr = 0; rr < 8; ++rr) { const f32x4 x = v_[rr][hc >> 1];
                    const unsigned h0 = f2bf(x.x), h1 = f2bf(x.y), h2 = f2bf(x.z), h3 = f2bf(x.w);
                    const float l0 = x.x - __uint_as_float(h0 << 16), l1 = x.y - __uint_as_float(h1 << 16), l2 = x.z - __uint_as_float(h2 << 16), l3 = x.w - __uint_as_float(h3 << 16);
                    const int o = (wave * 8 + rr) * XP + (lane & 31) * 4;
                    *(LAS v2u*)(XH + o) = (v2u){h0 | (h1 << 16), h2 | (h3 << 16)}; *(LAS v2u*)(XL + o) = (v2u){pk2(l0, l1), pk2(l2, l3)}; }
            }
#pragma unroll
            for (int pi = 0; pi < NPZ; ++pi) { const int pz = tid + pi * NWAVES * 64; if (pz < 2 * NR * 16) { const int tb = pz / (NR * 16), q = pz % (NR * 16), n = q >> 4, c8 = q & 15;
                *(LAS v4u*)((tb ? WL : WH) + n * XP + c8 * 8) = wreg[pi]; } }
            __syncthreads();
            if (hc < 7) { NG_WLOAD(hc + 1) }
            { const int rb = wave & 3, kq = wave >> 2, i = lane & 15, g = lane >> 4;
#pragma unroll
              for (int s = 0; s < 2; ++s) { const int ko = kq * 64 + s * 32 + g * 8;
                  const bf16x8n ah = *(const LAS bf16x8n*)(XH + (rb * 16 + i) * XP + ko), al = *(const LAS bf16x8n*)(XL + (rb * 16 + i) * XP + ko);
#pragma unroll
                  for (int nb = 0; nb < NB; ++nb) { const bf16x8n bh = *(const LAS bf16x8n*)(WH + (nb * 16 + i) * XP + ko), bl = *(const LAS bf16x8n*)(WL + (nb * 16 + i) * XP + ko);
                      acc[nb] = __builtin_amdgcn_mfma_f32_16x16x32_bf16(ah, bh, acc[nb], 0, 0, 0);
                      acc[nb] = __builtin_amdgcn_mfma_f32_16x16x32_bf16(ah, bl, acc[nb], 0, 0, 0);
                      acc[nb] = __builtin_amdgcn_mfma_f32_16x16x32_bf16(al, bh, acc[nb], 0, 0, 0); } } }
            __syncthreads();
        } }
        { const int rb = wave & 3, kq = wave >> 2, i = lane & 15, g = lane >> 4;
#pragma unroll
          for (int nb = 0; nb < NB; ++nb)
#pragma unroll
              for (int e = 0; e < 4; ++e) part[(kq * 64 + rb * 16 + 4 * g + e) * PW + nb * 16 + i] = acc[nb][e]; }
        __syncthreads();
#define NG_SUM2(o) (part[o] + part[64 * PW + (o)])
        if (KIND == 0) {
            { const int r = tid >> 3, j = tid & 7; const int o = r * PW + j;
                float z = NG_SUM2(o);
                z = z * rsv[r] + ((const float*)F.in[I_BF])[l * 8 + j];
                const float lf = fminf(z, 0.f) - 0.6931471805599453f * __builtin_amdgcn_logf(1.0f + __builtin_amdgcn_exp2f(-fabsf(z) * LOG2E));
                { const int row = row0 + r; ((float*)(F.ws + WS_LOGF))[((size_t)(row / SEQ) * 8 + j) * SEQ + (row % SEQ)] = lf; } }
        } else {
            if (tid < 64 && !(VAR & 4)) { const int r = tid, row = row0 + r; const float rs = rsv[r];
                const float* brg = (const float*)F.in[I_BRG] + l * 4; const float* bre = (const float*)F.in[I_BRE] + l * 32;
                float lg[4];
#pragma unroll
                for (int q = 0; q < 4; ++q) { const int o = r * PW + q; lg[q] = NG_SUM2(o) * rs + brg[q]; }
                int gi = 0; float gm = lg[0];
#pragma unroll
                for (int q = 1; q < 4; ++q) if (lg[q] > gm) { gm = lg[q]; gi = q; }
                float gs = 0.f;
#pragma unroll
                for (int q = 0; q < 4; ++q) gs += __builtin_amdgcn_exp2f((lg[q] - gm) * LOG2E);
                const float pg = 1.0f / gs;
                float le[8];
#pragma unroll
                for (int e = 0; e < 8; ++e) { const int o = r * PW + 4 + gi * 8 + e; le[e] = NG_SUM2(o) * rs + bre[gi * 8 + e]; }
                int i1 = 0; float m1 = le[0];
#pragma unroll
                for (int e = 1; e < 8; ++e) if (le[e] > m1) { m1 = le[e]; i1 = e; }
                int i2 = 0; float m2 = -INFINITY;
#pragma unroll
                for (int e = 0; e < 8; ++e) if (e != i1 && le[e] > m2) { m2 = le[e]; i2 = e; }
                const float e2 = __builtin_amdgcn_exp2f((m2 - m1) * LOG2E); const float w1 = pg / (1.0f + e2), w2 = pg * e2 / (1.0f + e2);
                LAS unsigned* lcnt = (LAS unsigned*)(rsv + 64); LAS unsigned* lbase = lcnt + 32;
                if (r < 32) lcnt[r] = 0u;
                LDS_WAIT();
                const int ex1 = gi * 8 + i1, ex2 = gi * 8 + i2;
                const unsigned k1 = __hip_atomic_fetch_add(lcnt + ex1, 1u, __ATOMIC_RELAXED, __HIP_MEMORY_SCOPE_WORKGROUP), k2 = __hip_atomic_fetch_add(lcnt + ex2, 1u, __ATOMIC_RELAXED, __HIP_MEMORY_SCOPE_WORKGROUP);
                LDS_WAIT();
                unsigned* CNT = F.ctl + CW_CNT + (size_t)l * NEXP * CNT_STRIDE;
                if (r < 32) { const unsigned mine = lcnt[r]; lbase[r] = mine ? atomicAdd(CNT + r * CNT_STRIDE, mine) : 0u; }
                LDS_WAIT();
                int* LIST = (int*)(F.ws + WS_LIST); float* GWT = (float*)(F.ws + WS_GWT);
                LIST[(size_t)ex1 * T + lbase[ex1] + k1] = row * 2; LIST[(size_t)ex2 * T + lbase[ex2] + k2] = row * 2 + 1;
                GWT[row * 2] = w1; GWT[row * 2 + 1] = w2; }
        }
#undef NG_SUM2
#undef NG_WLOAD
#pragma unroll
        for (int rr = 0; rr < 8; ++rr) { const int rl = wave * 8 + rr, row = row0 + rl; const float r = rsv[rl];
#pragma unroll
            for (int j = 0; j < 4; ++j) { const f32x4 g = *(const f32x4*)(gn + lane * 4 + 256 * j); const f32x4 h = v_[rr][j] * r * g;
                *(v2u*)(HN + (size_t)row * D + lane * 4 + 256 * j) = (v2u){pk2(h.x, h.y), pk2(h.z, h.w)}; } }
        __syncthreads();
    }
}
__device__ __forceinline__ double wave_sum_d(double v, int lane) {
#pragma unroll
    for (int o = 1; o < 64; o <<= 1) v += shx_d(v, o, lane);
    return v;
}
__device__ __forceinline__ void phase_router2(Frame& F, int l, bool dry = false) {
    constexpr int PW = 41;
    LAS float* sm = (LAS float*)(F.lds + RING_OFF);
    LAS unsigned* lcnt = (LAS unsigned*)(sm + 64 * PW); LAS unsigned* lbase = lcnt + 32;
    const float* SUMS = (const float*)(F.ws + WS_SUMS);
    for (int bt = F.vcu; bt < T / 64; bt += F.G) {
        const int row0 = bt * 64;
        { const int r = F.tid >> 3, j = F.tid & 7; const int c = j < 5 ? j * 8 : 48;
          if (j < 6) { const float* S0 = SUMS + (size_t)(row0 + r) * 64 + c;
              f32x4 a0 = *(const f32x4*)S0, a1 = *(const f32x4*)(S0 + (size_t)T * 64), a2 = *(const f32x4*)(S0 + (size_t)2 * T * 64), a3 = *(const f32x4*)(S0 + (size_t)3 * T * 64);
              f32x4 b0 = a0, b1 = a1, b2 = a2, b3 = a3;
              if (j < 5) { b0 = *(const f32x4*)(S0 + 4); b1 = *(const f32x4*)(S0 + (size_t)T * 64 + 4); b2 = *(const f32x4*)(S0 + (size_t)2 * T * 64 + 4); b3 = *(const f32x4*)(S0 + (size_t)3 * T * 64 + 4); }
              const f32x4 sa = (a0 + a1) + (a2 + a3), sb = (b0 + b1) + (b2 + b3);
              if (j < 5) {
#pragma unroll
                  for (int e = 0; e < 4; ++e) { sm[r * PW + c + e] = sa[e]; sm[r * PW + c + 4 + e] = sb[e]; } }
              else sm[r * PW + 40] = sa.x; } }
        __syncthreads();
        if (F.tid < 64) { const int r = F.tid, row = row0 + r;
            const float rs = 1.0f / sqrtf(sm[r * PW + 40] * (1.0f / D) + EPS);
            ((float*)(F.ws + WS_RSTD))[row] = rs;
            const float* brg = (const float*)F.in[I_BRG] + l * 4; const float* bre = (const float*)F.in[I_BRE] + l * 32;
            float lg[4];
#pragma unroll
            for (int q = 0; q < 4; ++q) lg[q] = sm[r * PW + q] * rs + brg[q];
            int gi = 0; float gm = lg[0];
#pragma unroll
            for (int q = 1; q < 4; ++q) if (lg[q] > gm) { gm = lg[q]; gi = q; }
            float gs = 0.f;
#pragma unroll
            for (int q = 0; q < 4; ++q) gs += __builtin_amdgcn_exp2f((lg[q] - gm) * LOG2E);
            const float pg = 1.0f / gs;
            float le[8];
#pragma unroll
            for (int e = 0; e < 8; ++e) le[e] = sm[r * PW + 4 + gi * 8 + e] * rs + bre[gi * 8 + e];
            int i1 = 0; float m1 = le[0];
#pragma unroll
            for (int e = 1; e < 8; ++e) if (le[e] > m1) { m1 = le[e]; i1 = e; }
            int i2 = 0; float m2 = -INFINITY;
#pragma unroll
            for (int e = 0; e < 8; ++e) if (e != i1 && le[e] > m2) { m2 = le[e]; i2 = e; }
            const float e2 = __builtin_amdgcn_exp2f((m2 - m1) * LOG2E); const float w1 = pg / (1.0f + e2), w2 = pg * e2 / (1.0f + e2);
            if (dry) { if (w1 + w2 == 1.2345e33f) ((float*)(F.ws + WS_GWT))[row * 2] = w1; } else {
            if (r < 32) lcnt[r] = 0u;
            LDS_WAIT();
            const int ex1 = gi * 8 + i1, ex2 = gi * 8 + i2;
            const unsigned k1 = __hip_atomic_fetch_add(lcnt + ex1, 1u, __ATOMIC_RELAXED, __HIP_MEMORY_SCOPE_WORKGROUP), k2 = __hip_atomic_fetch_add(lcnt + ex2, 1u, __ATOMIC_RELAXED, __HIP_MEMORY_SCOPE_WORKGROUP);
            LDS_WAIT();
            unsigned* CNT = F.ctl + CW_CNT + (size_t)l * NEXP * CNT_STRIDE;
            if (r < 32) { const unsigned mine = lcnt[r]; lbase[r] = mine ? atomicAdd(CNT + r * CNT_STRIDE, mine) : 0u; }
            LDS_WAIT();
            int* LIST = (int*)(F.ws + WS_LIST); float* GWT = (float*)(F.ws + WS_GWT);
            LIST[(size_t)ex1 * T + lbase[ex1] + k1] = row * 2; LIST[(size_t)ex2 * T + lbase[ex2] + k2] = row * 2 + 1;
            GWT[row * 2] = w1; GWT[row * 2 + 1] = w2; } }
        __syncthreads();
    }
}
__device__ __forceinline__ void phase_cumsum(Frame& F) {
    const float* LOGF = (const float*)(F.ws + WS_LOGF); float* CUM = (float*)(F.ws + WS_CUM);
    LAS double* red = (LAS double*)(F.lds + RING_OFF);
    for (int task = F.vcu; task < BATCH * 8 * 16; task += F.G) {
        const int seq = task >> 4, c = task & 15, b = seq >> 3, j = seq & 7;
        const float* src = LOGF + ((size_t)b * 8 + j) * SEQ;
        double acc = 0.0;
        for (int i = F.tid; i < c * 128; i += NWAVES * 64) { const f32x4 q = *(const f32x4*)(src + 4 * i); acc += ((double)q.x + (double)q.y) + ((double)q.z + (double)q.w); }
        acc = wave_sum_d(acc, F.lane);
        double v = (double)src[c * 512 + F.tid];
#pragma unroll
        for (int o = 1; o < 64; o <<= 1) { const double u = shx_d(v, 0, (F.lane - o) & 63); if (F.lane >= o) v += u; }
        if (F.lane == 63) { red[F.wave] = acc; red[8 + F.wave] = v; }
        else if (F.lane == 0 && false) {}
        __syncthreads();
        double base = 0.0;
#pragma unroll
        for (int w = 0; w < 8; ++w) { base += red[w]; if (w < F.wave) base += red[8 + w]; }
        CUM[(size_t)seq * SEQ + c * 512 + F.tid] = (float)((base + v) * 1.4426950408889634);
        __syncthreads();
    }
}
__device__ __forceinline__ void phase_diffc(Frame& F, int l) {
    const float* lq1 = (const float*)F.in[I_LQ1] + l * 64; const float* lk1 = (const float*)F.in[I_LK1] + l * 64;
    const float* lq2 = (const float*)F.in[I_LQ2] + l * 64; const float* lk2 = (const float*)F.in[I_LK2] + l * 64;
    const float li = lambda_init_of(l);
    const float lam = __builtin_amdgcn_exp2f(LOG2E * wave_sum(lq1[F.lane] * lk1[F.lane], F.lane)) - __builtin_amdgcn_exp2f(LOG2E * wave_sum(lq2[F.lane] * lk2[F.lane], F.lane)) + li;
    const float* sub = (const float*)F.in[I_SUBLN] + l * 128;
    const bf16* OA = (const bf16*)(F.ws + WS_OA); bf16* AD = (bf16*)(F.ws + WS_AD);
    const int gw = F.vcu * NWAVES + F.wave, NGW = F.G * NWAVES, lane = F.lane;
    const int d0 = (lane & 15) * 8;
    float sg[8];
#pragma unroll
    for (int e = 0; e < 8; ++e) sg[e] = sub[d0 + e] * (1.0f - li);
    for (int rb0 = gw; rb0 < T; rb0 += 8 * NGW) {
        v4u a_[8], b_[8];
#pragma unroll
        for (int q = 0; q < 8; ++q) { const int row = rb0 + q * NGW < T ? rb0 + q * NGW : rb0;
            a_[q] = __builtin_nontemporal_load((const v4u*)(OA + (size_t)row * 1024 + lane * 8)); b_[q] = __builtin_nontemporal_load((const v4u*)(OA + (size_t)row * 1024 + 512 + lane * 8)); }
#pragma unroll
        for (int q = 0; q < 8; ++q) { const int row = rb0 + q * NGW; if (row < T) { const v4u a = a_[q], b = b_[q];
        float v[8];
        v[0] = bflo(a.x) - lam * bflo(b.x); v[1] = bfhi(a.x) - lam * bfhi(b.x); v[2] = bflo(a.y) - lam * bflo(b.y); v[3] = bfhi(a.y) - lam * bfhi(b.y);
        v[4] = bflo(a.z) - lam * bflo(b.z); v[5] = bfhi(a.z) - lam * bfhi(b.z); v[6] = bflo(a.w) - lam * bflo(b.w); v[7] = bfhi(a.w) - lam * bfhi(b.w);
        float ss = 0.f;
#pragma unroll
        for (int e = 0; e < 8; ++e) ss += v[e] * v[e];
        ss += shx(ss, 1, lane); ss += shx(ss, 2, lane); ss += shx(ss, 4, lane); ss += shx(ss, 8, lane);
        const float r = __builtin_amdgcn_rsqf(ss * (1.0f / 128.0f) + EPS);
        v4u o; o.x = pk2(v[0] * r * sg[0], v[1] * r * sg[1]); o.y = pk2(v[2] * r * sg[2], v[3] * r * sg[3]); o.z = pk2(v[4] * r * sg[4], v[5] * r * sg[5]); o.w = pk2(v[6] * r * sg[6], v[7] * r * sg[7]);
        *(v4u*)(AD + (size_t)row * 512 + lane * 8) = o; } }
    }
}
__device__ __forceinline__ void phase_final(Frame& F, bool dry = false) {
    const bf16* Y = (const bf16*)(F.ws + WS_Y);
    const int gw = F.vcu * NWAVES + F.wave, NGW = F.G * NWAVES, lane = F.lane;
    for (int rb0 = gw; rb0 < T; rb0 += 4 * NGW) {
        f32x4 v_[4][4]; v2u a_[4][4], b_[4][4];
#pragma unroll
        for (int q = 0; q < 4; ++q) { const int row = rb0 + q * NGW < T ? rb0 + q * NGW : rb0;
#pragma unroll
            for (int j = 0; j < 4; ++j) { v_[q][j] = __builtin_nontemporal_load((const f32x4*)(F.out + (size_t)row * D + lane * 4 + 256 * j));
                a_[q][j] = __builtin_nontemporal_load((const v2u*)(Y + (size_t)row * D + lane * 4 + 256 * j)); b_[q][j] = __builtin_nontemporal_load((const v2u*)(Y + (size_t)T * D + (size_t)row * D + lane * 4 + 256 * j)); } }
#pragma unroll
        for (int q = 0; q < 4; ++q) { const int row = rb0 + q * NGW; if (row < T) {
#pragma unroll
            for (int j = 0; j < 4; ++j) { f32x4 v = v_[q][j]; const v2u a = a_[q][j], b = b_[q][j];
                v.x += bflo(a.x) + bflo(b.x); v.y += bfhi(a.x) + bfhi(b.x); v.z += bflo(a.y) + bflo(b.y); v.w += bfhi(a.y) + bfhi(b.y);
                if (!dry || v.x == 1.2345e33f) __builtin_nontemporal_store(v, (f32x4*)(F.out + (size_t)row * D + lane * 4 + 256 * j)); } } }
    }
}
namespace pg8 {
typedef short bf16x8 __attribute__((ext_vector_type(8)));
typedef unsigned u32x4 __attribute__((ext_vector_type(4)));
constexpr int BM = 256, BK = 64, HALF = 128, HTB = HALF * BK * 2, STAGE_BYTES = 8 * HTB;
__host__ __device__ __forceinline__ int lds_byte(int r, int c) { const int st = (r >> 4) * 2 + (c >> 5), rr = r & 15, cc = c & 31, ob = rr * 64 + cc * 2; return st * 1024 + (ob ^ (((ob >> 9) & 1) << 5)); }
__host__ __device__ __forceinline__ void stage_rc(int b, int& R, int& C) { const int st = b / 1024, sb = b % 1024, swz = sb ^ (((sb >> 9) & 1) << 5); R = (st >> 1) * 16 + swz / 64; C = (st & 1) * 32 + (swz % 64) / 2; }
__host__ __device__ __forceinline__ int perm32(int rho) { const int n = rho >> 4, i = rho & 15; return 8 * (i >> 2) + 4 * n + (i & 3); }
struct Unit { int pm, pn, ex, sl; };
__device__ __forceinline__ unsigned cvt_pk_bf16(float lo, float hi) { unsigned r; asm volatile("v_cvt_pk_bf16_f32 %0, %1, %2" : "=v"(r) : "v"(lo), "v"(hi)); return r; }

struct StaticOrder {
    int nM, nN, nwg, G, c, K;
    __device__ void init(int M, int N, int K_, int G_, int c_) { nM = M / BM; nN = N / BM; nwg = nM * nN; G = G_; c = c_; K = K_; }
    __device__ __forceinline__ bool next(int i, Unit& u) const {
        const long L = (long)i * G + c; if (L >= nwg) return false;
        int wgid = (int)L; { const int q = nwg / 8, r = nwg % 8, xcd = wgid % 8, off = wgid / 8; wgid = (xcd < r ? xcd * (q + 1) : r * (q + 1) + (xcd - r) * q) + off; }
        const int nig = 8 * nN, gid = wgid / nig, fm = gid * 8, gsz = (nM - fm) < 8 ? (nM - fm) : 8;
        u.pm = fm + ((wgid % nig) % gsz); u.pn = (wgid % nig) / gsz; u.ex = 0; u.sl = 0; return true;
    }
    static constexpr bool GATHER = false; static constexpr int A_AUX = 0;
    __device__ __forceinline__ void a_ready(const Unit&) const {}
    __device__ __forceinline__ size_t a_off(const Unit& u) const { return (size_t)u.pm * BM * K * 2; }
    __device__ __forceinline__ unsigned arow_off(const Unit&, int) const { return 0u; }
    __device__ __forceinline__ size_t b_off(const Unit& u) const { return (size_t)u.pn * BM * K * 2; }
};

template <class Epi, class Sched, bool ALIGN_EPI>
__device__ __forceinline__ void gemm_phase(LAS unsigned char* lds, const int wave0, const bf16* Ag, const bf16* Btg, const int K, const Sched& S, const Epi& E) {
    const int tid = fresh_tid(wave0);
    const int wid = __builtin_amdgcn_readfirstlane(tid >> 6), lane = tid & 63, wr = wid >> 2, wc = wid & 3, fr = lane & 15, fq = lane >> 4;
    const int nt = K / BK;
    constexpr bool GATHER = Sched::GATHER;
    int RA0 = 0; unsigned CA2 = 0u, voffA[2], voffB[2];
#pragma unroll
    for (int i = 0; i < 2; ++i) { int R, C; stage_rc(tid * 16 + i * 8192, R, C); if (i == 0) { RA0 = R; CA2 = (unsigned)C * 2u; }
        voffA[i] = (unsigned)(R * K + C) * 2u;
        const int Rb = Epi::BMODE == 2 ? 64 * (R >> 5) + perm32(R & 31) : (Epi::BMODE == 1 ? ((R & ~31) + perm32(R & 31)) : R);
        voffB[i] = (unsigned)(Rb * K + C) * 2u; }
    const size_t kstep = (size_t)(BK * 2);
    const size_t hstepB = (size_t)(Epi::BMODE == 2 ? 32 : HALF) * K * 2, hstepA = (size_t)HALF * K * 2;
    const unsigned ldsw = (unsigned)wid * 1024u;
    const int aoff = lds_byte(wr * 64 + fr, fq * 8), boff = lds_byte(wc * 32 + fr, fq * 8);
#define PG8_SA(b, h) (((b) * 2 + (h)) * HTB)
#define PG8_SB(b, h) ((4 + (b) * 2 + (h)) * HTB)
#define PG8_STAGE_A(bufoff, gbase, voff) do { _Pragma("unroll") for (int _i = 0; _i < 2; ++_i) \
        __builtin_amdgcn_global_load_lds((const unsigned*)((const char*)(gbase) + (voff)[_i]), (LAS unsigned*)(lds + (bufoff) + ldsw + _i * 8192), 16, 0, Sched::A_AUX); } while (0)
#define PG8_STAGE(bufoff, gbase, voff) do { _Pragma("unroll") for (int _i = 0; _i < 2; ++_i) \
        __builtin_amdgcn_global_load_lds((const unsigned*)((const char*)(gbase) + (voff)[_i]), (LAS unsigned*)(lds + (bufoff) + ldsw + _i * 8192), 16, 0, 0); } while (0)
#define PG8_LDA(dst, b, h) do { _Pragma("unroll") for (int m = 0; m < 4; ++m) _Pragma("unroll") for (int k = 0; k < 2; ++k) dst[m][k] = *(const LAS bf16x8*)(lds + PG8_SA(b, h) + aoff + m * 2048 + k * 1024); } while (0)
#define PG8_LDB(dst, b, h) do { _Pragma("unroll") for (int n = 0; n < 2; ++n) _Pragma("unroll") for (int k = 0; k < 2; ++k) dst[n][k] = *(const LAS bf16x8*)(lds + PG8_SB(b, h) + boff + n * 2048 + k * 1024); } while (0)
#define PG8_MMA(ai, bj, At, Bt) do { __builtin_amdgcn_s_setprio(1); _Pragma("unroll") for (int m = 0; m < 4; ++m) _Pragma("unroll") for (int n = 0; n < 2; ++n) _Pragma("unroll") for (int k = 0; k < 2; ++k) \
        acc[ai][bj][m][n] = __builtin_amdgcn_mfma_f32_16x16x32_bf16(Bt[n][k], At[m][k], acc[ai][bj][m][n], 0, 0, 0); __builtin_amdgcn_s_setprio(0); } while (0)
#define PG8_WAIT_V(n) asm volatile("s_waitcnt vmcnt(" #n ")" ::: "memory")
#define PG8_WAIT_L(n) asm volatile("s_waitcnt lgkmcnt(" #n ")" ::: "memory")
#define PG8_BAR __builtin_amdgcn_s_barrier()
#define PG8_SCHED __builtin_amdgcn_sched_barrier(0)
    Unit cur, nxt; int ui = 0;
    if (!S.next(0, cur)) return;
    f32x4 acc[2][2][4][2];
#pragma unroll
    for (int a = 0; a < 2; ++a)
#pragma unroll
        for (int b = 0; b < 2; ++b)
#pragma unroll
            for (int m = 0; m < 4; ++m)
#pragma unroll
                for (int n = 0; n < 2; ++n) acc[a][b][m][n] = (f32x4){0.f, 0.f, 0.f, 0.f};
    bf16x8 At[4][2], B0[2][2], B1[2][2];
    unsigned gc0[2] = {0u, 0u}, gc1[2] = {0u, 0u};
#define PG8_GOFF(u, d0, d1) do { d0[0] = S.arow_off(u, RA0) + CA2; d0[1] = S.arow_off(u, RA0 + 64) + CA2; d1[0] = S.arow_off(u, HALF + RA0) + CA2; d1[1] = S.arow_off(u, HALF + RA0 + 64) + CA2; } while (0)
    if constexpr (GATHER) PG8_GOFF(cur, gc0, gc1);
    S.a_ready(cur);
    const char* cA = (const char*)Ag; if constexpr (!GATHER) cA += S.a_off(cur);
    const char* cB = (const char*)Btg + S.b_off(cur);
    PG8_STAGE(PG8_SB(0, 0), cB, voffB); PG8_STAGE(PG8_SB(0, 1), cB + hstepB, voffB);
    if constexpr (GATHER) { PG8_STAGE_A(PG8_SA(0, 0), cA, gc0); PG8_STAGE_A(PG8_SA(0, 1), cA, gc1); } else { PG8_STAGE_A(PG8_SA(0, 0), cA, voffA); PG8_STAGE_A(PG8_SA(0, 1), cA + hstepA, voffA); }
    if (wr == 1) PG8_BAR;
    PG8_WAIT_V(2); PG8_BAR;
    PG8_STAGE(PG8_SB(1, 0), cB + kstep, voffB);
    if constexpr (GATHER) PG8_STAGE_A(PG8_SA(1, 0), cA + kstep, gc0); else PG8_STAGE_A(PG8_SA(1, 0), cA + kstep, voffA);
    PG8_STAGE(PG8_SB(1, 1), cB + hstepB + kstep, voffB);
    PG8_WAIT_V(6); PG8_BAR;
    for (;;) {
        const bool has_next = S.next(ui + 1, nxt);
        const char* nA = cA; if constexpr (!GATHER) { if (has_next) nA = (const char*)Ag + S.a_off(nxt); }
        const char* nB = has_next ? (const char*)Btg + S.b_off(nxt) : cB;
        for (int t = 0; t < nt; t += 2) {
            const bool last = (t == nt - 2);
            if (last && has_next) S.a_ready(nxt);
            const char* a1 = cA + (size_t)(t + 1) * kstep;
            const char* a2 = last ? nA : cA + (size_t)(t + 2) * kstep; const char* b2 = last ? nB : cB + (size_t)(t + 2) * kstep;
            const char* a3 = a2 + kstep; const char* b3 = b2 + kstep;
            unsigned vs0[2] = {gc0[0], gc0[1]}, vs1[2] = {gc1[0], gc1[1]};
            if constexpr (GATHER) { if (last && has_next) PG8_GOFF(nxt, vs0, vs1); }
#define PG8_STA(bufoff, base, h, vs) do { if constexpr (GATHER) PG8_STAGE_A(bufoff, base, vs); else PG8_STAGE_A(bufoff, (base) + (h) * hstepA, voffA); } while (0)
            PG8_LDB(B0, 0, 0); PG8_LDB(B1, 0, 1); PG8_SCHED; PG8_LDA(At, 0, 0); PG8_STA(PG8_SA(1, 1), a1, 1, gc1);
            PG8_WAIT_V(8); PG8_WAIT_L(0); PG8_BAR; PG8_MMA(0, 0, At, B0); PG8_MMA(0, 1, At, B1); PG8_BAR; PG8_SCHED;
            PG8_LDA(At, 0, 1); PG8_STAGE(PG8_SB(0, 0), b2, voffB); PG8_STAGE(PG8_SB(0, 1), b2 + hstepB, voffB); PG8_STA(PG8_SA(0, 0), a2, 0, vs0);
            PG8_WAIT_V(8); PG8_WAIT_L(0); PG8_BAR; PG8_MMA(1, 0, At, B0); PG8_MMA(1, 1, At, B1); PG8_BAR; PG8_SCHED;
            PG8_LDB(B0, 1, 0); PG8_LDB(B1, 1, 1); PG8_SCHED; PG8_LDA(At, 1, 0); PG8_STA(PG8_SA(0, 1), a2, 1, vs1);
            PG8_WAIT_V(8); PG8_WAIT_L(0); PG8_BAR; PG8_MMA(0, 0, At, B0); PG8_MMA(0, 1, At, B1); PG8_BAR; PG8_SCHED;
            PG8_LDA(At, 1, 1); PG8_STAGE(PG8_SB(1, 0), b3, voffB); PG8_STAGE(PG8_SB(1, 1), b3 + hstepB, voffB); PG8_STA(PG8_SA(1, 0), a3, 0, vs0);
            PG8_WAIT_V(8); PG8_WAIT_L(0); PG8_BAR; PG8_MMA(1, 0, At, B0); PG8_MMA(1, 1, At, B1); PG8_BAR; PG8_SCHED;
        }
        if constexpr (ALIGN_EPI) { if (wr == 0) PG8_BAR; }
        if constexpr (!Epi::AFTER_DRAIN) E(acc, cur, wr, wc, fr, fq);
        if (!has_next) break;
        if (!(Epi::CHAIN2 && cur.ex == 0)) {
#pragma unroll
        for (int a = 0; a < 2; ++a)
#pragma unroll
            for (int b = 0; b < 2; ++b)
#pragma unroll
                for (int m = 0; m < 4; ++m)
#pragma unroll
                    for (int n = 0; n < 2; ++n) acc[a][b][m][n] = (f32x4){0.f, 0.f, 0.f, 0.f}; }
        cur = nxt; cA = nA; cB = nB; ++ui;
        if constexpr (GATHER) PG8_GOFF(cur, gc0, gc1);
        if constexpr (ALIGN_EPI) { if (wr == 1) PG8_BAR; }
    }
    PG8_WAIT_V(0);
    if constexpr (!ALIGN_EPI) { if (wr == 0) PG8_BAR; }
    PG8_BAR;
    if constexpr (Epi::AFTER_DRAIN) E.fused(acc, cur, wr, wc, fr, fq, lds, tid);
#undef PG8_SA
#undef PG8_SB
#undef PG8_STAGE
#undef PG8_STAGE_A
#undef PG8_STA
#undef PG8_GOFF
#undef PG8_LDA
#undef PG8_LDB
#undef PG8_MMA
#undef PG8_WAIT_V
#undef PG8_WAIT_L
#undef PG8_BAR
#undef PG8_SCHED
}
}
typedef pg8::Unit Unit;
__device__ __forceinline__ float sigmoidf_(float v) { return __builtin_amdgcn_rcpf(1.0f + __builtin_amdgcn_exp2f(-v * LOG2E)); }

struct EpiInproj {
    static constexpr int BMODE = 2; static constexpr bool CHAIN2 = false, AFTER_DRAIN = false;
    bf16* O; const float* gt; const float* cs;
    __device__ __forceinline__ void operator()(f32x4 (&acc)[2][2][4][2], const Unit& u, int wr, int wc, int fr, int fq) const {
        const int seg = u.pn >> 1;
        const int col0 = u.pn * 256 + wc * 64 + 8 * fq;
        const bool isnorm = (seg == 0 || seg == 1 || seg == 3 || seg == 4), isdiff = seg < 2;
        f32x4 g[2][2];
        if (isnorm) {
            const float* gp = gt + (seg < 2 ? seg : seg - 1) * 64;
#pragma unroll
            for (int bj = 0; bj < 2; ++bj)
#pragma unroll
                for (int n = 0; n < 2; ++n) { const int d0 = (isdiff && bj == 0 && fq < 2) ? (4 * fq + 8 * n) : (32 * bj + 8 * fq + 4 * n); g[bj][n] = *(const f32x4*)(gp + d0); }
        }
#pragma unroll
        for (int ai = 0; ai < 2; ++ai)
#pragma unroll
            for (int m = 0; m < 4; ++m) {
                const int row = u.pm * 256 + ai * 128 + wr * 64 + m * 16 + fr;
                f32x4 v00 = acc[ai][0][m][0], v01 = acc[ai][0][m][1], v10 = acc[ai][1][m][0], v11 = acc[ai][1][m][1];
                if (isnorm) {
                    float ss = (v00.x * v00.x + v00.y * v00.y) + (v00.z * v00.z + v00.w * v00.w) + (v01.x * v01.x + v01.y * v01.y) + (v01.z * v01.z + v01.w * v01.w)
                             + (v10.x * v10.x + v10.y * v10.y) + (v10.z * v10.z + v10.w * v10.w) + (v11.x * v11.x + v11.y * v11.y) + (v11.z * v11.z + v11.w * v11.w);
                    ss += shx(ss, 16, fq * 16 + fr); ss += shx(ss, 32, fq * 16 + fr);
                    const float rs = __builtin_amdgcn_rsqf(ss * (1.0f / 64.0f) + EPS);
                    v00 = v00 * rs * g[0][0]; v01 = v01 * rs * g[0][1]; v10 = v10 * rs * g[1][0]; v11 = v11 * rs * g[1][1];
                    if (isdiff) {
                        const int fi = (fq & 1) * 4;
                        const f32x4 c = *(const f32x4*)(cs + (size_t)row * 16 + fi), s = *(const f32x4*)(cs + (size_t)row * 16 + 8 + fi);
                        const f32x4 r0 = v00 * c - v01 * s, r1 = v01 * c + v00 * s;
                        if (fq < 2) { v00 = r0; v01 = r1; }
                    }
                } else if (seg >= 6) {
#pragma unroll
                    for (int e = 0; e < 4; ++e) { v00[e] = sigmoidf_(v00[e]); v01[e] = sigmoidf_(v01[e]); v10[e] = sigmoidf_(v10[e]); v11[e] = sigmoidf_(v11[e]); }
                }
                bf16* rowp = O + (size_t)row * NP + col0;
                pg8::u32x4 w0, w1;
                w0.x = pg8::cvt_pk_bf16(v00.x, v00.y); w0.y = pg8::cvt_pk_bf16(v00.z, v00.w); w0.z = pg8::cvt_pk_bf16(v01.x, v01.y); w0.w = pg8::cvt_pk_bf16(v01.z, v01.w);
                w1.x = pg8::cvt_pk_bf16(v10.x, v10.y); w1.y = pg8::cvt_pk_bf16(v10.z, v10.w); w1.z = pg8::cvt_pk_bf16(v11.x, v11.y); w1.w = pg8::cvt_pk_bf16(v11.z, v11.w);
                *(pg8::u32x4*)(rowp) = w0; *(pg8::u32x4*)(rowp + 32) = w1;
            }
    }
};
template <bool FIRST> struct EpiYZ {
    static constexpr int BMODE = 1; static constexpr bool CHAIN2 = false, AFTER_DRAIN = false;
    bf16* Z; const bf16* G;
    __device__ __forceinline__ void operator()(f32x4 (&acc)[2][2][4][2], const Unit& u, int wr, int wc, int fr, int fq) const {
#pragma unroll
        for (int ai = 0; ai < 2; ++ai)
#pragma unroll
            for (int m = 0; m < 4; ++m) { const int row = u.pm * 256 + ai * 128 + wr * 64 + m * 16 + fr;
#pragma unroll
                for (int bj = 0; bj < 2; ++bj) { const int col = u.pn * 256 + bj * 128 + wc * 32 + 8 * fq;
                    const pg8::u32x4 gw = *(const pg8::u32x4*)(G + (size_t)row * NP + col);
                    f32x4 v0 = acc[ai][bj][m][0], v1 = acc[ai][bj][m][1];
                    v0.x *= bflo(gw.x); v0.y *= bfhi(gw.x); v0.z *= bflo(gw.y); v0.w *= bfhi(gw.y); v1.x *= bflo(gw.z); v1.y *= bfhi(gw.z); v1.z *= bflo(gw.w); v1.w *= bfhi(gw.w);
                    bf16* zp = Z + (size_t)row * D + col;
                    if (!FIRST) { const pg8::u32x4 zo = *(const pg8::u32x4*)zp;
                        v0.x += bflo(zo.x); v0.y += bfhi(zo.x); v0.z += bflo(zo.y); v0.w += bfhi(zo.y); v1.x += bflo(zo.z); v1.y += bfhi(zo.z); v1.z += bflo(zo.w); v1.w += bfhi(zo.w); }
                    pg8::u32x4 w; w.x = pg8::cvt_pk_bf16(v0.x, v0.y); w.y = pg8::cvt_pk_bf16(v0.z, v0.w); w.z = pg8::cvt_pk_bf16(v1.x, v1.y); w.w = pg8::cvt_pk_bf16(v1.z, v1.w);
                    *(pg8::u32x4*)zp = w; } }
    }
};
struct EpiWo {
    static constexpr int BMODE = 0; static constexpr bool CHAIN2 = false, AFTER_DRAIN = false;
    float* out; bool dry;
    __device__ __forceinline__ void operator()(f32x4 (&acc)[2][2][4][2], const Unit& u, int wr, int wc, int fr, int fq) const {
#pragma unroll
        for (int ai = 0; ai < 2; ++ai)
#pragma unroll
            for (int m = 0; m < 4; ++m) { const int row = u.pm * 256 + ai * 128 + wr * 64 + m * 16 + fr;
#pragma unroll
                for (int bj = 0; bj < 2; ++bj)
#pragma unroll
                    for (int n = 0; n < 2; ++n) { float* p = out + (size_t)row * D + u.pn * 256 + bj * 128 + wc * 32 + n * 16 + 4 * fq; const f32x4 nv = *(const f32x4*)p + acc[ai][bj][m][n]; if (!dry || nv.x == 1.2345e33f) *(f32x4*)p = nv; }
                if (m == 3) asm volatile("" ::: "memory"); }
    }
};
struct EpiWoR {
    static constexpr int BMODE = 2; static constexpr bool CHAIN2 = false, AFTER_DRAIN = true;
    float* out; const float* res; bf16* HN; const float* g2; const bf16* WT; float* SUMS; bool dry;
    __device__ __forceinline__ void operator()(f32x4 (&)[2][2][4][2], const Unit&, int, int, int, int) const {}
    __device__ __forceinline__ void fused(f32x4 (&acc)[2][2][4][2], const Unit& u, int wr, int wc, int fr, int fq, LAS unsigned char* lds, int tid) const {
        constexpr int PW = 49;
        LAS float* tab = (LAS float*)lds;
        const int lane = fq * 16 + fr;
        const int c0 = u.pn * 256 + wc * 64 + 8 * fq;
        pg8::bf16x8 wh[2][3], wl[2][3]; f32x4 gg[2][2];
#pragma unroll
        for (int bj = 0; bj < 2; ++bj) {
#pragma unroll
            for (int nb = 0; nb < 3; ++nb) { wh[bj][nb] = *(const pg8::bf16x8*)(WT + (size_t)(nb * 16 + fr) * D + c0 + 32 * bj); wl[bj][nb] = *(const pg8::bf16x8*)(WT + (size_t)48 * D + (size_t)(nb * 16 + fr) * D + c0 + 32 * bj); }
#pragma unroll
            for (int n = 0; n < 2; ++n) gg[bj][n] = *(const f32x4*)(g2 + c0 + 32 * bj + 4 * n); }
#pragma unroll
        for (int ai = 0; ai < 2; ++ai)
#pragma unroll
            for (int m = 0; m < 4; ++m) { const int row = u.pm * 256 + ai * 128 + wr * 64 + m * 16 + fr;
                float ss = 0.f; f32x4 dd[3];
#pragma unroll
                for (int nb = 0; nb < 3; ++nb) dd[nb] = (f32x4){0.f, 0.f, 0.f, 0.f};
#pragma unroll
                for (int bj = 0; bj < 2; ++bj) { float* p = out + (size_t)row * D + c0 + 32 * bj; const float* ps = res + (size_t)row * D + c0 + 32 * bj;
                    const f32x4 o0 = *(const f32x4*)ps, o1 = *(const f32x4*)(ps + 4); const f32x4 v0 = o0 + acc[ai][bj][m][0], v1 = o1 + acc[ai][bj][m][1];
                    *(f32x4*)p = dry ? o0 : v0; *(f32x4*)(p + 4) = dry ? o1 : v1;
                    ss += ((v0.x * v0.x + v0.y * v0.y) + (v0.z * v0.z + v0.w * v0.w)) + ((v1.x * v1.x + v1.y * v1.y) + (v1.z * v1.z + v1.w * v1.w));
                    { const f32x4 a = v0 * gg[bj][0], b = v1 * gg[bj][1]; pg8::u32x4 o; o.x = pg8::cvt_pk_bf16(a.x, a.y); o.y = pg8::cvt_pk_bf16(a.z, a.w); o.z = pg8::cvt_pk_bf16(b.x, b.y); o.w = pg8::cvt_pk_bf16(b.z, b.w);
                      *(pg8::u32x4*)(HN + (size_t)row * D + c0 + 32 * bj) = o; }
                    pg8::u32x4 hp, lp;
                    hp.x = pg8::cvt_pk_bf16(v0.x, v0.y); hp.y = pg8::cvt_pk_bf16(v0.z, v0.w); hp.z = pg8::cvt_pk_bf16(v1.x, v1.y); hp.w = pg8::cvt_pk_bf16(v1.z, v1.w);
                    lp.x = pg8::cvt_pk_bf16(v0.x - bflo(hp.x), v0.y - bfhi(hp.x)); lp.y = pg8::cvt_pk_bf16(v0.z - bflo(hp.y), v0.w - bfhi(hp.y));
                    lp.z = pg8::cvt_pk_bf16(v1.x - bflo(hp.z), v1.y - bfhi(hp.z)); lp.w = pg8::cvt_pk_bf16(v1.z - bflo(hp.w), v1.w - bfhi(hp.w));
                    const pg8::bf16x8 ah = __builtin_bit_cast(pg8::bf16x8, hp), al = __builtin_bit_cast(pg8::bf16x8, lp);
#pragma unroll
                    for (int nb = 0; nb < 3; ++nb) { dd[nb] = __builtin_amdgcn_mfma_f32_16x16x32_bf16(ah, wh[bj][nb], dd[nb], 0, 0, 0); dd[nb] = __builtin_amdgcn_mfma_f32_16x16x32_bf16(ah, wl[bj][nb], dd[nb], 0, 0, 0);
                        dd[nb] = __builtin_amdgcn_mfma_f32_16x16x32_bf16(al, wh[bj][nb], dd[nb], 0, 0, 0); } }
                ss += shx(ss, 16, lane); ss += shx(ss, 32, lane);
                acc[ai][0][m][0] = dd[0]; acc[ai][0][m][1] = dd[1]; acc[ai][1][m][0] = dd[2]; acc[ai][1][m][1].x = ss; }
#pragma unroll 1
        for (int ph = 0; ph < 2; ++ph) {
            if ((wc >> 1) == ph) { LAS float* tb = tab + (wc & 1) * 256 * PW;
#pragma unroll
                for (int ai = 0; ai < 2; ++ai)
#pragma unroll
                    for (int m = 0; m < 4; ++m) { const int rb = ai * 128 + wr * 64 + m * 16;
#pragma unroll
                        for (int nb = 0; nb < 3; ++nb) { const f32x4 d = nb == 0 ? acc[ai][0][m][0] : (nb == 1 ? acc[ai][0][m][1] : acc[ai][1][m][0]);
#pragma unroll
                            for (int e = 0; e < 4; ++e) { LAS float* q = tb + (rb + 4 * fq + e) * PW + nb * 16 + fr; if (ph == 0) *q = d[e]; else *q += d[e]; } }
                        if (fq == 0) { LAS float* q = tb + (rb + fr) * PW + 48; const float s = acc[ai][1][m][1].x; if (ph == 0) *q = s; else *q += s; } }
            }
            LDS_WAIT(); __builtin_amdgcn_s_barrier();
        }
        float* dst = SUMS + ((size_t)u.pn * T + (size_t)u.pm * 256) * 64;
#pragma unroll 4
        for (int i = tid; i < 256 * 64; i += 512) { const int r = i >> 6, c = i & 63; if (c < PW) dst[(size_t)r * 64 + c] = tab[r * PW + c] + tab[256 * PW + r * PW + c]; }
    }
};
constexpr int MOE_LDS = MISC_OFF + 128;
constexpr int MOE_SLOTS = 8;
template <bool DOWN_> struct MoeOrderT {
    static constexpr bool GATHER = !DOWN_; static constexpr int A_AUX = (DOWN_ && !MOE_BARRIER) ? 16 : 0;
    const LAS int* toff; const LAS int* ulist; const LAS int* idx;
    int Kb, l, wave0;
    unsigned* tcnt; unsigned* tmo;
    __device__ __forceinline__ bool next(int i, Unit& u) const {
        if (i >= ulist[8]) return false;
        const int L = ulist[i]; u.pm = L >> 2; u.pn = L & 3; u.sl = i; int e = 0;
#pragma unroll 1
        for (int q = 1; q < NEXP; ++q) if (u.pm >= toff[q]) e = q;
        u.ex = e; return true;
    }
    __device__ __forceinline__ void a_ready(const Unit& u) const {
        if constexpr (DOWN_ && !MOE_BARRIER) {
            if (wave0 == 0) {
                unsigned* w = tcnt + u.pm * TCNT_STRIDE; unsigned sp = 0;
                while ((unsigned)__builtin_amdgcn_readfirstlane(__hip_atomic_load(w, __ATOMIC_RELAXED, __HIP_MEMORY_SCOPE_AGENT)) < 32u) {
                    __builtin_amdgcn_s_sleep(2);
                    if ((++sp & 255u) == 0u) { if (__hip_atomic_load(tmo, __ATOMIC_RELAXED, __HIP_MEMORY_SCOPE_AGENT) != 0u) break;
                        if (sp > (1u << 20)) { if (fresh_lane() == 0) __hip_atomic_store(tmo, 1u, __ATOMIC_RELAXED, __HIP_MEMORY_SCOPE_AGENT); break; } } }
            }
            asm volatile("" ::: "memory"); __builtin_amdgcn_s_barrier(); asm volatile("" ::: "memory");
        }
    }
    __device__ __forceinline__ unsigned arow_off(const Unit& u, int r) const { const int as = idx[u.sl * 256 + r]; return (unsigned)(as < 0 ? 0 : (as >> 1)) * (unsigned)Kb; }
    __device__ __forceinline__ size_t a_off(const Unit& u) const { return (size_t)u.pm * 256 * (size_t)Kb; }
    __device__ __forceinline__ size_t b_off(const Unit& u) const { return ((size_t)(l * NEXP + u.ex) * 1024 + (size_t)u.pn * 256) * (size_t)Kb; }
};
template <bool DOWN_> __device__ __forceinline__ MoeOrderT<DOWN_> moe_order_setup(Frame& F, int l, int Kb) {
    LAS int* toff = (LAS int*)(F.lds + MOE_LDS); LAS int* ulist = toff + 40; LAS int* idx = (LAS int*)(F.lds + MOE_LDS + 256);
    const unsigned* cnt = F.ctl + CW_CNT + (size_t)l * NEXP * CNT_STRIDE;
    if (F.wave == 0) {
        const int ln = F.lane; int nt = ln < NEXP ? ((int)cnt[ln * CNT_STRIDE] + 255) >> 8 : 0, inc = nt;
#pragma unroll
        for (int o = 1; o < 64; o <<= 1) { const int u = __builtin_amdgcn_ds_bpermute(((ln - o) & 63) << 2, inc); if (ln >= o) inc += u; }
        if (ln < NEXP) toff[ln] = inc - nt;
        if (ln == NEXP - 1) toff[NEXP] = inc;
        const int U = __builtin_amdgcn_readlane(inc, NEXP - 1) * 4, G = F.G, c = F.vcu;
        if (ln == 0) { int n = 0;
#ifndef MOE_OLD_DEAL
#define MOE_OLD_DEAL 0
#endif
        if (!DOWN_ || MOE_OLD_DEAL) { for (int L = c; L < U && n < MOE_SLOTS; L += G) ulist[n++] = L; }
        else {
            const int r = U % G, NL = G - r, a = U < 2 * NL ? U : 2 * NL, base_low = a / NL, extra_low = a % NL, R = U - a, base_all = R / G, extra_all = R % G;
            const int ord = c >= r ? c - r : NL + c;
            const int nd = (ord < NL ? base_low + (ord < extra_low ? 1 : 0) : 0) + base_all + (ord < extra_all ? 1 : 0);
            int bp[5] = {0, extra_low < NL ? extra_low : NL, extra_all, NL, G};
            if (bp[1] > bp[2]) { const int t_ = bp[1]; bp[1] = bp[2]; bp[2] = t_; }
            if (bp[2] > bp[3]) { const int t_ = bp[2]; bp[2] = bp[3]; bp[3] = t_; }
            if (bp[1] > bp[2]) { const int t_ = bp[1]; bp[1] = bp[2]; bp[2] = t_; }
            int S = 0;
            for (int k = 0; k < nd && n < MOE_SLOTS; ++k) {
                ulist[n++] = S + ord;
                int cntk = 0;
#pragma unroll
                for (int q = 0; q < 4; ++q) { const int o = bp[q], oe = bp[q + 1]; const int ndo = (o < NL ? base_low + (o < extra_low ? 1 : 0) : 0) + base_all + (o < extra_all ? 1 : 0); if (oe > o && ndo > k) cntk += oe - o; }
                S += cntk; }
        }
        ulist[8] = n; }
    }
    __syncthreads();
    MoeOrderT<DOWN_> S; S.toff = toff; S.ulist = ulist; S.idx = idx; S.Kb = Kb; S.l = l; S.wave0 = F.wave0;
    S.tcnt = F.ctl + CW_TCNT + (size_t)l * MAX_TILES * TCNT_STRIDE; S.tmo = F.ctl + CW_TMO;
    const int* LIST = (const int*)(F.ws + WS_LIST);
    Unit u;
    for (int i = 0; S.next(i, u); ++i) {
        if (F.tid < 256) { const int r = (u.pm - toff[u.ex]) * 256 + F.tid; idx[i * 256 + F.tid] = r < (int)cnt[u.ex * CNT_STRIDE] ? LIST[(size_t)u.ex * T + r] : -1; }
    }
    __syncthreads();
    return S;
}
#ifndef HID_PLAIN
#define HID_PLAIN 0
#endif
struct EpiGateUp {
    static constexpr int BMODE = 1; static constexpr bool CHAIN2 = false, AFTER_DRAIN = false;
    bf16* HID; const float* GWT; const float* RSTD; const LAS int* idx; unsigned* tcnt;
    __device__ __forceinline__ void operator()(f32x4 (&acc)[2][2][4][2], const Unit& u, int wr, int wc, int fr, int fq) const {
#pragma unroll
        for (int ai = 0; ai < 2; ++ai)
#pragma unroll
            for (int m = 0; m < 4; ++m) { const int r = ai * 128 + wr * 64 + m * 16 + fr; const int as = idx[u.sl * 256 + r];
                const float w = as < 0 ? 0.f : GWT[as]; const float rs = as < 0 ? 0.f : RSTD[as >> 1];
                const f32x4 g0 = acc[ai][0][m][0] * rs, g1 = acc[ai][0][m][1] * rs, u0 = acc[ai][1][m][0] * rs, u1 = acc[ai][1][m][1] * rs;
                f32x4 h0, h1;
#pragma unroll
                for (int e = 0; e < 4; ++e) { h0[e] = g0[e] * sigmoidf_(g0[e]) * u0[e] * w; h1[e] = g1[e] * sigmoidf_(g1[e]) * u1[e] * w; }
                if (as < 0) { h0 = (f32x4){0.f, 0.f, 0.f, 0.f}; h1 = h0; }
                pg8::u32x4 o; o.x = pg8::cvt_pk_bf16(h0.x, h0.y); o.y = pg8::cvt_pk_bf16(h0.z, h0.w); o.z = pg8::cvt_pk_bf16(h1.x, h1.y); o.w = pg8::cvt_pk_bf16(h1.z, h1.w);
#if HID_PLAIN
                *(pg8::u32x4*)(HID + (size_t)(u.pm * 256 + r) * FF + u.pn * 128 + wc * 32 + 8 * fq) = o; }
#else
                asm volatile("global_store_dwordx4 %0, %1, off sc1\n\ts_nop 1" :: "v"(HID + (size_t)(u.pm * 256 + r) * FF + u.pn * 128 + wc * 32 + 8 * fq), "v"(o) : "memory"); }
#endif
#if !MOE_BARRIER
        asm volatile("s_waitcnt vmcnt(0)" ::: "memory");
        if (fr == 0 && fq == 0) __hip_atomic_fetch_add(tcnt + u.pm * TCNT_STRIDE, 1u, __ATOMIC_RELAXED, __HIP_MEMORY_SCOPE_AGENT);
#endif
    }
};
struct EpiDown {
    static constexpr int BMODE = 2; static constexpr bool CHAIN2 = false, AFTER_DRAIN = false;
    bf16* Y; const LAS int* idx;
    __device__ __forceinline__ void operator()(f32x4 (&acc)[2][2][4][2], const Unit& u, int wr, int wc, int fr, int fq) const {
#pragma unroll
        for (int ai = 0; ai < 2; ++ai)
#pragma unroll
            for (int m = 0; m < 4; ++m) { const int r = ai * 128 + wr * 64 + m * 16 + fr; const int as = idx[u.sl * 256 + r];
                if (as >= 0) { bf16* yp = Y + (size_t)(as & 1) * T * D + (size_t)(as >> 1) * D + u.pn * 256 + wc * 64 + 8 * fq;
#pragma unroll
                    for (int bj = 0; bj < 2; ++bj) { const f32x4 v0 = acc[ai][bj][m][0], v1 = acc[ai][bj][m][1];
                        pg8::u32x4 o; o.x = pg8::cvt_pk_bf16(v0.x, v0.y); o.y = pg8::cvt_pk_bf16(v0.z, v0.w); o.z = pg8::cvt_pk_bf16(v1.x, v1.y); o.w = pg8::cvt_pk_bf16(v1.z, v1.w);
                        *(pg8::u32x4*)(yp + bj * 32) = o; } } }
    }
};

__device__ __forceinline__ void phase_inproj(Frame& F, int l) {
    pg8::StaticOrder S; S.init(T, NP, D, F.G, F.bx);
    EpiInproj E{(bf16*)(F.ws + WS_QKVG), (const float*)(F.ws + WS_GT) + l * 256, (const float*)(F.ws + WS_COSSIN)};
    pg8::gemm_phase<EpiInproj, pg8::StaticOrder, true>(F.lds + RING_OFF, F.wave0, (const bf16*)(F.ws + WS_HN), (const bf16*)(F.ws + WS_WIN) + (size_t)l * NP * D, D, S, E);
}
struct YZOrder : pg8::StaticOrder {
    size_t aof, bof;
    __device__ __forceinline__ bool next(int i, Unit& u) const { const bool ok = pg8::StaticOrder::next(i >> 1, u); u.ex = i & 1; return ok; }
    __device__ __forceinline__ size_t a_off(const Unit& u) const { return pg8::StaticOrder::a_off(u) + (u.ex ? aof : (size_t)0); }
    __device__ __forceinline__ size_t b_off(const Unit& u) const { return pg8::StaticOrder::b_off(u) + (u.ex ? bof : (size_t)0); }
};
struct EpiYZm {
    static constexpr int BMODE = 2; static constexpr bool CHAIN2 = true, AFTER_DRAIN = false;
    bf16* Z; const bf16* GA; const bf16* GF;
    __device__ __forceinline__ void operator()(f32x4 (&acc)[2][2][4][2], const Unit& u, int wr, int wc, int fr, int fq) const {
#pragma unroll
        for (int ai = 0; ai < 2; ++ai)
#pragma unroll
            for (int m = 0; m < 4; ++m) { const int row = u.pm * 256 + ai * 128 + wr * 64 + m * 16 + fr;
#pragma unroll
                for (int bj = 0; bj < 2; ++bj) { const int col = u.pn * 256 + wc * 64 + bj * 32 + 8 * fq;
                    const pg8::u32x4 fw = *(const pg8::u32x4*)(GF + (size_t)row * NP + col);
                    f32x4 f0 = (f32x4){bflo(fw.x), bfhi(fw.x), bflo(fw.y), bfhi(fw.y)}, f1 = (f32x4){bflo(fw.z), bfhi(fw.z), bflo(fw.w), bfhi(fw.w)};
#pragma unroll
                    for (int e = 0; e < 4; ++e) { f0[e] = fmaxf(f0[e], 1e-20f); f1[e] = fmaxf(f1[e], 1e-20f); }
                    if (u.ex == 0) {
                        const pg8::u32x4 aw = *(const pg8::u32x4*)(GA + (size_t)row * NP + col);
                        const f32x4 a0 = (f32x4){bflo(aw.x), bfhi(aw.x), bflo(aw.y), bfhi(aw.y)}, a1 = (f32x4){bflo(aw.z), bfhi(aw.z), bflo(aw.w), bfhi(aw.w)};
#pragma unroll
                        for (int e = 0; e < 4; ++e) { acc[ai][bj][m][0][e] *= a0[e] * __builtin_amdgcn_rcpf(f0[e]); acc[ai][bj][m][1][e] *= a1[e] * __builtin_amdgcn_rcpf(f1[e]); }
                    } else {
                        const f32x4 v0 = acc[ai][bj][m][0] * f0, v1 = acc[ai][bj][m][1] * f1;
                        pg8::u32x4 w; w.x = pg8::cvt_pk_bf16(v0.x, v0.y); w.y = pg8::cvt_pk_bf16(v0.z, v0.w); w.z = pg8::cvt_pk_bf16(v1.x, v1.y); w.w = pg8::cvt_pk_bf16(v1.z, v1.w);
                        *(pg8::u32x4*)(Z + (size_t)row * D + col) = w; } } }
    }
};
__device__ __forceinline__ void phase_yz(Frame& F, int l) {
    YZOrder S; S.init(T, D, 512, F.G, F.bx);
    S.aof = (size_t)((const char*)(F.ws + WS_OF) - (const char*)(F.ws + WS_AD)); S.bof = (size_t)((const char*)(F.ws + WS_WF) - (const char*)(F.ws + WS_WD));
    EpiYZm E{(bf16*)(F.ws + WS_Z), (const bf16*)(F.ws + WS_QKVG) + C_GA, (const bf16*)(F.ws + WS_QKVG) + C_GF};
    pg8::gemm_phase<EpiYZm, YZOrder, true>(F.lds + RING_OFF, F.wave0, (const bf16*)(F.ws + WS_AD), (const bf16*)(F.ws + WS_WD) + (size_t)l * D * 512, 512, S, E);
}
__device__ __forceinline__ void phase_wo(Frame& F, int l, bool dry = false) {
    pg8::StaticOrder S; S.init(T, D, D, F.G, F.bx);
    EpiWoR E{F.out, (l == 0 && !dry) ? (const float*)F.in[I_X] : (const float*)F.out, (bf16*)(F.ws + WS_HN), (const float*)F.in[I_LN2] + (size_t)l * D, (const bf16*)(F.ws + WS_WRT) + (size_t)l * 2 * 48 * D, (float*)(F.ws + WS_SUMS), dry};
    pg8::gemm_phase<EpiWoR, pg8::StaticOrder, true>(F.lds + RING_OFF, F.wave0, (const bf16*)(F.ws + WS_Z), (const bf16*)(F.ws + WS_WO) + (size_t)l * D * D, D, S, E);
}
__device__ __forceinline__ void phase_gateup(Frame& F, int l) {
    const MoeOrderT<false> S = moe_order_setup<false>(F, l, D * 2);
    EpiGateUp E{(bf16*)(F.ws + WS_HID), (const float*)(F.ws + WS_GWT), (const float*)(F.ws + WS_RSTD), S.idx, S.tcnt};
    pg8::gemm_phase<EpiGateUp, MoeOrderT<false>, true>(F.lds + RING_OFF, F.wave0, (const bf16*)(F.ws + WS_HN), (const bf16*)(F.ws + WS_WGU), D, S, E);
}
__device__ __forceinline__ void phase_down(Frame& F, int l) {
    const MoeOrderT<true> S = moe_order_setup<true>(F, l, FF * 2);
    EpiDown E{(bf16*)(F.ws + WS_Y), S.idx};
    pg8::gemm_phase<EpiDown, MoeOrderT<true>, true>(F.lds + RING_OFF, F.wave0, (const bf16*)(F.ws + WS_HID), (const bf16*)(F.ws + WS_WDN), FF, S, E);
}
#include <hip/hip_bf16.h>
namespace attn_body {
using bf16=__hip_bfloat16;
using bf16x8=__attribute__((ext_vector_type(8)))short;
using s16x4=__attribute__((ext_vector_type(4)))short;
using f32x16=__attribute__((ext_vector_type(16)))float;
using u32x4=__attribute__((ext_vector_type(4)))unsigned;
constexpr int SEQ=8192,D=64,DM=5120;
constexpr int NW=8,QBLK=32,QB=QBLK*NW,KVBLK=64,NQB=SEQ/QB;
constexpr int ATTN_UNIT_ROWS=QB;
__device__ __forceinline__ int crow(int r,int hi){return (r&3)+8*(r>>2)+4*hi;}
#define SBAR() __builtin_amdgcn_sched_barrier(0)
__device__ __forceinline__ void cmask(f32x16&p0,f32x16&p1,int jb,int qrel,int hi){
  const float NEG=-INFINITY; int kb=64*jb+4*hi;
  #pragma unroll
  for(int r=0;r<16;++r){int kv=kb+(r&3)+8*(r>>2); if(kv>qrel)p0[r]=NEG; if(kv+32>qrel)p1[r]=NEG;}
}

constexpr int NSLOT=3, SLOTB=8192;
constexpr int LDS_K=0, LDS_V=NSLOT*SLOTB;
template<int DV> struct Lay { static constexpr int VM=DV/64, WS=LDS_V+NSLOT*SLOTB*VM, OST=WS+NW*64*4, CK=OST+NW*4096, BYTES=CK+(DV==64?SEQ*4+512:0); };
constexpr float C2=0.125f*1.4426950408889634f;
__device__ __forceinline__ void glds16(const void*gsrc,unsigned lds_dst){unsigned keep;
  asm volatile("s_mov_b32 %0, m0\n\ts_mov_b32 m0, %2\n\ts_nop 0\n\tglobal_load_lds_dwordx4 %1, off\n\ts_mov_b32 m0, %0":"=&s"(keep):"v"(gsrc),"s"(lds_dst):"memory");}
__device__ __forceinline__ float max3f(float a,float b,float c){float r;asm("v_max3_f32 %0, %1, %2, %3":"=v"(r):"v"(a),"v"(b),"v"(c));return r;}
__device__ __forceinline__ float max2f(float a,float b){float r;asm("v_max_f32_e32 %0, %1, %2":"=v"(r):"v"(a),"v"(b));return r;}
__device__ __forceinline__ float fadd_s(float a,float b){float r;asm("v_add_f32_e32 %0, %1, %2":"=v"(r):"v"(a),"v"(b));return r;}
__device__ __forceinline__ float fsub_s(float a,float b){float r;asm("v_sub_f32_e32 %0, %1, %2":"=v"(r):"v"(a),"v"(b));return r;}
typedef float f32x2_t __attribute__((ext_vector_type(2))); typedef __bf16 bf16x2_t __attribute__((ext_vector_type(2)));
__device__ __forceinline__ unsigned cvtpk_s(float lo,float hi){f32x2_t v={lo,hi};bf16x2_t b=__builtin_convertvector(v,bf16x2_t);return __builtin_bit_cast(unsigned,b);}
#define WAIT_BAR(N) asm volatile("s_waitcnt vmcnt(" #N ") lgkmcnt(0)\n\ts_barrier":::"memory")

__device__ __forceinline__ void qkt(f32x16&p0,f32x16&p1,const char*Kslot,const bf16x8*qr,int r32,int hi){
  const char*kb=Kslot+hi*1024+r32*16;
  #pragma unroll
  for(int d0=0;d0<4;++d0){
    const bf16x8 b0=*reinterpret_cast<const bf16x8*>(kb+d0*2048);
    const bf16x8 b1=*reinterpret_cast<const bf16x8*>(kb+d0*2048+512);
    if(d0==0){p0=__builtin_amdgcn_mfma_f32_32x32x16_bf16(b0,qr[0],p0,0,0,0);p1=__builtin_amdgcn_mfma_f32_32x32x16_bf16(b1,qr[0],p1,0,0,0);}
    else{p0=__builtin_amdgcn_mfma_f32_32x32x16_bf16(b0,qr[d0],p0,0,0,0);p1=__builtin_amdgcn_mfma_f32_32x32x16_bf16(b1,qr[d0],p1,0,0,0);}}
}
typedef __attribute__((address_space(3))) const char* lds_cptr;
typedef short v4i16_t __attribute__((ext_vector_type(4)));
__device__ __forceinline__ void kload8(bf16x8*kf,lds_cptr kp){
  kf[0]=*(const __attribute__((address_space(3))) bf16x8*)(kp);      kf[1]=*(const __attribute__((address_space(3))) bf16x8*)(kp+512);
  kf[2]=*(const __attribute__((address_space(3))) bf16x8*)(kp+2048); kf[3]=*(const __attribute__((address_space(3))) bf16x8*)(kp+2560);
  kf[4]=*(const __attribute__((address_space(3))) bf16x8*)(kp+4096); kf[5]=*(const __attribute__((address_space(3))) bf16x8*)(kp+4608);
  kf[6]=*(const __attribute__((address_space(3))) bf16x8*)(kp+6144); kf[7]=*(const __attribute__((address_space(3))) bf16x8*)(kp+6656);
}
__device__ __forceinline__ void kload2(bf16x8*kf,lds_cptr kp,int j){ kf[2*j]=*(const __attribute__((address_space(3))) bf16x8*)(kp+j*2048); kf[2*j+1]=*(const __attribute__((address_space(3))) bf16x8*)(kp+j*2048+512); }
__device__ __forceinline__ s16x4 vtr(lds_cptr p){ return __builtin_bit_cast(s16x4,__builtin_amdgcn_ds_read_tr16_b64_v4i16((__attribute__((address_space(3))) v4i16_t*)p)); }
__device__ __forceinline__ float rowmax(const f32x16&p0,const f32x16&p1){
  float a=max3f(p0[0],p0[1],p1[0]),b=max3f(p0[2],p0[3],p1[1]);a=max3f(a,p1[2],p1[3]);
  #pragma unroll
  for(int r=4;r<16;r+=4){a=max3f(a,p0[r],p0[r+1]);b=max3f(b,p0[r+2],p0[r+3]);a=max3f(a,p1[r],p1[r+1]);b=max3f(b,p1[r+2],p1[r+3]);}
  const float m=max2f(a,b);
  auto rr=__builtin_amdgcn_permlane32_swap(__float_as_uint(m),__float_as_uint(m),false,false);
  return max2f(__uint_as_float(rr[0]),__uint_as_float(rr[1]));
}
template<int NO> __device__ __forceinline__ void pv(f32x16*o,int vb,bf16x8 pa0,bf16x8 pa1,bf16x8 pa2,bf16x8 pa3){
  #pragma unroll
  for(int d0=0;d0<NO;++d0){s16x4 lo[4],hi[4];
    #pragma unroll
    for(int ks=0;ks<4;++ks){
      asm volatile("ds_read_b64_tr_b16 %0,%1 offset:%c2":"=&v"(lo[ks]):"v"(vb),"i"(d0*4096+ks*1024):"memory");
      asm volatile("ds_read_b64_tr_b16 %0,%1 offset:%c2":"=&v"(hi[ks]):"v"(vb),"i"(d0*4096+ks*1024+512):"memory");}
    asm volatile("s_waitcnt lgkmcnt(0)":::"memory");SBAR();
    #define PK(k) (bf16x8){lo[k][0],lo[k][1],lo[k][2],lo[k][3],hi[k][0],hi[k][1],hi[k][2],hi[k][3]}
    o[d0]=__builtin_amdgcn_mfma_f32_32x32x16_bf16(pa0,PK(0),o[d0],0,0,0);
    o[d0]=__builtin_amdgcn_mfma_f32_32x32x16_bf16(pa1,PK(1),o[d0],0,0,0);
    o[d0]=__builtin_amdgcn_mfma_f32_32x32x16_bf16(pa2,PK(2),o[d0],0,0,0);
    o[d0]=__builtin_amdgcn_mfma_f32_32x32x16_bf16(pa3,PK(3),o[d0],0,0,0);
    #undef PK
  }
}

typedef float f32x4_t __attribute__((ext_vector_type(4)));
__device__ __forceinline__ void bias_fill(f32x16&c0,f32x16&c1,float base,const __attribute__((address_space(3))) float*ck,int hi){
  #pragma unroll
  for(int g=0;g<4;++g){const f32x4_t a=*(const __attribute__((address_space(3))) f32x4_t*)(ck+8*g+4*hi),b=*(const __attribute__((address_space(3))) f32x4_t*)(ck+32+8*g+4*hi);
    #pragma unroll
    for(int e=0;e<4;++e){c0[4*g+e]=base-a[e];c1[4*g+e]=base-b[e];}}
}
typedef __attribute__((address_space(3))) const float* lds_fptr;
__device__ __forceinline__ void ck_load(f32x4_t (&ka)[4],f32x4_t (&kb)[4],lds_fptr ck,int hi){
  #pragma unroll
  for(int g=0;g<4;++g){ka[g]=*(const __attribute__((address_space(3))) f32x4_t*)(ck+8*g+4*hi);kb[g]=*(const __attribute__((address_space(3))) f32x4_t*)(ck+32+8*g+4*hi);}
}
__device__ __forceinline__ void ck_apply(f32x16&c0,f32x16&c1,const f32x4_t (&ka)[4],const f32x4_t (&kb)[4],float add){
  #pragma unroll
  for(int g=0;g<4;++g){
    #pragma unroll
    for(int e=0;e<4;++e){c0[4*g+e]=(c0[4*g+e]-ka[g][e])+add;c1[4*g+e]=(c1[4*g+e]-kb[g][e])+add;}}
}
__device__ __forceinline__ void ck_sub(f32x16&c0,f32x16&c1,const f32x4_t (&ka)[4],const f32x4_t (&kb)[4]){
  #pragma unroll
  for(int g=0;g<4;++g){
    #pragma unroll
    for(int e=0;e<4;++e){c0[4*g+e]-=ka[g][e];c1[4*g+e]-=kb[g][e];}}
}
template<bool BIAS> __device__ __forceinline__ void cfill(f32x16&c0,f32x16&c1,float base,const __attribute__((address_space(3))) float*ck,int hi){
  if(BIAS)bias_fill(c0,c1,base,ck,hi);
  else{
    #pragma unroll
    for(int r=0;r<16;++r){c0[r]=base;c1[r]=base;} }
}
#ifndef ATTN_STORE16
#define ATTN_STORE16(p,v) (*(u32x4*)(p)=(v))
#endif
__device__ __forceinline__ int fox_t0(int qb,const float*cum,float thr,int lane){
  const int q0=qb*QB,NTf=(q0+QB)/KVBLK; const float cq0=cum[q0];
  const int t1=lane,t2=lane+64;
  const bool ok1=(t1>=NTf-4)||(cq0-cum[64*t1+63]>=-thr), ok2=(t2>=NTf-4)||(cq0-cum[(t2<NTf?64*t2+63:q0)]>=-thr);
  const unsigned long long m1=__ballot(ok1),m2=__ballot(ok2);
  int T0=m1?__builtin_ctzll(m1):(m2?64+__builtin_ctzll(m2):NTf-4); T0&=~1; if(T0>NTf-4)T0=NTf-4; return __builtin_amdgcn_readfirstlane(T0);
}
template<int THRL,bool BIAS,int OP,int DV,bool NOREF> __device__ __forceinline__ void attn_unit(int qb,const bf16*Qb,const bf16*__restrict__ Kh0,const bf16*__restrict__ Vh0,bf16*Ob,const float*cum,float thr,char*shm,const int wave0,const int T0in=-1){
  constexpr int NO=DV/32, VM=DV/64; static_assert(DV==64||(DV==128&&!BIAS),"DV"); static_assert(!(NOREF&&BIAS),"NOREF");
  const int tid=fresh_tid(wave0); const int lane=tid&63,r32=lane&31,hi=lane>>5; const int wid=__builtin_amdgcn_readfirstlane(tid>>6);
  const int q0=qb*QB;
  const bf16*Qw=Qb+(long)(q0+wid*QBLK)*DM;
  int T0=0;
  if(BIAS){ T0=T0in>=0?T0in:fox_t0(qb,cum,thr,lane); }
  const bf16*Kh=Kh0+(long)T0*KVBLK*DM; const bf16*Vh=Vh0+(long)T0*KVBLK*DM;
  const unsigned lds0=(unsigned)(uintptr_t)shm;
  float*wsf=(float*)(shm+Lay<DV>::WS)+wid*64;
  const bf16*ksrc=Kh+(long)lane*DM+wid*8;
  const bf16*vsrc=Vh+(long)(16*(wid&3)+(lane>>2))*DM+(wid>>2)*32+(lane&3)*8;
  const unsigned kdst=lds0+LDS_K+wid*1024, vdst=lds0+LDS_V+wid*1024;
  #define DMA_K(t,slot) glds16(ksrc+(long)(t)*KVBLK*DM,(unsigned)__builtin_amdgcn_readfirstlane(kdst+(slot)))
  #define DMA_V(t,slot) do{ glds16(vsrc+(long)(t)*KVBLK*DM,(unsigned)__builtin_amdgcn_readfirstlane(vdst+(slot)*VM)); if(DV==128)glds16(vsrc+64+(long)(t)*KVBLK*DM,(unsigned)__builtin_amdgcn_readfirstlane(vdst+(slot)*VM+8192)); }while(0)
  const int vb0=(int)(lds0+LDS_V)+((lane>>4)&1)*32+(lane&3)*8+(4*hi+((lane&15)>>2))*64;
  const char*Kbase=shm+LDS_K; bf16x8 kf[8];
  const lds_cptr shm3=(lds_cptr)shm; const lds_cptr kp0=shm3+LDS_K+hi*1024+r32*16; const lds_cptr vp0=shm3+LDS_V+((lane>>4)&1)*32+(lane&3)*8+(4*hi+((lane&15)>>2))*64;
  const int NT=(q0+QB)/KVBLK-T0;
  const __attribute__((address_space(3))) float*ckl=(const __attribute__((address_space(3))) float*)(shm3+Lay<DV>::CK); float cq=0.f,cqm=0.f;
  const lds_fptr cl=ckl+NT*64; float fu=1.f;
  DMA_K(0,0);DMA_V(0,0);DMA_K(1,SLOTB);
  bf16x8 qr[4];
  #pragma unroll
  for(int d0=0;d0<4;++d0)qr[d0]=*reinterpret_cast<const bf16x8*>(&Qw[(long)r32*DM+d0*16+hi*8]);
  if(BIAS){ __attribute__((address_space(3))) f32x4_t*cw=(__attribute__((address_space(3))) f32x4_t*)(shm3+Lay<DV>::CK);
    for(int i=tid;i<NT*16;i+=NW*64){ const f32x4_t v=*(const f32x4_t*)(cum+64*T0+4*i); const float last=cum[64*T0+(i>>4)*64+63]; cw[i]=v-last; }
    __attribute__((address_space(3))) float*clw=(__attribute__((address_space(3))) float*)(shm3+Lay<DV>::CK)+NT*64;
    for(int t_=tid;t_<NT;t_+=NW*64)clw[t_]=cum[64*(T0+t_)+63];
    cq=cum[q0+wid*QBLK+r32]; cqm=cq; }
  float mhat=0.f,l_reg=0.f;f32x16 o[NO];
  #pragma unroll
  for(int d_=0;d_<NO;++d_)o[d_]=f32x16{};

  const int qrel=wid*QBLK+r32;
  #define CMASK(P0,P1,t) do{int jb_=(t)-(NT-4); if(jb_>=0)cmask(P0,P1,jb_,qrel,hi);}while(0)
  int resc=0;
  #define START(P0,P1) do{ resc=0; if constexpr(!NOREF&&!BIAS) { const float rm=rowmax(P0,P1); const float dl=rm; mhat=fadd_s(mhat,dl); \
      _Pragma("unroll") for(int r=0;r<16;++r){P0[r]=fsub_s(P0[r],dl);P1[r]=fsub_s(P1[r],dl);} \
      cqm=cq-mhat; } \
    _Pragma("unroll") for(int r=0;r<16;++r)P0[r]=__builtin_amdgcn_exp2f(P0[r]); }while(0)
  #define RESC() do{ if constexpr(!NOREF){ if(BIAS&&resc==1){ _Pragma("unroll") for(int d_=0;d_<NO;++d_) _Pragma("unroll") for(int r=0;r<16;++r)o[d_][r]*=fu; } \
    else if(resc){ asm volatile("s_waitcnt lgkmcnt(0)":::"memory"); \
      _Pragma("unroll") for(int d_=0;d_<NO;++d_) _Pragma("unroll") for(int r=0;r<16;++r)o[d_][r]*=wsf[crow(r,hi)]; } } }while(0)
  f32x16 pA0,pA1,pB0,pB1;
  int sl_prev=0,sl_cur=0,sl_next=SLOTB;
  #define ROT() do{sl_prev=sl_cur;sl_cur=sl_next;sl_next=(sl_next==(NSLOT-1)*SLOTB)?0:sl_next+SLOTB;}while(0)
  DMA_K(2,2*SLOTB);
  if constexpr(DV==128){WAIT_BAR(4);}else{WAIT_BAR(3);}
  if constexpr(NOREF||BIAS){pA0=f32x16{};pA1=f32x16{};}else{cfill<BIAS>(pA0,pA1,cqm,ckl,hi);}
  qkt(pA0,pA1,Kbase,qr,r32,hi);asm volatile("s_nop 15\n\ts_nop 7":"+v"(pA0),"+v"(pA1));
  if constexpr(BIAS){ f32x4_t ka_[4],kb_[4]; ck_load(ka_,kb_,ckl,hi); ck_apply(pA0,pA1,ka_,kb_,NT==4?cq-cl[0]:0.f); }
  CMASK(pA0,pA1,0);
  START(pA0,pA1);
  _Pragma("unroll") for(int r=0;r<16;++r)pA1[r]=__builtin_amdgcn_exp2f(pA1[r]);
  WAIT_BAR(0);
  DMA_K(3,0);DMA_V(1,SLOTB);
  ROT();
  kload8(kf,kp0+sl_cur);
  if constexpr(DV==128){WAIT_BAR(3);}else{WAIT_BAR(2);}
  s16x4 vlo[8],vhi[8]; u32x4 pw0,pw1,pw2,pw3;
  #define PKW(P,B) cvtpk_s(P[B],P[B+1])
  #define PAF(k) __builtin_bit_cast(bf16x8,pw##k)
  #define VFR(i) (bf16x8){vlo[i][0],vlo[i][1],vlo[i][2],vlo[i][3],vhi[i][0],vhi[i][1],vhi[i][2],vhi[i][3]}
  #define PIN(x) asm volatile("":"+v"(x))
  #define MX3(a,b,c) __builtin_fmaxf(__builtin_fmaxf((a),(b)),(c))
  #define GAPA(MF,A0,A1,A2,A3,W0,W1,PW) do{ MF; sacc+=A0; sacc+=A1; sacc+=A2; sacc+=A3; PIN(sacc); W0; W1; PIN(PW); SBAR(); }while(0)
  #define EX(v) __builtin_amdgcn_exp2f(v)
  #define GAPB(MF,X,B) do{ MF; X[B]=EX(X[B]); X[B+1]=EX(X[B+1]); X[B+2]=EX(X[B+2]); X[B+3]=EX(X[B+3]); PIN(X); SBAR(); }while(0)
  #define GAPC(MF,X,B,RL) do{ MF; X[B]=EX(X[B]); X[B+1]=EX(X[B+1]); PIN(X); RL; SBAR(); }while(0)
  #define VRD2(i) do{ vlo[i]=vtr(vp_+((((i)>>2)+2)*4096+((i)&3)*1024)); vhi[i]=vtr(vp_+((((i)>>2)+2)*4096+((i)&3)*1024+512)); }while(0)
  #define VRD(i) do{ vlo[i]=vtr(vp_+(((i)>>2)*4096+((i)&3)*1024)); vhi[i]=vtr(vp_+(((i)>>2)*4096+((i)&3)*1024+512)); }while(0)
  #define KRD(G,j) do{ if(G){ kload2(kf,kp0+sl_next,j); SBAR(); } }while(0)
  #define CIN(X) (X)
  #define STEP(C0,C1,P0,P1,t,GK,GV,GL,BND) do{ SBAR(); \
    const lds_cptr vp_=vp0+sl_prev*VM; \
    f32x4_t ka_[4],kb_[4]; \
    if constexpr(NOREF||BIAS){C0=f32x16{};C1=f32x16{};}else{cfill<BIAS>(C0,C1,cqm,ckl+64*(t),hi);} SBAR(); \
    VRD(0); SBAR(); float sacc=(P0[0]+P0[1]); \
    GAPA(C0=__builtin_amdgcn_mfma_f32_32x32x16_bf16(kf[0],qr[0],CIN(C0),0,0,0), P0[2],P0[3],P0[4],P0[5],     pw0[0]=PKW(P0,0), pw0[1]=PKW(P0,2), pw0); \
    VRD(4); SBAR(); GAPA(C1=__builtin_amdgcn_mfma_f32_32x32x16_bf16(kf[1],qr[0],CIN(C1),0,0,0), P0[6],P0[7],P0[8],P0[9],     pw0[2]=PKW(P0,4), pw0[3]=PKW(P0,6), pw0); \
    VRD(1); SBAR(); GAPA(C0=__builtin_amdgcn_mfma_f32_32x32x16_bf16(kf[2],qr[1],C0,0,0,0),   P0[10],P0[11],P0[12],P0[13], pw1[0]=PKW(P0,8), pw1[1]=PKW(P0,10), pw1); \
    VRD(5); SBAR(); GAPA(C1=__builtin_amdgcn_mfma_f32_32x32x16_bf16(kf[3],qr[1],C1,0,0,0),   P0[14],P0[15],P1[0],P1[1],   pw1[2]=PKW(P0,12),pw1[3]=PKW(P0,14), pw1); \
    VRD(2); SBAR(); GAPA(C0=__builtin_amdgcn_mfma_f32_32x32x16_bf16(kf[4],qr[2],C0,0,0,0),   P1[2],P1[3],P1[4],P1[5],     pw2[0]=PKW(P1,0), pw2[1]=PKW(P1,2), pw2); \
    if constexpr(BIAS){ck_load(ka_,kb_,ckl+64*(t),hi); SBAR();} \
    VRD(6); SBAR(); GAPA(C1=__builtin_amdgcn_mfma_f32_32x32x16_bf16(kf[5],qr[2],C1,0,0,0),   P1[6],P1[7],P1[8],P1[9],     pw2[2]=PKW(P1,4), pw2[3]=PKW(P1,6), pw2); \
    VRD(3); SBAR(); GAPA(C0=__builtin_amdgcn_mfma_f32_32x32x16_bf16(kf[6],qr[3],C0,0,0,0),   P1[10],P1[11],P1[12],P1[13], pw3[0]=PKW(P1,8), pw3[1]=PKW(P1,10), pw3); \
    VRD(7); SBAR(); GAPA(C1=__builtin_amdgcn_mfma_f32_32x32x16_bf16(kf[7],qr[3],C1,0,0,0),   P1[14],P1[15],0.f,0.f,       pw3[2]=PKW(P1,12),pw3[3]=PKW(P1,14), pw3); \
    l_reg+=sacc; \
    if(GK){DMA_K((t)+3,sl_cur);} if(GV){DMA_V((t)+1,sl_next);} \
    if constexpr(BIAS){ const bool bnd_=(BND)&&((t)>=NT-4); if constexpr((BND)==0){ck_sub(C0,C1,ka_,kb_);}else{ck_apply(C0,C1,ka_,kb_,bnd_?cq-cl[(t)]:0.f);} \
      if(!bnd_){ fu=__builtin_amdgcn_exp2f(cl[(t)]-cl[(t)-1]); l_reg*=fu; resc=1; } \
      else if((t)==NT-4){ const float f_=__builtin_amdgcn_exp2f(cq-cl[(t)-1]); l_reg*=f_; if(hi==0)wsf[r32]=f_; resc=2; } \
      else resc=0; } \
    CMASK(C0,C1,t); \
    if constexpr(!NOREF&&!BIAS){ float a=MX3(C0[0],C0[1],C1[0]),b=MX3(C0[2],C0[3],C1[1]); a=MX3(a,C1[2],C1[3]); \
      _Pragma("unroll") for(int r=4;r<16;r+=4){a=MX3(a,C0[r],C0[r+1]);b=MX3(b,C0[r+2],C0[r+3]);a=MX3(a,C1[r],C1[r+1]);b=MX3(b,C1[r+2],C1[r+3]);} \
      float rm=__builtin_fmaxf(a,b); { auto rr=__builtin_amdgcn_permlane32_swap(__float_as_uint(rm),__float_as_uint(rm),false,false); rm=__builtin_fmaxf(__uint_as_float(rr[0]),__uint_as_float(rr[1])); } \
      resc=0; \
      if(__builtin_expect(__any(rm>(float)THRL),0)){ const float dl=__builtin_fmaxf(rm,0.f); mhat+=dl; \
        _Pragma("unroll") for(int r=0;r<16;++r){C0[r]-=dl;C1[r]-=dl;} \
        cqm=cq-mhat; \
        const float f=__builtin_amdgcn_exp2f(-dl); l_reg*=f; if(hi==0)wsf[r32]=f; resc=2; } } \
    SBAR(); \
    if constexpr(DV==64){ \
    GAPB(o[0]=__builtin_amdgcn_mfma_f32_32x32x16_bf16(PAF(0),VFR(0),o[0],0,0,0), C0,0); \
    GAPB(o[1]=__builtin_amdgcn_mfma_f32_32x32x16_bf16(PAF(0),VFR(4),o[1],0,0,0), C0,4); \
    KRD(GL,0); GAPB(o[0]=__builtin_amdgcn_mfma_f32_32x32x16_bf16(PAF(1),VFR(1),o[0],0,0,0), C0,8); \
    KRD(GL,1); GAPB(o[1]=__builtin_amdgcn_mfma_f32_32x32x16_bf16(PAF(1),VFR(5),o[1],0,0,0), C0,12); \
    KRD(GL,2); GAPB(o[0]=__builtin_amdgcn_mfma_f32_32x32x16_bf16(PAF(2),VFR(2),o[0],0,0,0), C1,0); \
    KRD(GL,3); GAPB(o[1]=__builtin_amdgcn_mfma_f32_32x32x16_bf16(PAF(2),VFR(6),o[1],0,0,0), C1,4); \
    GAPB(o[0]=__builtin_amdgcn_mfma_f32_32x32x16_bf16(PAF(3),VFR(3),o[0],0,0,0), C1,8); \
    GAPB(o[1]=__builtin_amdgcn_mfma_f32_32x32x16_bf16(PAF(3),VFR(7),o[1],0,0,0), C1,12); \
    } else { \
    GAPC(o[0]=__builtin_amdgcn_mfma_f32_32x32x16_bf16(PAF(0),VFR(0),o[0],0,0,0), C0,0, VRD2(0)); \
    GAPC(o[1]=__builtin_amdgcn_mfma_f32_32x32x16_bf16(PAF(0),VFR(4),o[1],0,0,0), C0,2, VRD2(4)); \
    GAPC(o[0]=__builtin_amdgcn_mfma_f32_32x32x16_bf16(PAF(1),VFR(1),o[0],0,0,0), C0,4, VRD2(1)); \
    GAPC(o[1]=__builtin_amdgcn_mfma_f32_32x32x16_bf16(PAF(1),VFR(5),o[1],0,0,0), C0,6, VRD2(5)); \
    GAPC(o[0]=__builtin_amdgcn_mfma_f32_32x32x16_bf16(PAF(2),VFR(2),o[0],0,0,0), C0,8, VRD2(2)); \
    GAPC(o[1]=__builtin_amdgcn_mfma_f32_32x32x16_bf16(PAF(2),VFR(6),o[1],0,0,0), C0,10, VRD2(6)); \
    GAPC(o[0]=__builtin_amdgcn_mfma_f32_32x32x16_bf16(PAF(3),VFR(3),o[0],0,0,0), C0,12, VRD2(3)); \
    GAPC(o[1]=__builtin_amdgcn_mfma_f32_32x32x16_bf16(PAF(3),VFR(7),o[1],0,0,0), C0,14, VRD2(7)); \
    GAPC(o[2]=__builtin_amdgcn_mfma_f32_32x32x16_bf16(PAF(0),VFR(0),o[2],0,0,0), C1,0, (void)0); \
    KRD(GL,0); GAPC(o[3]=__builtin_amdgcn_mfma_f32_32x32x16_bf16(PAF(0),VFR(4),o[3],0,0,0), C1,2, (void)0); \
    KRD(GL,1); GAPC(o[2]=__builtin_amdgcn_mfma_f32_32x32x16_bf16(PAF(1),VFR(1),o[2],0,0,0), C1,4, (void)0); \
    KRD(GL,2); GAPC(o[3]=__builtin_amdgcn_mfma_f32_32x32x16_bf16(PAF(1),VFR(5),o[3],0,0,0), C1,6, (void)0); \
    KRD(GL,3); GAPC(o[2]=__builtin_amdgcn_mfma_f32_32x32x16_bf16(PAF(2),VFR(2),o[2],0,0,0), C1,8, (void)0); \
    GAPC(o[3]=__builtin_amdgcn_mfma_f32_32x32x16_bf16(PAF(2),VFR(6),o[3],0,0,0), C1,10, (void)0); \
    GAPC(o[2]=__builtin_amdgcn_mfma_f32_32x32x16_bf16(PAF(3),VFR(3),o[2],0,0,0), C1,12, (void)0); \
    GAPC(o[3]=__builtin_amdgcn_mfma_f32_32x32x16_bf16(PAF(3),VFR(7),o[3],0,0,0), C1,14, (void)0); \
    } \
    }while(0)
  #define WB_FULL() do{ if constexpr(DV==128){WAIT_BAR(3);}else{WAIT_BAR(2);} }while(0)
  int t=1;
  #undef CMASK
  #define CMASK(P0,P1,t) do{}while(0)
  for(;t+5<NT;t+=2){
    STEP(pB0,pB1,pA0,pA1,t,true,true,true,0);     WB_FULL(); RESC(); ROT();
    STEP(pA0,pA1,pB0,pB1,t+1,true,true,true,0);   WB_FULL(); RESC(); ROT();
  }
  #undef CMASK
  #define CMASK(P0,P1,t) do{int jb_=(t)-(NT-4); if(jb_>=0)cmask(P0,P1,jb_,qrel,hi);}while(0)
  #define ENDW(tt) do{ if((tt)+3<NT){WB_FULL();} else if((tt)+2<NT){ if constexpr(DV==128){WAIT_BAR(2);}else{WAIT_BAR(1);} } else {WAIT_BAR(0);} }while(0)
  for(;t+1<NT;t+=2){
    STEP(pB0,pB1,pA0,pA1,t,(t+3<NT),(t+1<NT),(t+1<NT),1);       ENDW(t);   RESC(); ROT();
    STEP(pA0,pA1,pB0,pB1,t+1,(t+4<NT),(t+2<NT),(t+2<NT),1);     ENDW(t+1); RESC(); ROT();
  }
  STEP(pB0,pB1,pA0,pA1,NT-1,false,false,false,1); RESC();
  { float sacc=pB0[0]+pB0[1]; _Pragma("unroll") for(int r=2;r<16;++r)sacc+=pB0[r]; _Pragma("unroll") for(int r=0;r<16;++r)sacc+=pB1[r]; l_reg+=sacc;
    pw0=(u32x4){PKW(pB0,0),PKW(pB0,2),PKW(pB0,4),PKW(pB0,6)};pw1=(u32x4){PKW(pB0,8),PKW(pB0,10),PKW(pB0,12),PKW(pB0,14)};pw2=(u32x4){PKW(pB1,0),PKW(pB1,2),PKW(pB1,4),PKW(pB1,6)};pw3=(u32x4){PKW(pB1,8),PKW(pB1,10),PKW(pB1,12),PKW(pB1,14)};
    SBAR(); pv<NO>(o,vb0+sl_cur*VM,PAF(0),PAF(1),PAF(2),PAF(3)); }
  #undef PKW
  #undef PAF
  #undef VFR
  #undef PIN
  #undef MX3
  #undef GAPA
  #undef GAPB
  #undef EX
  #undef VRD
  #undef VRD2
  #undef GAPC
  #undef KRD
  #undef STEP
  #undef CIN
  #undef ENDW
  #undef WB_FULL
  {auto rr=__builtin_amdgcn_permlane32_swap(__float_as_uint(l_reg),__float_as_uint(l_reg),false,false);l_reg=__uint_as_float(rr[0])+__uint_as_float(rr[1]);}
  if(hi==0)wsf[32+r32]=l_reg;asm volatile("s_waitcnt lgkmcnt(0)":::"memory");
  float rli[16];
  #pragma unroll
  for(int r=0;r<16;++r)rli[r]=__builtin_amdgcn_rcpf(wsf[32+crow(r,hi)]);
  bf16*Ow=Ob+(long)(q0+wid*QBLK)*OP;
  { bf16*stg=(bf16*)(shm+Lay<DV>::OST)+wid*2048;
    #pragma unroll
    for(int ps=0;ps<NO/2;++ps){
    #pragma unroll
    for(int r=0;r<16;++r){const int orow=crow(r,hi);
      #pragma unroll
      for(int d0=0;d0<2;++d0)stg[orow*64+d0*32+r32]=__float2bfloat16(o[2*ps+d0][r]*rli[r]);}
    asm volatile("s_waitcnt lgkmcnt(0)":::"memory");
    #pragma unroll
    for(int i=0;i<4;++i){const int row=i*8+(lane>>3),ch=lane&7; const u32x4 v=*(const u32x4*)(stg+row*64+ch*8); ATTN_STORE16(Ow+(long)row*OP+ps*64+ch*8,v);}
    asm volatile("s_waitcnt lgkmcnt(0)":::"memory"); } }
  asm volatile("s_waitcnt lgkmcnt(0)\n\ts_barrier":::"memory");
  #undef DMA_K
  #undef DMA_V
  #undef CMASK
  #undef START
  #undef RESC
  #undef ROT
}
constexpr int ATTN_LDS_BYTES=Lay<64>::BYTES>Lay<128>::BYTES?Lay<64>::BYTES:Lay<128>::BYTES;
#undef SBAR
#undef WAIT_BAR
}
__device__ __forceinline__ void diffc_item(Frame& F, int l, int b, int h, int qb) {
    const int lane = fresh_lane(); int w = F.wave0; asm volatile("" : "+s"(w));
    const float* lq1 = (const float*)F.in[I_LQ1] + l * 64; const float* lk1 = (const float*)F.in[I_LK1] + l * 64;
    const float* lq2 = (const float*)F.in[I_LQ2] + l * 64; const float* lk2 = (const float*)F.in[I_LK2] + l * 64;
    int ll = l; asm volatile("" : "+s"(ll));
    const float li = lambda_init_of(ll); const float oml = ll == 0 ? 1.0f - lambda_init_of(0) : 1.0f - lambda_init_of(1);
    const float lamv = __builtin_amdgcn_exp2f(LOG2E * wave_sum(lq1[lane] * lk1[lane], lane)) - __builtin_amdgcn_exp2f(LOG2E * wave_sum(lq2[lane] * lk2[lane], lane)) + li;
    const float lam = __builtin_bit_cast(float, __builtin_amdgcn_readfirstlane(__builtin_bit_cast(int, lamv)));
    const float* sub = (const float*)F.in[I_SUBLN] + l * 128;
    const bf16* OA = (const bf16*)(F.ws + WS_OA); bf16* AD = (bf16*)(F.ws + WS_AD);
    const int d0 = (lane & 15) * 8;
    float sg[8];
#pragma unroll
    for (int e = 0; e < 8; ++e) sg[e] = sub[d0 + e] * oml;
    const size_t row0 = (size_t)b * SEQ + (size_t)qb * 256 + w * 32 + (lane >> 4);
    v4u a_[8], b_[8];
#pragma unroll
    for (int q = 0; q < 8; ++q) { const bf16* src = OA + (row0 + q * 4) * 1024 + h * 128 + d0;
        asm volatile("global_load_dwordx4 %0, %2, off sc1\n\tglobal_load_dwordx4 %1, %2, off offset:1024 sc1" : "=&v"(a_[q]), "=&v"(b_[q]) : "v"(src) : "memory"); }
    asm volatile("s_waitcnt vmcnt(0)" : "+v"(a_[0]), "+v"(a_[1]), "+v"(a_[2]), "+v"(a_[3]), "+v"(a_[4]), "+v"(a_[5]), "+v"(a_[6]), "+v"(a_[7]), "+v"(b_[0]), "+v"(b_[1]), "+v"(b_[2]), "+v"(b_[3]), "+v"(b_[4]), "+v"(b_[5]), "+v"(b_[6]), "+v"(b_[7]) :: "memory");
#pragma unroll
    for (int q = 0; q < 8; ++q) { const v4u a = a_[q], bb = b_[q];
        typedef float f32x2_ __attribute__((ext_vector_type(2)));
        f32x2_ vv[4]; float ss = 0.f;
#pragma unroll
        for (int k = 0; k < 4; ++k) { const f32x2_ av = {bflo(a[k]), bfhi(a[k])}, bv = {bflo(bb[k]), bfhi(bb[k])}; vv[k] = av - lam * bv; ss += vv[k].x * vv[k].x + vv[k].y * vv[k].y; }
        ss += shx(ss, 1, lane); ss += shx(ss, 2, lane); ss += shx(ss, 4, lane); ss += shx(ss, 8, lane);
        const float r = __builtin_amdgcn_rsqf(ss * (1.0f / 128.0f) + EPS);
        v4u o;
#pragma unroll
        for (int k = 0; k < 4; ++k) o[k] = pk2(vv[k].x * r * sg[2 * k], vv[k].y * r * sg[2 * k + 1]);
        *(v4u*)(AD + (row0 + q * 4) * 512 + h * 128 + d0) = o; }
}
#define DIFF_HANDOFF(qb_) do { VM_WAIT(); __syncthreads(); volatile LAS unsigned* qw_ = F.MISC + 16; \
        if (fresh_tid(F.wave0) == 0) qw_[0] = __hip_atomic_fetch_add(F.ctl + CW_DCNT + ((((l * BATCH + b) * 4 + (m & 3)) * 32 + (qb_)) * DCNT_STRIDE), 1u, __ATOMIC_RELEASE, __HIP_MEMORY_SCOPE_AGENT); \
        __syncthreads(); const unsigned old_ = qw_[0]; __syncthreads(); \
        if (old_ == 1u) diffc_item(F, l, b, m & 3, (qb_)); } while (0)
template <int AVAR = 0> __device__ __forceinline__ void phase_attn(Frame& F, int l) {
    const attn_body::bf16* QKVG = (const attn_body::bf16*)(F.ws + WS_QKVG);
    attn_body::bf16* OA = (attn_body::bf16*)(F.ws + WS_OA); attn_body::bf16* OFp = (attn_body::bf16*)(F.ws + WS_OF);
    const float* CUM = (const float*)(F.ws + WS_CUM);
    char* shm = (char*)(F.lds + RING_OFF);
    bool noref;
    { const int ln = fresh_lane();
      const float* gtd = (const float*)(F.ws + WS_GT) + l * 256; float gq = fabsf(gtd[ln]), gk = fabsf(gtd[64 + ln]);
#pragma unroll
      for (int o = 1; o < 64; o <<= 1) { gq = fmaxf(gq, shx(gq, o, ln)); gk = fmaxf(gk, shx(gk, o, ln)); }
      noref = __builtin_amdgcn_readfirstlane((int)(1.02f * 64.0f * gq * gk < 100.0f)) != 0; }
    if (AVAR & 1) {} else if (noref) {
        for (int p = F.vcu; p < 256; p += F.G) {
            const int he = p >> 4, x = p & 15, b = he >> 3, m = he & 7;
            const attn_body::bf16* base = QKVG + (size_t)b * SEQ * NP;
#pragma unroll 1
            for (int s2 = 0; s2 < 2; ++s2) {
                attn_body::attn_unit<8, false, 1024, 128, true>(s2 == 0 ? 31 - x : x, base + C_QA + m * 64, base + C_KA + m * 64, base + C_VA + (m & 3) * 128, OA + (size_t)b * SEQ * 1024 + m * 128, nullptr, 0.f, shm, F.wave0);
                DIFF_HANDOFF(s2 == 0 ? 31 - x : x);
            }
        }
    } else {
        for (int p = F.vcu; p < 256; p += F.G) {
            const int he = p >> 4, x = p & 15, b = he >> 3, m = he & 7;
            const attn_body::bf16* base = QKVG + (size_t)b * SEQ * NP;
#pragma unroll 1
            for (int s2 = 0; s2 < 2; ++s2) {
                attn_body::attn_unit<8, false, 1024, 128, false>(s2 == 0 ? 31 - x : x, base + C_QA + m * 64, base + C_KA + m * 64, base + C_VA + (m & 3) * 128, OA + (size_t)b * SEQ * 1024 + m * 128, nullptr, 0.f, shm, F.wave0);
                DIFF_HANDOFF(s2 == 0 ? 31 - x : x);
            }
        }
    }
    float thr2;
    { const int ln = fresh_lane();
      const float* gtf = (const float*)(F.ws + WS_GT) + l * 256 + 128; float gq = fabsf(gtf[ln]), gk = fabsf(gtf[64 + ln]);
#pragma unroll
      for (int o = 1; o < 64; o <<= 1) { gq = fmaxf(gq, shx(gq, o, ln)); gk = fmaxf(gk, shx(gk, o, ln)); }
      thr2 = __builtin_bit_cast(float, __builtin_amdgcn_readfirstlane(__builtin_bit_cast(int, 150.0f + 2.0f * 1.02f * 64.0f * gq * gk + 8.0f))); }
    if (!(AVAR & 2)) {
        unsigned* qctr = F.ctl + CW_FOXQ + 16 * l; volatile LAS unsigned* qw = F.MISC + 16;
        for (;;) {
            if (fresh_tid(F.wave0) == 0) qw[0] = __hip_atomic_fetch_add(qctr, 1u, __ATOMIC_RELAXED, __HIP_MEMORY_SCOPE_AGENT);
            __syncthreads();
            const int u = (int)qw[0];
            __syncthreads();
            if (u >= 512) break;
            const int qb = 31 - (u >> 4), hf = u & 15, b = hf >> 3, h = hf & 7;
            const attn_body::bf16* base = QKVG + (size_t)b * SEQ * NP;
            attn_body::attn_unit<8, true, 512, 64, false>(qb, base + C_QF + h * 64, base + C_KF + h * 64, base + C_VF + h * 64, OFp + (size_t)b * SEQ * 512 + h * 64, CUM + ((size_t)b * 8 + h) * SEQ, (AVAR & 4) ? 1e30f : thr2, shm, F.wave0, -1);
        }
    }
}
#if BUILD_ORACLE
namespace orc {
__device__ __forceinline__ void tile_mm(const bf16* A, int lda, const int* arow  , const bf16* B, int ldb, int brow0, int K, float (*sA)[68], float (*sB)[68], float (&acc)[4][4]) {
    const int tid = threadIdx.x, ty = tid >> 4, tx = tid & 15, lr = tid >> 2, lc = (tid & 3) * 8;
    for (int k0 = 0; k0 < K; k0 += 32) {
        __syncthreads();
        { const int ar = arow[lr]; v4u a = (v4u){0u, 0u, 0u, 0u}; if (ar >= 0) a = *(const v4u*)(A + (size_t)ar * lda + k0 + lc);
          const v4u b = *(const v4u*)(B + (size_t)(brow0 + lr) * ldb + k0 + lc);
          sA[lc + 0][lr] = bflo(a.x); sA[lc + 1][lr] = bfhi(a.x); sA[lc + 2][lr] = bflo(a.y); sA[lc + 3][lr] = bfhi(a.y); sA[lc + 4][lr] = bflo(a.z); sA[lc + 5][lr] = bfhi(a.z); sA[lc + 6][lr] = bflo(a.w); sA[lc + 7][lr] = bfhi(a.w);
          sB[lc + 0][lr] = bflo(b.x); sB[lc + 1][lr] = bfhi(b.x); sB[lc + 2][lr] = bflo(b.y); sB[lc + 3][lr] = bfhi(b.y); sB[lc + 4][lr] = bflo(b.z); sB[lc + 5][lr] = bfhi(b.z); sB[lc + 6][lr] = bflo(b.w); sB[lc + 7][lr] = bfhi(b.w); }
        __syncthreads();
#pragma unroll 8
        for (int kk = 0; kk < 32; ++kk) { const f32x4 a = *(const f32x4*)&sA[kk][ty * 4], b = *(const f32x4*)&sB[kk][tx * 4];
#pragma unroll
            for (int i = 0; i < 4; ++i)
#pragma unroll
                for (int j = 0; j < 4; ++j) acc[i][j] += a[i] * b[j]; }
    }
}
__device__ __forceinline__ void put_tile(float (*Ct)[65], const float (&acc)[4][4]) {
    const int tid = threadIdx.x, ty = tid >> 4, tx = tid & 15;
#pragma unroll
    for (int i = 0; i < 4; ++i)
#pragma unroll
        for (int j = 0; j < 4; ++j) Ct[ty * 4 + i][tx * 4 + j] = acc[i][j];
}
#define ORC_SHARED __shared__ float sA[32][68]; __shared__ float sB[32][68]; __shared__ float Ct[64][65]; __shared__ int arow[64];
#define ZACC(a) _Pragma("unroll") for (int i_ = 0; i_ < 4; ++i_) _Pragma("unroll") for (int j_ = 0; j_ < 4; ++j_) a[i_][j_] = 0.f

__global__ void __launch_bounds__(256) inproj(Args a, int l) {
    ORC_SHARED
    const int n0 = blockIdx.x * 64, m0 = blockIdx.y * 64, tid = threadIdx.x;
    const bf16* HN = (const bf16*)(a.ws + WS_HN); const bf16* W = (const bf16*)(a.ws + WS_WIN) + (size_t)l * NP * D; bf16* QKVG = (bf16*)(a.ws + WS_QKVG);
    if (tid < 64) arow[tid] = m0 + tid;
    float acc[4][4]; ZACC(acc);
    tile_mm(HN, D, arow, W, D, n0, D, sA, sB, acc);
    put_tile(Ct, acc); __syncthreads();
    if (tid < 64) {
        const int row = m0 + tid, seg = n0 / 512; float v[64];
#pragma unroll
        for (int s = 0; s < 64; ++s) v[s] = Ct[tid][s];
        if (seg == 0 || seg == 1 || seg == 3 || seg == 4) {
            float ss = 0.f;
#pragma unroll
            for (int s = 0; s < 64; ++s) ss += v[s] * v[s];
            const float rs = 1.0f / sqrtf(ss * (1.0f / 64.0f) + EPS);
            const float* g = (const float*)a.in[seg == 0 ? I_QND : seg == 1 ? I_KND : seg == 3 ? I_QNF : I_KNF] + l * 64;
            const bool diff = seg < 2;
#pragma unroll
            for (int s = 0; s < 64; ++s) { const int d = (diff && s < 32) ? pi32(s) : s; v[s] = v[s] * rs * g[d]; }
            if (diff) { const float* cs = (const float*)(a.ws + WS_COSSIN) + (size_t)row * 16;
#pragma unroll
                for (int i = 0; i < 8; ++i) { const int s1 = pi32(i), s2 = pi32(i + 8); const float t1 = v[s1], t2 = v[s2], c = cs[i], sn = cs[8 + i]; v[s1] = t1 * c - t2 * sn; v[s2] = t2 * c + t1 * sn; } }
            if (seg == 0 || seg == 3) {
#pragma unroll
                for (int s = 0; s < 64; ++s) v[s] *= C2; }
        } else if (seg >= 6) {
#pragma unroll
            for (int s = 0; s < 64; ++s) v[s] = 1.0f / (1.0f + expf(-v[s]));
        }
#pragma unroll
        for (int s = 0; s < 64; s += 2) *(unsigned*)(QKVG + (size_t)row * NP + n0 + s) = pk2(v[s], v[s + 1]);
    }
}
struct AttnP { const bf16* Q; const bf16* K; const bf16* V; bf16* O; int qc, kc, vc, oc, opitch; int bias; };
__global__ void __launch_bounds__(256) attn(Args a, int mode  ) {
    __shared__ float sK[64][64]; __shared__ float sV[64][64]; __shared__ float sC[64];
    const int qb = blockIdx.x, he = blockIdx.y, tid = threadIdx.x;
    const bf16* QKVG = (const bf16*)(a.ws + WS_QKVG);
    int b, qc, kc, vc, oc, opitch; bf16* O; const float* cum = nullptr;
    if (mode == 0) { b = he / 16; const int r = he % 16, m = r >> 1, vh = r & 1; qc = C_QA + m * 64; kc = C_KA + m * 64; vc = C_VA + (m & 3) * 128 + vh * 64; O = (bf16*)(a.ws + WS_OA); oc = m * 128 + vh * 64; opitch = 1024; }
    else { b = he / 8; const int h = he % 8; qc = C_QF + h * 64; kc = C_KF + h * 64; vc = C_VF + h * 64; O = (bf16*)(a.ws + WS_OF); oc = h * 64; opitch = 512; cum = (const float*)(a.ws + WS_CUM) + ((size_t)b * 8 + h) * SEQ; }
    const int q0 = qb * 256, qi = q0 + tid; const size_t rowg = (size_t)b * SEQ + qi;
    float q[64], o[64];
#pragma unroll
    for (int d = 0; d < 64; ++d) { q[d] = bf2f(QKVG[rowg * NP + qc + d]); o[d] = 0.f; }
    const float cq = cum ? cum[qi] : 0.f;
    float m = -INFINITY, lsum = 0.f;
    const int nkt = (q0 + 256) / 64;
    for (int kt = 0; kt < nkt; ++kt) {
        __syncthreads();
        { const int r = tid >> 2, c0 = (tid & 3) * 16; const size_t kr = (size_t)b * SEQ + kt * 64 + r;
#pragma unroll
          for (int c = 0; c < 16; ++c) { sK[r][c0 + c] = bf2f(QKVG[kr * NP + kc + c0 + c]); sV[r][c0 + c] = bf2f(QKVG[kr * NP + vc + c0 + c]); }
          if (tid < 64) sC[tid] = cum ? cum[kt * 64 + tid] : 0.f; }
        __syncthreads();
        for (int j = 0; j < 64; ++j) {
            const int key = kt * 64 + j;
            if (key <= qi) {
                float s = 0.f;
#pragma unroll
                for (int d = 0; d < 64; ++d) s += q[d] * sK[j][d];
                s += cq - sC[j];
                if (s > m) { const float corr = exp2f(m - s); lsum *= corr;
#pragma unroll
                    for (int d = 0; d < 64; ++d) o[d] *= corr;
                    m = s; }
                const float p = exp2f(s - m); lsum += p;
#pragma unroll
                for (int d = 0; d < 64; ++d) o[d] += p * sV[j][d];
            }
        }
    }
    const float inv = 1.0f / lsum;
#pragma unroll
    for (int d = 0; d < 64; d += 2) *(unsigned*)(O + rowg * opitch + oc + d) = pk2(o[d] * inv, o[d + 1] * inv);
}
__global__ void __launch_bounds__(256) yz(Args a, int l) {
    ORC_SHARED
    __shared__ float Ct2[64][65];
    const int n0 = blockIdx.x * 64, m0 = blockIdx.y * 64, tid = threadIdx.x;
    if (tid < 64) arow[tid] = m0 + tid;
    float acc[4][4], acc2[4][4]; ZACC(acc); ZACC(acc2);
    tile_mm((const bf16*)(a.ws + WS_AD), 512, arow, (const bf16*)(a.ws + WS_WD) + (size_t)l * D * 512, 512, n0, 512, sA, sB, acc);
    tile_mm((const bf16*)(a.ws + WS_OF), 512, arow, (const bf16*)(a.ws + WS_WF) + (size_t)l * D * 512, 512, n0, 512, sA, sB, acc2);
    put_tile(Ct, acc); put_tile(Ct2, acc2); __syncthreads();
    const bf16* QKVG = (const bf16*)(a.ws + WS_QKVG); bf16* Z = (bf16*)(a.ws + WS_Z);
    if (tid < 64) { const int row = m0 + tid;
        for (int s = 0; s < 64; ++s) { const float ga = bf2f(QKVG[(size_t)row * NP + C_GA + n0 + s]), gf = bf2f(QKVG[(size_t)row * NP + C_GF + n0 + s]);
            Z[(size_t)row * D + n0 + s] = (bf16)f2bf(ga * Ct[tid][s] + gf * Ct2[tid][s]); } }
}
__global__ void __launch_bounds__(256) wo(Args a, int l) {
    ORC_SHARED
    const int n0 = blockIdx.x * 64, m0 = blockIdx.y * 64, tid = threadIdx.x;
    if (tid < 64) arow[tid] = m0 + tid;
    float acc[4][4]; ZACC(acc);
    tile_mm((const bf16*)(a.ws + WS_Z), D, arow, (const bf16*)(a.ws + WS_WO) + (size_t)l * D * D, D, n0, D, sA, sB, acc);
    put_tile(Ct, acc); __syncthreads();
    if (tid < 64) { const int row = m0 + tid; for (int s = 0; s < 64; ++s) a.out[(size_t)row * D + n0 + s] += Ct[tid][s]; }
}
__device__ __forceinline__ int find_expert(const unsigned* cnt, int t256, int& tile_in_e, int& cnt_e) {
    int off = 0;
    for (int e = 0; e < NEXP; ++e) { const int c = (int)cnt[e * CNT_STRIDE], nt = (c + 255) >> 8; if (t256 < off + nt) { tile_in_e = t256 - off; cnt_e = c; return e; } off += nt; }
    return -1;
}
__global__ void __launch_bounds__(256) gateup(Args a, int l) {
    ORC_SHARED
    __shared__ float Ct2[64][65]; __shared__ int asg[64];
    const int f0 = blockIdx.x * 64, m64 = blockIdx.y, tid = threadIdx.x;
    const unsigned* cnt = (const unsigned*)(a.ws + WS_CTL) + CW_CNT + (size_t)l * NEXP * CNT_STRIDE;
    int tie, ce; const int e = find_expert(cnt, m64 >> 2, tie, ce);
    if (e < 0) return;
    const int* LIST = (const int*)(a.ws + WS_LIST) + (size_t)e * T;
    if (tid < 64) { const int r = tie * 256 + (m64 & 3) * 64 + tid; const int as = r < ce ? LIST[r] : -1; asg[tid] = as; arow[tid] = as < 0 ? -1 : (as >> 1); }
    __syncthreads();
    const bf16* W = (const bf16*)(a.ws + WS_WGU) + ((size_t)l * NEXP + e) * 1024 * 1024;
    const int brow = (f0 >> 7) * 256 + (f0 & 127);
    float acc[4][4], acc2[4][4]; ZACC(acc); ZACC(acc2);
    tile_mm((const bf16*)(a.ws + WS_HN), D, arow, W, D, brow, D, sA, sB, acc);
    tile_mm((const bf16*)(a.ws + WS_HN), D, arow, W, D, brow + 128, D, sA, sB, acc2);
    put_tile(Ct, acc); put_tile(Ct2, acc2); __syncthreads();
    bf16* HID = (bf16*)(a.ws + WS_HID); const float* GWT = (const float*)(a.ws + WS_GWT);
    if (tid < 64) { const int as = asg[tid]; const float w = as < 0 ? 0.f : GWT[as]; const size_t hr = (size_t)m64 * 64 + tid;
        for (int s = 0; s < 64; ++s) { const float g = Ct[tid][s], u = Ct2[tid][s]; const float h = as < 0 ? 0.f : (g / (1.0f + expf(-g))) * u * w; HID[hr * FF + f0 + s] = (bf16)f2bf(h); } }
}
__global__ void __launch_bounds__(256) down(Args a, int l) {
    ORC_SHARED
    __shared__ int asg[64];
    const int n0 = blockIdx.x * 64, m64 = blockIdx.y, tid = threadIdx.x;
    const unsigned* cnt = (const unsigned*)(a.ws + WS_CTL) + CW_CNT + (size_t)l * NEXP * CNT_STRIDE;
    int tie, ce; const int e = find_expert(cnt, m64 >> 2, tie, ce);
    if (e < 0) return;
    const int* LIST = (const int*)(a.ws + WS_LIST) + (size_t)e * T;
    if (tid < 64) { const int r = tie * 256 + (m64 & 3) * 64 + tid; asg[tid] = r < ce ? LIST[r] : -1; arow[tid] = m64 * 64 + tid; }
    __syncthreads();
    float acc[4][4]; ZACC(acc);
    tile_mm((const bf16*)(a.ws + WS_HID), FF, arow, (const bf16*)(a.ws + WS_WDN) + ((size_t)l * NEXP + e) * 1024 * 512, FF, n0, FF, sA, sB, acc);
    put_tile(Ct, acc); __syncthreads();
    bf16* Y = (bf16*)(a.ws + WS_Y);
    if (tid < 64) { const int as = asg[tid]; if (as >= 0) { const size_t base = (size_t)(as & 1) * T * D + (size_t)(as >> 1) * D + n0;
        for (int s = 0; s < 64; ++s) Y[base + s] = (bf16)f2bf(Ct[tid][s]); } }
}
}
#endif
#define XB_TMO      128
#define XB_XCNT(j)  (256  + 64 * (j))
#define XB_XSUB(j)  (1280 + 64 * (j))
#define XB_XGEN(j)  (2304 + 64 * (j))
#define XB_TOP      3328
#define XB_TOPGEN   3392
#define XCD_BAR_WORDS 3456
#define XB_SPIN_CAP (1u << 18)
__device__ __forceinline__ unsigned xb_ld(unsigned* p)              { return __hip_atomic_load(p, __ATOMIC_RELAXED, __HIP_MEMORY_SCOPE_AGENT); }
__device__ __forceinline__ unsigned xb_add(unsigned* p, unsigned v) { return __hip_atomic_fetch_add(p, v, __ATOMIC_RELAXED, __HIP_MEMORY_SCOPE_AGENT); }
__device__ __forceinline__ unsigned xb_xcc_id() { return (unsigned)__builtin_amdgcn_s_getreg((3 << 11) | 20) & 0xFu; }
#define XB_SPIN(cond, bar) do { unsigned _sp = 0; while (cond) { __builtin_amdgcn_s_sleep(1); \
    if ((++_sp & 255u) == 0u) { if (xb_ld(&(bar)[XB_TMO])) break; if (_sp > XB_SPIN_CAP) { atomicAdd(&(bar)[XB_TMO], 1u); break; } } } } while (0)
struct XcdBarrier { unsigned* bar; unsigned x; volatile LAS unsigned* st; };
__device__ __forceinline__ XcdBarrier xcd_barrier_post(unsigned* bar, volatile LAS unsigned* st, const int tid) {
    XcdBarrier b; b.bar = bar; b.x = xb_xcc_id(); b.st = st;
    if (tid == 0) (void)xb_add(&bar[XB_XCNT(b.x)], 1u);
    return b;
}
__device__ __forceinline__ void xcd_barrier_complete(unsigned* bar, unsigned x, unsigned& nloc, unsigned& nx) {
    const unsigned G = gridDim.x * gridDim.y * gridDim.z;
    unsigned sum, cnt, mine, sp = 0u;
    for (;;) {
        sum = 0u; cnt = 0u; mine = 0u;
#pragma unroll
        for (unsigned j = 0; j < 16; ++j) { const unsigned c = xb_ld(&bar[XB_XCNT(j)]); sum += c; cnt += (c > 0u) ? 1u : 0u; mine = (j == x) ? c : mine; }
        if (sum == G) break;
        __builtin_amdgcn_s_sleep(1);
        if ((++sp & 255u) == 0u) { if (xb_ld(&bar[XB_TMO])) break; if (sp > XB_SPIN_CAP) { atomicAdd(&bar[XB_TMO], 1u); break; } }
    }
    nloc = mine > 0u ? mine : 1u; nx = cnt > 0u ? cnt : 1u;
}
__device__ __forceinline__ void xcd_barrier(const XcdBarrier& b, const int tid) {
    asm volatile("s_waitcnt vmcnt(0)" ::: "memory");
    __syncthreads();
    if (tid == 0) {
        unsigned* bar = b.bar;
        __builtin_amdgcn_s_waitcnt(0);
        unsigned nloc = b.st[0], nx = b.st[1];
        if (nloc == 0u) { xcd_barrier_complete(bar, b.x, nloc, nx); b.st[0] = nloc; b.st[1] = nx; }
        const unsigned old = xb_add(&bar[XB_XSUB(b.x)], 1u);
        const unsigned gen = old / nloc;
        if (old + 1u == (gen + 1u) * nloc) {
            __builtin_amdgcn_fence(__ATOMIC_RELEASE, "agent");
            asm volatile("s_waitcnt vmcnt(0)" ::: "memory");
            const unsigned og = xb_add(&bar[XB_TOP], 1u);
            const unsigned tg = og / nx;
            if (og + 1u == (tg + 1u) * nx) xb_add(&bar[XB_TOPGEN], 1u);
            else XB_SPIN(xb_ld(&bar[XB_TOPGEN]) == tg, bar);
            __builtin_amdgcn_fence(__ATOMIC_ACQUIRE, "agent");
            xb_add(&bar[XB_XGEN(b.x)], 1u);
            asm volatile("s_waitcnt vmcnt(0)" ::: "memory");
        } else {
            XB_SPIN(xb_ld(&bar[XB_XGEN(b.x)]) == gen, bar);
            __builtin_amdgcn_fence(__ATOMIC_ACQUIRE, "agent");
            asm volatile("s_waitcnt vmcnt(0)" ::: "memory");
        }
    }
    __syncthreads();
}

__global__ void __launch_bounds__(NWAVES * 64, 2) mega(Args args) {
    extern __shared__ __attribute__((aligned(16))) unsigned char lds[];
    Frame F;
    F.lds = (LAS unsigned char*)lds;
    F.MISC = (volatile LAS unsigned*)(F.lds + MISC_OFF);
    F.wave0 = __builtin_amdgcn_readfirstlane((int)threadIdx.x >> 6);
    F.tid = fresh_tid(F.wave0); F.lane = F.tid & 63; F.wave = F.wave0;
    F.G = gridDim.x; { const int bx = blockIdx.x; F.vcu = (F.G % 8 == 0) ? (bx % 8) * (F.G / 8) + bx / 8 : bx; }
    F.in = args.in; F.out = args.out; F.ws = args.ws; F.ctl = (unsigned*)(args.ws + WS_CTL);
    for (int u = F.tid; u < (LDS_BYTES - LDSCTL_OFF) / 4; u += NWAVES * 64) ((LAS unsigned*)(F.lds + LDSCTL_OFF))[u] = 0u;
    __syncthreads();
    const int vcu0 = F.vcu;
    const int lo = args.ph_lo, hi = args.ph_hi;
    const bool multi = (hi - lo) > 1;
    XcdBarrier bar; bar.bar = F.ctl + CW_BAR; bar.x = 0; bar.st = nullptr;
    if (multi) bar = xcd_barrier_post(F.ctl + CW_BAR, F.MISC + 8, F.tid);
#define IN(k) (lo <= (k) && (k) < hi)
#define FRESH() do { { int w0_ = F.wave0; asm volatile("" : "+s"(w0_)); F.wave = w0_; F.lane = fresh_lane(); F.tid = w0_ * 64 + F.lane; } \
    { unsigned char* w_ = args.ws; float* o_ = args.out; asm volatile("" : "+s"(w_), "+s"(o_)); F.ws = w_; F.out = o_; F.ctl = (unsigned*)(w_ + WS_CTL); int v_ = vcu0, g_ = (int)gridDim.x, b_ = (int)blockIdx.x; asm volatile("" : "+s"(v_), "+s"(g_), "+s"(b_)); F.vcu = v_; F.G = g_; F.bx = b_; } } while (0)
#ifndef DUP_MASK
#define DUP_MASK 0
#endif
#define DUP(k) if ((DUP_MASK >> (k)) & 1)
#define SEAM(k) do { if (IN(k) && IN((k) + 1)) { xcd_barrier(bar, fresh_tid(F.wave0)); DUP(13) xcd_barrier(bar, fresh_tid(F.wave0)); } } while (0)
    if (IN(PH_PRO)) { FRESH(); phase_prologue(F); DUP(15) { __syncthreads(); FRESH(); phase_prologue(F); } }
    SEAM(PH_PRO);
    for (int l = 0; l < DEPTH; ++l) {
        const int pb = 1 + PH_PER_LAYER * l;
        if (IN(pb + K_NORM1)) { FRESH(); phase_normgemm<0>(F, l); }
        SEAM(pb + K_NORM1);
        if (IN(pb + K_CUMSUM)) { FRESH(); phase_cumsum(F); DUP(K_CUMSUM) { __syncthreads(); FRESH(); phase_cumsum(F); } }
        if (IN(pb + K_INPROJ)) { FRESH(); phase_inproj(F, l); DUP(K_INPROJ) { __syncthreads(); FRESH(); phase_inproj(F, l); } }
        SEAM(pb + K_INPROJ);
        if (IN(pb + K_ATTN)) { FRESH(); phase_attn<0>(F, l); }
        SEAM(pb + K_ATTN);
        if (IN(pb + K_YZ)) { FRESH(); phase_yz(F, l); DUP(K_YZ) { __syncthreads(); FRESH(); phase_yz(F, l); } }
        SEAM(pb + K_YZ);
        if (IN(pb + K_WO)) { FRESH(); phase_wo(F, l);  }
        SEAM(pb + K_WO);
        if (IN(pb + K_ROUTER)) { FRESH(); phase_router2(F, l); }
        SEAM(pb + K_ROUTER);
        if (IN(pb + K_GATEUP)) { FRESH(); phase_gateup(F, l); DUP(K_GATEUP) { __syncthreads(); FRESH(); phase_gateup(F, l); } }
#if MOE_BARRIER
        SEAM(pb + K_GATEUP);
#else
        __syncthreads();
#endif
        if (IN(pb + K_DOWN)) { FRESH(); phase_down(F, l); DUP(K_DOWN) { __syncthreads(); FRESH(); phase_down(F, l); } }
        SEAM(pb + K_DOWN);
    }
#ifndef TAIL_VAR
#define TAIL_VAR 0
#endif
#ifndef TAIL_MASK
#define TAIL_MASK 0
#endif
#define TAILP(k, call) do { if ((TAIL_MASK >> (k)) & 1) { xcd_barrier(bar, fresh_tid(F.wave0)); FRESH(); call; } } while (0)
    if (IN(PH_FINAL)) { FRESH(); phase_final(F); DUP(14) { __syncthreads(); FRESH(); phase_final(F, true); } }
    if (multi && TAIL_MASK) { const int l = 1;
        TAILP(15, phase_prologue(F)); TAILP(K_CUMSUM, phase_cumsum(F)); TAILP(K_INPROJ, phase_inproj(F, l)); TAILP(K_ATTN, phase_attn<TAIL_VAR>(F, l));
        TAILP(K_DIFFC, phase_diffc(F, l)); TAILP(K_YZ, phase_yz(F, l)); TAILP(K_WO, phase_wo(F, l, true)); TAILP(K_ROUTER, phase_router2(F, l, true)); TAILP(K_GATEUP, phase_gateup(F, l)); TAILP(K_DOWN, phase_down(F, l));
        TAILP(14, phase_final(F, true)); }
#undef IN
#undef FRESH
#undef SEAM
#undef DUP
}

#ifndef FAST_MASK
#define FAST_MASK 0
#endif
#ifndef ONE_LAUNCH
#define ONE_LAUNCH 0
#endif
extern "C" void kernel_launch(void* const* d_in, const int* in_sizes, int n_in, void* d_out, int out_size, void* d_ws, size_t ws_size, hipStream_t stream) {
    static int grid = 0;
    if (grid == 0) {
        if (n_in != 25 || in_sizes[0] != T * D || out_size != T * D || ws_size < WS_END) { fprintf(stderr, "kernel_launch: unexpected shapes (n_in %d, in0 %d, out %d, ws %zu); nothing launched\n", n_in, n_in > 0 ? in_sizes[0] : -1, out_size, ws_size); grid = -1; return; }
        int dev = 0, cus = 0, per_cu = 0;
        if (hipGetDevice(&dev) != hipSuccess || hipDeviceGetAttribute(&cus, hipDeviceAttributeMultiprocessorCount, dev) != hipSuccess) { grid = -1; return; }
        if (hipFuncSetAttribute((const void*)mega, hipFuncAttributeMaxDynamicSharedMemorySize, LDS_BYTES) != hipSuccess) { fprintf(stderr, "kernel_launch: hipFuncSetAttribute failed\n"); grid = -1; return; }
        if (hipOccupancyMaxActiveBlocksPerMultiprocessor(&per_cu, (const void*)mega, NWAVES * 64, LDS_BYTES) != hipSuccess || per_cu < 1) { fprintf(stderr, "kernel_launch: occupancy query reports %d\n", per_cu); }
        (void)hipGetLastError();
        grid = cus;
    }
    if (grid < 0) return;
    (void)hipMemsetAsync((char*)d_ws + WS_CTL, 0, CTL_ZERO_BYTES, stream);
    Args a{};
    for (int i = 0; i < 25; ++i) a.in[i] = d_in[i];
    a.out = (float*)d_out; a.ws = (unsigned char*)d_ws;
#if ONE_LAUNCH
    a.ph_lo = 0; a.ph_hi = N_PHASES;
    hipLaunchKernelGGL(mega, dim3(grid), dim3(NWAVES * 64), LDS_BYTES, stream, a);
#else
    for (int p = 0; p < N_PHASES; ++p) {
        const int l = (p - 1) / PH_PER_LAYER, k = (p >= 1 && p < PH_FINAL) ? (p - 1) % PH_PER_LAYER : -1;
        const bool heavy = (k == K_INPROJ || k == K_ATTN || k == K_YZ || k == K_WO || k == K_GATEUP || k == K_DOWN);
#if BUILD_ORACLE
        if (heavy && !((FAST_MASK >> k) & 1)) {
            if (k == K_INPROJ) hipLaunchKernelGGL(orc::inproj, dim3(80, 256), dim3(256), 0, stream, a, l);
            else if (k == K_ATTN) { hipLaunchKernelGGL(orc::attn, dim3(32, 32), dim3(256), 0, stream, a, 0); hipLaunchKernelGGL(orc::attn, dim3(32, 16), dim3(256), 0, stream, a, 1); }
            else if (k == K_YZ) hipLaunchKernelGGL(orc::yz, dim3(16, 256), dim3(256), 0, stream, a, l);
            else if (k == K_WO) hipLaunchKernelGGL(orc::wo, dim3(16, 256), dim3(256), 0, stream, a, l);
            else if (k == K_GATEUP) hipLaunchKernelGGL(orc::gateup, dim3(8, HID_ROWS / 64), dim3(256), 0, stream, a, l);
            else hipLaunchKernelGGL(orc::down, dim3(16, HID_ROWS / 64), dim3(256), 0, stream, a, l);
            continue;
        }
#endif
        a.ph_lo = p; a.ph_hi = p + 1;
        hipLaunchKernelGGL(mega, dim3(grid), dim3(NWAVES * 64), LDS_BYTES, stream, a);
    }
#endif
}
```

```cpp
#define BUILD_ORACLE 0
#define ONE_LAUNCH 1
#include <hip/hip_runtime.h>
#include <cstdio>
#include <cstdint>

constexpr int D = 1024, BATCH = 2, SEQ = 8192, T = BATCH * SEQ, DEPTH = 2;
constexpr int HD = 64, NEXP = 32, FF = 512;
constexpr int INC = 5128;
constexpr int NP = 5120;
constexpr int C_QA = 0, C_KA = 512, C_VA = 1024, C_QF = 1536, C_KF = 2048, C_VF = 2560, C_GA = 3072, C_GF = 4096;
constexpr float EPS = 1e-6f;
constexpr float LOG2E = 1.4426950408889634f;
constexpr float C2 = 0.125f * 1.4426950408889634f;
constexpr int HID_ROWS = 2 * T + NEXP * 256;

constexpr size_t MiB = 1u << 20;
constexpr size_t WS_CTL = 0, CTL_ZERO_BYTES = 128 * 1024;
constexpr size_t WS_FZT = 1 * MiB;
constexpr size_t WS_WRT = 1 * MiB + 128 * 1024;
constexpr size_t WS_GT = 1 * MiB + 640 * 1024;
constexpr size_t WS_LOGF = 2 * MiB;
constexpr size_t WS_CUM = 2 * MiB + 512 * 1024;
constexpr size_t WS_COSSIN = 3 * MiB;
constexpr size_t WS_GWT = 4 * MiB;
constexpr size_t WS_LIST = 5 * MiB;
constexpr size_t WS_WIN = 8 * MiB;
constexpr size_t WS_WD = 28 * MiB;
constexpr size_t WS_WF = 30 * MiB;
constexpr size_t WS_WO = 32 * MiB;
constexpr size_t WS_WGU = 36 * MiB;
constexpr size_t WS_WDN = 164 * MiB;
constexpr size_t WS_QKVG = 228 * MiB;
constexpr size_t WS_HID = 228 * MiB;
constexpr size_t WS_Y = 280 * MiB;
constexpr size_t WS_HN = 388 * MiB;
constexpr size_t WS_AD = 388 * MiB;
constexpr size_t WS_OA = 420 * MiB;
constexpr size_t WS_Z = 420 * MiB;
constexpr size_t WS_OF = 452 * MiB;
constexpr size_t WS_SUMS = 468 * MiB;
constexpr size_t WS_RSTD = 4 * MiB + 256 * 1024;
constexpr size_t WS_END = 484 * MiB;
static_assert(WS_HID + (size_t)HID_ROWS * FF * 2 <= WS_Y && WS_Y + (size_t)2 * T * D * 2 <= WS_HN, "ws map");
constexpr int CW_TMO = 0;
constexpr int CW_CNT = 16384, CNT_STRIDE = 64;
constexpr int CW_BAR = 4096;
constexpr int CW_FOXQ = 128;
static_assert((16384 + 2 * 32 * 64) * 4 <= (int)CTL_ZERO_BYTES, "control words inside the memset");
constexpr int CW_DCNT = 24576, DCNT_STRIDE = 16;
static_assert(CW_DCNT + DEPTH * BATCH * 4 * 32 * DCNT_STRIDE <= (int)(CTL_ZERO_BYTES / 4), "pair counters inside the memset");
constexpr int CW_TCNT = 8192, TCNT_STRIDE = 16, MAX_TILES = HID_ROWS / 256;

typedef unsigned short bf16;
typedef unsigned v4u __attribute__((ext_vector_type(4)));
typedef unsigned v2u __attribute__((ext_vector_type(2)));
typedef float f32x4 __attribute__((ext_vector_type(4)));
#define LAS __attribute__((address_space(3)))
#define GAS __attribute__((address_space(1)))
#define LDS_WAIT() asm volatile("s_waitcnt lgkmcnt(0)" ::: "memory")
#define VM_WAIT() asm volatile("s_waitcnt vmcnt(0)" ::: "memory")

__device__ __forceinline__ unsigned f2bf(float f) { unsigned u = __builtin_bit_cast(unsigned, f); return (u + 0x7fffu + ((u >> 16) & 1u)) >> 16; }
__device__ __forceinline__ unsigned pk2(float lo, float hi) { return f2bf(lo) | (f2bf(hi) << 16); }
__device__ __forceinline__ float bflo(unsigned w) { return __uint_as_float(w << 16); }
__device__ __forceinline__ float bfhi(unsigned w) { return __uint_as_float(w & 0xffff0000u); }
__device__ __forceinline__ float bf2f(bf16 b) { return __uint_as_float((unsigned)b << 16); }
__device__ __forceinline__ float shx(float v, int mask, int lane) { return __int_as_float(__builtin_amdgcn_ds_bpermute((lane ^ mask) << 2, __float_as_int(v))); }
__device__ __forceinline__ float shl_(float v, int src) { return __int_as_float(__builtin_amdgcn_ds_bpermute(src << 2, __float_as_int(v))); }
__device__ __forceinline__ double shx_d(double v, int mask, int lane) { const long long b = __builtin_bit_cast(long long, v); const int lo = __builtin_amdgcn_ds_bpermute((lane ^ mask) << 2, (int)b), hi = __builtin_amdgcn_ds_bpermute((lane ^ mask) << 2, (int)(b >> 32));
    return __builtin_bit_cast(double, ((long long)hi << 32) | (unsigned)lo); }
__device__ __forceinline__ float wave_sum(float v, int lane) {
#pragma unroll
    for (int o = 1; o < 64; o <<= 1) v += shx(v, o, lane);
    return v;
}
__device__ __forceinline__ int fresh_lane() { unsigned m = ~0u; asm volatile("" : "+s"(m)); return (int)__builtin_amdgcn_mbcnt_hi(m, __builtin_amdgcn_mbcnt_lo(m, 0u)); }
__device__ __forceinline__ int fresh_tid(int wave0) { int w = wave0; asm volatile("" : "+s"(w)); return w * 64 + fresh_lane(); }
__device__ __forceinline__ int pi32(int n) { return n < 4 ? n : (n < 8 ? n + 4 : (n < 12 ? n - 4 : n)); }
__host__ __device__ constexpr float lambda_init_of(int l) { return l == 0 ? 0.2f : 0.35550906759f; }

struct Args { const void* in[25]; float* out; unsigned char* ws; int ph_lo, ph_hi; };
enum { I_X = 0, I_POS, I_LN1, I_WIN, I_BF, I_QND, I_KND, I_LQ1, I_LK1, I_LQ2, I_LK2, I_SUBLN, I_QNF, I_KNF, I_WDO, I_WFO, I_WO, I_LN2, I_WRG, I_BRG, I_WRE, I_BRE, I_WEG, I_WEU, I_WED };
#ifndef MOE_BARRIER
#define MOE_BARRIER 0
#endif
constexpr int PH_PRO = 0, PH_PER_LAYER = 10, PH_FINAL = 1 + PH_PER_LAYER * DEPTH, N_PHASES = PH_FINAL + 1;
enum { K_NORM1 = 0, K_CUMSUM, K_INPROJ, K_ATTN, K_DIFFC, K_YZ, K_WO, K_ROUTER, K_GATEUP, K_DOWN };
constexpr int NWAVES = 8;
constexpr int RING_OFF = 0, RING_BYTES = 131072;
constexpr int LDSCTL_OFF = RING_BYTES, MISC_OFF = LDSCTL_OFF + 320;
constexpr int LDS_BYTES = 147456;
struct Frame {
    LAS unsigned char* lds;
    volatile LAS unsigned* MISC;
    unsigned* ctl;
    int tid, lane, wave, vcu, G, wave0, bx;
    const void* const* in;
    float* out; unsigned char* ws;
};

__device__ __forceinline__ void p0_transpose_item(const float* W, int ld, int k0, int n0src, bf16* WT, int Kd, int drow0, bool swz, LAS float* scr, int lane) {
#pragma unroll 8
    for (int i = 0; i < 32; ++i) { const int kk = 2 * i + (lane >> 5); scr[kk * 33 + (lane & 31)] = __builtin_nontemporal_load(W + (size_t)(k0 + kk) * ld + n0src + (lane & 31)); }
    LDS_WAIT(); asm volatile("" ::: "memory");
    const int c = lane & 7;
#pragma unroll
    for (int j = 0; j < 4; ++j) { const int n = (lane >> 3) + 8 * j; const LAS float* s = scr + (8 * c) * 33 + n;
        v4u o; o.x = pk2(s[0 * 33], s[1 * 33]); o.y = pk2(s[2 * 33], s[3 * 33]); o.z = pk2(s[4 * 33], s[5 * 33]); o.w = pk2(s[6 * 33], s[7 * 33]);
        const int nd = swz ? pi32(n) : n;
        __builtin_nontemporal_store(o, (v4u*)(WT + (size_t)(drow0 + nd) * Kd + k0 + 8 * c)); }
    LDS_WAIT(); asm volatile("" ::: "memory");
}
__device__ __forceinline__ void phase_prologue(Frame& F) {
    LAS float* scr = (LAS float*)(F.lds + RING_OFF + F.wave * 16384);
    const int gw = F.vcu * NWAVES + F.wave, NGW = F.G * NWAVES;
    const float* w_in = (const float*)F.in[I_WIN]; const float* wdo = (const float*)F.in[I_WDO]; const float* wfo = (const float*)F.in[I_WFO]; const float* wo = (const float*)F.in[I_WO];
    const float* weg = (const float*)F.in[I_WEG]; const float* weu = (const float*)F.in[I_WEU]; const float* wed = (const float*)F.in[I_WED];
    bf16* WIN = (bf16*)(F.ws + WS_WIN); bf16* WD = (bf16*)(F.ws + WS_WD); bf16* WF = (bf16*)(F.ws + WS_WF); bf16* WO = (bf16*)(F.ws + WS_WO);
    bf16* WGU = (bf16*)(F.ws + WS_WGU); bf16* WDN = (bf16*)(F.ws + WS_WDN);
    constexpr int I_IN = 16 * 160 * DEPTH;
    constexpr int I_DF = 8 * 32 * DEPTH;
    constexpr int I_O = 16 * 32 * DEPTH;
    constexpr int I_GU = 16 * 16 * 64 * 2;
    constexpr int I_DN = 8 * 32 * 64;
    constexpr int NITEMS = I_IN + 2 * I_DF + I_O + I_GU + I_DN;
    for (int it = gw; it < NITEMS; it += NGW) {
        int r = it;
        if (r < I_GU) {
            const int nb = r & 15, kb = (r >> 4) & 15, which = (r >> 8) & 1, lge = r >> 9;
            const float* src = (which ? weu : weg) + (size_t)lge * D * FF;
            const int n0 = 32 * nb, drow = (n0 >> 7) * 256 + (n0 & 127) + which * 128;
            p0_transpose_item(src, FF, 64 * kb, n0, WGU + (size_t)lge * 1024 * 1024, D, drow, false, scr, F.lane); continue; }
        r -= I_GU;
        if (r < I_DN) {
            const int nb = r & 31, kb = (r >> 5) & 7, lge = r >> 8;
            p0_transpose_item(wed + (size_t)lge * FF * D, D, 64 * kb, 32 * nb, WDN + (size_t)lge * 1024 * 512, FF, 32 * nb, false, scr, F.lane); continue; }
        r -= I_DN;
        if (r < I_IN) {
            const int l = r / 2560, q = r % 2560, kb = q / 160, nb = q % 160;
            const int nsrc = nb < 96 ? 32 * nb : 32 * nb + 8;
            const bool swz = (nb < 32) && ((nb & 1) == 0);
            p0_transpose_item(w_in + (size_t)l * D * INC, INC, 64 * kb, nsrc, WIN + (size_t)l * NP * D, D, 32 * nb, swz, scr, F.lane); continue; }
        r -= I_IN;
        if (r < 2 * I_DF) {
            const int nb = r & 31, kb = (r >> 5) & 7, l = (r >> 8) & 1, which = r >> 9;
            p0_transpose_item((which ? wfo : wdo) + (size_t)l * 512 * D, D, 64 * kb, 32 * nb, (which ? WF : WD) + (size_t)l * D * 512, 512, 32 * nb, false, scr, F.lane); continue; }
        r -= 2 * I_DF;
        { const int nb = r & 31, kb = (r >> 5) & 15, l = r >> 9;
          p0_transpose_item(wo + (size_t)l * D * D, D, 64 * kb, 32 * nb, WO + (size_t)l * D * D, D, 32 * nb, false, scr, F.lane); }
    }
    const int gt = (F.vcu * NWAVES + F.wave) * 64 + F.lane, NGT = F.G * NWAVES * 64;
    bf16* FZT = (bf16*)(F.ws + WS_FZT); bf16* WRT = (bf16*)(F.ws + WS_WRT); float* CS = (float*)(F.ws + WS_COSSIN);
    const float* ln1 = (const float*)F.in[I_LN1]; const float* ln2 = (const float*)F.in[I_LN2];
    for (int i = gt; i < DEPTH * 16 * D; i += NGT) { const int l = i / (16 * D), q = i % (16 * D), j = q / D, k = q % D;
        const float w = j < 8 ? w_in[(size_t)l * D * INC + (size_t)k * INC + 3072 + j] * ln1[l * D + k] : 0.f;
        const unsigned h = f2bf(w); const float r = w - __uint_as_float(h << 16);
        FZT[(size_t)l * 2 * 16 * D + q] = (bf16)h; FZT[(size_t)l * 2 * 16 * D + 16 * D + q] = (bf16)f2bf(r); }
    const float* wrg = (const float*)F.in[I_WRG]; const float* wre = (const float*)F.in[I_WRE];
    for (int i = gt; i < DEPTH * 48 * D; i += NGT) { const int l = i / (48 * D), q = i % (48 * D), j = q / D, k = q % D;
        const float w = (j < 4 ? wrg[(size_t)l * D * 4 + k * 4 + j] : (j < 36 ? wre[(size_t)l * D * 32 + k * 32 + (j - 4)] : 0.f)) * ln2[l * D + k];
        const unsigned h = f2bf(w); const float r = w - __uint_as_float(h << 16);
        WRT[(size_t)l * 2 * 48 * D + q] = (bf16)h; WRT[(size_t)l * 2 * 48 * D + 48 * D + q] = (bf16)f2bf(r); }
    { float* GT = (float*)(F.ws + WS_GT);
      for (int i = gt; i < DEPTH * 4 * 64; i += NGT) { const int l = i >> 8, q = (i >> 6) & 3, d = i & 63;
          const float* src = (const float*)F.in[q == 0 ? I_QND : (q == 1 ? I_KND : (q == 2 ? I_QNF : I_KNF))];
          GT[i] = src[l * 64 + d] * ((q & 1) ? 1.0f : C2); } }
    const int* pos = (const int*)F.in[I_POS];
    for (int i = gt; i < T * 8; i += NGT) { const int t = i >> 3, f = i & 7;
        const double inv = exp2(-(double)f * (1.0 / 8.0) * 18.931568569324174);
        const double ang = (double)pos[t] * (double)(float)inv;
        CS[t * 16 + f] = (float)cos(ang); CS[t * 16 + 8 + f] = (float)sin(ang); }
}

typedef short bf16x8n __attribute__((ext_vector_type(8)));
typedef float f32x4m __attribute__((ext_vector_type(4)));
template <int KIND, int VAR = 0> __device__ __forceinline__ void phase_normgemm(Frame& F, int l) {
    constexpr int NB = KIND == 0 ? 1 : 3;
    constexpr int NR = NB * 16;
    constexpr int PW = 49, XP = 136;
    LAS bf16* XH = (LAS bf16*)(F.lds + RING_OFF);
    LAS bf16* XL = XH + 64 * XP;
    LAS bf16* WH = XL + 64 * XP;
    LAS bf16* WL = WH + 48 * XP;
    LAS float* part = (LAS float*)(WL + 48 * XP);
    LAS float* rsv = part + 2 * 64 * PW;
    const float* xsrc = (KIND == 0 && l == 0) ? (const float*)F.in[I_X] : F.out;
    const bool addy = (KIND == 0 && l > 0);
    const float* gn = (const float*)F.in[KIND == 0 ? I_LN1 : I_LN2] + (size_t)l * D;
    const bf16* WT = (const bf16*)(F.ws + (KIND == 0 ? WS_FZT : WS_WRT)) + (size_t)l * 2 * NR * D;
    const bf16* Y = (const bf16*)(F.ws + WS_Y); bf16* HN = (bf16*)(F.ws + WS_HN);
    const int lane = F.lane, wave = F.wave, tid = F.tid;
    for (int bt = F.vcu; bt < T / 64; bt += F.G) {
        const int row0 = bt * 64;
        f32x4 v_[8][4];
#pragma unroll
        for (int hh = 0; hh < 2; ++hh) {
#pragma unroll
            for (int r4 = 0; r4 < 4; ++r4) { const int rr = hh * 4 + r4, row = row0 + wave * 8 + rr;
#pragma unroll
                for (int j = 0; j < 4; ++j) v_[rr][j] = *(const f32x4*)(xsrc + (size_t)row * D + lane * 4 + 256 * j);
                if (addy) {
#pragma unroll
                    for (int j = 0; j < 4; ++j) { const v2u a = __builtin_nontemporal_load((const v2u*)(Y + (size_t)row * D + lane * 4 + 256 * j)), b = __builtin_nontemporal_load((const v2u*)(Y + (size_t)T * D + (size_t)row * D + lane * 4 + 256 * j));
                        v_[rr][j].x += bflo(a.x) + bflo(b.x); v_[rr][j].y += bfhi(a.x) + bfhi(b.x); v_[rr][j].z += bflo(a.y) + bflo(b.y); v_[rr][j].w += bfhi(a.y) + bfhi(b.y); }
                }
            }
            if (addy) asm volatile("" ::: "memory");
        }
#pragma unroll
        for (int rr = 0; rr < 8; ++rr) { const int rl = wave * 8 + rr, row = row0 + rl; float ss = 0.f;
#pragma unroll
            for (int j = 0; j < 4; ++j) { const f32x4 x = v_[rr][j]; if (KIND == 0 && l > 0) *(f32x4*)(F.out + (size_t)row * D + lane * 4 + 256 * j) = x; ss += (x.x * x.x + x.y * x.y) + (x.z * x.z + x.w * x.w); }
            const float r = 1.0f / sqrtf(wave_sum(ss, lane) * (1.0f / D) + EPS);
            if (lane == 0) rsv[rl] = r;
        }
        f32x4m acc[NB];
#pragma unroll
        for (int nb = 0; nb < NB; ++nb) acc[nb] = (f32x4m){0.f, 0.f, 0.f, 0.f};
        constexpr int NPZ = (2 * NR * 16 + NWAVES * 64 - 1) / (NWAVES * 64);
        v4u wreg[NPZ];
#define NG_WLOAD(hc_) _Pragma("unroll") for (int pi = 0; pi < NPZ; ++pi) { const int pz = tid + pi * NWAVES * 64; if (pz < 2 * NR * 16) { const int tb = pz / (NR * 16), q = pz % (NR * 16), n = q >> 4, c8 = q & 15; \
            wreg[pi] = *(const v4u*)(WT + (size_t)tb * NR * D + (size_t)n * D + (hc_) * 128 + c8 * 8); } }
        if (!(VAR & 2)) {
        NG_WLOAD(0)
#pragma unroll
        for (int hc = 0; hc < 8; ++hc) {
            if ((lane >> 5) == (hc & 1)) {
#pragma unroll
                for (int rr = 0; rr < 8; ++rr) { const f32x4 x = v_[rr][hc >> 1];
                    const unsigned h0 = f2bf(x.x), h1 = f2bf(x.y), h2 = f2bf(x.z), h3 = f2bf(x.w);
                    const float l0 = x.x - __uint_as_float(h0 << 16), l1 = x.y - __uint_as_float(h1 << 16), l2 = x.z - __uint_as_float(h2 << 16), l3 = x.w - __uint_as_float(h3 << 16);
                    const int o = (wave * 8 + rr) * XP + (lane & 31) * 4;
                    *(LAS v2u*)(XH + o) = (v2u){h0 | (h1 << 16), h2 | (h3 << 16)}; *(LAS v2u*)(XL + o) = (v2u){pk2(l0, l1), pk2(l2, l3)}; }
            }
#pragma unroll
            for (int pi = 0; pi < NPZ; ++pi) { const int pz = tid + pi * NWAVES * 64; if (pz < 2 * NR * 16) { const int tb = pz / (NR * 16), q = pz % (NR * 16), n = q >> 4, c8 = q & 15;
                *(LAS v4u*)((tb ? WL : WH) + n * XP + c8 * 8) = wreg[pi]; } }
            __syncthreads();
            if (hc < 7) { NG_WLOAD(hc + 1) }
            { const int rb = wave & 3, kq = wave >> 2, i = lane & 15, g = lane >> 4;
#pragma unroll
              for (int s = 0; s < 2; ++s) { const int ko = kq * 64 + s * 32 + g * 8;
                  const bf16x8n ah = *(const LAS bf16x8n*)(XH + (rb * 16 + i) * XP + ko), al = *(const LAS bf16x8n*)(XL + (rb * 16 + i) * XP + ko);
#pragma unroll
                  for (int nb = 0; nb < NB; ++nb) { const bf16x8n bh = *(const LAS bf16x8n*)(WH + (nb * 16 + i) * XP + ko), bl = *(const LAS bf16x8n*)(WL + (nb * 16 + i) * XP + ko);
                      acc[nb] = __builtin_amdgcn_mfma_f32_16x16x32_bf16(ah, bh, acc[nb], 0, 0, 0);
                      acc[nb] = __builtin_amdgcn_mfma_f32_16x16x32_bf16(ah, bl, acc[nb], 0, 0, 0);
                      acc[nb] = __builtin_amdgcn_mfma_f32_16x16x32_bf16(al, bh, acc[nb], 0, 0, 0); } } }
            __syncthreads();
        } }
        { const int rb = wave & 3, kq = wave >> 2, i = lane & 15, g = lane >> 4;
#pragma unroll
          for (int nb = 0; nb < NB; ++nb)
#pragma unroll
              for (int e = 0; e < 4; ++e) part[(kq * 64 + rb * 16 + 4 * g + e) * PW + nb * 16 + i] = acc[nb][e]; }
        __syncthreads();
#define NG_SUM2(o) (part[o] + part[64 * PW + (o)])
        if (KIND == 0) {
            { const int r = tid >> 3, j = tid & 7; const int o = r * PW + j;
                float z = NG_SUM2(o);
                z = z * rsv[r] + ((const float*)F.in[I_BF])[l * 8 + j];
                const float lf = fminf(z, 0.f) - 0.6931471805599453f * __builtin_amdgcn_logf(1.0f + __builtin_amdgcn_exp2f(-fabsf(z) * LOG2E));
                { const int row = row0 + r; ((float*)(F.ws + WS_LOGF))[((size_t)(row / SEQ) * 8 + j) * SEQ + (row % SEQ)] = lf; } }
        } else {
            if (tid < 64 && !(VAR & 4)) { const int r = tid, row = row0 + r; const float rs = rsv[r];
                const float* brg = (const float*)F.in[I_BRG] + l * 4; const float* bre = (const float*)F.in[I_BRE] + l * 32;
                float lg[4];
#pragma unroll
                for (int q = 0; q < 4; ++q) { const int o = r * PW + q; lg[q] = NG_SUM2(o) * rs + brg[q]; }
                int gi = 0; float gm = lg[0];
#pragma unroll
                for (int q = 1; q < 4; ++q) if (lg[q] > gm) { gm = lg[q]; gi = q; }
                float gs = 0.f;
#pragma unroll
                for (int q = 0; q < 4; ++q) gs += __builtin_amdgcn_exp2f((lg[q] - gm) * LOG2E);
                const float pg = 1.0f / gs;
                float le[8];
#pragma unroll
                for (int e = 0; e < 8; ++e) { const int o = r * PW + 4 + gi * 8 + e; le[e] = NG_SUM2(o) * rs + bre[gi * 8 + e]; }
                int i1 = 0; float m1 = le[0];
#pragma unroll
                for (int e = 1; e < 8; ++e) if (le[e] > m1) { m1 = le[e]; i1 = e; }
                int i2 = 0; float m2 = -INFINITY;
#pragma unroll
                for (int e = 0; e < 8; ++e) if (e != i1 && le[e] > m2) { m2 = le[e]; i2 = e; }
                const float e2 = __builtin_amdgcn_exp2f((m2 - m1) * LOG2E); const float w1 = pg / (1.0f + e2), w2 = pg * e2 / (1.0f + e2);
                LAS unsigned* lcnt = (LAS unsigned*)(rsv + 64); LAS unsigned* lbase = lcnt + 32;
                if (r < 32) lcnt[r] = 0u;
                LDS_WAIT();
                const int ex1 = gi * 8 + i1, ex2 = gi * 8 + i2;
                const unsigned k1 = __hip_atomic_fetch_add(lcnt + ex1, 1u, __ATOMIC_RELAXED, __HIP_MEMORY_SCOPE_WORKGROUP), k2 = __hip_atomic_fetch_add(lcnt + ex2, 1u, __ATOMIC_RELAXED, __HIP_MEMORY_SCOPE_WORKGROUP);
                LDS_WAIT();
                unsigned* CNT = F.ctl + CW_CNT + (size_t)l * NEXP * CNT_STRIDE;
                if (r < 32) { const unsigned mine = lcnt[r]; lbase[r] = mine ? atomicAdd(CNT + r * CNT_STRIDE, mine) : 0u; }
                LDS_WAIT();
                int* LIST = (int*)(F.ws + WS_LIST); float* GWT = (float*)(F.ws + WS_GWT);
                LIST[(size_t)ex1 * T + lbase[ex1] + k1] = row * 2; LIST[(size_t)ex2 * T + lbase[ex2] + k2] = row * 2 + 1;
                GWT[row * 2] = w1; GWT[row * 2 + 1] = w2; }
        }
#undef NG_SUM2
#undef NG_WLOAD
#pragma unroll
        for (int rr = 0; rr < 8; ++rr) { const int rl = wave * 8 + rr, row = row0 + rl; const float r = rsv[rl];
#pragma unroll
            for (int j = 0; j < 4; ++j) { const f32x4 g = *(const f32x4*)(gn + lane * 4 + 256 * j); const f32x4 h = v_[rr][j] * r * g;
                *(v2u*)(HN + (size_t)row * D + lane * 4 + 256 * j) = (v2u){pk2(h.x, h.y), pk2(h.z, h.w)}; } }
        __syncthreads();
    }
}
__device__ __forceinline__ double wave_sum_d(double v, int lane) {
#pragma unroll
    for (int o = 1; o < 64; o <<= 1) v += shx_d(v, o, lane);
    return v;
}
__device__ __forceinline__ void phase_router2(Frame& F, int l, bool dry = false) {
    constexpr int PW = 41;
    LAS float* sm = (LAS float*)(F.lds + RING_OFF);
    LAS unsigned* lcnt = (LAS unsigned*)(sm + 64 * PW); LAS unsigned* lbase = lcnt + 32;
    const float* SUMS = (const float*)(F.ws + WS_SUMS);
    for (int bt = F.vcu; bt < T / 64; bt += F.G) {
        const int row0 = bt * 64;
        { const int r = F.tid >> 3, j = F.tid & 7; const int c = j < 5 ? j * 8 : 48;
          if (j < 6) { const float* S0 = SUMS + (size_t)(row0 + r) * 64 + c;
              f32x4 a0 = *(const f32x4*)S0, a1 = *(const f32x4*)(S0 + (size_t)T * 64), a2 = *(const f32x4*)(S0 + (size_t)2 * T * 64), a3 = *(const f32x4*)(S0 + (size_t)3 * T * 64);
              f32x4 b0 = a0, b1 = a1, b2 = a2, b3 = a3;
              if (j < 5) { b0 = *(const f32x4*)(S0 + 4); b1 = *(const f32x4*)(S0 + (size_t)T * 64 + 4); b2 = *(const f32x4*)(S0 + (size_t)2 * T * 64 + 4); b3 = *(const f32x4*)(S0 + (size_t)3 * T * 64 + 4); }
              const f32x4 sa = (a0 + a1) + (a2 + a3), sb = (b0 + b1) + (b2 + b3);
              if (j < 5) {
#pragma unroll
                  for (int e = 0; e < 4; ++e) { sm[r * PW + c + e] = sa[e]; sm[r * PW + c + 4 + e] = sb[e]; } }
              else sm[r * PW + 40] = sa.x; } }
        __syncthreads();
        if (F.tid < 64) { const int r = F.tid, row = row0 + r;
            const float rs = 1.0f / sqrtf(sm[r * PW + 40] * (1.0f / D) + EPS);
            ((float*)(F.ws + WS_RSTD))[row] = rs;
            const float* brg = (const float*)F.in[I_BRG] + l * 4; const float* bre = (const float*)F.in[I_BRE] + l * 32;
            float lg[4];
#pragma unroll
            for (int q = 0; q < 4; ++q) lg[q] = sm[r * PW + q] * rs + brg[q];
            int gi = 0; float gm = lg[0];
#pragma unroll
            for (int q = 1; q < 4; ++q) if (lg[q] > gm) { gm = lg[q]; gi = q; }
            float gs = 0.f;
#pragma unroll
            for (int q = 0; q < 4; ++q) gs += __builtin_amdgcn_exp2f((lg[q] - gm) * LOG2E);
            const float pg = 1.0f / gs;
            float le[8];
#pragma unroll
            for (int e = 0; e < 8; ++e) le[e] = sm[r * PW + 4 + gi * 8 + e] * rs + bre[gi * 8 + e];
            int i1 = 0; float m1 = le[0];
#pragma unroll
            for (int e = 1; e < 8; ++e) if (le[e] > m1) { m1 = le[e]; i1 = e; }
            int i2 = 0; float m2 = -INFINITY;
#pragma unroll
            for (int e = 0; e < 8; ++e) if (e != i1 && le[e] > m2) { m2 = le[e]; i2 = e; }
            const float e2 = __builtin_amdgcn_exp2f((m2 - m1) * LOG2E); const float w1 = pg / (1.0f + e2), w2 = pg * e2 / (1.0f + e2);
            if (dry) { if (w1 + w2 == 1.2345e33f) ((float*)(F.ws + WS_GWT))[row * 2] = w1; } else {
            if (r < 32) lcnt[r] = 0u;
            LDS_WAIT();
            const int ex1 = gi * 8 + i1, ex2 = gi * 8 + i2;
            const unsigned k1 = __hip_atomic_fetch_add(lcnt + ex1, 1u, __ATOMIC_RELAXED, __HIP_MEMORY_SCOPE_WORKGROUP), k2 = __hip_atomic_fetch_add(lcnt + ex2, 1u, __ATOMIC_RELAXED, __HIP_MEMORY_SCOPE_WORKGROUP);
            LDS_WAIT();
            unsigned* CNT = F.ctl + CW_CNT + (size_t)l * NEXP * CNT_STRIDE;
            if (r < 32) { const unsigned mine = lcnt[r]; lbase[r] = mine ? atomicAdd(CNT + r * CNT_STRIDE, mine) : 0u; }
            LDS_WAIT();
            int* LIST = (int*)(F.ws + WS_LIST); float* GWT = (float*)(F.ws + WS_GWT);
            LIST[(size_t)ex1 * T + lbase[ex1] + k1] = row * 2; LIST[(size_t)ex2 * T + lbase[ex2] + k2] = row * 2 + 1;
            GWT[row * 2] = w1; GWT[row * 2 + 1] = w2; } }
        __syncthreads();
    }
}
__device__ __forceinline__ void phase_cumsum(Frame& F) {
    const float* LOGF = (const float*)(F.ws + WS_LOGF); float* CUM = (float*)(F.ws + WS_CUM);
    LAS double* red = (LAS double*)(F.lds + RING_OFF);
    for (int task = F.vcu; task < BATCH * 8 * 16; task += F.G) {
        const int seq = task >> 4, c = task & 15, b = seq >> 3, j = seq & 7;
        const float* src = LOGF + ((size_t)b * 8 + j) * SEQ;
        double acc = 0.0;
        for (int i = F.tid; i < c * 128; i += NWAVES * 64) { const f32x4 q = *(const f32x4*)(src + 4 * i); acc += ((double)q.x + (double)q.y) + ((double)q.z + (double)q.w); }
        acc = wave_sum_d(acc, F.lane);
        double v = (double)src[c * 512 + F.tid];
#pragma unroll
        for (int o = 1; o < 64; o <<= 1) { const double u = shx_d(v, 0, (F.lane - o) & 63); if (F.lane >= o) v += u; }
        if (F.lane == 63) { red[F.wave] = acc; red[8 + F.wave] = v; }
        else if (F.lane == 0 && false) {}
        __syncthreads();
        double base = 0.0;
#pragma unroll
        for (int w = 0; w < 8; ++w) { base += red[w]; if (w < F.wave) base += red[8 + w]; }
        CUM[(size_t)seq * SEQ + c * 512 + F.tid] = (float)((base + v) * 1.4426950408889634);
        __syncthreads();
    }
}
__device__ __forceinline__ void phase_diffc(Frame& F, int l) {
    const float* lq1 = (const float*)F.in[I_LQ1] + l * 64; const float* lk1 = (const float*)F.in[I_LK1] + l * 64;
    const float* lq2 = (const float*)F.in[I_LQ2] + l * 64; const float* lk2 = (const float*)F.in[I_LK2] + l * 64;
    const float li = lambda_init_of(l);
    const float lam = __builtin_amdgcn_exp2f(LOG2E * wave_sum(lq1[F.lane] * lk1[F.lane], F.lane)) - __builtin_amdgcn_exp2f(LOG2E * wave_sum(lq2[F.lane] * lk2[F.lane], F.lane)) + li;
    const float* sub = (const float*)F.in[I_SUBLN] + l * 128;
    const bf16* OA = (const bf16*)(F.ws + WS_OA); bf16* AD = (bf16*)(F.ws + WS_AD);
    const int gw = F.vcu * NWAVES + F.wave, NGW = F.G * NWAVES, lane = F.lane;
    const int d0 = (lane & 15) * 8;
    float sg[8];
#pragma unroll
    for (int e = 0; e < 8; ++e) sg[e] = sub[d0 + e] * (1.0f - li);
    for (int rb0 = gw; rb0 < T; rb0 += 8 * NGW) {
        v4u a_[8], b_[8];
#pragma unroll
        for (int q = 0; q < 8; ++q) { const int row = rb0 + q * NGW < T ? rb0 + q * NGW : rb0;
            a_[q] = __builtin_nontemporal_load((const v4u*)(OA + (size_t)row * 1024 + lane * 8)); b_[q] = __builtin_nontemporal_load((const v4u*)(OA + (size_t)row * 1024 + 512 + lane * 8)); }
#pragma unroll
        for (int q = 0; q < 8; ++q) { const int row = rb0 + q * NGW; if (row < T) { const v4u a = a_[q], b = b_[q];
        float v[8];
        v[0] = bflo(a.x) - lam * bflo(b.x); v[1] = bfhi(a.x) - lam * bfhi(b.x); v[2] = bflo(a.y) - lam * bflo(b.y); v[3] = bfhi(a.y) - lam * bfhi(b.y);
        v[4] = bflo(a.z) - lam * bflo(b.z); v[5] = bfhi(a.z) - lam * bfhi(b.z); v[6] = bflo(a.w) - lam * bflo(b.w); v[7] = bfhi(a.w) - lam * bfhi(b.w);
        float ss = 0.f;
#pragma unroll
        for (int e = 0; e < 8; ++e) ss += v[e] * v[e];
        ss += shx(ss, 1, lane); ss += shx(ss, 2, lane); ss += shx(ss, 4, lane); ss += shx(ss, 8, lane);
        const float r = __builtin_amdgcn_rsqf(ss * (1.0f / 128.0f) + EPS);
        v4u o; o.x = pk2(v[0] * r * sg[0], v[1] * r * sg[1]); o.y = pk2(v[2] * r * sg[2], v[3] * r * sg[3]); o.z = pk2(v[4] * r * sg[4], v[5] * r * sg[5]); o.w = pk2(v[6] * r * sg[6], v[7] * r * sg[7]);
        *(v4u*)(AD + (size_t)row * 512 + lane * 8) = o; } }
    }
}
__device__ __forceinline__ void phase_final(Frame& F, bool dry = false) {
    const bf16* Y = (const bf16*)(F.ws + WS_Y);
    const int gw = F.vcu * NWAVES + F.wave, NGW = F.G * NWAVES, lane = F.lane;
    for (int rb0 = gw; rb0 < T; rb0 += 4 * NGW) {
        f32x4 v_[4][4]; v2u a_[4][4], b_[4][4];
#pragma unroll
        for (int q = 0; q < 4; ++q) { const int row = rb0 + q * NGW < T ? rb0 + q * NGW : rb0;
#pragma unroll
            for (int j = 0; j < 4; ++j) { v_[q][j] = __builtin_nontemporal_load((const f32x4*)(F.out + (size_t)row * D + lane * 4 + 256 * j));
                a_[q][j] = __builtin_nontemporal_load((const v2u*)(Y + (size_t)row * D + lane * 4 + 256 * j)); b_[q][j] = __builtin_nontemporal_load((const v2u*)(Y + (size_t)T * D + (size_t)row * D + lane * 4 + 256 * j)); } }
#pragma unroll
        for (int q = 0; q < 4; ++q) { const int row = rb0 + q * NGW; if (row < T) {
#pragma unroll
            for (int j = 0; j < 4; ++j) { f32x4 v = v_[q][j]; const v2u a = a_[q][j], b = b_[q][j];
                v.x += bflo(a.x) + bflo(b.x); v.y += bfhi(a.x) + bfhi(b.x); v.z += bflo(a.y) + bflo(b.y); v.w += bfhi(a.y) + bfhi(b.y);
                if (!dry || v.x == 1.2345e33f) __builtin_nontemporal_store(v, (f32x4*)(F.out + (size_t)row * D + lane * 4 + 256 * j)); } } }
    }
}
namespace pg8 {
typedef short bf16x8 __attribute__((ext_vector_type(8)));
typedef unsigned u32x4 __attribute__((ext_vector_type(4)));
constexpr int BM = 256, BK = 64, HALF = 128, HTB = HALF * BK * 2, STAGE_BYTES = 8 * HTB;
__host__ __device__ __forceinline__ int lds_byte(int r, int c) { const int st = (r >> 4) * 2 + (c >> 5), rr = r & 15, cc = c & 31, ob = rr * 64 + cc * 2; return st * 1024 + (ob ^ (((ob >> 9) & 1) << 5)); }
__host__ __device__ __forceinline__ void stage_rc(int b, int& R, int& C) { const int st = b / 1024, sb = b % 1024, swz = sb ^ (((sb >> 9) & 1) << 5); R = (st >> 1) * 16 + swz / 64; C = (st & 1) * 32 + (swz % 64) / 2; }
__host__ __device__ __forceinline__ int perm32(int rho) { const int n = rho >> 4, i = rho & 15; return 8 * (i >> 2) + 4 * n + (i & 3); }
struct Unit { int pm, pn, ex, sl; };
__device__ __forceinline__ unsigned cvt_pk_bf16(float lo, float hi) { unsigned r; asm volatile("v_cvt_pk_bf16_f32 %0, %1, %2" : "=v"(r) : "v"(lo), "v"(hi)); return r; }

struct StaticOrder {
    int nM, nN, nwg, G, c, K;
    __device__ void init(int M, int N, int K_, int G_, int c_) { nM = M / BM; nN = N / BM; nwg = nM * nN; G = G_; c = c_; K = K_; }
    __device__ __forceinline__ bool next(int i, Unit& u) const {
        const long L = (long)i * G + c; if (L >= nwg) return false;
        int wgid = (int)L; { const int q = nwg / 8, r = nwg % 8, xcd = wgid % 8, off = wgid / 8; wgid = (xcd < r ? xcd * (q + 1) : r * (q + 1) + (xcd - r) * q) + off; }
        const int nig = 8 * nN, gid = wgid / nig, fm = gid * 8, gsz = (nM - fm) < 8 ? (nM - fm) : 8;
        u.pm = fm + ((wgid % nig) % gsz); u.pn = (wgid % nig) / gsz; u.ex = 0; u.sl = 0; return true;
    }
    static constexpr bool GATHER = false; static constexpr int A_AUX = 0;
    __device__ __forceinline__ void a_ready(const Unit&) const {}
    __device__ __forceinline__ size_t a_off(const Unit& u) const { return (size_t)u.pm * BM * K * 2; }
    __device__ __forceinline__ unsigned arow_off(const Unit&, int) const { return 0u; }
    __device__ __forceinline__ size_t b_off(const Unit& u) const { return (size_t)u.pn * BM * K * 2; }
};

template <class Epi, class Sched, bool ALIGN_EPI>
__device__ __forceinline__ void gemm_phase(LAS unsigned char* lds, const int wave0, const bf16* Ag, const bf16* Btg, const int K, const Sched& S, const Epi& E) {
    const int tid = fresh_tid(wave0);
    const int wid = __builtin_amdgcn_readfirstlane(tid >> 6), lane = tid & 63, wr = wid >> 2, wc = wid & 3, fr = lane & 15, fq = lane >> 4;
    const int nt = K / BK;
    constexpr bool GATHER = Sched::GATHER;
    int RA0 = 0; unsigned CA2 = 0u, voffA[2], voffB[2];
#pragma unroll
    for (int i = 0; i < 2; ++i) { int R, C; stage_rc(tid * 16 + i * 8192, R, C); if (i == 0) { RA0 = R; CA2 = (unsigned)C * 2u; }
        voffA[i] = (unsigned)(R * K + C) * 2u;
        const int Rb = Epi::BMODE == 2 ? 64 * (R >> 5) + perm32(R & 31) : (Epi::BMODE == 1 ? ((R & ~31) + perm32(R & 31)) : R);
        voffB[i] = (unsigned)(Rb * K + C) * 2u; }
    const size_t kstep = (size_t)(BK * 2);
    const size_t hstepB = (size_t)(Epi::BMODE == 2 ? 32 : HALF) * K * 2, hstepA = (size_t)HALF * K * 2;
    const unsigned ldsw = (unsigned)wid * 1024u;
    const int aoff = lds_byte(wr * 64 + fr, fq * 8), boff = lds_byte(wc * 32 + fr, fq * 8);
#define PG8_SA(b, h) (((b) * 2 + (h)) * HTB)
#define PG8_SB(b, h) ((4 + (b) * 2 + (h)) * HTB)
#define PG8_STAGE_A(bufoff, gbase, voff) do { _Pragma("unroll") for (int _i = 0; _i < 2; ++_i) \
        __builtin_amdgcn_global_load_lds((const unsigned*)((const char*)(gbase) + (voff)[_i]), (LAS unsigned*)(lds + (bufoff) + ldsw + _i * 8192), 16, 0, Sched::A_AUX); } while (0)
#define PG8_STAGE(bufoff, gbase, voff) do { _Pragma("unroll") for (int _i = 0; _i < 2; ++_i) \
        __builtin_amdgcn_global_load_lds((const unsigned*)((const char*)(gbase) + (voff)[_i]), (LAS unsigned*)(lds + (bufoff) + ldsw + _i * 8192), 16, 0, 0); } while (0)
#define PG8_LDA(dst, b, h) do { _Pragma("unroll") for (int m = 0; m < 4; ++m) _Pragma("unroll") for (int k = 0; k < 2; ++k) dst[m][k] = *(const LAS bf16x8*)(lds + PG8_SA(b, h) + aoff + m * 2048 + k * 1024); } while (0)
#define PG8_LDB(dst, b, h) do { _Pragma("unroll") for (int n = 0; n < 2; ++n) _Pragma("unroll") for (int k = 0; k < 2; ++k) dst[n][k] = *(const LAS bf16x8*)(lds + PG8_SB(b, h) + boff + n * 2048 + k * 1024); } while (0)
#define PG8_MMA(ai, bj, At, Bt) do { __builtin_amdgcn_s_setprio(1); _Pragma("unroll") for (int m = 0; m < 4; ++m) _Pragma("unroll") for (int n = 0; n < 2; ++n) _Pragma("unroll") for (int k = 0; k < 2; ++k) \
        acc[ai][bj][m][n] = __builtin_amdgcn_mfma_f32_16x16x32_bf16(Bt[n][k], At[m][k], acc[ai][bj][m][n], 0, 0, 0); __builtin_amdgcn_s_setprio(0); } while (0)
#define PG8_WAIT_V(n) asm volatile("s_waitcnt vmcnt(" #n ")" ::: "memory")
#define PG8_WAIT_L(n) asm volatile("s_waitcnt lgkmcnt(" #n ")" ::: "memory")
#define PG8_BAR __builtin_amdgcn_s_barrier()
#define PG8_SCHED __builtin_amdgcn_sched_barrier(0)
    Unit cur, nxt; int ui = 0;
    if (!S.next(0, cur)) return;
    f32x4 acc[2][2][4][2];
#pragma unroll
    for (int a = 0; a < 2; ++a)
#pragma unroll
        for (int b = 0; b < 2; ++b)
#pragma unroll
            for (int m = 0; m < 4; ++m)
#pragma unroll
                for (int n = 0; n < 2; ++n) acc[a][b][m][n] = (f32x4){0.f, 0.f, 0.f, 0.f};
    bf16x8 At[4][2], B0[2][2], B1[2][2];
    unsigned gc0[2] = {0u, 0u}, gc1[2] = {0u, 0u};
#define PG8_GOFF(u, d0, d1) do { d0[0] = S.arow_off(u, RA0) + CA2; d0[1] = S.arow_off(u, RA0 + 64) + CA2; d1[0] = S.arow_off(u, HALF + RA0) + CA2; d1[1] = S.arow_off(u, HALF + RA0 + 64) + CA2; } while (0)
    if constexpr (GATHER) PG8_GOFF(cur, gc0, gc1);
    S.a_ready(cur);
    const char* cA = (const char*)Ag; if constexpr (!GATHER) cA += S.a_off(cur);
    const char* cB = (const char*)Btg + S.b_off(cur);
    PG8_STAGE(PG8_SB(0, 0), cB, voffB); PG8_STAGE(PG8_SB(0, 1), cB + hstepB, voffB);
    if constexpr (GATHER) { PG8_STAGE_A(PG8_SA(0, 0), cA, gc0); PG8_STAGE_A(PG8_SA(0, 1), cA, gc1); } else { PG8_STAGE_A(PG8_SA(0, 0), cA, voffA); PG8_STAGE_A(PG8_SA(0, 1), cA + hstepA, voffA); }
    if (wr == 1) PG8_BAR;
    PG8_WAIT_V(2); PG8_BAR;
    PG8_STAGE(PG8_SB(1, 0), cB + kstep, voffB);
    if constexpr (GATHER) PG8_STAGE_A(PG8_SA(1, 0), cA + kstep, gc0); else PG8_STAGE_A(PG8_SA(1, 0), cA + kstep, voffA);
    PG8_STAGE(PG8_SB(1, 1), cB + hstepB + kstep, voffB);
    PG8_WAIT_V(6); PG8_BAR;
    for (;;) {
        const bool has_next = S.next(ui + 1, nxt);
        const char* nA = cA; if constexpr (!GATHER) { if (has_next) nA = (const char*)Ag + S.a_off(nxt); }
        const char* nB = has_next ? (const char*)Btg + S.b_off(nxt) : cB;
        for (int t = 0; t < nt; t += 2) {
            const bool last = (t == nt - 2);
            if (last && has_next) S.a_ready(nxt);
            const char* a1 = cA + (size_t)(t + 1) * kstep;
            const char* a2 = last ? nA : cA + (size_t)(t + 2) * kstep; const char* b2 = last ? nB : cB + (size_t)(t + 2) * kstep;
            const char* a3 = a2 + kstep; const char* b3 = b2 + kstep;
            unsigned vs0[2] = {gc0[0], gc0[1]}, vs1[2] = {gc1[0], gc1[1]};
            if constexpr (GATHER) { if (last && has_next) PG8_GOFF(nxt, vs0, vs1); }
#define PG8_STA(bufoff, base, h, vs) do { if constexpr (GATHER) PG8_STAGE_A(bufoff, base, vs); else PG8_STAGE_A(bufoff, (base) + (h) * hstepA, voffA); } while (0)
            PG8_LDB(B0, 0, 0); PG8_LDB(B1, 0, 1); PG8_SCHED; PG8_LDA(At, 0, 0); PG8_STA(PG8_SA(1, 1), a1, 1, gc1);
            PG8_WAIT_V(8); PG8_WAIT_L(0); PG8_BAR; PG8_MMA(0, 0, At, B0); PG8_MMA(0, 1, At, B1); PG8_BAR; PG8_SCHED;
            PG8_LDA(At, 0, 1); PG8_STAGE(PG8_SB(0, 0), b2, voffB); PG8_STAGE(PG8_SB(0, 1), b2 + hstepB, voffB); PG8_STA(PG8_SA(0, 0), a2, 0, vs0);
            PG8_WAIT_V(8); PG8_WAIT_L(0); PG8_BAR; PG8_MMA(1, 0, At, B0); PG8_MMA(1, 1, At, B1); PG8_BAR; PG8_SCHED;
            PG8_LDB(B0, 1, 0); PG8_LDB(B1, 1, 1); PG8_SCHED; PG8_LDA(At, 1, 0); PG8_STA(PG8_SA(0, 1), a2, 1, vs1);
            PG8_WAIT_V(8); PG8_WAIT_L(0); PG8_BAR; PG8_MMA(0, 0, At, B0); PG8_MMA(0, 1, At, B1); PG8_BAR; PG8_SCHED;
            PG8_LDA(At, 1, 1); PG8_STAGE(PG8_SB(1, 0), b3, voffB); PG8_STAGE(PG8_SB(1, 1), b3 + hstepB, voffB); PG8_STA(PG8_SA(1, 0), a3, 0, vs0);
            PG8_WAIT_V(8); PG8_WAIT_L(0); PG8_BAR; PG8_MMA(1, 0, At, B0); PG8_MMA(1, 1, At, B1); PG8_BAR; PG8_SCHED;
        }
        if constexpr (ALIGN_EPI) { if (wr == 0) PG8_BAR; }
        if constexpr (!Epi::AFTER_DRAIN) E(acc, cur, wr, wc, fr, fq);
        if (!has_next) break;
        if (!(Epi::CHAIN2 && cur.ex == 0)) {
#pragma unroll
        for (int a = 0; a < 2; ++a)
#pragma unroll
            for (int b = 0; b < 2; ++b)
#pragma unroll
                for (int m = 0; m < 4; ++m)
#pragma unroll
                    for (int n = 0; n < 2; ++n) acc[a][b][m][n] = (f32x4){0.f, 0.f, 0.f, 0.f}; }
        cur = nxt; cA = nA; cB = nB; ++ui;
        if constexpr (GATHER) PG8_GOFF(cur, gc0, gc1);
        if constexpr (ALIGN_EPI) { if (wr == 1) PG8_BAR; }
    }
    PG8_WAIT_V(0);
    if constexpr (!ALIGN_EPI) { if (wr == 0) PG8_BAR; }
    PG8_BAR;
    if constexpr (Epi::AFTER_DRAIN) E.fused(acc, cur, wr, wc, fr, fq, lds, tid);
#undef PG8_SA
#undef PG8_SB
#undef PG8_STAGE
#undef PG8_STAGE_A
#undef PG8_STA
#undef PG8_GOFF
#undef PG8_LDA
#undef PG8_LDB
#undef PG8_MMA
#undef PG8_WAIT_V
#undef PG8_WAIT_L
#undef PG8_BAR
#undef PG8_SCHED
}
}
typedef pg8::Unit Unit;
__device__ __forceinline__ float sigmoidf_(float v) { return __builtin_amdgcn_rcpf(1.0f + __builtin_amdgcn_exp2f(-v * LOG2E)); }

struct EpiInproj {
    static constexpr int BMODE = 2; static constexpr bool CHAIN2 = false, AFTER_DRAIN = false;
    bf16* O; const float* gt; const float* cs;
    __device__ __forceinline__ void operator()(f32x4 (&acc)[2][2][4][2], const Unit& u, int wr, int wc, int fr, int fq) const {
        const int seg = u.pn >> 1;
        const int col0 = u.pn * 256 + wc * 64 + 8 * fq;
        const bool isnorm = (seg == 0 || seg == 1 || seg == 3 || seg == 4), isdiff = seg < 2;
        f32x4 g[2][2];
        if (isnorm) {
            const float* gp = gt + (seg < 2 ? seg : seg - 1) * 64;
#pragma unroll
            for (int bj = 0; bj < 2; ++bj)
#pragma unroll
                for (int n = 0; n < 2; ++n) { const int d0 = (isdiff && bj == 0 && fq < 2) ? (4 * fq + 8 * n) : (32 * bj + 8 * fq + 4 * n); g[bj][n] = *(const f32x4*)(gp + d0); }
        }
#pragma unroll
        for (int ai = 0; ai < 2; ++ai)
#pragma unroll
            for (int m = 0; m < 4; ++m) {
                const int row = u.pm * 256 + ai * 128 + wr * 64 + m * 16 + fr;
                f32x4 v00 = acc[ai][0][m][0], v01 = acc[ai][0][m][1], v10 = acc[ai][1][m][0], v11 = acc[ai][1][m][1];
                if (isnorm) {
                    float ss = (v00.x * v00.x + v00.y * v00.y) + (v00.z * v00.z + v00.w * v00.w) + (v01.x * v01.x + v01.y * v01.y) + (v01.z * v01.z + v01.w * v01.w)
                             + (v10.x * v10.x + v10.y * v10.y) + (v10.z * v10.z + v10.w * v10.w) + (v11.x * v11.x + v11.y * v11.y) + (v11.z * v11.z + v11.w * v11.w);
                    ss += shx(ss, 16, fq * 16 + fr); ss += shx(ss, 32, fq * 16 + fr);
                    const float rs = __builtin_amdgcn_rsqf(ss * (1.0f / 64.0f) + EPS);
                    v00 = v00 * rs * g[0][0]; v01 = v01 * rs * g[0][1]; v10 = v10 * rs * g[1][0]; v11 = v11 * rs * g[1][1];
                    if (isdiff) {
                        const int fi = (fq & 1) * 4;
                        const f32x4 c = *(const f32x4*)(cs + (size_t)row * 16 + fi), s = *(const f32x4*)(cs + (size_t)row * 16 + 8 + fi);
                        const f32x4 r0 = v00 * c - v01 * s, r1 = v01 * c + v00 * s;
                        if (fq < 2) { v00 = r0; v01 = r1; }
                    }
                } else if (seg >= 6) {
#pragma unroll
                    for (int e = 0; e < 4; ++e) { v00[e] = sigmoidf_(v00[e]); v01[e] = sigmoidf_(v01[e]); v10[e] = sigmoidf_(v10[e]); v11[e] = sigmoidf_(v11[e]); }
                }
                bf16* rowp = O + (size_t)row * NP + col0;
                pg8::u32x4 w0, w1;
                w0.x = pg8::cvt_pk_bf16(v00.x, v00.y); w0.y = pg8::cvt_pk_bf16(v00.z, v00.w); w0.z = pg8::cvt_pk_bf16(v01.x, v01.y); w0.w = pg8::cvt_pk_bf16(v01.z, v01.w);
                w1.x = pg8::cvt_pk_bf16(v10.x, v10.y); w1.y = pg8::cvt_pk_bf16(v10.z, v10.w); w1.z = pg8::cvt_pk_bf16(v11.x, v11.y); w1.w = pg8::cvt_pk_bf16(v11.z, v11.w);
                *(pg8::u32x4*)(rowp) = w0; *(pg8::u32x4*)(rowp + 32) = w1;
            }
    }
};
template <bool FIRST> struct EpiYZ {
    static constexpr int BMODE = 1; static constexpr bool CHAIN2 = false, AFTER_DRAIN = false;
    bf16* Z; const bf16* G;
    __device__ __forceinline__ void operator()(f32x4 (&acc)[2][2][4][2], const Unit& u, int wr, int wc, int fr, int fq) const {
#pragma unroll
        for (int ai = 0; ai < 2; ++ai)
#pragma unroll
            for (int m = 0; m < 4; ++m) { const int row = u.pm * 256 + ai * 128 + wr * 64 + m * 16 + fr;
#pragma unroll
                for (int bj = 0; bj < 2; ++bj) { const int col = u.pn * 256 + bj * 128 + wc * 32 + 8 * fq;
                    const pg8::u32x4 gw = *(const pg8::u32x4*)(G + (size_t)row * NP + col);
                    f32x4 v0 = acc[ai][bj][m][0], v1 = acc[ai][bj][m][1];
                    v0.x *= bflo(gw.x); v0.y *= bfhi(gw.x); v0.z *= bflo(gw.y); v0.w *= bfhi(gw.y); v1.x *= bflo(gw.z); v1.y *= bfhi(gw.z); v1.z *= bflo(gw.w); v1.w *= bfhi(gw.w);
                    bf16* zp = Z + (size_t)row * D + col;
                    if (!FIRST) { const pg8::u32x4 zo = *(const pg8::u32x4*)zp;
                        v0.x += bflo(zo.x); v0.y += bfhi(zo.x); v0.z += bflo(zo.y); v0.w += bfhi(zo.y); v1.x += bflo(zo.z); v1.y += bfhi(zo.z); v1.z += bflo(zo.w); v1.w += bfhi(zo.w); }
                    pg8::u32x4 w; w.x = pg8::cvt_pk_bf16(v0.x, v0.y); w.y = pg8::cvt_pk_bf16(v0.z, v0.w); w.z = pg8::cvt_pk_bf16(v1.x, v1.y); w.w = pg8::cvt_pk_bf16(v1.z, v1.w);
                    *(pg8::u32x4*)zp = w; } }
    }
};
struct EpiWo {
    static constexpr int BMODE = 0; static constexpr bool CHAIN2 = false, AFTER_DRAIN = false;
    float* out; bool dry;
    __device__ __forceinline__ void operator()(f32x4 (&acc)[2][2][4][2], const Unit& u, int wr, int wc, int fr, int fq) const {
#pragma unroll
        for (int ai = 0; ai < 2; ++ai)
#pragma unroll
            for (int m = 0; m < 4; ++m) { const int row = u.pm * 256 + ai * 128 + wr * 64 + m * 16 + fr;
#pragma unroll
                for (int bj = 0; bj < 2; ++bj)
#pragma unroll
                    for (int n = 0; n < 2; ++n) { float* p = out + (size_t)row * D + u.pn * 256 + bj * 128 + wc * 32 + n * 16 + 4 * fq; const f32x4 nv = *(const f32x4*)p + acc[ai][bj][m][n]; if (!dry || nv.x == 1.2345e33f) *(f32x4*)p = nv; }
                if (m == 3) asm volatile("" ::: "memory"); }
    }
};
struct EpiWoR {
    static constexpr int BMODE = 2; static constexpr bool CHAIN2 = false, AFTER_DRAIN = true;
    float* out; const float* res; bf16* HN; const float* g2; const bf16* WT; float* SUMS; bool dry;
    __device__ __forceinline__ void operator()(f32x4 (&)[2][2][4][2], const Unit&, int, int, int, int) const {}
    __device__ __forceinline__ void fused(f32x4 (&acc)[2][2][4][2], const Unit& u, int wr, int wc, int fr, int fq, LAS unsigned char* lds, int tid) const {
        constexpr int PW = 49;
        LAS float* tab = (LAS float*)lds;
        const int lane = fq * 16 + fr;
        const int c0 = u.pn * 256 + wc * 64 + 8 * fq;
#pragma unroll
        for (int ai = 0; ai < 2; ++ai)
#pragma unroll
            for (int mh = 0; mh < 2; ++mh) {
                f32x4 t_[2][2][2];
#pragma unroll
                for (int m2 = 0; m2 < 2; ++m2)
#pragma unroll
                    for (int bj = 0; bj < 2; ++bj) { const float* ps = res + (size_t)(u.pm * 256 + ai * 128 + wr * 64 + (mh * 2 + m2) * 16 + fr) * D + c0 + 32 * bj; t_[m2][bj][0] = *(const f32x4*)ps; t_[m2][bj][1] = *(const f32x4*)(ps + 4); }
#pragma unroll
                for (int m2 = 0; m2 < 2; ++m2)
#pragma unroll
                    for (int bj = 0; bj < 2; ++bj) { const int m = mh * 2 + m2; float* p = out + (size_t)(u.pm * 256 + ai * 128 + wr * 64 + m * 16 + fr) * D + c0 + 32 * bj;
                        acc[ai][bj][m][0] += t_[m2][bj][0]; acc[ai][bj][m][1] += t_[m2][bj][1];
                        *(f32x4*)p = dry ? t_[m2][bj][0] : acc[ai][bj][m][0]; *(f32x4*)(p + 4) = dry ? t_[m2][bj][1] : acc[ai][bj][m][1]; }
                asm volatile("" ::: "memory");
            }
        pg8::bf16x8 wh[2][3], wl[2][3]; f32x4 gg[2][2];
#pragma unroll
        for (int bj = 0; bj < 2; ++bj) {
#pragma unroll
            for (int nb = 0; nb < 3; ++nb) { wh[bj][nb] = *(const pg8::bf16x8*)(WT + (size_t)(nb * 16 + fr) * D + c0 + 32 * bj); wl[bj][nb] = *(const pg8::bf16x8*)(WT + (size_t)48 * D + (size_t)(nb * 16 + fr) * D + c0 + 32 * bj); }
#pragma unroll
            for (int n = 0; n < 2; ++n) gg[bj][n] = *(const f32x4*)(g2 + c0 + 32 * bj + 4 * n); }
#pragma unroll
        for (int ai = 0; ai < 2; ++ai)
#pragma unroll
            for (int m = 0; m < 4; ++m) { const int row = u.pm * 256 + ai * 128 + wr * 64 + m * 16 + fr;
                float ss = 0.f; f32x4 dd[3];
#pragma unroll
                for (int nb = 0; nb < 3; ++nb) dd[nb] = (f32x4){0.f, 0.f, 0.f, 0.f};
#pragma unroll
                for (int bj = 0; bj < 2; ++bj) {
                    const f32x4 v0 = acc[ai][bj][m][0], v1 = acc[ai][bj][m][1];
                    ss += ((v0.x * v0.x + v0.y * v0.y) + (v0.z * v0.z + v0.w * v0.w)) + ((v1.x * v1.x + v1.y * v1.y) + (v1.z * v1.z + v1.w * v1.w));
                    { const f32x4 a = v0 * gg[bj][0], b = v1 * gg[bj][1]; pg8::u32x4 o; o.x = pg8::cvt_pk_bf16(a.x, a.y); o.y = pg8::cvt_pk_bf16(a.z, a.w); o.z = pg8::cvt_pk_bf16(b.x, b.y); o.w = pg8::cvt_pk_bf16(b.z, b.w);
                      *(pg8::u32x4*)(HN + (size_t)row * D + c0 + 32 * bj) = o; }
                    pg8::u32x4 hp, lp;
                    hp.x = pg8::cvt_pk_bf16(v0.x, v0.y); hp.y = pg8::cvt_pk_bf16(v0.z, v0.w); hp.z = pg8::cvt_pk_bf16(v1.x, v1.y); hp.w = pg8::cvt_pk_bf16(v1.z, v1.w);
                    lp.x = pg8::cvt_pk_bf16(v0.x - bflo(hp.x), v0.y - bfhi(hp.x)); lp.y = pg8::cvt_pk_bf16(v0.z - bflo(hp.y), v0.w - bfhi(hp.y));
                    lp.z = pg8::cvt_pk_bf16(v1.x - bflo(hp.z), v1.y - bfhi(hp.z)); lp.w = pg8::cvt_pk_bf16(v1.z - bflo(hp.w), v1.w - bfhi(hp.w));
                    const pg8::bf16x8 ah = __builtin_bit_cast(pg8::bf16x8, hp), al = __builtin_bit_cast(pg8::bf16x8, lp);
#pragma unroll
                    for (int nb = 0; nb < 3; ++nb) { dd[nb] = __builtin_amdgcn_mfma_f32_16x16x32_bf16(ah, wh[bj][nb], dd[nb], 0, 0, 0); dd[nb] = __builtin_amdgcn_mfma_f32_16x16x32_bf16(ah, wl[bj][nb], dd[nb], 0, 0, 0);
                        dd[nb] = __builtin_amdgcn_mfma_f32_16x16x32_bf16(al, wh[bj][nb], dd[nb], 0, 0, 0); } }
                ss += shx(ss, 16, lane); ss += shx(ss, 32, lane);
                acc[ai][0][m][0] = dd[0]; acc[ai][0][m][1] = dd[1]; acc[ai][1][m][0] = dd[2]; acc[ai][1][m][1].x = ss; }
#pragma unroll 1
        for (int ph = 0; ph < 2; ++ph) {
            if ((wc >> 1) == ph) { LAS float* tb = tab + (wc & 1) * 256 * PW;
#pragma unroll
                for (int ai = 0; ai < 2; ++ai)
#pragma unroll
                    for (int m = 0; m < 4; ++m) { const int rb = ai * 128 + wr * 64 + m * 16;
#pragma unroll
                        for (int nb = 0; nb < 3; ++nb) { const f32x4 d = nb == 0 ? acc[ai][0][m][0] : (nb == 1 ? acc[ai][0][m][1] : acc[ai][1][m][0]);
#pragma unroll
                            for (int e = 0; e < 4; ++e) { LAS float* q = tb + (rb + 4 * fq + e) * PW + nb * 16 + fr; if (ph == 0) *q = d[e]; else *q += d[e]; } }
                        if (fq == 0) { LAS float* q = tb + (rb + fr) * PW + 48; const float s = acc[ai][1][m][1].x; if (ph == 0) *q = s; else *q += s; } }
            }
            LDS_WAIT(); __builtin_amdgcn_s_barrier();
        }
        float* dst = SUMS + ((size_t)u.pn * T + (size_t)u.pm * 256) * 64;
#pragma unroll 4
        for (int i = tid; i < 256 * 64; i += 512) { const int r = i >> 6, c = i & 63; if (c < PW) dst[(size_t)r * 64 + c] = tab[r * PW + c] + tab[256 * PW + r * PW + c]; }
    }
};
constexpr int MOE_LDS = MISC_OFF + 128;
constexpr int MOE_SLOTS = 8;
template <bool DOWN_> struct MoeOrderT {
    static constexpr bool GATHER = !DOWN_; static constexpr int A_AUX = 0;
    const LAS int* toff; const LAS int* ulist; const LAS int* idx;
    int Kb, l, wave0;
    unsigned* tcnt; unsigned* tmo;
    __device__ __forceinline__ bool next(int i, Unit& u) const {
        if (i >= ulist[8]) return false;
        const int L = ulist[i]; u.pm = L >> 2; u.pn = L & 3; u.sl = i; int e = 0;
#pragma unroll 1
        for (int q = 1; q < NEXP; ++q) if (u.pm >= toff[q]) e = q;
        u.ex = e; return true;
    }
    __device__ __forceinline__ void a_ready(const Unit& u) const {
        if constexpr (DOWN_ && !MOE_BARRIER) {
            if (wave0 == 0) {
                unsigned* w = tcnt + u.pm * TCNT_STRIDE; unsigned sp = 0;
                while ((unsigned)__builtin_amdgcn_readfirstlane(__hip_atomic_load(w, __ATOMIC_RELAXED, __HIP_MEMORY_SCOPE_AGENT)) < 32u) {
                    __builtin_amdgcn_s_sleep(2);
                    if ((++sp & 255u) == 0u) { if (__hip_atomic_load(tmo, __ATOMIC_RELAXED, __HIP_MEMORY_SCOPE_AGENT) != 0u) break;
                        if (sp > (1u << 20)) { if (fresh_lane() == 0) __hip_atomic_store(tmo, 1u, __ATOMIC_RELAXED, __HIP_MEMORY_SCOPE_AGENT); break; } } }
                __builtin_amdgcn_fence(__ATOMIC_ACQUIRE, "agent");
                asm volatile("s_waitcnt vmcnt(0)" ::: "memory");
            }
            asm volatile("" ::: "memory"); __builtin_amdgcn_s_barrier(); asm volatile("" ::: "memory");
        }
    }
    __device__ __forceinline__ unsigned arow_off(const Unit& u, int r) const { const int as = idx[u.sl * 256 + r]; return (unsigned)(as < 0 ? 0 : (as >> 1)) * (unsigned)Kb; }
    __device__ __forceinline__ size_t a_off(const Unit& u) const { return (size_t)u.pm * 256 * (size_t)Kb; }
    __device__ __forceinline__ size_t b_off(const Unit& u) const { return ((size_t)(l * NEXP + u.ex) * 1024 + (size_t)u.pn * 256) * (size_t)Kb; }
};
template <bool DOWN_> __device__ __forceinline__ MoeOrderT<DOWN_> moe_order_setup(Frame& F, int l, int Kb) {
    LAS int* toff = (LAS int*)(F.lds + MOE_LDS); LAS int* ulist = toff + 40; LAS int* idx = (LAS int*)(F.lds + MOE_LDS + 256);
    const unsigned* cnt = F.ctl + CW_CNT + (size_t)l * NEXP * CNT_STRIDE;
    if (F.wave == 0) {
        const int ln = F.lane; int nt = ln < NEXP ? ((int)cnt[ln * CNT_STRIDE] + 255) >> 8 : 0, inc = nt;
#pragma unroll
        for (int o = 1; o < 64; o <<= 1) { const int u = __builtin_amdgcn_ds_bpermute(((ln - o) & 63) << 2, inc); if (ln >= o) inc += u; }
        if (ln < NEXP) toff[ln] = inc - nt;
        if (ln == NEXP - 1) toff[NEXP] = inc;
        const int U = __builtin_amdgcn_readlane(inc, NEXP - 1) * 4, G = F.G, c = F.vcu;
        if (ln == 0) { int n = 0;
#ifndef MOE_OLD_DEAL
#define MOE_OLD_DEAL 0
#endif
        if (!DOWN_ || MOE_OLD_DEAL) { for (int L = c; L < U && n < MOE_SLOTS; L += G) ulist[n++] = L; }
        else {
            const int r = U % G, NL = G - r, a = U < 2 * NL ? U : 2 * NL, base_low = a / NL, extra_low = a % NL, R = U - a, base_all = R / G, extra_all = R % G;
            const int ord = c >= r ? c - r : NL + c;
            const int nd = (ord < NL ? base_low + (ord < extra_low ? 1 : 0) : 0) + base_all + (ord < extra_all ? 1 : 0);
            int bp[5] = {0, extra_low < NL ? extra_low : NL, extra_all, NL, G};
            if (bp[1] > bp[2]) { const int t_ = bp[1]; bp[1] = bp[2]; bp[2] = t_; }
            if (bp[2] > bp[3]) { const int t_ = bp[2]; bp[2] = bp[3]; bp[3] = t_; }
            if (bp[1] > bp[2]) { const int t_ = bp[1]; bp[1] = bp[2]; bp[2] = t_; }
            int S = 0;
            for (int k = 0; k < nd && n < MOE_SLOTS; ++k) {
                ulist[n++] = S + ord;
                int cntk = 0;
#pragma unroll
                for (int q = 0; q < 4; ++q) { const int o = bp[q], oe = bp[q + 1]; const int ndo = (o < NL ? base_low + (o < extra_low ? 1 : 0) : 0) + base_all + (o < extra_all ? 1 : 0); if (oe > o && ndo > k) cntk += oe - o; }
                S += cntk; }
        }
        ulist[8] = n; }
    }
    __syncthreads();
    MoeOrderT<DOWN_> S; S.toff = toff; S.ulist = ulist; S.idx = idx; S.Kb = Kb; S.l = l; S.wave0 = F.wave0;
    S.tcnt = F.ctl + CW_TCNT + (size_t)l * MAX_TILES * TCNT_STRIDE; S.tmo = F.ctl + CW_TMO;
    const int* LIST = (const int*)(F.ws + WS_LIST);
    Unit u;
    for (int i = 0; S.next(i, u); ++i) {
        if (F.tid < 256) { const int r = (u.pm - toff[u.ex]) * 256 + F.tid; idx[i * 256 + F.tid] = r < (int)cnt[u.ex * CNT_STRIDE] ? LIST[(size_t)u.ex * T + r] : -1; }
    }
    __syncthreads();
    return S;
}
#ifndef HID_PLAIN
#define HID_PLAIN 0
#endif
struct EpiGateUp {
    static constexpr int BMODE = 1; static constexpr bool CHAIN2 = false, AFTER_DRAIN = false;
    bf16* HID; const float* GWT; const float* RSTD; const LAS int* idx; unsigned* tcnt;
    __device__ __forceinline__ void operator()(f32x4 (&acc)[2][2][4][2], const Unit& u, int wr, int wc, int fr, int fq) const {
#pragma unroll
        for (int ai = 0; ai < 2; ++ai)
#pragma unroll
            for (int m = 0; m < 4; ++m) { const int r = ai * 128 + wr * 64 + m * 16 + fr; const int as = idx[u.sl * 256 + r];
                const float w = as < 0 ? 0.f : GWT[as]; const float rs = as < 0 ? 0.f : RSTD[as >> 1];
                const f32x4 g0 = acc[ai][0][m][0] * rs, g1 = acc[ai][0][m][1] * rs, u0 = acc[ai][1][m][0] * rs, u1 = acc[ai][1][m][1] * rs;
                f32x4 h0, h1;
#pragma unroll
                for (int e = 0; e < 4; ++e) { h0[e] = g0[e] * sigmoidf_(g0[e]) * u0[e] * w; h1[e] = g1[e] * sigmoidf_(g1[e]) * u1[e] * w; }
                if (as < 0) { h0 = (f32x4){0.f, 0.f, 0.f, 0.f}; h1 = h0; }
                pg8::u32x4 o; o.x = pg8::cvt_pk_bf16(h0.x, h0.y); o.y = pg8::cvt_pk_bf16(h0.z, h0.w); o.z = pg8::cvt_pk_bf16(h1.x, h1.y); o.w = pg8::cvt_pk_bf16(h1.z, h1.w);
#if HID_PLAIN
                *(pg8::u32x4*)(HID + (size_t)(u.pm * 256 + r) * FF + u.pn * 128 + wc * 32 + 8 * fq) = o; }
#else
                asm volatile("global_store_dwordx4 %0, %1, off sc1\n\ts_nop 1" :: "v"(HID + (size_t)(u.pm * 256 + r) * FF + u.pn * 128 + wc * 32 + 8 * fq), "v"(o) : "memory"); }
#endif
#if !MOE_BARRIER
        asm volatile("s_waitcnt vmcnt(0)" ::: "memory");
        if (fr == 0 && fq == 0) __hip_atomic_fetch_add(tcnt + u.pm * TCNT_STRIDE, 1u, __ATOMIC_RELAXED, __HIP_MEMORY_SCOPE_AGENT);
#endif
    }
};
struct EpiDown {
    static constexpr int BMODE = 2; static constexpr bool CHAIN2 = false, AFTER_DRAIN = false;
    bf16* Y; const LAS int* idx;
    __device__ __forceinline__ void operator()(f32x4 (&acc)[2][2][4][2], const Unit& u, int wr, int wc, int fr, int fq) const {
#pragma unroll
        for (int ai = 0; ai < 2; ++ai)
#pragma unroll
            for (int m = 0; m < 4; ++m) { const int r = ai * 128 + wr * 64 + m * 16 + fr; const int as = idx[u.sl * 256 + r];
                if (as >= 0) { bf16* yp = Y + (size_t)(as & 1) * T * D + (size_t)(as >> 1) * D + u.pn * 256 + wc * 64 + 8 * fq;
#pragma unroll
                    for (int bj = 0; bj < 2; ++bj) { const f32x4 v0 = acc[ai][bj][m][0], v1 = acc[ai][bj][m][1];
                        pg8::u32x4 o; o.x = pg8::cvt_pk_bf16(v0.x, v0.y); o.y = pg8::cvt_pk_bf16(v0.z, v0.w); o.z = pg8::cvt_pk_bf16(v1.x, v1.y); o.w = pg8::cvt_pk_bf16(v1.z, v1.w);
                        *(pg8::u32x4*)(yp + bj * 32) = o; } } }
    }
};

__device__ __forceinline__ void phase_inproj(Frame& F, int l) {
    pg8::StaticOrder S; S.init(T, NP, D, F.G, F.bx);
    EpiInproj E{(bf16*)(F.ws + WS_QKVG), (const float*)(F.ws + WS_GT) + l * 256, (const float*)(F.ws + WS_COSSIN)};
    pg8::gemm_phase<EpiInproj, pg8::StaticOrder, true>(F.lds + RING_OFF, F.wave0, (const bf16*)(F.ws + WS_HN), (const bf16*)(F.ws + WS_WIN) + (size_t)l * NP * D, D, S, E);
}
struct YZOrder : pg8::StaticOrder {
    size_t aof, bof;
    __device__ __forceinline__ bool next(int i, Unit& u) const { const bool ok = pg8::StaticOrder::next(i >> 1, u); u.ex = i & 1; return ok; }
    __device__ __forceinline__ size_t a_off(const Unit& u) const { return pg8::StaticOrder::a_off(u) + (u.ex ? aof : (size_t)0); }
    __device__ __forceinline__ size_t b_off(const Unit& u) const { return pg8::StaticOrder::b_off(u) + (u.ex ? bof : (size_t)0); }
};
struct EpiYZm {
    static constexpr int BMODE = 2; static constexpr bool CHAIN2 = true, AFTER_DRAIN = false;
    bf16* Z; const bf16* GA; const bf16* GF;
    __device__ __forceinline__ void operator()(f32x4 (&acc)[2][2][4][2], const Unit& u, int wr, int wc, int fr, int fq) const {
#pragma unroll
        for (int ai = 0; ai < 2; ++ai)
#pragma unroll
            for (int m = 0; m < 4; ++m) { const int row = u.pm * 256 + ai * 128 + wr * 64 + m * 16 + fr;
#pragma unroll
                for (int bj = 0; bj < 2; ++bj) { const int col = u.pn * 256 + wc * 64 + bj * 32 + 8 * fq;
                    const pg8::u32x4 fw = *(const pg8::u32x4*)(GF + (size_t)row * NP + col);
                    f32x4 f0 = (f32x4){bflo(fw.x), bfhi(fw.x), bflo(fw.y), bfhi(fw.y)}, f1 = (f32x4){bflo(fw.z), bfhi(fw.z), bflo(fw.w), bfhi(fw.w)};
#pragma unroll
                    for (int e = 0; e < 4; ++e) { f0[e] = fmaxf(f0[e], 1e-20f); f1[e] = fmaxf(f1[e], 1e-20f); }
                    if (u.ex == 0) {
                        const pg8::u32x4 aw = *(const pg8::u32x4*)(GA + (size_t)row * NP + col);
                        const f32x4 a0 = (f32x4){bflo(aw.x), bfhi(aw.x), bflo(aw.y), bfhi(aw.y)}, a1 = (f32x4){bflo(aw.z), bfhi(aw.z), bflo(aw.w), bfhi(aw.w)};
#pragma unroll
                        for (int e = 0; e < 4; ++e) { acc[ai][bj][m][0][e] *= a0[e] * __builtin_amdgcn_rcpf(f0[e]); acc[ai][bj][m][1][e] *= a1[e] * __builtin_amdgcn_rcpf(f1[e]); }
                    } else {
                        const f32x4 v0 = acc[ai][bj][m][0] * f0, v1 = acc[ai][bj][m][1] * f1;
                        pg8::u32x4 w; w.x = pg8::cvt_pk_bf16(v0.x, v0.y); w.y = pg8::cvt_pk_bf16(v0.z, v0.w); w.z = pg8::cvt_pk_bf16(v1.x, v1.y); w.w = pg8::cvt_pk_bf16(v1.z, v1.w);
                        *(pg8::u32x4*)(Z + (size_t)row * D + col) = w; } } }
    }
};
__device__ __forceinline__ void phase_yz(Frame& F, int l) {
    YZOrder S; S.init(T, D, 512, F.G, F.bx);
    S.aof = (size_t)((const char*)(F.ws + WS_OF) - (const char*)(F.ws + WS_AD)); S.bof = (size_t)((const char*)(F.ws + WS_WF) - (const char*)(F.ws + WS_WD));
    EpiYZm E{(bf16*)(F.ws + WS_Z), (const bf16*)(F.ws + WS_QKVG) + C_GA, (const bf16*)(F.ws + WS_QKVG) + C_GF};
    pg8::gemm_phase<EpiYZm, YZOrder, true>(F.lds + RING_OFF, F.wave0, (const bf16*)(F.ws + WS_AD), (const bf16*)(F.ws + WS_WD) + (size_t)l * D * 512, 512, S, E);
}
__device__ __forceinline__ void phase_wo(Frame& F, int l, bool dry = false) {
    pg8::StaticOrder S; S.init(T, D, D, F.G, F.bx);
    EpiWoR E{F.out, (l == 0 && !dry) ? (const float*)F.in[I_X] : (const float*)F.out, (bf16*)(F.ws + WS_HN), (const float*)F.in[I_LN2] + (size_t)l * D, (const bf16*)(F.ws + WS_WRT) + (size_t)l * 2 * 48 * D, (float*)(F.ws + WS_SUMS), dry};
    pg8::gemm_phase<EpiWoR, pg8::StaticOrder, true>(F.lds + RING_OFF, F.wave0, (const bf16*)(F.ws + WS_Z), (const bf16*)(F.ws + WS_WO) + (size_t)l * D * D, D, S, E);
}
__device__ __forceinline__ void phase_gateup(Frame& F, int l) {
    const MoeOrderT<false> S = moe_order_setup<false>(F, l, D * 2);
    EpiGateUp E{(bf16*)(F.ws + WS_HID), (const float*)(F.ws + WS_GWT), (const float*)(F.ws + WS_RSTD), S.idx, S.tcnt};
    pg8::gemm_phase<EpiGateUp, MoeOrderT<false>, true>(F.lds + RING_OFF, F.wave0, (const bf16*)(F.ws + WS_HN), (const bf16*)(F.ws + WS_WGU), D, S, E);
}
__device__ __forceinline__ void phase_down(Frame& F, int l) {
    const MoeOrderT<true> S = moe_order_setup<true>(F, l, FF * 2);
    EpiDown E{(bf16*)(F.ws + WS_Y), S.idx};
    pg8::gemm_phase<EpiDown, MoeOrderT<true>, true>(F.lds + RING_OFF, F.wave0, (const bf16*)(F.ws + WS_HID), (const bf16*)(F.ws + WS_WDN), FF, S, E);
}
#include <hip/hip_bf16.h>
namespace attn_body {
using bf16=__hip_bfloat16;
using bf16x8=__attribute__((ext_vector_type(8)))short;
using s16x4=__attribute__((ext_vector_type(4)))short;
using f32x16=__attribute__((ext_vector_type(16)))float;
using u32x4=__attribute__((ext_vector_type(4)))unsigned;
constexpr int SEQ=8192,D=64,DM=5120;
constexpr int NW=8,QBLK=32,QB=QBLK*NW,KVBLK=64,NQB=SEQ/QB;
constexpr int ATTN_UNIT_ROWS=QB;
__device__ __forceinline__ int crow(int r,int hi){return (r&3)+8*(r>>2)+4*hi;}
#define SBAR() __builtin_amdgcn_sched_barrier(0)
__device__ __forceinline__ void cmask(f32x16&p0,f32x16&p1,int jb,int qrel,int hi){
  const float NEG=-INFINITY; int kb=64*jb+4*hi;
  #pragma unroll
  for(int r=0;r<16;++r){int kv=kb+(r&3)+8*(r>>2); if(kv>qrel)p0[r]=NEG; if(kv+32>qrel)p1[r]=NEG;}
}

constexpr int NSLOT=3, SLOTB=8192;
constexpr int LDS_K=0, LDS_V=NSLOT*SLOTB;
template<int DV> struct Lay { static constexpr int VM=DV/64, WS=LDS_V+NSLOT*SLOTB*VM, OST=WS+NW*64*4, CK=OST+NW*4096, BYTES=CK+(DV==64?SEQ*4+512:0); };
constexpr float C2=0.125f*1.4426950408889634f;
__device__ __forceinline__ void glds16(const void*gsrc,unsigned lds_dst){unsigned keep;
  asm volatile("s_mov_b32 %0, m0\n\ts_mov_b32 m0, %2\n\ts_nop 0\n\tglobal_load_lds_dwordx4 %1, off\n\ts_mov_b32 m0, %0":"=&s"(keep):"v"(gsrc),"s"(lds_dst):"memory");}
__device__ __forceinline__ float max3f(float a,float b,float c){float r;asm("v_max3_f32 %0, %1, %2, %3":"=v"(r):"v"(a),"v"(b),"v"(c));return r;}
__device__ __forceinline__ float max2f(float a,float b){float r;asm("v_max_f32_e32 %0, %1, %2":"=v"(r):"v"(a),"v"(b));return r;}
__device__ __forceinline__ float fadd_s(float a,float b){float r;asm("v_add_f32_e32 %0, %1, %2":"=v"(r):"v"(a),"v"(b));return r;}
__device__ __forceinline__ float fsub_s(float a,float b){float r;asm("v_sub_f32_e32 %0, %1, %2":"=v"(r):"v"(a),"v"(b));return r;}
typedef float f32x2_t __attribute__((ext_vector_type(2))); typedef __bf16 bf16x2_t __attribute__((ext_vector_type(2)));
__device__ __forceinline__ unsigned cvtpk_s(float lo,float hi){f32x2_t v={lo,hi};bf16x2_t b=__builtin_convertvector(v,bf16x2_t);return __builtin_bit_cast(unsigned,b);}
#define WAIT_BAR(N) asm volatile("s_waitcnt vmcnt(" #N ") lgkmcnt(0)\n\ts_barrier":::"memory")

__device__ __forceinline__ void qkt(f32x16&p0,f32x16&p1,const char*Kslot,const bf16x8*qr,int r32,int hi){
  const char*kb=Kslot+hi*1024+r32*16;
  #pragma unroll
  for(int d0=0;d0<4;++d0){
    const bf16x8 b0=*reinterpret_cast<const bf16x8*>(kb+d0*2048);
    const bf16x8 b1=*reinterpret_cast<const bf16x8*>(kb+d0*2048+512);
    if(d0==0){p0=__builtin_amdgcn_mfma_f32_32x32x16_bf16(b0,qr[0],p0,0,0,0);p1=__builtin_amdgcn_mfma_f32_32x32x16_bf16(b1,qr[0],p1,0,0,0);}
    else{p0=__builtin_amdgcn_mfma_f32_32x32x16_bf16(b0,qr[d0],p0,0,0,0);p1=__builtin_amdgcn_mfma_f32_32x32x16_bf16(b1,qr[d0],p1,0,0,0);}}
}
typedef __attribute__((address_space(3))) const char* lds_cptr;
typedef short v4i16_t __attribute__((ext_vector_type(4)));
__device__ __forceinline__ void kload8(bf16x8*kf,lds_cptr kp){
  kf[0]=*(const __attribute__((address_space(3))) bf16x8*)(kp);      kf[1]=*(const __attribute__((address_space(3))) bf16x8*)(kp+512);
  kf[2]=*(const __attribute__((address_space(3))) bf16x8*)(kp+2048); kf[3]=*(const __attribute__((address_space(3))) bf16x8*)(kp+2560);
  kf[4]=*(const __attribute__((address_space(3))) bf16x8*)(kp+4096); kf[5]=*(const __attribute__((address_space(3))) bf16x8*)(kp+4608);
  kf[6]=*(const __attribute__((address_space(3))) bf16x8*)(kp+6144); kf[7]=*(const __attribute__((address_space(3))) bf16x8*)(kp+6656);
}
__device__ __forceinline__ void kload2(bf16x8*kf,lds_cptr kp,int j){ kf[2*j]=*(const __attribute__((address_space(3))) bf16x8*)(kp+j*2048); kf[2*j+1]=*(const __attribute__((address_space(3))) bf16x8*)(kp+j*2048+512); }
__device__ __forceinline__ s16x4 vtr(lds_cptr p){ return __builtin_bit_cast(s16x4,__builtin_amdgcn_ds_read_tr16_b64_v4i16((__attribute__((address_space(3))) v4i16_t*)p)); }
__device__ __forceinline__ float rowmax(const f32x16&p0,const f32x16&p1){
  float a=max3f(p0[0],p0[1],p1[0]),b=max3f(p0[2],p0[3],p1[1]);a=max3f(a,p1[2],p1[3]);
  #pragma unroll
  for(int r=4;r<16;r+=4){a=max3f(a,p0[r],p0[r+1]);b=max3f(b,p0[r+2],p0[r+3]);a=max3f(a,p1[r],p1[r+1]);b=max3f(b,p1[r+2],p1[r+3]);}
  const float m=max2f(a,b);
  auto rr=__builtin_amdgcn_permlane32_swap(__float_as_uint(m),__float_as_uint(m),false,false);
  return max2f(__uint_as_float(rr[0]),__uint_as_float(rr[1]));
}
template<int NO> __device__ __forceinline__ void pv(f32x16*o,int vb,bf16x8 pa0,bf16x8 pa1,bf16x8 pa2,bf16x8 pa3){
  #pragma unroll
  for(int d0=0;d0<NO;++d0){s16x4 lo[4],hi[4];
    #pragma unroll
    for(int ks=0;ks<4;++ks){
      asm volatile("ds_read_b64_tr_b16 %0,%1 offset:%c2":"=&v"(lo[ks]):"v"(vb),"i"(d0*4096+ks*1024):"memory");
      asm volatile("ds_read_b64_tr_b16 %0,%1 offset:%c2":"=&v"(hi[ks]):"v"(vb),"i"(d0*4096+ks*1024+512):"memory");}
    asm volatile("s_waitcnt lgkmcnt(0)":::"memory");SBAR();
    #define PK(k) (bf16x8){lo[k][0],lo[k][1],lo[k][2],lo[k][3],hi[k][0],hi[k][1],hi[k][2],hi[k][3]}
    o[d0]=__builtin_amdgcn_mfma_f32_32x32x16_bf16(pa0,PK(0),o[d0],0,0,0);
    o[d0]=__builtin_amdgcn_mfma_f32_32x32x16_bf16(pa1,PK(1),o[d0],0,0,0);
    o[d0]=__builtin_amdgcn_mfma_f32_32x32x16_bf16(pa2,PK(2),o[d0],0,0,0);
    o[d0]=__builtin_amdgcn_mfma_f32_32x32x16_bf16(pa3,PK(3),o[d0],0,0,0);
    #undef PK
  }
}

typedef float f32x4_t __attribute__((ext_vector_type(4)));
__device__ __forceinline__ void bias_fill(f32x16&c0,f32x16&c1,float base,const __attribute__((address_space(3))) float*ck,int hi){
  #pragma unroll
  for(int g=0;g<4;++g){const f32x4_t a=*(const __attribute__((address_space(3))) f32x4_t*)(ck+8*g+4*hi),b=*(const __attribute__((address_space(3))) f32x4_t*)(ck+32+8*g+4*hi);
    #pragma unroll
    for(int e=0;e<4;++e){c0[4*g+e]=base-a[e];c1[4*g+e]=base-b[e];}}
}
typedef __attribute__((address_space(3))) const float* lds_fptr;
__device__ __forceinline__ void ck_load(f32x4_t (&ka)[4],f32x4_t (&kb)[4],lds_fptr ck,int hi){
  #pragma unroll
  for(int g=0;g<4;++g){ka[g]=*(const __attribute__((address_space(3))) f32x4_t*)(ck+8*g+4*hi);kb[g]=*(const __attribute__((address_space(3))) f32x4_t*)(ck+32+8*g+4*hi);}
}
__device__ __forceinline__ void ck_apply(f32x16&c0,f32x16&c1,const f32x4_t (&ka)[4],const f32x4_t (&kb)[4],float add){
  #pragma unroll
  for(int g=0;g<4;++g){
    #pragma unroll
    for(int e=0;e<4;++e){c0[4*g+e]=(c0[4*g+e]-ka[g][e])+add;c1[4*g+e]=(c1[4*g+e]-kb[g][e])+add;}}
}
__device__ __forceinline__ void ck_sub(f32x16&c0,f32x16&c1,const f32x4_t (&ka)[4],const f32x4_t (&kb)[4]){
  #pragma unroll
  for(int g=0;g<4;++g){
    #pragma unroll
    for(int e=0;e<4;++e){c0[4*g+e]-=ka[g][e];c1[4*g+e]-=kb[g][e];}}
}
template<bool BIAS> __device__ __forceinline__ void cfill(f32x16&c0,f32x16&c1,float base,const __attribute__((address_space(3))) float*ck,int hi){
  if(BIAS)bias_fill(c0,c1,base,ck,hi);
  else{
    #pragma unroll
    for(int r=0;r<16;++r){c0[r]=base;c1[r]=base;} }
}
#ifndef ATTN_STORE16
#define ATTN_STORE16(p,v) (*(u32x4*)(p)=(v))
#endif
__device__ __forceinline__ int fox_t0(int qb,const float*cum,float thr,int lane){
  const int q0=qb*QB,NTf=(q0+QB)/KVBLK; const float cq0=cum[q0];
  const int t1=lane,t2=lane+64;
  const bool ok1=(t1>=NTf-4)||(cq0-cum[64*t1+63]>=-thr), ok2=(t2>=NTf-4)||(cq0-cum[(t2<NTf?64*t2+63:q0)]>=-thr);
  const unsigned long long m1=__ballot(ok1),m2=__ballot(ok2);
  int T0=m1?__builtin_ctzll(m1):(m2?64+__builtin_ctzll(m2):NTf-4); T0&=~1; if(T0>NTf-4)T0=NTf-4; return __builtin_amdgcn_readfirstlane(T0);
}
template<int THRL,bool BIAS,int OP,int DV,bool NOREF> __device__ __forceinline__ void attn_unit(int qb,const bf16*Qb,const bf16*__restrict__ Kh0,const bf16*__restrict__ Vh0,bf16*Ob,const float*cum,float thr,char*shm,const int wave0,const int T0in=-1){
  constexpr int NO=DV/32, VM=DV/64; static_assert(DV==64||(DV==128&&!BIAS),"DV"); static_assert(!(NOREF&&BIAS),"NOREF");
  const int tid=fresh_tid(wave0); const int lane=tid&63,r32=lane&31,hi=lane>>5; const int wid=__builtin_amdgcn_readfirstlane(tid>>6);
  const int q0=qb*QB;
  const bf16*Qw=Qb+(long)(q0+wid*QBLK)*DM;
  int T0=0;
  if(BIAS){ T0=T0in>=0?T0in:fox_t0(qb,cum,thr,lane); }
  const bf16*Kh=Kh0+(long)T0*KVBLK*DM; const bf16*Vh=Vh0+(long)T0*KVBLK*DM;
  const unsigned lds0=(unsigned)(uintptr_t)shm;
  float*wsf=(float*)(shm+Lay<DV>::WS)+wid*64;
  const bf16*ksrc=Kh+(long)lane*DM+wid*8;
  const bf16*vsrc=Vh+(long)(16*(wid&3)+(lane>>2))*DM+(wid>>2)*32+(lane&3)*8;
  const unsigned kdst=lds0+LDS_K+wid*1024, vdst=lds0+LDS_V+wid*1024;
  #define DMA_K(t,slot) glds16(ksrc+(long)(t)*KVBLK*DM,(unsigned)__builtin_amdgcn_readfirstlane(kdst+(slot)))
  #define DMA_V(t,slot) do{ glds16(vsrc+(long)(t)*KVBLK*DM,(unsigned)__builtin_amdgcn_readfirstlane(vdst+(slot)*VM)); if(DV==128)glds16(vsrc+64+(long)(t)*KVBLK*DM,(unsigned)__builtin_amdgcn_readfirstlane(vdst+(slot)*VM+8192)); }while(0)
  const int vb0=(int)(lds0+LDS_V)+((lane>>4)&1)*32+(lane&3)*8+(4*hi+((lane&15)>>2))*64;
  const char*Kbase=shm+LDS_K; bf16x8 kf[8];
  const lds_cptr shm3=(lds_cptr)shm; const lds_cptr kp0=shm3+LDS_K+hi*1024+r32*16; const lds_cptr vp0=shm3+LDS_V+((lane>>4)&1)*32+(lane&3)*8+(4*hi+((lane&15)>>2))*64;
  const int NT=(q0+QB)/KVBLK-T0;
  const __attribute__((address_space(3))) float*ckl=(const __attribute__((address_space(3))) float*)(shm3+Lay<DV>::CK); float cq=0.f,cqm=0.f;
  const lds_fptr cl=ckl+NT*64; float fu=1.f;
  DMA_K(0,0);DMA_V(0,0);DMA_K(1,SLOTB);
  bf16x8 qr[4];
  #pragma unroll
  for(int d0=0;d0<4;++d0)qr[d0]=*reinterpret_cast<const bf16x8*>(&Qw[(long)r32*DM+d0*16+hi*8]);
  if(BIAS){ __attribute__((address_space(3))) f32x4_t*cw=(__attribute__((address_space(3))) f32x4_t*)(shm3+Lay<DV>::CK);
    for(int i=tid;i<NT*16;i+=NW*64){ const f32x4_t v=*(const f32x4_t*)(cum+64*T0+4*i); const float last=cum[64*T0+(i>>4)*64+63]; cw[i]=v-last; }
    __attribute__((address_space(3))) float*clw=(__attribute__((address_space(3))) float*)(shm3+Lay<DV>::CK)+NT*64;
    for(int t_=tid;t_<NT;t_+=NW*64)clw[t_]=cum[64*(T0+t_)+63];
    cq=cum[q0+wid*QBLK+r32]; cqm=cq; }
  float mhat=0.f,l_reg=0.f;f32x16 o[NO];
  #pragma unroll
  for(int d_=0;d_<NO;++d_)o[d_]=f32x16{};

  const int qrel=wid*QBLK+r32;
  #define CMASK(P0,P1,t) do{int jb_=(t)-(NT-4); if(jb_>=0)cmask(P0,P1,jb_,qrel,hi);}while(0)
  int resc=0;
  #define START(P0,P1) do{ resc=0; if constexpr(!NOREF&&!BIAS) { const float rm=rowmax(P0,P1); const float dl=rm; mhat=fadd_s(mhat,dl); \
      _Pragma("unroll") for(int r=0;r<16;++r){P0[r]=fsub_s(P0[r],dl);P1[r]=fsub_s(P1[r],dl);} \
      cqm=cq-mhat; } \
    _Pragma("unroll") for(int r=0;r<16;++r)P0[r]=__builtin_amdgcn_exp2f(P0[r]); }while(0)
  #define RESC() do{ if constexpr(!NOREF){ if(BIAS&&resc==1){ _Pragma("unroll") for(int d_=0;d_<NO;++d_) _Pragma("unroll") for(int r=0;r<16;++r)o[d_][r]*=fu; } \
    else if(resc){ asm volatile("s_waitcnt lgkmcnt(0)":::"memory"); \
      _Pragma("unroll") for(int d_=0;d_<NO;++d_) _Pragma("unroll") for(int r=0;r<16;++r)o[d_][r]*=wsf[crow(r,hi)]; } } }while(0)
  f32x16 pA0,pA1,pB0,pB1;
  int sl_prev=0,sl_cur=0,sl_next=SLOTB;
  #define ROT() do{sl_prev=sl_cur;sl_cur=sl_next;sl_next=(sl_next==(NSLOT-1)*SLOTB)?0:sl_next+SLOTB;}while(0)
  DMA_K(2,2*SLOTB);
  if constexpr(DV==128){WAIT_BAR(4);}else{WAIT_BAR(3);}
  if constexpr(NOREF||BIAS){pA0=f32x16{};pA1=f32x16{};}else{cfill<BIAS>(pA0,pA1,cqm,ckl,hi);}
  qkt(pA0,pA1,Kbase,qr,r32,hi);asm volatile("s_nop 15\n\ts_nop 7":"+v"(pA0),"+v"(pA1));
  if constexpr(BIAS){ f32x4_t ka_[4],kb_[4]; ck_load(ka_,kb_,ckl,hi); ck_apply(pA0,pA1,ka_,kb_,NT==4?cq-cl[0]:0.f); }
  CMASK(pA0,pA1,0);
  START(pA0,pA1);
  _Pragma("unroll") for(int r=0;r<16;++r)pA1[r]=__builtin_amdgcn_exp2f(pA1[r]);
  WAIT_BAR(0);
  DMA_K(3,0);DMA_V(1,SLOTB);
  ROT();
  kload8(kf,kp0+sl_cur);
  if constexpr(DV==128){WAIT_BAR(3);}else{WAIT_BAR(2);}
  s16x4 vlo[8],vhi[8]; u32x4 pw0,pw1,pw2,pw3;
  #define PKW(P,B) cvtpk_s(P[B],P[B+1])
  #define PAF(k) __builtin_bit_cast(bf16x8,pw##k)
  #define VFR(i) (bf16x8){vlo[i][0],vlo[i][1],vlo[i][2],vlo[i][3],vhi[i][0],vhi[i][1],vhi[i][2],vhi[i][3]}
  #define PIN(x) asm volatile("":"+v"(x))
  #define MX3(a,b,c) __builtin_fmaxf(__builtin_fmaxf((a),(b)),(c))
  #define GAPA(MF,A0,A1,A2,A3,W0,W1,PW) do{ MF; sacc+=A0; sacc+=A1; sacc+=A2; sacc+=A3; PIN(sacc); W0; W1; PIN(PW); SBAR(); }while(0)
  #define EX(v) __builtin_amdgcn_exp2f(v)
  #define GAPB(MF,X,B) do{ MF; X[B]=EX(X[B]); X[B+1]=EX(X[B+1]); X[B+2]=EX(X[B+2]); X[B+3]=EX(X[B+3]); PIN(X); SBAR(); }while(0)
  #define GAPC(MF,X,B,RL) do{ MF; X[B]=EX(X[B]); X[B+1]=EX(X[B+1]); PIN(X); RL; SBAR(); }while(0)
  #define VRD2(i) do{ vlo[i]=vtr(vp_+((((i)>>2)+2)*4096+((i)&3)*1024)); vhi[i]=vtr(vp_+((((i)>>2)+2)*4096+((i)&3)*1024+512)); }while(0)
  #define VRD(i) do{ vlo[i]=vtr(vp_+(((i)>>2)*4096+((i)&3)*1024)); vhi[i]=vtr(vp_+(((i)>>2)*4096+((i)&3)*1024+512)); }while(0)
  #define KRD(G,j) do{ if(G){ kload2(kf,kp0+sl_next,j); SBAR(); } }while(0)
  #define CIN(X) (X)
  #define STEP(C0,C1,P0,P1,t,GK,GV,GL,BND) do{ SBAR(); \
    const lds_cptr vp_=vp0+sl_prev*VM; \
    f32x4_t ka_[4],kb_[4]; \
    if constexpr(NOREF||BIAS){C0=f32x16{};C1=f32x16{};}else{cfill<BIAS>(C0,C1,cqm,ckl+64*(t),hi);} SBAR(); \
    VRD(0); SBAR(); float sacc=(P0[0]+P0[1]); \
    GAPA(C0=__builtin_amdgcn_mfma_f32_32x32x16_bf16(kf[0],qr[0],CIN(C0),0,0,0), P0[2],P0[3],P0[4],P0[5],     pw0[0]=PKW(P0,0), pw0[1]=PKW(P0,2), pw0); \
    VRD(4); SBAR(); GAPA(C1=__builtin_amdgcn_mfma_f32_32x32x16_bf16(kf[1],qr[0],CIN(C1),0,0,0), P0[6],P0[7],P0[8],P0[9],     pw0[2]=PKW(P0,4), pw0[3]=PKW(P0,6), pw0); \
    VRD(1); SBAR(); GAPA(C0=__builtin_amdgcn_mfma_f32_32x32x16_bf16(kf[2],qr[1],C0,0,0,0),   P0[10],P0[11],P0[12],P0[13], pw1[0]=PKW(P0,8), pw1[1]=PKW(P0,10), pw1); \
    VRD(5); SBAR(); GAPA(C1=__builtin_amdgcn_mfma_f32_32x32x16_bf16(kf[3],qr[1],C1,0,0,0),   P0[14],P0[15],P1[0],P1[1],   pw1[2]=PKW(P0,12),pw1[3]=PKW(P0,14), pw1); \
    VRD(2); SBAR(); GAPA(C0=__builtin_amdgcn_mfma_f32_32x32x16_bf16(kf[4],qr[2],C0,0,0,0),   P1[2],P1[3],P1[4],P1[5],     pw2[0]=PKW(P1,0), pw2[1]=PKW(P1,2), pw2); \
    if constexpr(BIAS){ck_load(ka_,kb_,ckl+64*(t),hi); SBAR();} \
    VRD(6); SBAR(); GAPA(C1=__builtin_amdgcn_mfma_f32_32x32x16_bf16(kf[5],qr[2],C1,0,0,0),   P1[6],P1[7],P1[8],P1[9],     pw2[2]=PKW(P1,4), pw2[3]=PKW(P1,6), pw2); \
    VRD(3); SBAR(); GAPA(C0=__builtin_amdgcn_mfma_f32_32x32x16_bf16(kf[6],qr[3],C0,0,0,0),   P1[10],P1[11],P1[12],P1[13], pw3[0]=PKW(P1,8), pw3[1]=PKW(P1,10), pw3); \
    VRD(7); SBAR(); GAPA(C1=__builtin_amdgcn_mfma_f32_32x32x16_bf16(kf[7],qr[3],C1,0,0,0),   P1[14],P1[15],0.f,0.f,       pw3[2]=PKW(P1,12),pw3[3]=PKW(P1,14), pw3); \
    l_reg+=sacc; \
    if(GK){DMA_K((t)+3,sl_cur);} if(GV){DMA_V((t)+1,sl_next);} \
    if constexpr(BIAS){ const bool bnd_=(BND)&&((t)>=NT-4); if constexpr((BND)==0){ck_sub(C0,C1,ka_,kb_);}else{ck_apply(C0,C1,ka_,kb_,bnd_?cq-cl[(t)]:0.f);} \
      if(!bnd_){ fu=__builtin_amdgcn_exp2f(cl[(t)]-cl[(t)-1]); l_reg*=fu; resc=1; } \
      else if((t)==NT-4){ const float f_=__builtin_amdgcn_exp2f(cq-cl[(t)-1]); l_reg*=f_; if(hi==0)wsf[r32]=f_; resc=2; } \
      else resc=0; } \
    CMASK(C0,C1,t); \
    if constexpr(!NOREF&&!BIAS){ float a=MX3(C0[0],C0[1],C1[0]),b=MX3(C0[2],C0[3],C1[1]); a=MX3(a,C1[2],C1[3]); \
      _Pragma("unroll") for(int r=4;r<16;r+=4){a=MX3(a,C0[r],C0[r+1]);b=MX3(b,C0[r+2],C0[r+3]);a=MX3(a,C1[r],C1[r+1]);b=MX3(b,C1[r+2],C1[r+3]);} \
      float rm=__builtin_fmaxf(a,b); { auto rr=__builtin_amdgcn_permlane32_swap(__float_as_uint(rm),__float_as_uint(rm),false,false); rm=__builtin_fmaxf(__uint_as_float(rr[0]),__uint_as_float(rr[1])); } \
      resc=0; \
      if(__builtin_expect(__any(rm>(float)THRL),0)){ const float dl=__builtin_fmaxf(rm,0.f); mhat+=dl; \
        _Pragma("unroll") for(int r=0;r<16;++r){C0[r]-=dl;C1[r]-=dl;} \
        cqm=cq-mhat; \
        const float f=__builtin_amdgcn_exp2f(-dl); l_reg*=f; if(hi==0)wsf[r32]=f; resc=2; } } \
    SBAR(); \
    if constexpr(DV==64){ \
    GAPB(o[0]=__builtin_amdgcn_mfma_f32_32x32x16_bf16(PAF(0),VFR(0),o[0],0,0,0), C0,0); \
    GAPB(o[1]=__builtin_amdgcn_mfma_f32_32x32x16_bf16(PAF(0),VFR(4),o[1],0,0,0), C0,4); \
    KRD(GL,0); GAPB(o[0]=__builtin_amdgcn_mfma_f32_32x32x16_bf16(PAF(1),VFR(1),o[0],0,0,0), C0,8); \
    KRD(GL,1); GAPB(o[1]=__builtin_amdgcn_mfma_f32_32x32x16_bf16(PAF(1),VFR(5),o[1],0,0,0), C0,12); \
    KRD(GL,2); GAPB(o[0]=__builtin_amdgcn_mfma_f32_32x32x16_bf16(PAF(2),VFR(2),o[0],0,0,0), C1,0); \
    KRD(GL,3); GAPB(o[1]=__builtin_amdgcn_mfma_f32_32x32x16_bf16(PAF(2),VFR(6),o[1],0,0,0), C1,4); \
    GAPB(o[0]=__builtin_amdgcn_mfma_f32_32x32x16_bf16(PAF(3),VFR(3),o[0],0,0,0), C1,8); \
    GAPB(o[1]=__builtin_amdgcn_mfma_f32_32x32x16_bf16(PAF(3),VFR(7),o[1],0,0,0), C1,12); \
    } else { \
    GAPC(o[0]=__builtin_amdgcn_mfma_f32_32x32x16_bf16(PAF(0),VFR(0),o[0],0,0,0), C0,0, VRD2(0)); \
    GAPC(o[1]=__builtin_amdgcn_mfma_f32_32x32x16_bf16(PAF(0),VFR(4),o[1],0,0,0), C0,2, VRD2(4)); \
    GAPC(o[0]=__builtin_amdgcn_mfma_f32_32x32x16_bf16(PAF(1),VFR(1),o[0],0,0,0), C0,4, VRD2(1)); \
    GAPC(o[1]=__builtin_amdgcn_mfma_f32_32x32x16_bf16(PAF(1),VFR(5),o[1],0,0,0), C0,6, VRD2(5)); \
    GAPC(o[0]=__builtin_amdgcn_mfma_f32_32x32x16_bf16(PAF(2),VFR(2),o[0],0,0,0), C0,8, VRD2(2)); \
    GAPC(o[1]=__builtin_amdgcn_mfma_f32_32x32x16_bf16(PAF(2),VFR(6),o[1],0,0,0), C0,10, VRD2(6)); \
    GAPC(o[0]=__builtin_amdgcn_mfma_f32_32x32x16_bf16(PAF(3),VFR(3),o[0],0,0,0), C0,12, VRD2(3)); \
    GAPC(o[1]=__builtin_amdgcn_mfma_f32_32x32x16_bf16(PAF(3),VFR(7),o[1],0,0,0), C0,14, VRD2(7)); \
    GAPC(o[2]=__builtin_amdgcn_mfma_f32_32x32x16_bf16(PAF(0),VFR(0),o[2],0,0,0), C1,0, (void)0); \
    KRD(GL,0); GAPC(o[3]=__builtin_amdgcn_mfma_f32_32x32x16_bf16(PAF(0),VFR(4),o[3],0,0,0), C1,2, (void)0); \
    KRD(GL,1); GAPC(o[2]=__builtin_amdgcn_mfma_f32_32x32x16_bf16(PAF(1),VFR(1),o[2],0,0,0), C1,4, (void)0); \
    KRD(GL,2); GAPC(o[3]=__builtin_amdgcn_mfma_f32_32x32x16_bf16(PAF(1),VFR(5),o[3],0,0,0), C1,6, (void)0); \
    KRD(GL,3); GAPC(o[2]=__builtin_amdgcn_mfma_f32_32x32x16_bf16(PAF(2),VFR(2),o[2],0,0,0), C1,8, (void)0); \
    GAPC(o[3]=__builtin_amdgcn_mfma_f32_32x32x16_bf16(PAF(2),VFR(6),o[3],0,0,0), C1,10, (void)0); \
    GAPC(o[2]=__builtin_amdgcn_mfma_f32_32x32x16_bf16(PAF(3),VFR(3),o[2],0,0,0), C1,12, (void)0); \
    GAPC(o[3]=__builtin_amdgcn_mfma_f32_32x32x16_bf16(PAF(3),VFR(7),o[3],0,0,0), C1,14, (void)0); \
    } \
    }while(0)
  #define WB_FULL() do{ if constexpr(DV==128){WAIT_BAR(3);}else{WAIT_BAR(2);} }while(0)
  int t=1;
  #undef CMASK
  #define CMASK(P0,P1,t) do{}while(0)
  for(;t+5<NT;t+=2){
    STEP(pB0,pB1,pA0,pA1,t,true,true,true,0);     WB_FULL(); RESC(); ROT();
    STEP(pA0,pA1,pB0,pB1,t+1,true,true,true,0);   WB_FULL(); RESC(); ROT();
  }
  #undef CMASK
  #define CMASK(P0,P1,t) do{int jb_=(t)-(NT-4); if(jb_>=0)cmask(P0,P1,jb_,qrel,hi);}while(0)
  #define ENDW(tt) do{ if((tt)+3<NT){WB_FULL();} else if((tt)+2<NT){ if constexpr(DV==128){WAIT_BAR(2);}else{WAIT_BAR(1);} } else {WAIT_BAR(0);} }while(0)
  for(;t+1<NT;t+=2){
    STEP(pB0,pB1,pA0,pA1,t,(t+3<NT),(t+1<NT),(t+1<NT),1);       ENDW(t);   RESC(); ROT();
    STEP(pA0,pA1,pB0,pB1,t+1,(t+4<NT),(t+2<NT),(t+2<NT),1);     ENDW(t+1); RESC(); ROT();
  }
  STEP(pB0,pB1,pA0,pA1,NT-1,false,false,false,1); RESC();
  { float sacc=pB0[0]+pB0[1]; _Pragma("unroll") for(int r=2;r<16;++r)sacc+=pB0[r]; _Pragma("unroll") for(int r=0;r<16;++r)sacc+=pB1[r]; l_reg+=sacc;
    pw0=(u32x4){PKW(pB0,0),PKW(pB0,2),PKW(pB0,4),PKW(pB0,6)};pw1=(u32x4){PKW(pB0,8),PKW(pB0,10),PKW(pB0,12),PKW(pB0,14)};pw2=(u32x4){PKW(pB1,0),PKW(pB1,2),PKW(pB1,4),PKW(pB1,6)};pw3=(u32x4){PKW(pB1,8),PKW(pB1,10),PKW(pB1,12),PKW(pB1,14)};
    SBAR(); pv<NO>(o,vb0+sl_cur*VM,PAF(0),PAF(1),PAF(2),PAF(3)); }
  #undef PKW
  #undef PAF
  #undef VFR
  #undef PIN
  #undef MX3
  #undef GAPA
  #undef GAPB
  #undef EX
  #undef VRD
  #undef VRD2
  #undef GAPC
  #undef KRD
  #undef STEP
  #undef CIN
  #undef ENDW
  #undef WB_FULL
  {auto rr=__builtin_amdgcn_permlane32_swap(__float_as_uint(l_reg),__float_as_uint(l_reg),false,false);l_reg=__uint_as_float(rr[0])+__uint_as_float(rr[1]);}
  if(hi==0)wsf[32+r32]=l_reg;asm volatile("s_waitcnt lgkmcnt(0)":::"memory");
  float rli[16];
  #pragma unroll
  for(int r=0;r<16;++r)rli[r]=__builtin_amdgcn_rcpf(wsf[32+crow(r,hi)]);
  bf16*Ow=Ob+(long)(q0+wid*QBLK)*OP;
  { bf16*stg=(bf16*)(shm+Lay<DV>::OST)+wid*2048;
    #pragma unroll
    for(int ps=0;ps<NO/2;++ps){
    #pragma unroll
    for(int r=0;r<16;++r){const int orow=crow(r,hi);
      #pragma unroll
      for(int d0=0;d0<2;++d0)stg[orow*64+d0*32+r32]=__float2bfloat16(o[2*ps+d0][r]*rli[r]);}
    asm volatile("s_waitcnt lgkmcnt(0)":::"memory");
    #pragma unroll
    for(int i=0;i<4;++i){const int row=i*8+(lane>>3),ch=lane&7; const u32x4 v=*(const u32x4*)(stg+row*64+ch*8); ATTN_STORE16(Ow+(long)row*OP+ps*64+ch*8,v);}
    asm volatile("s_waitcnt lgkmcnt(0)":::"memory"); } }
  asm volatile("s_waitcnt lgkmcnt(0)\n\ts_barrier":::"memory");
  #undef DMA_K
  #undef DMA_V
  #undef CMASK
  #undef START
  #undef RESC
  #undef ROT
}
constexpr int ATTN_LDS_BYTES=Lay<64>::BYTES>Lay<128>::BYTES?Lay<64>::BYTES:Lay<128>::BYTES;
#undef SBAR
#undef WAIT_BAR
}
__device__ __forceinline__ void diffc_item(Frame& F, int l, int b, int h, int qb) {
    const int lane = fresh_lane(); int w = F.wave0; asm volatile("" : "+s"(w));
    const float* lq1 = (const float*)F.in[I_LQ1] + l * 64; const float* lk1 = (const float*)F.in[I_LK1] + l * 64;
    const float* lq2 = (const float*)F.in[I_LQ2] + l * 64; const float* lk2 = (const float*)F.in[I_LK2] + l * 64;
    int ll = l; asm volatile("" : "+s"(ll));
    const float li = lambda_init_of(ll); const float oml = ll == 0 ? 1.0f - lambda_init_of(0) : 1.0f - lambda_init_of(1);
    const float lamv = __builtin_amdgcn_exp2f(LOG2E * wave_sum(lq1[lane] * lk1[lane], lane)) - __builtin_amdgcn_exp2f(LOG2E * wave_sum(lq2[lane] * lk2[lane], lane)) + li;
    const float lam = __builtin_bit_cast(float, __builtin_amdgcn_readfirstlane(__builtin_bit_cast(int, lamv)));
    const float* sub = (const float*)F.in[I_SUBLN] + l * 128;
    const bf16* OA = (const bf16*)(F.ws + WS_OA); bf16* AD = (bf16*)(F.ws + WS_AD);
    const int d0 = (lane & 15) * 8;
    float sg[8];
#pragma unroll
    for (int e = 0; e < 8; ++e) sg[e] = sub[d0 + e] * oml;
    const size_t row0 = (size_t)b * SEQ + (size_t)qb * 256 + w * 32 + (lane >> 4);
    v4u a_[8], b_[8];
#pragma unroll
    for (int q = 0; q < 8; ++q) { const bf16* src = OA + (row0 + q * 4) * 1024 + h * 128 + d0;
        asm volatile("global_load_dwordx4 %0, %2, off sc1\n\tglobal_load_dwordx4 %1, %2, off offset:1024 sc1" : "=&v"(a_[q]), "=&v"(b_[q]) : "v"(src) : "memory"); }
    asm volatile("s_waitcnt vmcnt(0)" : "+v"(a_[0]), "+v"(a_[1]), "+v"(a_[2]), "+v"(a_[3]), "+v"(a_[4]), "+v"(a_[5]), "+v"(a_[6]), "+v"(a_[7]), "+v"(b_[0]), "+v"(b_[1]), "+v"(b_[2]), "+v"(b_[3]), "+v"(b_[4]), "+v"(b_[5]), "+v"(b_[6]), "+v"(b_[7]) :: "memory");
#pragma unroll
    for (int q = 0; q < 8; ++q) { const v4u a = a_[q], bb = b_[q];
        typedef float f32x2_ __attribute__((ext_vector_type(2)));
        f32x2_ vv[4]; float ss = 0.f;
#pragma unroll
        for (int k = 0; k < 4; ++k) { const f32x2_ av = {bflo(a[k]), bfhi(a[k])}, bv = {bflo(bb[k]), bfhi(bb[k])}; vv[k] = av - lam * bv; ss += vv[k].x * vv[k].x + vv[k].y * vv[k].y; }
        ss += shx(ss, 1, lane); ss += shx(ss, 2, lane); ss += shx(ss, 4, lane); ss += shx(ss, 8, lane);
        const float r = __builtin_amdgcn_rsqf(ss * (1.0f / 128.0f) + EPS);
        v4u o;
#pragma unroll
        for (int k = 0; k < 4; ++k) o[k] = pk2(vv[k].x * r * sg[2 * k], vv[k].y * r * sg[2 * k + 1]);
        *(v4u*)(AD + (row0 + q * 4) * 512 + h * 128 + d0) = o; }
}
#define DIFF_HANDOFF(qb_) do { VM_WAIT(); __syncthreads(); volatile LAS unsigned* qw_ = F.MISC + 16; \
        if (fresh_tid(F.wave0) == 0) qw_[0] = __hip_atomic_fetch_add(F.ctl + CW_DCNT + ((((l * BATCH + b) * 4 + (m & 3)) * 32 + (qb_)) * DCNT_STRIDE), 1u, __ATOMIC_RELEASE, __HIP_MEMORY_SCOPE_AGENT); \
        __syncthreads(); const unsigned old_ = qw_[0]; __syncthreads(); \
        if (old_ == 1u) diffc_item(F, l, b, m & 3, (qb_)); } while (0)
template <int AVAR = 0> __device__ __forceinline__ void phase_attn(Frame& F, int l) {
    const attn_body::bf16* QKVG = (const attn_body::bf16*)(F.ws + WS_QKVG);
    attn_body::bf16* OA = (attn_body::bf16*)(F.ws + WS_OA); attn_body::bf16* OFp = (attn_body::bf16*)(F.ws + WS_OF);
    const float* CUM = (const float*)(F.ws + WS_CUM);
    char* shm = (char*)(F.lds + RING_OFF);
    bool noref;
    { const int ln = fresh_lane();
      const float* gtd = (const float*)(F.ws + WS_GT) + l * 256; float gq = fabsf(gtd[ln]), gk = fabsf(gtd[64 + ln]);
#pragma unroll
      for (int o = 1; o < 64; o <<= 1) { gq = fmaxf(gq, shx(gq, o, ln)); gk = fmaxf(gk, shx(gk, o, ln)); }
      noref = __builtin_amdgcn_readfirstlane((int)(1.02f * 64.0f * gq * gk < 100.0f)) != 0; }
    if (AVAR & 1) {} else if (noref) {
        for (int p = F.vcu; p < 256; p += F.G) {
            const int he = p >> 4, x = p & 15, b = he >> 3, m = he & 7;
            const attn_body::bf16* base = QKVG + (size_t)b * SEQ * NP;
#pragma unroll 1
            for (int s2 = 0; s2 < 2; ++s2) {
                attn_body::attn_unit<8, false, 1024, 128, true>(s2 == 0 ? 31 - x : x, base + C_QA + m * 64, base + C_KA + m * 64, base + C_VA + (m & 3) * 128, OA + (size_t)b * SEQ * 1024 + m * 128, nullptr, 0.f, shm, F.wave0);
                DIFF_HANDOFF(s2 == 0 ? 31 - x : x);
            }
        }
    } else {
        for (int p = F.vcu; p < 256; p += F.G) {
            const int he = p >> 4, x = p & 15, b = he >> 3, m = he & 7;
            const attn_body::bf16* base = QKVG + (size_t)b * SEQ * NP;
#pragma unroll 1
            for (int s2 = 0; s2 < 2; ++s2) {
                attn_body::attn_unit<8, false, 1024, 128, false>(s2 == 0 ? 31 - x : x, base + C_QA + m * 64, base + C_KA + m * 64, base + C_VA + (m & 3) * 128, OA + (size_t)b * SEQ * 1024 + m * 128, nullptr, 0.f, shm, F.wave0);
                DIFF_HANDOFF(s2 == 0 ? 31 - x : x);
            }
        }
    }
    float thr2;
    { const int ln = fresh_lane();
      const float* gtf = (const float*)(F.ws + WS_GT) + l * 256 + 128; float gq = fabsf(gtf[ln]), gk = fabsf(gtf[64 + ln]);
#pragma unroll
      for (int o = 1; o < 64; o <<= 1) { gq = fmaxf(gq, shx(gq, o, ln)); gk = fmaxf(gk, shx(gk, o, ln)); }
      thr2 = __builtin_bit_cast(float, __builtin_amdgcn_readfirstlane(__builtin_bit_cast(int, 150.0f + 2.0f * 1.02f * 64.0f * gq * gk + 8.0f))); }
    if (!(AVAR & 2)) {
        unsigned* qctr = F.ctl + CW_FOXQ + 16 * l; volatile LAS unsigned* qw = F.MISC + 16;
        for (;;) {
            if (fresh_tid(F.wave0) == 0) qw[0] = __hip_atomic_fetch_add(qctr, 1u, __ATOMIC_RELAXED, __HIP_MEMORY_SCOPE_AGENT);
            __syncthreads();
            const int u = (int)qw[0];
            __syncthreads();
            if (u >= 512) break;
            const int qb = 31 - (u >> 4), hf = u & 15, b = hf >> 3, h = hf & 7;
            const attn_body::bf16* base = QKVG + (size_t)b * SEQ * NP;
            attn_body::attn_unit<8, true, 512, 64, false>(qb, base + C_QF + h * 64, base + C_KF + h * 64, base + C_VF + h * 64, OFp + (size_t)b * SEQ * 512 + h * 64, CUM + ((size_t)b * 8 + h) * SEQ, (AVAR & 4) ? 1e30f : thr2, shm, F.wave0, -1);
        }
    }
}
#if BUILD_ORACLE
namespace orc {
__device__ __forceinline__ void tile_mm(const bf16* A, int lda, const int* arow  , const bf16* B, int ldb, int brow0, int K, float (*sA)[68], float (*sB)[68], float (&acc)[4][4]) {
    const int tid = threadIdx.x, ty = tid >> 4, tx = tid & 15, lr = tid >> 2, lc = (tid & 3) * 8;
    for (int k0 = 0; k0 < K; k0 += 32) {
        __syncthreads();
        { const int ar = arow[lr]; v4u a = (v4u){0u, 0u, 0u, 0u}; if (ar >= 0) a = *(const v4u*)(A + (size_t)ar * lda + k0 + lc);
          const v4u b = *(const v4u*)(B + (size_t)(brow0 + lr) * ldb + k0 + lc);
          sA[lc + 0][lr] = bflo(a.x); sA[lc + 1][lr] = bfhi(a.x); sA[lc + 2][lr] = bflo(a.y); sA[lc + 3][lr] = bfhi(a.y); sA[lc + 4][lr] = bflo(a.z); sA[lc + 5][lr] = bfhi(a.z); sA[lc + 6][lr] = bflo(a.w); sA[lc + 7][lr] = bfhi(a.w);
          sB[lc + 0][lr] = bflo(b.x); sB[lc + 1][lr] = bfhi(b.x); sB[lc + 2][lr] = bflo(b.y); sB[lc + 3][lr] = bfhi(b.y); sB[lc + 4][lr] = bflo(b.z); sB[lc + 5][lr] = bfhi(b.z); sB[lc + 6][lr] = bflo(b.w); sB[lc + 7][lr] = bfhi(b.w); }
        __syncthreads();
#pragma unroll 8
        for (int kk = 0; kk < 32; ++kk) { const f32x4 a = *(const f32x4*)&sA[kk][ty * 4], b = *(const f32x4*)&sB[kk][tx * 4];
#pragma unroll
            for (int i = 0; i < 4; ++i)
#pragma unroll
                for (int j = 0; j < 4; ++j) acc[i][j] += a[i] * b[j]; }
    }
}
__device__ __forceinline__ void put_tile(float (*Ct)[65], const float (&acc)[4][4]) {
    const int tid = threadIdx.x, ty = tid >> 4, tx = tid & 15;
#pragma unroll
    for (int i = 0; i < 4; ++i)
#pragma unroll
        for (int j = 0; j < 4; ++j) Ct[ty * 4 + i][tx * 4 + j] = acc[i][j];
}
#define ORC_SHARED __shared__ float sA[32][68]; __shared__ float sB[32][68]; __shared__ float Ct[64][65]; __shared__ int arow[64];
#define ZACC(a) _Pragma("unroll") for (int i_ = 0; i_ < 4; ++i_) _Pragma("unroll") for (int j_ = 0; j_ < 4; ++j_) a[i_][j_] = 0.f

__global__ void __launch_bounds__(256) inproj(Args a, int l) {
    ORC_SHARED
    const int n0 = blockIdx.x * 64, m0 = blockIdx.y * 64, tid = threadIdx.x;
    const bf16* HN = (const bf16*)(a.ws + WS_HN); const bf16* W = (const bf16*)(a.ws + WS_WIN) + (size_t)l * NP * D; bf16* QKVG = (bf16*)(a.ws + WS_QKVG);
    if (tid < 64) arow[tid] = m0 + tid;
    float acc[4][4]; ZACC(acc);
    tile_mm(HN, D, arow, W, D, n0, D, sA, sB, acc);
    put_tile(Ct, acc); __syncthreads();
    if (tid < 64) {
        const int row = m0 + tid, seg = n0 / 512; float v[64];
#pragma unroll
        for (int s = 0; s < 64; ++s) v[s] = Ct[tid][s];
        if (seg == 0 || seg == 1 || seg == 3 || seg == 4) {
            float ss = 0.f;
#pragma unroll
            for (int s = 0; s < 64; ++s) ss += v[s] * v[s];
            const float rs = 1.0f / sqrtf(ss * (1.0f / 64.0f) + EPS);
            const float* g = (const float*)a.in[seg == 0 ? I_QND : seg == 1 ? I_KND : seg == 3 ? I_QNF : I_KNF] + l * 64;
            const bool diff = seg < 2;
#pragma unroll
            for (int s = 0; s < 64; ++s) { const int d = (diff && s < 32) ? pi32(s) : s; v[s] = v[s] * rs * g[d]; }
            if (diff) { const float* cs = (const float*)(a.ws + WS_COSSIN) + (size_t)row * 16;
#pragma unroll
                for (int i = 0; i < 8; ++i) { const int s1 = pi32(i), s2 = pi32(i + 8); const float t1 = v[s1], t2 = v[s2], c = cs[i], sn = cs[8 + i]; v[s1] = t1 * c - t2 * sn; v[s2] = t2 * c + t1 * sn; } }
            if (seg == 0 || seg == 3) {
#pragma unroll
                for (int s = 0; s < 64; ++s) v[s] *= C2; }
        } else if (seg >= 6) {
#pragma unroll
            for (int s = 0; s < 64; ++s) v[s] = 1.0f / (1.0f + expf(-v[s]));
        }
#pragma unroll
        for (int s = 0; s < 64; s += 2) *(unsigned*)(QKVG + (size_t)row * NP + n0 + s) = pk2(v[s], v[s + 1]);
    }
}
struct AttnP { const bf16* Q; const bf16* K; const bf16* V; bf16* O; int qc, kc, vc, oc, opitch; int bias; };
__global__ void __launch_bounds__(256) attn(Args a, int mode  ) {
    __shared__ float sK[64][64]; __shared__ float sV[64][64]; __shared__ float sC[64];
    const int qb = blockIdx.x, he = blockIdx.y, tid = threadIdx.x;
    const bf16* QKVG = (const bf16*)(a.ws + WS_QKVG);
    int b, qc, kc, vc, oc, opitch; bf16* O; const float* cum = nullptr;
    if (mode == 0) { b = he / 16; const int r = he % 16, m = r >> 1, vh = r & 1; qc = C_QA + m * 64; kc = C_KA + m * 64; vc = C_VA + (m & 3) * 128 + vh * 64; O = (bf16*)(a.ws + WS_OA); oc = m * 128 + vh * 64; opitch = 1024; }
    else { b = he / 8; const int h = he % 8; qc = C_QF + h * 64; kc = C_KF + h * 64; vc = C_VF + h * 64; O = (bf16*)(a.ws + WS_OF); oc = h * 64; opitch = 512; cum = (const float*)(a.ws + WS_CUM) + ((size_t)b * 8 + h) * SEQ; }
    const int q0 = qb * 256, qi = q0 + tid; const size_t rowg = (size_t)b * SEQ + qi;
    float q[64], o[64];
#pragma unroll
    for (int d = 0; d < 64; ++d) { q[d] = bf2f(QKVG[rowg * NP + qc + d]); o[d] = 0.f; }
    const float cq = cum ? cum[qi] : 0.f;
    float m = -INFINITY, lsum = 0.f;
    const int nkt = (q0 + 256) / 64;
    for (int kt = 0; kt < nkt; ++kt) {
        __syncthreads();
        { const int r = tid >> 2, c0 = (tid & 3) * 16; const size_t kr = (size_t)b * SEQ + kt * 64 + r;
#pragma unroll
          for (int c = 0; c < 16; ++c) { sK[r][c0 + c] = bf2f(QKVG[kr * NP + kc + c0 + c]); sV[r][c0 + c] = bf2f(QKVG[kr * NP + vc + c0 + c]); }
          if (tid < 64) sC[tid] = cum ? cum[kt * 64 + tid] : 0.f; }
        __syncthreads();
        for (int j = 0; j < 64; ++j) {
            const int key = kt * 64 + j;
            if (key <= qi) {
                float s = 0.f;
#pragma unroll
                for (int d = 0; d < 64; ++d) s += q[d] * sK[j][d];
                s += cq - sC[j];
                if (s > m) { const float corr = exp2f(m - s); lsum *= corr;
#pragma unroll
                    for (int d = 0; d < 64; ++d) o[d] *= corr;
                    m = s; }
                const float p = exp2f(s - m); lsum += p;
#pragma unroll
                for (int d = 0; d < 64; ++d) o[d] += p * sV[j][d];
            }
        }
    }
    const float inv = 1.0f / lsum;
#pragma unroll
    for (int d = 0; d < 64; d += 2) *(unsigned*)(O + rowg * opitch + oc + d) = pk2(o[d] * inv, o[d + 1] * inv);
}
__global__ void __launch_bounds__(256) yz(Args a, int l) {
    ORC_SHARED
    __shared__ float Ct2[64][65];
    const int n0 = blockIdx.x * 64, m0 = blockIdx.y * 64, tid = threadIdx.x;
    if (tid < 64) arow[tid] = m0 + tid;
    float acc[4][4], acc2[4][4]; ZACC(acc); ZACC(acc2);
    tile_mm((const bf16*)(a.ws + WS_AD), 512, arow, (const bf16*)(a.ws + WS_WD) + (size_t)l * D * 512, 512, n0, 512, sA, sB, acc);
    tile_mm((const bf16*)(a.ws + WS_OF), 512, arow, (const bf16*)(a.ws + WS_WF) + (size_t)l * D * 512, 512, n0, 512, sA, sB, acc2);
    put_tile(Ct, acc); put_tile(Ct2, acc2); __syncthreads();
    const bf16* QKVG = (const bf16*)(a.ws + WS_QKVG); bf16* Z = (bf16*)(a.ws + WS_Z);
    if (tid < 64) { const int row = m0 + tid;
        for (int s = 0; s < 64; ++s) { const float ga = bf2f(QKVG[(size_t)row * NP + C_GA + n0 + s]), gf = bf2f(QKVG[(size_t)row * NP + C_GF + n0 + s]);
            Z[(size_t)row * D + n0 + s] = (bf16)f2bf(ga * Ct[tid][s] + gf * Ct2[tid][s]); } }
}
__global__ void __launch_bounds__(256) wo(Args a, int l) {
    ORC_SHARED
    const int n0 = blockIdx.x * 64, m0 = blockIdx.y * 64, tid = threadIdx.x;
    if (tid < 64) arow[tid] = m0 + tid;
    float acc[4][4]; ZACC(acc);
    tile_mm((const bf16*)(a.ws + WS_Z), D, arow, (const bf16*)(a.ws + WS_WO) + (size_t)l * D * D, D, n0, D, sA, sB, acc);
    put_tile(Ct, acc); __syncthreads();
    if (tid < 64) { const int row = m0 + tid; for (int s = 0; s < 64; ++s) a.out[(size_t)row * D + n0 + s] += Ct[tid][s]; }
}
__device__ __forceinline__ int find_expert(const unsigned* cnt, int t256, int& tile_in_e, int& cnt_e) {
    int off = 0;
    for (int e = 0; e < NEXP; ++e) { const int c = (int)cnt[e * CNT_STRIDE], nt = (c + 255) >> 8; if (t256 < off + nt) { tile_in_e = t256 - off; cnt_e = c; return e; } off += nt; }
    return -1;
}
__global__ void __launch_bounds__(256) gateup(Args a, int l) {
    ORC_SHARED
    __shared__ float Ct2[64][65]; __shared__ int asg[64];
    const int f0 = blockIdx.x * 64, m64 = blockIdx.y, tid = threadIdx.x;
    const unsigned* cnt = (const unsigned*)(a.ws + WS_CTL) + CW_CNT + (size_t)l * NEXP * CNT_STRIDE;
    int tie, ce; const int e = find_expert(cnt, m64 >> 2, tie, ce);
    if (e < 0) return;
    const int* LIST = (const int*)(a.ws + WS_LIST) + (size_t)e * T;
    if (tid < 64) { const int r = tie * 256 + (m64 & 3) * 64 + tid; const int as = r < ce ? LIST[r] : -1; asg[tid] = as; arow[tid] = as < 0 ? -1 : (as >> 1); }
    __syncthreads();
    const bf16* W = (const bf16*)(a.ws + WS_WGU) + ((size_t)l * NEXP + e) * 1024 * 1024;
    const int brow = (f0 >> 7) * 256 + (f0 & 127);
    float acc[4][4], acc2[4][4]; ZACC(acc); ZACC(acc2);
    tile_mm((const bf16*)(a.ws + WS_HN), D, arow, W, D, brow, D, sA, sB, acc);
    tile_mm((const bf16*)(a.ws + WS_HN), D, arow, W, D, brow + 128, D, sA, sB, acc2);
    put_tile(Ct, acc); put_tile(Ct2, acc2); __syncthreads();
    bf16* HID = (bf16*)(a.ws + WS_HID); const float* GWT = (const float*)(a.ws + WS_GWT);
    if (tid < 64) { const int as = asg[tid]; const float w = as < 0 ? 0.f : GWT[as]; const size_t hr = (size_t)m64 * 64 + tid;
        for (int s = 0; s < 64; ++s) { const float g = Ct[tid][s], u = Ct2[tid][s]; const float h = as < 0 ? 0.f : (g / (1.0f + expf(-g))) * u * w; HID[hr * FF + f0 + s] = (bf16)f2bf(h); } }
}
__global__ void __launch_bounds__(256) down(Args a, int l) {
    ORC_SHARED
    __shared__ int asg[64];
    const int n0 = blockIdx.x * 64, m64 = blockIdx.y, tid = threadIdx.x;
    const unsigned* cnt = (const unsigned*)(a.ws + WS_CTL) + CW_CNT + (size_t)l * NEXP * CNT_STRIDE;
    int tie, ce; const int e = find_expert(cnt, m64 >> 2, tie, ce);
    if (e < 0) return;
    const int* LIST = (const int*)(a.ws + WS_LIST) + (size_t)e * T;
    if (tid < 64) { const int r = tie * 256 + (m64 & 3) * 64 + tid; asg[tid] = r < ce ? LIST[r] : -1; arow[tid] = m64 * 64 + tid; }
    __syncthreads();
    float acc[4][4]; ZACC(acc);
    tile_mm((const bf16*)(a.ws + WS_HID), FF, arow, (const bf16*)(a.ws + WS_WDN) + ((size_t)l * NEXP + e) * 1024 * 512, FF, n0, FF, sA, sB, acc);
    put_tile(Ct, acc); __syncthreads();
    bf16* Y = (bf16*)(a.ws + WS_Y);
    if (tid < 64) { const int as = asg[tid]; if (as >= 0) { const size_t base = (size_t)(as & 1) * T * D + (size_t)(as >> 1) * D + n0;
        for (int s = 0; s < 64; ++s) Y[base + s] = (bf16)f2bf(Ct[tid][s]); } }
}
}
#endif
#define XB_TMO      128
#define XB_XCNT(j)  (256  + 64 * (j))
#define XB_XSUB(j)  (1280 + 64 * (j))
#define XB_XGEN(j)  (2304 + 64 * (j))
#define XB_TOP      3328
#define XB_TOPGEN   3392
#define XCD_BAR_WORDS 3456
#define XB_SPIN_CAP (1u << 18)
__device__ __forceinline__ unsigned xb_ld(unsigned* p)              { return __hip_atomic_load(p, __ATOMIC_RELAXED, __HIP_MEMORY_SCOPE_AGENT); }
__device__ __forceinline__ unsigned xb_add(unsigned* p, unsigned v) { return __hip_atomic_fetch_add(p, v, __ATOMIC_RELAXED, __HIP_MEMORY_SCOPE_AGENT); }
__device__ __forceinline__ unsigned xb_xcc_id() { return (unsigned)__builtin_amdgcn_s_getreg((3 << 11) | 20) & 0xFu; }
#define XB_SPIN(cond, bar) do { unsigned _sp = 0; while (cond) { __builtin_amdgcn_s_sleep(1); \
    if ((++_sp & 255u) == 0u) { if (xb_ld(&(bar)[XB_TMO])) break; if (_sp > XB_SPIN_CAP) { atomicAdd(&(bar)[XB_TMO], 1u); break; } } } } while (0)
struct XcdBarrier { unsigned* bar; unsigned x; volatile LAS unsigned* st; };
__device__ __forceinline__ XcdBarrier xcd_barrier_post(unsigned* bar, volatile LAS unsigned* st, const int tid) {
    XcdBarrier b; b.bar = bar; b.x = xb_xcc_id(); b.st = st;
    if (tid == 0) (void)xb_add(&bar[XB_XCNT(b.x)], 1u);
    return b;
}
__device__ __forceinline__ void xcd_barrier_complete(unsigned* bar, unsigned x, unsigned& nloc, unsigned& nx) {
    const unsigned G = gridDim.x * gridDim.y * gridDim.z;
    unsigned sum, cnt, mine, sp = 0u;
    for (;;) {
        sum = 0u; cnt = 0u; mine = 0u;
#pragma unroll
        for (unsigned j = 0; j < 16; ++j) { const unsigned c = xb_ld(&bar[XB_XCNT(j)]); sum += c; cnt += (c > 0u) ? 1u : 0u; mine = (j == x) ? c : mine; }
        if (sum == G) break;
        __builtin_amdgcn_s_sleep(1);
        if ((++sp & 255u) == 0u) { if (xb_ld(&bar[XB_TMO])) break; if (sp > XB_SPIN_CAP) { atomicAdd(&bar[XB_TMO], 1u); break; } }
    }
    nloc = mine > 0u ? mine : 1u; nx = cnt > 0u ? cnt : 1u;
}
__device__ __forceinline__ void xcd_barrier(const XcdBarrier& b, const int tid) {
    asm volatile("s_waitcnt vmcnt(0)" ::: "memory");
    __syncthreads();
    if (tid == 0) {
        unsigned* bar = b.bar;
        __builtin_amdgcn_s_waitcnt(0);
        unsigned nloc = b.st[0], nx = b.st[1];
        if (nloc == 0u) { xcd_barrier_complete(bar, b.x, nloc, nx); b.st[0] = nloc; b.st[1] = nx; }
        const unsigned old = xb_add(&bar[XB_XSUB(b.x)], 1u);
        const unsigned gen = old / nloc;
        if (old + 1u == (gen + 1u) * nloc) {
            __builtin_amdgcn_fence(__ATOMIC_RELEASE, "agent");
            asm volatile("s_waitcnt vmcnt(0)" ::: "memory");
            const unsigned og = xb_add(&bar[XB_TOP], 1u);
            const unsigned tg = og / nx;
            if (og + 1u == (tg + 1u) * nx) xb_add(&bar[XB_TOPGEN], 1u);
            else XB_SPIN(xb_ld(&bar[XB_TOPGEN]) == tg, bar);
            __builtin_amdgcn_fence(__ATOMIC_ACQUIRE, "agent");
            xb_add(&bar[XB_XGEN(b.x)], 1u);
            asm volatile("s_waitcnt vmcnt(0)" ::: "memory");
        } else {
            XB_SPIN(xb_ld(&bar[XB_XGEN(b.x)]) == gen, bar);
            __builtin_amdgcn_fence(__ATOMIC_ACQUIRE, "agent");
            asm volatile("s_waitcnt vmcnt(0)" ::: "memory");
        }
    }
    __syncthreads();
}

__global__ void __launch_bounds__(NWAVES * 64, 2) mega(Args args) {
    extern __shared__ __attribute__((aligned(16))) unsigned char lds[];
    Frame F;
    F.lds = (LAS unsigned char*)lds;
    F.MISC = (volatile LAS unsigned*)(F.lds + MISC_OFF);
    F.wave0 = __builtin_amdgcn_readfirstlane((int)threadIdx.x >> 6);
    F.tid = fresh_tid(F.wave0); F.lane = F.tid & 63; F.wave = F.wave0;
    F.G = gridDim.x; { const int bx = blockIdx.x; F.vcu = (F.G % 8 == 0) ? (bx % 8) * (F.G / 8) + bx / 8 : bx; }
    F.in = args.in; F.out = args.out; F.ws = args.ws; F.ctl = (unsigned*)(args.ws + WS_CTL);
    for (int u = F.tid; u < (LDS_BYTES - LDSCTL_OFF) / 4; u += NWAVES * 64) ((LAS unsigned*)(F.lds + LDSCTL_OFF))[u] = 0u;
    __syncthreads();
    const int vcu0 = F.vcu;
    const int lo = args.ph_lo, hi = args.ph_hi;
    const bool multi = (hi - lo) > 1;
    XcdBarrier bar; bar.bar = F.ctl + CW_BAR; bar.x = 0; bar.st = nullptr;
    if (multi) bar = xcd_barrier_post(F.ctl + CW_BAR, F.MISC + 8, F.tid);
#define IN(k) (lo <= (k) && (k) < hi)
#define FRESH() do { { int w0_ = F.wave0; asm volatile("" : "+s"(w0_)); F.wave = w0_; F.lane = fresh_lane(); F.tid = w0_ * 64 + F.lane; } \
    { unsigned char* w_ = args.ws; float* o_ = args.out; asm volatile("" : "+s"(w_), "+s"(o_)); F.ws = w_; F.out = o_; F.ctl = (unsigned*)(w_ + WS_CTL); int v_ = vcu0, g_ = (int)gridDim.x, b_ = (int)blockIdx.x; asm volatile("" : "+s"(v_), "+s"(g_), "+s"(b_)); F.vcu = v_; F.G = g_; F.bx = b_; } } while (0)
#ifndef DUP_MASK
#define DUP_MASK 0
#endif
#define DUP(k) if ((DUP_MASK >> (k)) & 1)
#define SEAM(k) do { if (IN(k) && IN((k) + 1)) { xcd_barrier(bar, fresh_tid(F.wave0)); DUP(13) xcd_barrier(bar, fresh_tid(F.wave0)); } } while (0)
    if (IN(PH_PRO)) { FRESH(); phase_prologue(F); DUP(15) { __syncthreads(); FRESH(); phase_prologue(F); } }
    SEAM(PH_PRO);
    for (int l = 0; l < DEPTH; ++l) {
        const int pb = 1 + PH_PER_LAYER * l;
        if (IN(pb + K_NORM1)) { FRESH(); phase_normgemm<0>(F, l); }
        SEAM(pb + K_NORM1);
        if (IN(pb + K_CUMSUM)) { FRESH(); phase_cumsum(F); DUP(K_CUMSUM) { __syncthreads(); FRESH(); phase_cumsum(F); } }
        if (IN(pb + K_INPROJ)) { FRESH(); phase_inproj(F, l); DUP(K_INPROJ) { __syncthreads(); FRESH(); phase_inproj(F, l); } }
        SEAM(pb + K_INPROJ);
        if (IN(pb + K_ATTN)) { FRESH(); phase_attn<0>(F, l); }
        SEAM(pb + K_ATTN);
        if (IN(pb + K_YZ)) { FRESH(); phase_yz(F, l); DUP(K_YZ) { __syncthreads(); FRESH(); phase_yz(F, l); } }
        SEAM(pb + K_YZ);
        if (IN(pb + K_WO)) { FRESH(); phase_wo(F, l);  }
        SEAM(pb + K_WO);
        if (IN(pb + K_ROUTER)) { FRESH(); phase_router2(F, l); }
        SEAM(pb + K_ROUTER);
        if (IN(pb + K_GATEUP)) { FRESH(); phase_gateup(F, l); DUP(K_GATEUP) { __syncthreads(); FRESH(); phase_gateup(F, l); } }
#if MOE_BARRIER
        SEAM(pb + K_GATEUP);
#else
        __syncthreads();
#endif
        if (IN(pb + K_DOWN)) { FRESH(); phase_down(F, l); DUP(K_DOWN) { __syncthreads(); FRESH(); phase_down(F, l); } }
        SEAM(pb + K_DOWN);
    }
#ifndef TAIL_VAR
#define TAIL_VAR 0
#endif
#ifndef TAIL_MASK
#define TAIL_MASK 0
#endif
#define TAILP(k, call) do { if ((TAIL_MASK >> (k)) & 1) { xcd_barrier(bar, fresh_tid(F.wave0)); FRESH(); call; } } while (0)
    if (IN(PH_FINAL)) { FRESH(); phase_final(F); DUP(14) { __syncthreads(); FRESH(); phase_final(F, true); } }
    if (multi && TAIL_MASK) { const int l = 1;
        TAILP(15, phase_prologue(F)); TAILP(K_CUMSUM, phase_cumsum(F)); TAILP(K_INPROJ, phase_inproj(F, l)); TAILP(K_ATTN, phase_attn<TAIL_VAR>(F, l));
        TAILP(K_DIFFC, phase_diffc(F, l)); TAILP(K_YZ, phase_yz(F, l)); TAILP(K_WO, phase_wo(F, l, true)); TAILP(K_ROUTER, phase_router2(F, l, true)); TAILP(K_GATEUP, phase_gateup(F, l)); TAILP(K_DOWN, phase_down(F, l));
        TAILP(14, phase_final(F, true)); }
#undef IN
#undef FRESH
#undef SEAM
#undef DUP
}

#ifndef FAST_MASK
#define FAST_MASK 0
#endif
#ifndef ONE_LAUNCH
#define ONE_LAUNCH 0
#endif
extern "C" void kernel_launch(void* const* d_in, const int* in_sizes, int n_in, void* d_out, int out_size, void* d_ws, size_t ws_size, hipStream_t stream) {
    static int grid = 0;
    if (grid == 0) {
        if (n_in != 25 || in_sizes[0] != T * D || out_size != T * D || ws_size < WS_END) { fprintf(stderr, "kernel_launch: unexpected shapes (n_in %d, in0 %d, out %d, ws %zu); nothing launched\n", n_in, n_in > 0 ? in_sizes[0] : -1, out_size, ws_size); grid = -1; return; }
        int dev = 0, cus = 0, per_cu = 0;
        if (hipGetDevice(&dev) != hipSuccess || hipDeviceGetAttribute(&cus, hipDeviceAttributeMultiprocessorCount, dev) != hipSuccess) { grid = -1; return; }
        if (hipFuncSetAttribute((const void*)mega, hipFuncAttributeMaxDynamicSharedMemorySize, LDS_BYTES) != hipSuccess) { fprintf(stderr, "kernel_launch: hipFuncSetAttribute failed\n"); grid = -1; return; }
        if (hipOccupancyMaxActiveBlocksPerMultiprocessor(&per_cu, (const void*)mega, NWAVES * 64, LDS_BYTES) != hipSuccess || per_cu < 1) { fprintf(stderr, "kernel_launch: occupancy query reports %d\n", per_cu); }
        (void)hipGetLastError();
        grid = cus;
    }
    if (grid < 0) return;
    (void)hipMemsetAsync((char*)d_ws + WS_CTL, 0, CTL_ZERO_BYTES, stream);
    Args a{};
    for (int i = 0; i < 25; ++i) a.in[i] = d_in[i];
    a.out = (float*)d_out; a.ws = (unsigned char*)d_ws;
#if ONE_LAUNCH
    a.ph_lo = 0; a.ph_hi = N_PHASES;
    hipLaunchKernelGGL(mega, dim3(grid), dim3(NWAVES * 64), LDS_BYTES, stream, a);
#else
    for (int p = 0; p < N_PHASES; ++p) {
        const int l = (p - 1) / PH_PER_LAYER, k = (p >= 1 && p < PH_FINAL) ? (p - 1) % PH_PER_LAYER : -1;
        const bool heavy = (k == K_INPROJ || k == K_ATTN || k == K_YZ || k == K_WO || k == K_GATEUP || k == K_DOWN);
#if BUILD_ORACLE
        if (heavy && !((FAST_MASK >> k) & 1)) {
            if (k == K_INPROJ) hipLaunchKernelGGL(orc::inproj, dim3(80, 256), dim3(256), 0, stream, a, l);
            else if (k == K_ATTN) { hipLaunchKernelGGL(orc::attn, dim3(32, 32), dim3(256), 0, stream, a, 0); hipLaunchKernelGGL(orc::attn, dim3(32, 16), dim3(256), 0, stream, a, 1); }
            else if (k == K_YZ) hipLaunchKernelGGL(orc::yz, dim3(16, 256), dim3(256), 0, stream, a, l);
            else if (k == K_WO) hipLaunchKernelGGL(orc::wo, dim3(16, 256), dim3(256), 0, stream, a, l);
            else if (k == K_GATEUP) hipLaunchKernelGGL(orc::gateup, dim3(8, HID_ROWS / 64), dim3(256), 0, stream, a, l);
            else hipLaunchKernelGGL(orc::down, dim3(16, HID_ROWS / 64), dim3(256), 0, stream, a, l);
            continue;
        }
#endif
        a.ph_lo = p; a.ph_hi = p + 1;
        hipLaunchKernelGGL(mega, dim3(grid), dim3(NWAVES * 64), LDS_BYTES, stream, a);
    }
#endif
}
```

```cpp
#define BUILD_ORACLE 0
#define ONE_LAUNCH 1
#define SC1_STORES 1
#include <hip/hip_runtime.h>
#include <cstdio>
#include <cstdint>

constexpr int D = 1024, BATCH = 2, SEQ = 8192, T = BATCH * SEQ, DEPTH = 2;
constexpr int HD = 64, NEXP = 32, FF = 512;
constexpr int INC = 5128;
constexpr int NP = 5120;
constexpr int C_QA = 0, C_KA = 512, C_VA = 1024, C_QF = 1536, C_KF = 2048, C_VF = 2560, C_GA = 3072, C_GF = 4096;
constexpr float EPS = 1e-6f;
constexpr float LOG2E = 1.4426950408889634f;
constexpr float C2 = 0.125f * 1.4426950408889634f;
constexpr int HID_ROWS = 2 * T + NEXP * 256;

constexpr size_t MiB = 1u << 20;
constexpr size_t WS_CTL = 0, CTL_ZERO_BYTES = 128 * 1024;
constexpr size_t WS_FZT = 1 * MiB;
constexpr size_t WS_WRT = 1 * MiB + 128 * 1024;
constexpr size_t WS_GT = 1 * MiB + 640 * 1024;
constexpr size_t WS_LOGF = 2 * MiB;
constexpr size_t WS_CUM = 2 * MiB + 512 * 1024;
constexpr size_t WS_COSSIN = 3 * MiB;
constexpr size_t WS_GWT = 4 * MiB;
constexpr size_t WS_LIST = 5 * MiB;
constexpr size_t WS_WIN = 8 * MiB;
constexpr size_t WS_WD = 28 * MiB;
constexpr size_t WS_WF = 30 * MiB;
constexpr size_t WS_WO = 32 * MiB;
constexpr size_t WS_WGU = 36 * MiB;
constexpr size_t WS_WDN = 164 * MiB;
constexpr size_t WS_QKVG = 228 * MiB;
constexpr size_t WS_HID = 228 * MiB;
constexpr size_t WS_Y = 280 * MiB;
constexpr size_t WS_HN = 388 * MiB;
constexpr size_t WS_AD = 388 * MiB;
constexpr size_t WS_OA = 420 * MiB;
constexpr size_t WS_Z = 420 * MiB;
constexpr size_t WS_OF = 452 * MiB;
constexpr size_t WS_SUMS = 468 * MiB;
constexpr size_t WS_RSTD = 4 * MiB + 256 * 1024;
constexpr size_t WS_END = 484 * MiB;
static_assert(WS_HID + (size_t)HID_ROWS * FF * 2 <= WS_Y && WS_Y + (size_t)2 * T * D * 2 <= WS_HN, "ws map");
constexpr int CW_TMO = 0;
constexpr int CW_CNT = 16384, CNT_STRIDE = 64;
constexpr int CW_BAR = 4096;
constexpr int CW_FOXQ = 128;
static_assert((16384 + 2 * 32 * 64) * 4 <= (int)CTL_ZERO_BYTES, "control words inside the memset");
constexpr int CW_DCNT = 24576, DCNT_STRIDE = 16;
static_assert(CW_DCNT + DEPTH * BATCH * 4 * 32 * DCNT_STRIDE <= (int)(CTL_ZERO_BYTES / 4), "pair counters inside the memset");
constexpr int CW_TCNT = 8192, TCNT_STRIDE = 16, MAX_TILES = HID_ROWS / 256;

typedef unsigned short bf16;
typedef unsigned v4u __attribute__((ext_vector_type(4)));
typedef unsigned v2u __attribute__((ext_vector_type(2)));
typedef float f32x4 __attribute__((ext_vector_type(4)));
#define LAS __attribute__((address_space(3)))
#define GAS __attribute__((address_space(1)))
#define LDS_WAIT() asm volatile("s_waitcnt lgkmcnt(0)" ::: "memory")
#define VM_WAIT() asm volatile("s_waitcnt vmcnt(0)" ::: "memory")

__device__ __forceinline__ unsigned f2bf(float f) { unsigned u = __builtin_bit_cast(unsigned, f); return (u + 0x7fffu + ((u >> 16) & 1u)) >> 16; }
__device__ __forceinline__ unsigned pk2(float lo, float hi) { return f2bf(lo) | (f2bf(hi) << 16); }
__device__ __forceinline__ float bflo(unsigned w) { return __uint_as_float(w << 16); }
__device__ __forceinline__ float bfhi(unsigned w) { return __uint_as_float(w & 0xffff0000u); }
__device__ __forceinline__ float bf2f(bf16 b) { return __uint_as_float((unsigned)b << 16); }
__device__ __forceinline__ float shx(float v, int mask, int lane) { return __int_as_float(__builtin_amdgcn_ds_bpermute((lane ^ mask) << 2, __float_as_int(v))); }
__device__ __forceinline__ float shl_(float v, int src) { return __int_as_float(__builtin_amdgcn_ds_bpermute(src << 2, __float_as_int(v))); }
__device__ __forceinline__ double shx_d(double v, int mask, int lane) { const long long b = __builtin_bit_cast(long long, v); const int lo = __builtin_amdgcn_ds_bpermute((lane ^ mask) << 2, (int)b), hi = __builtin_amdgcn_ds_bpermute((lane ^ mask) << 2, (int)(b >> 32));
    return __builtin_bit_cast(double, ((long long)hi << 32) | (unsigned)lo); }
__device__ __forceinline__ float wave_sum(float v, int lane) {
#pragma unroll
    for (int o = 1; o < 64; o <<= 1) v += shx(v, o, lane);
    return v;
}
__device__ __forceinline__ int fresh_lane() { unsigned m = ~0u; asm volatile("" : "+s"(m)); return (int)__builtin_amdgcn_mbcnt_hi(m, __builtin_amdgcn_mbcnt_lo(m, 0u)); }
__device__ __forceinline__ int fresh_tid(int wave0) { int w = wave0; asm volatile("" : "+s"(w)); return w * 64 + fresh_lane(); }
__device__ __forceinline__ int pi32(int n) { return n < 4 ? n : (n < 8 ? n + 4 : (n < 12 ? n - 4 : n)); }
__host__ __device__ constexpr float lambda_init_of(int l) { return l == 0 ? 0.2f : 0.35550906759f; }

struct Args { const void* in[25]; float* out; unsigned char* ws; int ph_lo, ph_hi; };
enum { I_X = 0, I_POS, I_LN1, I_WIN, I_BF, I_QND, I_KND, I_LQ1, I_LK1, I_LQ2, I_LK2, I_SUBLN, I_QNF, I_KNF, I_WDO, I_WFO, I_WO, I_LN2, I_WRG, I_BRG, I_WRE, I_BRE, I_WEG, I_WEU, I_WED };
#ifndef SC1_STORES
#define SC1_STORES 0
#endif
#ifndef MOE_BARRIER
#define MOE_BARRIER 0
#endif
constexpr int PH_PRO = 0, PH_PER_LAYER = 10, PH_FINAL = 1 + PH_PER_LAYER * DEPTH, N_PHASES = PH_FINAL + 1;
enum { K_NORM1 = 0, K_CUMSUM, K_INPROJ, K_ATTN, K_DIFFC, K_YZ, K_WO, K_ROUTER, K_GATEUP, K_DOWN };
constexpr int NWAVES = 8;
constexpr int RING_OFF = 0, RING_BYTES = 131072;
constexpr int LDSCTL_OFF = RING_BYTES, MISC_OFF = LDSCTL_OFF + 320;
constexpr int LDS_BYTES = 147456;
struct Frame {
    LAS unsigned char* lds;
    volatile LAS unsigned* MISC;
    unsigned* ctl;
    int tid, lane, wave, vcu, G, wave0, bx;
    const void* const* in;
    float* out; unsigned char* ws;
};

__device__ __forceinline__ void p0_transpose_item(const float* W, int ld, int k0, int n0src, bf16* WT, int Kd, int drow0, bool swz, LAS float* scr, int lane) {
#pragma unroll 8
    for (int i = 0; i < 32; ++i) { const int kk = 2 * i + (lane >> 5); scr[kk * 33 + (lane & 31)] = __builtin_nontemporal_load(W + (size_t)(k0 + kk) * ld + n0src + (lane & 31)); }
    LDS_WAIT(); asm volatile("" ::: "memory");
    const int c = lane & 7;
#pragma unroll
    for (int j = 0; j < 4; ++j) { const int n = (lane >> 3) + 8 * j; const LAS float* s = scr + (8 * c) * 33 + n;
        v4u o; o.x = pk2(s[0 * 33], s[1 * 33]); o.y = pk2(s[2 * 33], s[3 * 33]); o.z = pk2(s[4 * 33], s[5 * 33]); o.w = pk2(s[6 * 33], s[7 * 33]);
        const int nd = swz ? pi32(n) : n;
        __builtin_nontemporal_store(o, (v4u*)(WT + (size_t)(drow0 + nd) * Kd + k0 + 8 * c)); }
    LDS_WAIT(); asm volatile("" ::: "memory");
}
__device__ __forceinline__ void phase_prologue(Frame& F) {
    LAS float* scr = (LAS float*)(F.lds + RING_OFF + F.wave * 16384);
    const int gw = F.vcu * NWAVES + F.wave, NGW = F.G * NWAVES;
    const float* w_in = (const float*)F.in[I_WIN]; const float* wdo = (const float*)F.in[I_WDO]; const float* wfo = (const float*)F.in[I_WFO]; const float* wo = (const float*)F.in[I_WO];
    const float* weg = (const float*)F.in[I_WEG]; const float* weu = (const float*)F.in[I_WEU]; const float* wed = (const float*)F.in[I_WED];
    bf16* WIN = (bf16*)(F.ws + WS_WIN); bf16* WD = (bf16*)(F.ws + WS_WD); bf16* WF = (bf16*)(F.ws + WS_WF); bf16* WO = (bf16*)(F.ws + WS_WO);
    bf16* WGU = (bf16*)(F.ws + WS_WGU); bf16* WDN = (bf16*)(F.ws + WS_WDN);
    constexpr int I_IN = 16 * 160 * DEPTH;
    constexpr int I_DF = 8 * 32 * DEPTH;
    constexpr int I_O = 16 * 32 * DEPTH;
    constexpr int I_GU = 16 * 16 * 64 * 2;
    constexpr int I_DN = 8 * 32 * 64;
    constexpr int NITEMS = I_IN + 2 * I_DF + I_O + I_GU + I_DN;
    for (int it = gw; it < NITEMS; it += NGW) {
        int r = it;
        if (r < I_GU) {
            const int nb = r & 15, kb = (r >> 4) & 15, which = (r >> 8) & 1, lge = r >> 9;
            const float* src = (which ? weu : weg) + (size_t)lge * D * FF;
            const int n0 = 32 * nb, drow = (n0 >> 7) * 256 + (n0 & 127) + which * 128;
            p0_transpose_item(src, FF, 64 * kb, n0, WGU + (size_t)lge * 1024 * 1024, D, drow, false, scr, F.lane); continue; }
        r -= I_GU;
        if (r < I_DN) {
            const int nb = r & 31, kb = (r >> 5) & 7, lge = r >> 8;
            p0_transpose_item(wed + (size_t)lge * FF * D, D, 64 * kb, 32 * nb, WDN + (size_t)lge * 1024 * 512, FF, 32 * nb, false, scr, F.lane); continue; }
        r -= I_DN;
        if (r < I_IN) {
            const int l = r / 2560, q = r % 2560, kb = q / 160, nb = q % 160;
            const int nsrc = nb < 96 ? 32 * nb : 32 * nb + 8;
            const bool swz = (nb < 32) && ((nb & 1) == 0);
            p0_transpose_item(w_in + (size_t)l * D * INC, INC, 64 * kb, nsrc, WIN + (size_t)l * NP * D, D, 32 * nb, swz, scr, F.lane); continue; }
        r -= I_IN;
        if (r < 2 * I_DF) {
            const int nb = r & 31, kb = (r >> 5) & 7, l = (r >> 8) & 1, which = r >> 9;
            p0_transpose_item((which ? wfo : wdo) + (size_t)l * 512 * D, D, 64 * kb, 32 * nb, (which ? WF : WD) + (size_t)l * D * 512, 512, 32 * nb, false, scr, F.lane); continue; }
        r -= 2 * I_DF;
        { const int nb = r & 31, kb = (r >> 5) & 15, l = r >> 9;
          p0_transpose_item(wo + (size_t)l * D * D, D, 64 * kb, 32 * nb, WO + (size_t)l * D * D, D, 32 * nb, false, scr, F.lane); }
    }
    const int gt = (F.vcu * NWAVES + F.wave) * 64 + F.lane, NGT = F.G * NWAVES * 64;
    bf16* FZT = (bf16*)(F.ws + WS_FZT); bf16* WRT = (bf16*)(F.ws + WS_WRT); float* CS = (float*)(F.ws + WS_COSSIN);
    const float* ln1 = (const float*)F.in[I_LN1]; const float* ln2 = (const float*)F.in[I_LN2];
    for (int i = gt; i < DEPTH * 16 * D; i += NGT) { const int l = i / (16 * D), q = i % (16 * D), j = q / D, k = q % D;
        const float w = j < 8 ? w_in[(size_t)l * D * INC + (size_t)k * INC + 3072 + j] * ln1[l * D + k] : 0.f;
        const unsigned h = f2bf(w); const float r = w - __uint_as_float(h << 16);
        FZT[(size_t)l * 2 * 16 * D + q] = (bf16)h; FZT[(size_t)l * 2 * 16 * D + 16 * D + q] = (bf16)f2bf(r); }
    const float* wrg = (const float*)F.in[I_WRG]; const float* wre = (const float*)F.in[I_WRE];
    for (int i = gt; i < DEPTH * 48 * D; i += NGT) { const int l = i / (48 * D), q = i % (48 * D), j = q / D, k = q % D;
        const float w = (j < 4 ? wrg[(size_t)l * D * 4 + k * 4 + j] : (j < 36 ? wre[(size_t)l * D * 32 + k * 32 + (j - 4)] : 0.f)) * ln2[l * D + k];
        const unsigned h = f2bf(w); const float r = w - __uint_as_float(h << 16);
        WRT[(size_t)l * 2 * 48 * D + q] = (bf16)h; WRT[(size_t)l * 2 * 48 * D + 48 * D + q] = (bf16)f2bf(r); }
    { float* GT = (float*)(F.ws + WS_GT);
      for (int i = gt; i < DEPTH * 4 * 64; i += NGT) { const int l = i >> 8, q = (i >> 6) & 3, d = i & 63;
          const float* src = (const float*)F.in[q == 0 ? I_QND : (q == 1 ? I_KND : (q == 2 ? I_QNF : I_KNF))];
          GT[i] = src[l * 64 + d] * ((q & 1) ? 1.0f : C2); } }
    const int* pos = (const int*)F.in[I_POS];
    for (int i = gt; i < T * 8; i += NGT) { const int t = i >> 3, f = i & 7;
        const double inv = exp2(-(double)f * (1.0 / 8.0) * 18.931568569324174);
        const double ang = (double)pos[t] * (double)(float)inv;
        CS[t * 16 + f] = (float)cos(ang); CS[t * 16 + 8 + f] = (float)sin(ang); }
}

typedef short bf16x8n __attribute__((ext_vector_type(8)));
typedef float f32x4m __attribute__((ext_vector_type(4)));
template <int KIND, int VAR = 0> __device__ __forceinline__ void phase_normgemm(Frame& F, int l) {
    constexpr int NB = KIND == 0 ? 1 : 3;
    constexpr int NR = NB * 16;
    constexpr int PW = 49, XP = 136;
    LAS bf16* XH = (LAS bf16*)(F.lds + RING_OFF);
    LAS bf16* XL = XH + 64 * XP;
    LAS bf16* WH = XL + 64 * XP;
    LAS bf16* WL = WH + 48 * XP;
    LAS float* part = (LAS float*)(WL + 48 * XP);
    LAS float* rsv = part + 2 * 64 * PW;
    const float* xsrc = (KIND == 0 && l == 0) ? (const float*)F.in[I_X] : F.out;
    const bool addy = (KIND == 0 && l > 0);
    const float* gn = (const float*)F.in[KIND == 0 ? I_LN1 : I_LN2] + (size_t)l * D;
    const bf16* WT = (const bf16*)(F.ws + (KIND == 0 ? WS_FZT : WS_WRT)) + (size_t)l * 2 * NR * D;
    const bf16* Y = (const bf16*)(F.ws + WS_Y); bf16* HN = (bf16*)(F.ws + WS_HN);
    const int lane = F.lane, wave = F.wave, tid = F.tid;
    for (int bt = F.vcu; bt < T / 64; bt += F.G) {
        const int row0 = bt * 64;
        f32x4 v_[8][4];
#pragma unroll
        for (int hh = 0; hh < 2; ++hh) {
#pragma unroll
            for (int r4 = 0; r4 < 4; ++r4) { const int rr = hh * 4 + r4, row = row0 + wave * 8 + rr;
#pragma unroll
                for (int j = 0; j < 4; ++j) v_[rr][j] = *(const f32x4*)(xsrc + (size_t)row * D + lane * 4 + 256 * j);
                if (addy) {
#pragma unroll
                    for (int j = 0; j < 4; ++j) { const v2u a = __builtin_nontemporal_load((const v2u*)(Y + (size_t)row * D + lane * 4 + 256 * j)), b = __builtin_nontemporal_load((const v2u*)(Y + (size_t)T * D + (size_t)row * D + lane * 4 + 256 * j));
                        v_[rr][j].x += bflo(a.x) + bflo(b.x); v_[rr][j].y += bfhi(a.x) + bfhi(b.x); v_[rr][j].z += bflo(a.y) + bflo(b.y); v_[rr][j].w += bfhi(a.y) + bfhi(b.y); }
                }
            }
            if (addy) asm volatile("" ::: "memory");
        }
#pragma unroll
        for (int rr = 0; rr < 8; ++rr) { const int rl = wave * 8 + rr, row = row0 + rl; float ss = 0.f;
#pragma unroll
            for (int j = 0; j < 4; ++j) { const f32x4 x = v_[rr][j]; if (KIND == 0 && l > 0) *(f32x4*)(F.out + (size_t)row * D + lane * 4 + 256 * j) = x; ss += (x.x * x.x + x.y * x.y) + (x.z * x.z + x.w * x.w); }
            const float r = 1.0f / sqrtf(wave_sum(ss, lane) * (1.0f / D) + EPS);
            if (lane == 0) rsv[rl] = r;
        }
        f32x4m acc[NB];
#pragma unroll
        for (int nb = 0; nb < NB; ++nb) acc[nb] = (f32x4m){0.f, 0.f, 0.f, 0.f};
        constexpr int NPZ = (2 * NR * 16 + NWAVES * 64 - 1) / (NWAVES * 64);
        v4u wreg[NPZ];
#define NG_WLOAD(hc_) _Pragma("unroll") for (int pi = 0; pi < NPZ; ++pi) { const int pz = tid + pi * NWAVES * 64; if (pz < 2 * NR * 16) { const int tb = pz / (NR * 16), q = pz % (NR * 16), n = q >> 4, c8 = q & 15; \
            wreg[pi] = *(const v4u*)(WT + (size_t)tb * NR * D + (size_t)n * D + (hc_) * 128 + c8 * 8); } }
        if (!(VAR & 2)) {
        NG_WLOAD(0)
#pragma unroll
        for (int hc = 0; hc < 8; ++hc) {
            if ((lane >> 5) == (hc & 1)) {
#pragma unroll
                for (int rr = 0; rr < 8; ++rr) { const f32x4 x = v_[rr][hc >> 1];
                    const unsigned h0 = f2bf(x.x), h1 = f2bf(x.y), h2 = f2bf(x.z), h3 = f2bf(x.w);
                    const float l0 = x.x - __uint_as_float(h0 << 16), l1 = x.y - __uint_as_float(h1 << 16), l2 = x.z - __uint_as_float(h2 << 16), l3 = x.w - __uint_as_float(h3 << 16);
                    const int o = (wave * 8 + rr) * XP + (lane & 31) * 4;
                    *(LAS v2u*)(XH + o) = (v2u){h0 | (h1 << 16), h2 | (h3 << 16)}; *(LAS v2u*)(XL + o) = (v2u){pk2(l0, l1), pk2(l2, l3)}; }
            }
#pragma unroll
            for (int pi = 0; pi < NPZ; ++pi) { const int pz = tid + pi * NWAVES * 64; if (pz < 2 * NR * 16) { const int tb = pz / (NR * 16), q = pz % (NR * 16), n = q >> 4, c8 = q & 15;
                *(LAS v4u*)((tb ? WL : WH) + n * XP + c8 * 8) = wreg[pi]; } }
            __syncthreads();
            if (hc < 7) { NG_WLOAD(hc + 1) }
            { const int rb = wave & 3, kq = wave >> 2, i = lane & 15, g = lane >> 4;
#pragma unroll
              for (int s = 0; s < 2; ++s) { const int ko = kq * 64 + s * 32 + g * 8;
                  const bf16x8n ah = *(const LAS bf16x8n*)(XH + (rb * 16 + i) * XP + ko), al = *(const LAS bf16x8n*)(XL + (rb * 16 + i) * XP + ko);
#pragma unroll
                  for (int nb = 0; nb < NB; ++nb) { const bf16x8n bh = *(const LAS bf16x8n*)(WH + (nb * 16 + i) * XP + ko), bl = *(const LAS bf16x8n*)(WL + (nb * 16 + i) * XP + ko);
                      acc[nb] = __builtin_amdgcn_mfma_f32_16x16x32_bf16(ah, bh, acc[nb], 0, 0, 0);
                      acc[nb] = __builtin_amdgcn_mfma_f32_16x16x32_bf16(ah, bl, acc[nb], 0, 0, 0);
                      acc[nb] = __builtin_amdgcn_mfma_f32_16x16x32_bf16(al, bh, acc[nb], 0, 0, 0); } } }
            __syncthreads();
        } }
        { const int rb = wave & 3, kq = wave >> 2, i = lane & 15, g = lane >> 4;
#pragma unroll
          for (int nb = 0; nb < NB; ++nb)
#pragma unroll
              for (int e = 0; e < 4; ++e) part[(kq * 64 + rb * 16 + 4 * g + e) * PW + nb * 16 + i] = acc[nb][e]; }
        __syncthreads();
#define NG_SUM2(o) (part[o] + part[64 * PW + (o)])
        if (KIND == 0) {
            { const int r = tid >> 3, j = tid & 7; const int o = r * PW + j;
                float z = NG_SUM2(o);
                z = z * rsv[r] + ((const float*)F.in[I_BF])[l * 8 + j];
                const float lf = fminf(z, 0.f) - 0.6931471805599453f * __builtin_amdgcn_logf(1.0f + __builtin_amdgcn_exp2f(-fabsf(z) * LOG2E));
                { const int row = row0 + r; ((float*)(F.ws + WS_LOGF))[((size_t)(row / SEQ) * 8 + j) * SEQ + (row % SEQ)] = lf; } }
        } else {
            if (tid < 64 && !(VAR & 4)) { const int r = tid, row = row0 + r; const float rs = rsv[r];
                const float* brg = (const float*)F.in[I_BRG] + l * 4; const float* bre = (const float*)F.in[I_BRE] + l * 32;
                float lg[4];
#pragma unroll
                for (int q = 0; q < 4; ++q) { const int o = r * PW + q; lg[q] = NG_SUM2(o) * rs + brg[q]; }
                int gi = 0; float gm = lg[0];
#pragma unroll
                for (int q = 1; q < 4; ++q) if (lg[q] > gm) { gm = lg[q]; gi = q; }
                float gs = 0.f;
#pragma unroll
                for (int q = 0; q < 4; ++q) gs += __builtin_amdgcn_exp2f((lg[q] - gm) * LOG2E);
                const float pg = 1.0f / gs;
                float le[8];
#pragma unroll
                for (int e = 0; e < 8; ++e) { const int o = r * PW + 4 + gi * 8 + e; le[e] = NG_SUM2(o) * rs + bre[gi * 8 + e]; }
                int i1 = 0; float m1 = le[0];
#pragma unroll
                for (int e = 1; e < 8; ++e) if (le[e] > m1) { m1 = le[e]; i1 = e; }
                int i2 = 0; float m2 = -INFINITY;
#pragma unroll
                for (int e = 0; e < 8; ++e) if (e != i1 && le[e] > m2) { m2 = le[e]; i2 = e; }
                const float e2 = __builtin_amdgcn_exp2f((m2 - m1) * LOG2E); const float w1 = pg / (1.0f + e2), w2 = pg * e2 / (1.0f + e2);
                LAS unsigned* lcnt = (LAS unsigned*)(rsv + 64); LAS unsigned* lbase = lcnt + 32;
                if (r < 32) lcnt[r] = 0u;
                LDS_WAIT();
                const int ex1 = gi * 8 + i1, ex2 = gi * 8 + i2;
                const unsigned k1 = __hip_atomic_fetch_add(lcnt + ex1, 1u, __ATOMIC_RELAXED, __HIP_MEMORY_SCOPE_WORKGROUP), k2 = __hip_atomic_fetch_add(lcnt + ex2, 1u, __ATOMIC_RELAXED, __HIP_MEMORY_SCOPE_WORKGROUP);
                LDS_WAIT();
                unsigned* CNT = F.ctl + CW_CNT + (size_t)l * NEXP * CNT_STRIDE;
                if (r < 32) { const unsigned mine = lcnt[r]; lbase[r] = mine ? atomicAdd(CNT + r * CNT_STRIDE, mine) : 0u; }
                LDS_WAIT();
                int* LIST = (int*)(F.ws + WS_LIST); float* GWT = (float*)(F.ws + WS_GWT);
                LIST[(size_t)ex1 * T + lbase[ex1] + k1] = row * 2; LIST[(size_t)ex2 * T + lbase[ex2] + k2] = row * 2 + 1;
                GWT[row * 2] = w1; GWT[row * 2 + 1] = w2; }
        }
#undef NG_SUM2
#undef NG_WLOAD
#pragma unroll
        for (int rr = 0; rr < 8; ++rr) { const int rl = wave * 8 + rr, row = row0 + rl; const float r = rsv[rl];
#pragma unroll
            for (int j = 0; j < 4; ++j) { const f32x4 g = *(const f32x4*)(gn + lane * 4 + 256 * j); const f32x4 h = v_[rr][j] * r * g;
                *(v2u*)(HN + (size_t)row * D + lane * 4 + 256 * j) = (v2u){pk2(h.x, h.y), pk2(h.z, h.w)}; } }
        __syncthreads();
    }
}
__device__ __forceinline__ double wave_sum_d(double v, int lane) {
#pragma unroll
    for (int o = 1; o < 64; o <<= 1) v += shx_d(v, o, lane);
    return v;
}
__device__ __forceinline__ void phase_router2(Frame& F, int l, bool dry = false) {
    constexpr int PW = 41;
    LAS float* sm = (LAS float*)(F.lds + RING_OFF);
    LAS unsigned* lcnt = (LAS unsigned*)(sm + 64 * PW); LAS unsigned* lbase = lcnt + 32;
    const float* SUMS = (const float*)(F.ws + WS_SUMS);
    for (int bt = F.vcu; bt < T / 64; bt += F.G) {
        const int row0 = bt * 64;
        { const int r = F.tid >> 3, j = F.tid & 7; const int c = j < 5 ? j * 8 : 48;
          if (j < 6) { const float* S0 = SUMS + (size_t)(row0 + r) * 64 + c;
              f32x4 a0 = *(const f32x4*)S0, a1 = *(const f32x4*)(S0 + (size_t)T * 64), a2 = *(const f32x4*)(S0 + (size_t)2 * T * 64), a3 = *(const f32x4*)(S0 + (size_t)3 * T * 64);
              f32x4 b0 = a0, b1 = a1, b2 = a2, b3 = a3;
              if (j < 5) { b0 = *(const f32x4*)(S0 + 4); b1 = *(const f32x4*)(S0 + (size_t)T * 64 + 4); b2 = *(const f32x4*)(S0 + (size_t)2 * T * 64 + 4); b3 = *(const f32x4*)(S0 + (size_t)3 * T * 64 + 4); }
              const f32x4 sa = (a0 + a1) + (a2 + a3), sb = (b0 + b1) + (b2 + b3);
              if (j < 5) {
#pragma unroll
                  for (int e = 0; e < 4; ++e) { sm[r * PW + c + e] = sa[e]; sm[r * PW + c + 4 + e] = sb[e]; } }
              else sm[r * PW + 40] = sa.x; } }
        __syncthreads();
        if (F.tid < 64) { const int r = F.tid, row = row0 + r;
            const float rs = 1.0f / sqrtf(sm[r * PW + 40] * (1.0f / D) + EPS);
            ((float*)(F.ws + WS_RSTD))[row] = rs;
            const float* brg = (const float*)F.in[I_BRG] + l * 4; const float* bre = (const float*)F.in[I_BRE] + l * 32;
            float lg[4];
#pragma unroll
            for (int q = 0; q < 4; ++q) lg[q] = sm[r * PW + q] * rs + brg[q];
            int gi = 0; float gm = lg[0];
#pragma unroll
            for (int q = 1; q < 4; ++q) if (lg[q] > gm) { gm = lg[q]; gi = q; }
            float gs = 0.f;
#pragma unroll
            for (int q = 0; q < 4; ++q) gs += __builtin_amdgcn_exp2f((lg[q] - gm) * LOG2E);
            const float pg = 1.0f / gs;
            float le[8];
#pragma unroll
            for (int e = 0; e < 8; ++e) le[e] = sm[r * PW + 4 + gi * 8 + e] * rs + bre[gi * 8 + e];
            int i1 = 0; float m1 = le[0];
#pragma unroll
            for (int e = 1; e < 8; ++e) if (le[e] > m1) { m1 = le[e]; i1 = e; }
            int i2 = 0; float m2 = -INFINITY;
#pragma unroll
            for (int e = 0; e < 8; ++e) if (e != i1 && le[e] > m2) { m2 = le[e]; i2 = e; }
            const float e2 = __builtin_amdgcn_exp2f((m2 - m1) * LOG2E); const float w1 = pg / (1.0f + e2), w2 = pg * e2 / (1.0f + e2);
            if (dry) { if (w1 + w2 == 1.2345e33f) ((float*)(F.ws + WS_GWT))[row * 2] = w1; } else {
            if (r < 32) lcnt[r] = 0u;
            LDS_WAIT();
            const int ex1 = gi * 8 + i1, ex2 = gi * 8 + i2;
            const unsigned k1 = __hip_atomic_fetch_add(lcnt + ex1, 1u, __ATOMIC_RELAXED, __HIP_MEMORY_SCOPE_WORKGROUP), k2 = __hip_atomic_fetch_add(lcnt + ex2, 1u, __ATOMIC_RELAXED, __HIP_MEMORY_SCOPE_WORKGROUP);
            LDS_WAIT();
            unsigned* CNT = F.ctl + CW_CNT + (size_t)l * NEXP * CNT_STRIDE;
            if (r < 32) { const unsigned mine = lcnt[r]; lbase[r] = mine ? atomicAdd(CNT + r * CNT_STRIDE, mine) : 0u; }
            LDS_WAIT();
            int* LIST = (int*)(F.ws + WS_LIST); float* GWT = (float*)(F.ws + WS_GWT);
            LIST[(size_t)ex1 * T + lbase[ex1] + k1] = row * 2; LIST[(size_t)ex2 * T + lbase[ex2] + k2] = row * 2 + 1;
            GWT[row * 2] = w1; GWT[row * 2 + 1] = w2; } }
        __syncthreads();
    }
}
__device__ __forceinline__ void phase_cumsum(Frame& F) {
    const float* LOGF = (const float*)(F.ws + WS_LOGF); float* CUM = (float*)(F.ws + WS_CUM);
    LAS double* red = (LAS double*)(F.lds + RING_OFF);
    for (int task = F.vcu; task < BATCH * 8 * 16; task += F.G) {
        const int seq = task >> 4, c = task & 15, b = seq >> 3, j = seq & 7;
        const float* src = LOGF + ((size_t)b * 8 + j) * SEQ;
        double acc = 0.0;
        for (int i = F.tid; i < c * 128; i += NWAVES * 64) { const f32x4 q = *(const f32x4*)(src + 4 * i); acc += ((double)q.x + (double)q.y) + ((double)q.z + (double)q.w); }
        acc = wave_sum_d(acc, F.lane);
        double v = (double)src[c * 512 + F.tid];
#pragma unroll
        for (int o = 1; o < 64; o <<= 1) { const double u = shx_d(v, 0, (F.lane - o) & 63); if (F.lane >= o) v += u; }
        if (F.lane == 63) { red[F.wave] = acc; red[8 + F.wave] = v; }
        else if (F.lane == 0 && false) {}
        __syncthreads();
        double base = 0.0;
#pragma unroll
        for (int w = 0; w < 8; ++w) { base += red[w]; if (w < F.wave) base += red[8 + w]; }
        CUM[(size_t)seq * SEQ + c * 512 + F.tid] = (float)((base + v) * 1.4426950408889634);
        __syncthreads();
    }
}
__device__ __forceinline__ void phase_diffc(Frame& F, int l) {
    const float* lq1 = (const float*)F.in[I_LQ1] + l * 64; const float* lk1 = (const float*)F.in[I_LK1] + l * 64;
    const float* lq2 = (const float*)F.in[I_LQ2] + l * 64; const float* lk2 = (const float*)F.in[I_LK2] + l * 64;
    const float li = lambda_init_of(l);
    const float lam = __builtin_amdgcn_exp2f(LOG2E * wave_sum(lq1[F.lane] * lk1[F.lane], F.lane)) - __builtin_amdgcn_exp2f(LOG2E * wave_sum(lq2[F.lane] * lk2[F.lane], F.lane)) + li;
    const float* sub = (const float*)F.in[I_SUBLN] + l * 128;
    const bf16* OA = (const bf16*)(F.ws + WS_OA); bf16* AD = (bf16*)(F.ws + WS_AD);
    const int gw = F.vcu * NWAVES + F.wave, NGW = F.G * NWAVES, lane = F.lane;
    const int d0 = (lane & 15) * 8;
    float sg[8];
#pragma unroll
    for (int e = 0; e < 8; ++e) sg[e] = sub[d0 + e] * (1.0f - li);
    for (int rb0 = gw; rb0 < T; rb0 += 8 * NGW) {
        v4u a_[8], b_[8];
#pragma unroll
        for (int q = 0; q < 8; ++q) { const int row = rb0 + q * NGW < T ? rb0 + q * NGW : rb0;
            a_[q] = __builtin_nontemporal_load((const v4u*)(OA + (size_t)row * 1024 + lane * 8)); b_[q] = __builtin_nontemporal_load((const v4u*)(OA + (size_t)row * 1024 + 512 + lane * 8)); }
#pragma unroll
        for (int q = 0; q < 8; ++q) { const int row = rb0 + q * NGW; if (row < T) { const v4u a = a_[q], b = b_[q];
        float v[8];
        v[0] = bflo(a.x) - lam * bflo(b.x); v[1] = bfhi(a.x) - lam * bfhi(b.x); v[2] = bflo(a.y) - lam * bflo(b.y); v[3] = bfhi(a.y) - lam * bfhi(b.y);
        v[4] = bflo(a.z) - lam * bflo(b.z); v[5] = bfhi(a.z) - lam * bfhi(b.z); v[6] = bflo(a.w) - lam * bflo(b.w); v[7] = bfhi(a.w) - lam * bfhi(b.w);
        float ss = 0.f;
#pragma unroll
        for (int e = 0; e < 8; ++e) ss += v[e] * v[e];
        ss += shx(ss, 1, lane); ss += shx(ss, 2, lane); ss += shx(ss, 4, lane); ss += shx(ss, 8, lane);
        const float r = __builtin_amdgcn_rsqf(ss * (1.0f / 128.0f) + EPS);
        v4u o; o.x = pk2(v[0] * r * sg[0], v[1] * r * sg[1]); o.y = pk2(v[2] * r * sg[2], v[3] * r * sg[3]); o.z = pk2(v[4] * r * sg[4], v[5] * r * sg[5]); o.w = pk2(v[6] * r * sg[6], v[7] * r * sg[7]);
        *(v4u*)(AD + (size_t)row * 512 + lane * 8) = o; } }
    }
}
__device__ __forceinline__ void phase_final(Frame& F, bool dry = false) {
    const bf16* Y = (const bf16*)(F.ws + WS_Y);
    const int gw = F.vcu * NWAVES + F.wave, NGW = F.G * NWAVES, lane = F.lane;
    for (int rb0 = gw; rb0 < T; rb0 += 4 * NGW) {
        f32x4 v_[4][4]; v2u a_[4][4], b_[4][4];
#pragma unroll
        for (int q = 0; q < 4; ++q) { const int row = rb0 + q * NGW < T ? rb0 + q * NGW : rb0;
#pragma unroll
            for (int j = 0; j < 4; ++j) { v_[q][j] = __builtin_nontemporal_load((const f32x4*)(F.out + (size_t)row * D + lane * 4 + 256 * j));
                a_[q][j] = __builtin_nontemporal_load((const v2u*)(Y + (size_t)row * D + lane * 4 + 256 * j)); b_[q][j] = __builtin_nontemporal_load((const v2u*)(Y + (size_t)T * D + (size_t)row * D + lane * 4 + 256 * j)); } }
#pragma unroll
        for (int q = 0; q < 4; ++q) { const int row = rb0 + q * NGW; if (row < T) {
#pragma unroll
            for (int j = 0; j < 4; ++j) { f32x4 v = v_[q][j]; const v2u a = a_[q][j], b = b_[q][j];
                v.x += bflo(a.x) + bflo(b.x); v.y += bfhi(a.x) + bfhi(b.x); v.z += bflo(a.y) + bflo(b.y); v.w += bfhi(a.y) + bfhi(b.y);
                if (!dry || v.x == 1.2345e33f) __builtin_nontemporal_store(v, (f32x4*)(F.out + (size_t)row * D + lane * 4 + 256 * j)); } } }
    }
}
namespace pg8 {
typedef short bf16x8 __attribute__((ext_vector_type(8)));
typedef unsigned u32x4 __attribute__((ext_vector_type(4)));
constexpr int BM = 256, BK = 64, HALF = 128, HTB = HALF * BK * 2, STAGE_BYTES = 8 * HTB;
__host__ __device__ __forceinline__ int lds_byte(int r, int c) { const int st = (r >> 4) * 2 + (c >> 5), rr = r & 15, cc = c & 31, ob = rr * 64 + cc * 2; return st * 1024 + (ob ^ (((ob >> 9) & 1) << 5)); }
__host__ __device__ __forceinline__ void stage_rc(int b, int& R, int& C) { const int st = b / 1024, sb = b % 1024, swz = sb ^ (((sb >> 9) & 1) << 5); R = (st >> 1) * 16 + swz / 64; C = (st & 1) * 32 + (swz % 64) / 2; }
__host__ __device__ __forceinline__ int perm32(int rho) { const int n = rho >> 4, i = rho & 15; return 8 * (i >> 2) + 4 * n + (i & 3); }
struct Unit { int pm, pn, ex, sl; };
__device__ __forceinline__ unsigned cvt_pk_bf16(float lo, float hi) { unsigned r; asm volatile("v_cvt_pk_bf16_f32 %0, %1, %2" : "=v"(r) : "v"(lo), "v"(hi)); return r; }

struct StaticOrder {
    int nM, nN, nwg, G, c, K;
    __device__ void init(int M, int N, int K_, int G_, int c_) { nM = M / BM; nN = N / BM; nwg = nM * nN; G = G_; c = c_; K = K_; }
    __device__ __forceinline__ bool next(int i, Unit& u) const {
        const long L = (long)i * G + c; if (L >= nwg) return false;
        int wgid = (int)L; { const int q = nwg / 8, r = nwg % 8, xcd = wgid % 8, off = wgid / 8; wgid = (xcd < r ? xcd * (q + 1) : r * (q + 1) + (xcd - r) * q) + off; }
        const int nig = 8 * nN, gid = wgid / nig, fm = gid * 8, gsz = (nM - fm) < 8 ? (nM - fm) : 8;
        u.pm = fm + ((wgid % nig) % gsz); u.pn = (wgid % nig) / gsz; u.ex = 0; u.sl = 0; return true;
    }
    static constexpr bool GATHER = false; static constexpr int A_AUX = 0;
    __device__ __forceinline__ void a_ready(const Unit&) const {}
    __device__ __forceinline__ size_t a_off(const Unit& u) const { return (size_t)u.pm * BM * K * 2; }
    __device__ __forceinline__ unsigned arow_off(const Unit&, int) const { return 0u; }
    __device__ __forceinline__ size_t b_off(const Unit& u) const { return (size_t)u.pn * BM * K * 2; }
};

template <class Epi, class Sched, bool ALIGN_EPI>
__device__ __forceinline__ void gemm_phase(LAS unsigned char* lds, const int wave0, const bf16* Ag, const bf16* Btg, const int K, const Sched& S, const Epi& E) {
    const int tid = fresh_tid(wave0);
    const int wid = __builtin_amdgcn_readfirstlane(tid >> 6), lane = tid & 63, wr = wid >> 2, wc = wid & 3, fr = lane & 15, fq = lane >> 4;
    const int nt = K / BK;
    constexpr bool GATHER = Sched::GATHER;
    int RA0 = 0; unsigned CA2 = 0u, voffA[2], voffB[2];
#pragma unroll
    for (int i = 0; i < 2; ++i) { int R, C; stage_rc(tid * 16 + i * 8192, R, C); if (i == 0) { RA0 = R; CA2 = (unsigned)C * 2u; }
        voffA[i] = (unsigned)(R * K + C) * 2u;
        const int Rb = Epi::BMODE == 2 ? 64 * (R >> 5) + perm32(R & 31) : (Epi::BMODE == 1 ? ((R & ~31) + perm32(R & 31)) : R);
        voffB[i] = (unsigned)(Rb * K + C) * 2u; }
    const size_t kstep = (size_t)(BK * 2);
    const size_t hstepB = (size_t)(Epi::BMODE == 2 ? 32 : HALF) * K * 2, hstepA = (size_t)HALF * K * 2;
    const unsigned ldsw = (unsigned)wid * 1024u;
    const int aoff = lds_byte(wr * 64 + fr, fq * 8), boff = lds_byte(wc * 32 + fr, fq * 8);
#define PG8_SA(b, h) (((b) * 2 + (h)) * HTB)
#define PG8_SB(b, h) ((4 + (b) * 2 + (h)) * HTB)
#define PG8_STAGE_A(bufoff, gbase, voff) do { _Pragma("unroll") for (int _i = 0; _i < 2; ++_i) \
        __builtin_amdgcn_global_load_lds((const unsigned*)((const char*)(gbase) + (voff)[_i]), (LAS unsigned*)(lds + (bufoff) + ldsw + _i * 8192), 16, 0, Sched::A_AUX); } while (0)
#define PG8_STAGE(bufoff, gbase, voff) do { _Pragma("unroll") for (int _i = 0; _i < 2; ++_i) \
        __builtin_amdgcn_global_load_lds((const unsigned*)((const char*)(gbase) + (voff)[_i]), (LAS unsigned*)(lds + (bufoff) + ldsw + _i * 8192), 16, 0, 0); } while (0)
#define PG8_LDA(dst, b, h) do { _Pragma("unroll") for (int m = 0; m < 4; ++m) _Pragma("unroll") for (int k = 0; k < 2; ++k) dst[m][k] = *(const LAS bf16x8*)(lds + PG8_SA(b, h) + aoff + m * 2048 + k * 1024); } while (0)
#define PG8_LDB(dst, b, h) do { _Pragma("unroll") for (int n = 0; n < 2; ++n) _Pragma("unroll") for (int k = 0; k < 2; ++k) dst[n][k] = *(const LAS bf16x8*)(lds + PG8_SB(b, h) + boff + n * 2048 + k * 1024); } while (0)
#define PG8_MMA(ai, bj, At, Bt) do { __builtin_amdgcn_s_setprio(1); _Pragma("unroll") for (int m = 0; m < 4; ++m) _Pragma("unroll") for (int n = 0; n < 2; ++n) _Pragma("unroll") for (int k = 0; k < 2; ++k) \
        acc[ai][bj][m][n] = __builtin_amdgcn_mfma_f32_16x16x32_bf16(Bt[n][k], At[m][k], acc[ai][bj][m][n], 0, 0, 0); __builtin_amdgcn_s_setprio(0); } while (0)
#define PG8_WAIT_V(n) asm volatile("s_waitcnt vmcnt(" #n ")" ::: "memory")
#define PG8_WAIT_L(n) asm volatile("s_waitcnt lgkmcnt(" #n ")" ::: "memory")
#define PG8_BAR __builtin_amdgcn_s_barrier()
#define PG8_SCHED __builtin_amdgcn_sched_barrier(0)
    Unit cur, nxt; int ui = 0;
    if (!S.next(0, cur)) return;
    f32x4 acc[2][2][4][2];
#pragma unroll
    for (int a = 0; a < 2; ++a)
#pragma unroll
        for (int b = 0; b < 2; ++b)
#pragma unroll
            for (int m = 0; m < 4; ++m)
#pragma unroll
                for (int n = 0; n < 2; ++n) acc[a][b][m][n] = (f32x4){0.f, 0.f, 0.f, 0.f};
    bf16x8 At[4][2], B0[2][2], B1[2][2];
    unsigned gc0[2] = {0u, 0u}, gc1[2] = {0u, 0u};
#define PG8_GOFF(u, d0, d1) do { d0[0] = S.arow_off(u, RA0) + CA2; d0[1] = S.arow_off(u, RA0 + 64) + CA2; d1[0] = S.arow_off(u, HALF + RA0) + CA2; d1[1] = S.arow_off(u, HALF + RA0 + 64) + CA2; } while (0)
    if constexpr (GATHER) PG8_GOFF(cur, gc0, gc1);
    S.a_ready(cur);
    const char* cA = (const char*)Ag; if constexpr (!GATHER) cA += S.a_off(cur);
    const char* cB = (const char*)Btg + S.b_off(cur);
    PG8_STAGE(PG8_SB(0, 0), cB, voffB); PG8_STAGE(PG8_SB(0, 1), cB + hstepB, voffB);
    if constexpr (GATHER) { PG8_STAGE_A(PG8_SA(0, 0), cA, gc0); PG8_STAGE_A(PG8_SA(0, 1), cA, gc1); } else { PG8_STAGE_A(PG8_SA(0, 0), cA, voffA); PG8_STAGE_A(PG8_SA(0, 1), cA + hstepA, voffA); }
    if (wr == 1) PG8_BAR;
    PG8_WAIT_V(2); PG8_BAR;
    PG8_STAGE(PG8_SB(1, 0), cB + kstep, voffB);
    if constexpr (GATHER) PG8_STAGE_A(PG8_SA(1, 0), cA + kstep, gc0); else PG8_STAGE_A(PG8_SA(1, 0), cA + kstep, voffA);
    PG8_STAGE(PG8_SB(1, 1), cB + hstepB + kstep, voffB);
    PG8_WAIT_V(6); PG8_BAR;
    for (;;) {
        const bool has_next = S.next(ui + 1, nxt);
        const char* nA = cA; if constexpr (!GATHER) { if (has_next) nA = (const char*)Ag + S.a_off(nxt); }
        const char* nB = has_next ? (const char*)Btg + S.b_off(nxt) : cB;
        for (int t = 0; t < nt; t += 2) {
            const bool last = (t == nt - 2);
            if (last && has_next) S.a_ready(nxt);
            const char* a1 = cA + (size_t)(t + 1) * kstep;
            const char* a2 = last ? nA : cA + (size_t)(t + 2) * kstep; const char* b2 = last ? nB : cB + (size_t)(t + 2) * kstep;
            const char* a3 = a2 + kstep; const char* b3 = b2 + kstep;
            unsigned vs0[2] = {gc0[0], gc0[1]}, vs1[2] = {gc1[0], gc1[1]};
            if constexpr (GATHER) { if (last && has_next) PG8_GOFF(nxt, vs0, vs1); }
#define PG8_STA(bufoff, base, h, vs) do { if constexpr (GATHER) PG8_STAGE_A(bufoff, base, vs); else PG8_STAGE_A(bufoff, (base) + (h) * hstepA, voffA); } while (0)
            PG8_LDB(B0, 0, 0); PG8_LDB(B1, 0, 1); PG8_SCHED; PG8_LDA(At, 0, 0); PG8_STA(PG8_SA(1, 1), a1, 1, gc1);
            PG8_WAIT_V(8); PG8_WAIT_L(0); PG8_BAR; PG8_MMA(0, 0, At, B0); PG8_MMA(0, 1, At, B1); PG8_BAR; PG8_SCHED;
            PG8_LDA(At, 0, 1); PG8_STAGE(PG8_SB(0, 0), b2, voffB); PG8_STAGE(PG8_SB(0, 1), b2 + hstepB, voffB); PG8_STA(PG8_SA(0, 0), a2, 0, vs0);
            PG8_WAIT_V(8); PG8_WAIT_L(0); PG8_BAR; PG8_MMA(1, 0, At, B0); PG8_MMA(1, 1, At, B1); PG8_BAR; PG8_SCHED;
            PG8_LDB(B0, 1, 0); PG8_LDB(B1, 1, 1); PG8_SCHED; PG8_LDA(At, 1, 0); PG8_STA(PG8_SA(0, 1), a2, 1, vs1);
            PG8_WAIT_V(8); PG8_WAIT_L(0); PG8_BAR; PG8_MMA(0, 0, At, B0); PG8_MMA(0, 1, At, B1); PG8_BAR; PG8_SCHED;
            PG8_LDA(At, 1, 1); PG8_STAGE(PG8_SB(1, 0), b3, voffB); PG8_STAGE(PG8_SB(1, 1), b3 + hstepB, voffB); PG8_STA(PG8_SA(1, 0), a3, 0, vs0);
            PG8_WAIT_V(8); PG8_WAIT_L(0); PG8_BAR; PG8_MMA(1, 0, At, B0); PG8_MMA(1, 1, At, B1); PG8_BAR; PG8_SCHED;
        }
        if constexpr (ALIGN_EPI) { if (wr == 0) PG8_BAR; }
        if constexpr (!Epi::AFTER_DRAIN) E(acc, cur, wr, wc, fr, fq);
        if (!has_next) break;
        if (!(Epi::CHAIN2 && cur.ex == 0)) {
#pragma unroll
        for (int a = 0; a < 2; ++a)
#pragma unroll
            for (int b = 0; b < 2; ++b)
#pragma unroll
                for (int m = 0; m < 4; ++m)
#pragma unroll
                    for (int n = 0; n < 2; ++n) acc[a][b][m][n] = (f32x4){0.f, 0.f, 0.f, 0.f}; }
        cur = nxt; cA = nA; cB = nB; ++ui;
        if constexpr (GATHER) PG8_GOFF(cur, gc0, gc1);
        if constexpr (ALIGN_EPI) { if (wr == 1) PG8_BAR; }
    }
    PG8_WAIT_V(0);
    if constexpr (!ALIGN_EPI) { if (wr == 0) PG8_BAR; }
    PG8_BAR;
    if constexpr (Epi::AFTER_DRAIN) E.fused(acc, cur, wr, wc, fr, fq, lds, tid);
#undef PG8_SA
#undef PG8_SB
#undef PG8_STAGE
#undef PG8_STAGE_A
#undef PG8_STA
#undef PG8_GOFF
#undef PG8_LDA
#undef PG8_LDB
#undef PG8_MMA
#undef PG8_WAIT_V
#undef PG8_WAIT_L
#undef PG8_BAR
#undef PG8_SCHED
}
}
typedef pg8::Unit Unit;
__device__ __forceinline__ float sigmoidf_(float v) { return __builtin_amdgcn_rcpf(1.0f + __builtin_amdgcn_exp2f(-v * LOG2E)); }

struct EpiInproj {
    static constexpr int BMODE = 2; static constexpr bool CHAIN2 = false, AFTER_DRAIN = false;
    bf16* O; const float* gt; const float* cs;
    __device__ __forceinline__ void operator()(f32x4 (&acc)[2][2][4][2], const Unit& u, int wr, int wc, int fr, int fq) const {
        const int seg = u.pn >> 1;
        const int col0 = u.pn * 256 + wc * 64 + 8 * fq;
        const bool isnorm = (seg == 0 || seg == 1 || seg == 3 || seg == 4), isdiff = seg < 2;
        f32x4 g[2][2];
        if (isnorm) {
            const float* gp = gt + (seg < 2 ? seg : seg - 1) * 64;
#pragma unroll
            for (int bj = 0; bj < 2; ++bj)
#pragma unroll
                for (int n = 0; n < 2; ++n) { const int d0 = (isdiff && bj == 0 && fq < 2) ? (4 * fq + 8 * n) : (32 * bj + 8 * fq + 4 * n); g[bj][n] = *(const f32x4*)(gp + d0); }
        }
#pragma unroll
        for (int ai = 0; ai < 2; ++ai)
#pragma unroll
            for (int m = 0; m < 4; ++m) {
                const int row = u.pm * 256 + ai * 128 + wr * 64 + m * 16 + fr;
                f32x4 v00 = acc[ai][0][m][0], v01 = acc[ai][0][m][1], v10 = acc[ai][1][m][0], v11 = acc[ai][1][m][1];
                if (isnorm) {
                    float ss = (v00.x * v00.x + v00.y * v00.y) + (v00.z * v00.z + v00.w * v00.w) + (v01.x * v01.x + v01.y * v01.y) + (v01.z * v01.z + v01.w * v01.w)
                             + (v10.x * v10.x + v10.y * v10.y) + (v10.z * v10.z + v10.w * v10.w) + (v11.x * v11.x + v11.y * v11.y) + (v11.z * v11.z + v11.w * v11.w);
                    ss += shx(ss, 16, fq * 16 + fr); ss += shx(ss, 32, fq * 16 + fr);
                    const float rs = __builtin_amdgcn_rsqf(ss * (1.0f / 64.0f) + EPS);
                    v00 = v00 * rs * g[0][0]; v01 = v01 * rs * g[0][1]; v10 = v10 * rs * g[1][0]; v11 = v11 * rs * g[1][1];
                    if (isdiff) {
                        const int fi = (fq & 1) * 4;
                        const f32x4 c = *(const f32x4*)(cs + (size_t)row * 16 + fi), s = *(const f32x4*)(cs + (size_t)row * 16 + 8 + fi);
                        const f32x4 r0 = v00 * c - v01 * s, r1 = v01 * c + v00 * s;
                        if (fq < 2) { v00 = r0; v01 = r1; }
                    }
                } else if (seg >= 6) {
#pragma unroll
                    for (int e = 0; e < 4; ++e) { v00[e] = sigmoidf_(v00[e]); v01[e] = sigmoidf_(v01[e]); v10[e] = sigmoidf_(v10[e]); v11[e] = sigmoidf_(v11[e]); }
                }
                bf16* rowp = O + (size_t)row * NP + col0;
                pg8::u32x4 w0, w1;
                w0.x = pg8::cvt_pk_bf16(v00.x, v00.y); w0.y = pg8::cvt_pk_bf16(v00.z, v00.w); w0.z = pg8::cvt_pk_bf16(v01.x, v01.y); w0.w = pg8::cvt_pk_bf16(v01.z, v01.w);
                w1.x = pg8::cvt_pk_bf16(v10.x, v10.y); w1.y = pg8::cvt_pk_bf16(v10.z, v10.w); w1.z = pg8::cvt_pk_bf16(v11.x, v11.y); w1.w = pg8::cvt_pk_bf16(v11.z, v11.w);
#if SC1_STORES
                asm volatile("global_store_dwordx4 %0, %1, off sc1\n\tglobal_store_dwordx4 %0, %2, off offset:64 sc1\n\ts_nop 1" :: "v"(rowp), "v"(w0), "v"(w1) : "memory");
#else
                *(pg8::u32x4*)(rowp) = w0; *(pg8::u32x4*)(rowp + 32) = w1;
#endif
            }
    }
};
template <bool FIRST> struct EpiYZ {
    static constexpr int BMODE = 1; static constexpr bool CHAIN2 = false, AFTER_DRAIN = false;
    bf16* Z; const bf16* G;
    __device__ __forceinline__ void operator()(f32x4 (&acc)[2][2][4][2], const Unit& u, int wr, int wc, int fr, int fq) const {
#pragma unroll
        for (int ai = 0; ai < 2; ++ai)
#pragma unroll
            for (int m = 0; m < 4; ++m) { const int row = u.pm * 256 + ai * 128 + wr * 64 + m * 16 + fr;
#pragma unroll
                for (int bj = 0; bj < 2; ++bj) { const int col = u.pn * 256 + bj * 128 + wc * 32 + 8 * fq;
                    const pg8::u32x4 gw = *(const pg8::u32x4*)(G + (size_t)row * NP + col);
                    f32x4 v0 = acc[ai][bj][m][0], v1 = acc[ai][bj][m][1];
                    v0.x *= bflo(gw.x); v0.y *= bfhi(gw.x); v0.z *= bflo(gw.y); v0.w *= bfhi(gw.y); v1.x *= bflo(gw.z); v1.y *= bfhi(gw.z); v1.z *= bflo(gw.w); v1.w *= bfhi(gw.w);
                    bf16* zp = Z + (size_t)row * D + col;
                    if (!FIRST) { const pg8::u32x4 zo = *(const pg8::u32x4*)zp;
                        v0.x += bflo(zo.x); v0.y += bfhi(zo.x); v0.z += bflo(zo.y); v0.w += bfhi(zo.y); v1.x += bflo(zo.z); v1.y += bfhi(zo.z); v1.z += bflo(zo.w); v1.w += bfhi(zo.w); }
                    pg8::u32x4 w; w.x = pg8::cvt_pk_bf16(v0.x, v0.y); w.y = pg8::cvt_pk_bf16(v0.z, v0.w); w.z = pg8::cvt_pk_bf16(v1.x, v1.y); w.w = pg8::cvt_pk_bf16(v1.z, v1.w);
                    *(pg8::u32x4*)zp = w; } }
    }
};
struct EpiWo {
    static constexpr int BMODE = 0; static constexpr bool CHAIN2 = false, AFTER_DRAIN = false;
    float* out; bool dry;
    __device__ __forceinline__ void operator()(f32x4 (&acc)[2][2][4][2], const Unit& u, int wr, int wc, int fr, int fq) const {
#pragma unroll
        for (int ai = 0; ai < 2; ++ai)
#pragma unroll
            for (int m = 0; m < 4; ++m) { const int row = u.pm * 256 + ai * 128 + wr * 64 + m * 16 + fr;
#pragma unroll
                for (int bj = 0; bj < 2; ++bj)
#pragma unroll
                    for (int n = 0; n < 2; ++n) { float* p = out + (size_t)row * D + u.pn * 256 + bj * 128 + wc * 32 + n * 16 + 4 * fq; const f32x4 nv = *(const f32x4*)p + acc[ai][bj][m][n]; if (!dry || nv.x == 1.2345e33f) *(f32x4*)p = nv; }
                if (m == 3) asm volatile("" ::: "memory"); }
    }
};
struct EpiWoR {
    static constexpr int BMODE = 2; static constexpr bool CHAIN2 = false, AFTER_DRAIN = true;
    float* out; const float* res; bf16* HN; const float* g2; const bf16* WT; float* SUMS; bool dry;
    __device__ __forceinline__ void operator()(f32x4 (&)[2][2][4][2], const Unit&, int, int, int, int) const {}
    __device__ __forceinline__ void fused(f32x4 (&acc)[2][2][4][2], const Unit& u, int wr, int wc, int fr, int fq, LAS unsigned char* lds, int tid) const {
        constexpr int PW = 49;
        LAS float* tab = (LAS float*)lds;
        const int lane = fq * 16 + fr;
        const int c0 = u.pn * 256 + wc * 64 + 8 * fq;
        pg8::bf16x8 wh[2][3], wl[2][3]; f32x4 gg[2][2];
#pragma unroll
        for (int bj = 0; bj < 2; ++bj) {
#pragma unroll
            for (int nb = 0; nb < 3; ++nb) { wh[bj][nb] = *(const pg8::bf16x8*)(WT + (size_t)(nb * 16 + fr) * D + c0 + 32 * bj); wl[bj][nb] = *(const pg8::bf16x8*)(WT + (size_t)48 * D + (size_t)(nb * 16 + fr) * D + c0 + 32 * bj); }
#pragma unroll
            for (int n = 0; n < 2; ++n) gg[bj][n] = *(const f32x4*)(g2 + c0 + 32 * bj + 4 * n); }
#pragma unroll
        for (int ai = 0; ai < 2; ++ai)
#pragma unroll
            for (int m = 0; m < 4; ++m) { const int row = u.pm * 256 + ai * 128 + wr * 64 + m * 16 + fr;
                float ss = 0.f; f32x4 dd[3];
#pragma unroll
                for (int nb = 0; nb < 3; ++nb) dd[nb] = (f32x4){0.f, 0.f, 0.f, 0.f};
#pragma unroll
                for (int bj = 0; bj < 2; ++bj) { float* p = out + (size_t)row * D + c0 + 32 * bj; const float* ps = res + (size_t)row * D + c0 + 32 * bj;
                    const f32x4 o0 = *(const f32x4*)ps, o1 = *(const f32x4*)(ps + 4); const f32x4 v0 = o0 + acc[ai][bj][m][0], v1 = o1 + acc[ai][bj][m][1];
                    *(f32x4*)p = dry ? o0 : v0; *(f32x4*)(p + 4) = dry ? o1 : v1;
                    ss += ((v0.x * v0.x + v0.y * v0.y) + (v0.z * v0.z + v0.w * v0.w)) + ((v1.x * v1.x + v1.y * v1.y) + (v1.z * v1.z + v1.w * v1.w));
                    { const f32x4 a = v0 * gg[bj][0], b = v1 * gg[bj][1]; pg8::u32x4 o; o.x = pg8::cvt_pk_bf16(a.x, a.y); o.y = pg8::cvt_pk_bf16(a.z, a.w); o.z = pg8::cvt_pk_bf16(b.x, b.y); o.w = pg8::cvt_pk_bf16(b.z, b.w);
                      *(pg8::u32x4*)(HN + (size_t)row * D + c0 + 32 * bj) = o; }
                    pg8::u32x4 hp, lp;
                    hp.x = pg8::cvt_pk_bf16(v0.x, v0.y); hp.y = pg8::cvt_pk_bf16(v0.z, v0.w); hp.z = pg8::cvt_pk_bf16(v1.x, v1.y); hp.w = pg8::cvt_pk_bf16(v1.z, v1.w);
                    lp.x = pg8::cvt_pk_bf16(v0.x - bflo(hp.x), v0.y - bfhi(hp.x)); lp.y = pg8::cvt_pk_bf16(v0.z - bflo(hp.y), v0.w - bfhi(hp.y));
                    lp.z = pg8::cvt_pk_bf16(v1.x - bflo(hp.z), v1.y - bfhi(hp.z)); lp.w = pg8::cvt_pk_bf16(v1.z - bflo(hp.w), v1.w - bfhi(hp.w));
                    const pg8::bf16x8 ah = __builtin_bit_cast(pg8::bf16x8, hp), al = __builtin_bit_cast(pg8::bf16x8, lp);
#pragma unroll
                    for (int nb = 0; nb < 3; ++nb) { dd[nb] = __builtin_amdgcn_mfma_f32_16x16x32_bf16(ah, wh[bj][nb], dd[nb], 0, 0, 0); dd[nb] = __builtin_amdgcn_mfma_f32_16x16x32_bf16(ah, wl[bj][nb], dd[nb], 0, 0, 0);
                        dd[nb] = __builtin_amdgcn_mfma_f32_16x16x32_bf16(al, wh[bj][nb], dd[nb], 0, 0, 0); } }
                ss += shx(ss, 16, lane); ss += shx(ss, 32, lane);
                acc[ai][0][m][0] = dd[0]; acc[ai][0][m][1] = dd[1]; acc[ai][1][m][0] = dd[2]; acc[ai][1][m][1].x = ss; }
#pragma unroll 1
        for (int ph = 0; ph < 2; ++ph) {
            if ((wc >> 1) == ph) { LAS float* tb = tab + (wc & 1) * 256 * PW;
#pragma unroll
                for (int ai = 0; ai < 2; ++ai)
#pragma unroll
                    for (int m = 0; m < 4; ++m) { const int rb = ai * 128 + wr * 64 + m * 16;
#pragma unroll
                        for (int nb = 0; nb < 3; ++nb) { const f32x4 d = nb == 0 ? acc[ai][0][m][0] : (nb == 1 ? acc[ai][0][m][1] : acc[ai][1][m][0]);
#pragma unroll
                            for (int e = 0; e < 4; ++e) { LAS float* q = tb + (rb + 4 * fq + e) * PW + nb * 16 + fr; if (ph == 0) *q = d[e]; else *q += d[e]; } }
                        if (fq == 0) { LAS float* q = tb + (rb + fr) * PW + 48; const float s = acc[ai][1][m][1].x; if (ph == 0) *q = s; else *q += s; } }
            }
            LDS_WAIT(); __builtin_amdgcn_s_barrier();
        }
        float* dst = SUMS + ((size_t)u.pn * T + (size_t)u.pm * 256) * 64;
#pragma unroll 4
        for (int i = tid; i < 256 * 64; i += 512) { const int r = i >> 6, c = i & 63; if (c < PW) dst[(size_t)r * 64 + c] = tab[r * PW + c] + tab[256 * PW + r * PW + c]; }
    }
};
constexpr int MOE_LDS = MISC_OFF + 128;
constexpr int MOE_SLOTS = 8;
template <bool DOWN_> struct MoeOrderT {
    static constexpr bool GATHER = !DOWN_; static constexpr int A_AUX = 0;
    const LAS int* toff; const LAS int* ulist; const LAS int* idx;
    int Kb, l, wave0;
    unsigned* tcnt; unsigned* tmo;
    __device__ __forceinline__ bool next(int i, Unit& u) const {
        if (i >= ulist[8]) return false;
        const int L = ulist[i]; u.pm = L >> 2; u.pn = L & 3; u.sl = i; int e = 0;
#pragma unroll 1
        for (int q = 1; q < NEXP; ++q) if (u.pm >= toff[q]) e = q;
        u.ex = e; return true;
    }
    __device__ __forceinline__ void a_ready(const Unit& u) const {
        if constexpr (DOWN_ && !MOE_BARRIER) {
            if (wave0 == 0) {
                unsigned* w = tcnt + u.pm * TCNT_STRIDE; unsigned sp = 0;
                while ((unsigned)__builtin_amdgcn_readfirstlane(__hip_atomic_load(w, __ATOMIC_RELAXED, __HIP_MEMORY_SCOPE_AGENT)) < 32u) {
                    __builtin_amdgcn_s_sleep(2);
                    if ((++sp & 255u) == 0u) { if (__hip_atomic_load(tmo, __ATOMIC_RELAXED, __HIP_MEMORY_SCOPE_AGENT) != 0u) break;
                        if (sp > (1u << 20)) { if (fresh_lane() == 0) __hip_atomic_store(tmo, 1u, __ATOMIC_RELAXED, __HIP_MEMORY_SCOPE_AGENT); break; } } }
                __builtin_amdgcn_fence(__ATOMIC_ACQUIRE, "agent");
                asm volatile("s_waitcnt vmcnt(0)" ::: "memory");
            }
            asm volatile("" ::: "memory"); __builtin_amdgcn_s_barrier(); asm volatile("" ::: "memory");
        }
    }
    __device__ __forceinline__ unsigned arow_off(const Unit& u, int r) const { const int as = idx[u.sl * 256 + r]; return (unsigned)(as < 0 ? 0 : (as >> 1)) * (unsigned)Kb; }
    __device__ __forceinline__ size_t a_off(const Unit& u) const { return (size_t)u.pm * 256 * (size_t)Kb; }
    __device__ __forceinline__ size_t b_off(const Unit& u) const { return ((size_t)(l * NEXP + u.ex) * 1024 + (size_t)u.pn * 256) * (size_t)Kb; }
};
template <bool DOWN_> __device__ __forceinline__ MoeOrderT<DOWN_> moe_order_setup(Frame& F, int l, int Kb) {
    LAS int* toff = (LAS int*)(F.lds + MOE_LDS); LAS int* ulist = toff + 40; LAS int* idx = (LAS int*)(F.lds + MOE_LDS + 256);
    const unsigned* cnt = F.ctl + CW_CNT + (size_t)l * NEXP * CNT_STRIDE;
    if (F.wave == 0) {
        const int ln = F.lane; int nt = ln < NEXP ? ((int)cnt[ln * CNT_STRIDE] + 255) >> 8 : 0, inc = nt;
#pragma unroll
        for (int o = 1; o < 64; o <<= 1) { const int u = __builtin_amdgcn_ds_bpermute(((ln - o) & 63) << 2, inc); if (ln >= o) inc += u; }
        if (ln < NEXP) toff[ln] = inc - nt;
        if (ln == NEXP - 1) toff[NEXP] = inc;
        const int U = __builtin_amdgcn_readlane(inc, NEXP - 1) * 4, G = F.G, c = F.vcu;
        if (ln == 0) { int n = 0;
#ifndef MOE_OLD_DEAL
#define MOE_OLD_DEAL 0
#endif
        if (!DOWN_ || MOE_OLD_DEAL) { for (int L = c; L < U && n < MOE_SLOTS; L += G) ulist[n++] = L; }
        else {
            const int r = U % G, NL = G - r, a = U < 2 * NL ? U : 2 * NL, base_low = a / NL, extra_low = a % NL, R = U - a, base_all = R / G, extra_all = R % G;
            const int ord = c >= r ? c - r : NL + c;
            const int nd = (ord < NL ? base_low + (ord < extra_low ? 1 : 0) : 0) + base_all + (ord < extra_all ? 1 : 0);
            int bp[5] = {0, extra_low < NL ? extra_low : NL, extra_all, NL, G};
            if (bp[1] > bp[2]) { const int t_ = bp[1]; bp[1] = bp[2]; bp[2] = t_; }
            if (bp[2] > bp[3]) { const int t_ = bp[2]; bp[2] = bp[3]; bp[3] = t_; }
            if (bp[1] > bp[2]) { const int t_ = bp[1]; bp[1] = bp[2]; bp[2] = t_; }
            int S = 0;
            for (int k = 0; k < nd && n < MOE_SLOTS; ++k) {
                ulist[n++] = S + ord;
                int cntk = 0;
#pragma unroll
                for (int q = 0; q < 4; ++q) { const int o = bp[q], oe = bp[q + 1]; const int ndo = (o < NL ? base_low + (o < extra_low ? 1 : 0) : 0) + base_all + (o < extra_all ? 1 : 0); if (oe > o && ndo > k) cntk += oe - o; }
                S += cntk; }
        }
        ulist[8] = n; }
    }
    __syncthreads();
    MoeOrderT<DOWN_> S; S.toff = toff; S.ulist = ulist; S.idx = idx; S.Kb = Kb; S.l = l; S.wave0 = F.wave0;
    S.tcnt = F.ctl + CW_TCNT + (size_t)l * MAX_TILES * TCNT_STRIDE; S.tmo = F.ctl + CW_TMO;
    const int* LIST = (const int*)(F.ws + WS_LIST);
    Unit u;
    for (int i = 0; S.next(i, u); ++i) {
        if (F.tid < 256) { const int r = (u.pm - toff[u.ex]) * 256 + F.tid; idx[i * 256 + F.tid] = r < (int)cnt[u.ex * CNT_STRIDE] ? LIST[(size_t)u.ex * T + r] : -1; }
    }
    __syncthreads();
    return S;
}
#ifndef HID_PLAIN
#define HID_PLAIN 0
#endif
struct EpiGateUp {
    static constexpr int BMODE = 1; static constexpr bool CHAIN2 = false, AFTER_DRAIN = false;
    bf16* HID; const float* GWT; const float* RSTD; const LAS int* idx; unsigned* tcnt;
    __device__ __forceinline__ void operator()(f32x4 (&acc)[2][2][4][2], const Unit& u, int wr, int wc, int fr, int fq) const {
#pragma unroll
        for (int ai = 0; ai < 2; ++ai)
#pragma unroll
            for (int m = 0; m < 4; ++m) { const int r = ai * 128 + wr * 64 + m * 16 + fr; const int as = idx[u.sl * 256 + r];
                const float w = as < 0 ? 0.f : GWT[as]; const float rs = as < 0 ? 0.f : RSTD[as >> 1];
                const f32x4 g0 = acc[ai][0][m][0] * rs, g1 = acc[ai][0][m][1] * rs, u0 = acc[ai][1][m][0] * rs, u1 = acc[ai][1][m][1] * rs;
                f32x4 h0, h1;
#pragma unroll
                for (int e = 0; e < 4; ++e) { h0[e] = g0[e] * sigmoidf_(g0[e]) * u0[e] * w; h1[e] = g1[e] * sigmoidf_(g1[e]) * u1[e] * w; }
                if (as < 0) { h0 = (f32x4){0.f, 0.f, 0.f, 0.f}; h1 = h0; }
                pg8::u32x4 o; o.x = pg8::cvt_pk_bf16(h0.x, h0.y); o.y = pg8::cvt_pk_bf16(h0.z, h0.w); o.z = pg8::cvt_pk_bf16(h1.x, h1.y); o.w = pg8::cvt_pk_bf16(h1.z, h1.w);
#if HID_PLAIN
                *(pg8::u32x4*)(HID + (size_t)(u.pm * 256 + r) * FF + u.pn * 128 + wc * 32 + 8 * fq) = o; }
#else
                asm volatile("global_store_dwordx4 %0, %1, off sc1\n\ts_nop 1" :: "v"(HID + (size_t)(u.pm * 256 + r) * FF + u.pn * 128 + wc * 32 + 8 * fq), "v"(o) : "memory"); }
#endif
#if !MOE_BARRIER
        asm volatile("s_waitcnt vmcnt(0)" ::: "memory");
        if (fr == 0 && fq == 0) __hip_atomic_fetch_add(tcnt + u.pm * TCNT_STRIDE, 1u, __ATOMIC_RELAXED, __HIP_MEMORY_SCOPE_AGENT);
#endif
    }
};
struct EpiDown {
    static constexpr int BMODE = 2; static constexpr bool CHAIN2 = false, AFTER_DRAIN = false;
    bf16* Y; const LAS int* idx;
    __device__ __forceinline__ void operator()(f32x4 (&acc)[2][2][4][2], const Unit& u, int wr, int wc, int fr, int fq) const {
#pragma unroll
        for (int ai = 0; ai < 2; ++ai)
#pragma unroll
            for (int m = 0; m < 4; ++m) { const int r = ai * 128 + wr * 64 + m * 16 + fr; const int as = idx[u.sl * 256 + r];
                if (as >= 0) { bf16* yp = Y + (size_t)(as & 1) * T * D + (size_t)(as >> 1) * D + u.pn * 256 + wc * 64 + 8 * fq;
#pragma unroll
                    for (int bj = 0; bj < 2; ++bj) { const f32x4 v0 = acc[ai][bj][m][0], v1 = acc[ai][bj][m][1];
                        pg8::u32x4 o; o.x = pg8::cvt_pk_bf16(v0.x, v0.y); o.y = pg8::cvt_pk_bf16(v0.z, v0.w); o.z = pg8::cvt_pk_bf16(v1.x, v1.y); o.w = pg8::cvt_pk_bf16(v1.z, v1.w);
                        *(pg8::u32x4*)(yp + bj * 32) = o; } } }
    }
};

__device__ __forceinline__ void phase_inproj(Frame& F, int l) {
    pg8::StaticOrder S; S.init(T, NP, D, F.G, F.bx);
    EpiInproj E{(bf16*)(F.ws + WS_QKVG), (const float*)(F.ws + WS_GT) + l * 256, (const float*)(F.ws + WS_COSSIN)};
    pg8::gemm_phase<EpiInproj, pg8::StaticOrder, true>(F.lds + RING_OFF, F.wave0, (const bf16*)(F.ws + WS_HN), (const bf16*)(F.ws + WS_WIN) + (size_t)l * NP * D, D, S, E);
}
struct YZOrder : pg8::StaticOrder {
    size_t aof, bof;
    __device__ __forceinline__ bool next(int i, Unit& u) const { const bool ok = pg8::StaticOrder::next(i >> 1, u); u.ex = i & 1; return ok; }
    __device__ __forceinline__ size_t a_off(const Unit& u) const { return pg8::StaticOrder::a_off(u) + (u.ex ? aof : (size_t)0); }
    __device__ __forceinline__ size_t b_off(const Unit& u) const { return pg8::StaticOrder::b_off(u) + (u.ex ? bof : (size_t)0); }
};
struct EpiYZm {
    static constexpr int BMODE = 2; static constexpr bool CHAIN2 = true, AFTER_DRAIN = false;
    bf16* Z; const bf16* GA; const bf16* GF;
    __device__ __forceinline__ void operator()(f32x4 (&acc)[2][2][4][2], const Unit& u, int wr, int wc, int fr, int fq) const {
#pragma unroll
        for (int ai = 0; ai < 2; ++ai)
#pragma unroll
            for (int m = 0; m < 4; ++m) { const int row = u.pm * 256 + ai * 128 + wr * 64 + m * 16 + fr;
#pragma unroll
                for (int bj = 0; bj < 2; ++bj) { const int col = u.pn * 256 + wc * 64 + bj * 32 + 8 * fq;
                    const pg8::u32x4 fw = *(const pg8::u32x4*)(GF + (size_t)row * NP + col);
                    f32x4 f0 = (f32x4){bflo(fw.x), bfhi(fw.x), bflo(fw.y), bfhi(fw.y)}, f1 = (f32x4){bflo(fw.z), bfhi(fw.z), bflo(fw.w), bfhi(fw.w)};
#pragma unroll
                    for (int e = 0; e < 4; ++e) { f0[e] = fmaxf(f0[e], 1e-20f); f1[e] = fmaxf(f1[e], 1e-20f); }
                    if (u.ex == 0) {
                        const pg8::u32x4 aw = *(const pg8::u32x4*)(GA + (size_t)row * NP + col);
                        const f32x4 a0 = (f32x4){bflo(aw.x), bfhi(aw.x), bflo(aw.y), bfhi(aw.y)}, a1 = (f32x4){bflo(aw.z), bfhi(aw.z), bflo(aw.w), bfhi(aw.w)};
#pragma unroll
                        for (int e = 0; e < 4; ++e) { acc[ai][bj][m][0][e] *= a0[e] * __builtin_amdgcn_rcpf(f0[e]); acc[ai][bj][m][1][e] *= a1[e] * __builtin_amdgcn_rcpf(f1[e]); }
                    } else {
                        const f32x4 v0 = acc[ai][bj][m][0] * f0, v1 = acc[ai][bj][m][1] * f1;
                        pg8::u32x4 w; w.x = pg8::cvt_pk_bf16(v0.x, v0.y); w.y = pg8::cvt_pk_bf16(v0.z, v0.w); w.z = pg8::cvt_pk_bf16(v1.x, v1.y); w.w = pg8::cvt_pk_bf16(v1.z, v1.w);
                        *(pg8::u32x4*)(Z + (size_t)row * D + col) = w; } } }
    }
};
__device__ __forceinline__ void phase_yz(Frame& F, int l) {
    YZOrder S; S.init(T, D, 512, F.G, F.bx);
    S.aof = (size_t)((const char*)(F.ws + WS_OF) - (const char*)(F.ws + WS_AD)); S.bof = (size_t)((const char*)(F.ws + WS_WF) - (const char*)(F.ws + WS_WD));
    EpiYZm E{(bf16*)(F.ws + WS_Z), (const bf16*)(F.ws + WS_QKVG) + C_GA, (const bf16*)(F.ws + WS_QKVG) + C_GF};
    pg8::gemm_phase<EpiYZm, YZOrder, true>(F.lds + RING_OFF, F.wave0, (const bf16*)(F.ws + WS_AD), (const bf16*)(F.ws + WS_WD) + (size_t)l * D * 512, 512, S, E);
}
__device__ __forceinline__ void phase_wo(Frame& F, int l, bool dry = false) {
    pg8::StaticOrder S; S.init(T, D, D, F.G, F.bx);
    EpiWoR E{F.out, (l == 0 && !dry) ? (const float*)F.in[I_X] : (const float*)F.out, (bf16*)(F.ws + WS_HN), (const float*)F.in[I_LN2] + (size_t)l * D, (const bf16*)(F.ws + WS_WRT) + (size_t)l * 2 * 48 * D, (float*)(F.ws + WS_SUMS), dry};
    pg8::gemm_phase<EpiWoR, pg8::StaticOrder, true>(F.lds + RING_OFF, F.wave0, (const bf16*)(F.ws + WS_Z), (const bf16*)(F.ws + WS_WO) + (size_t)l * D * D, D, S, E);
}
__device__ __forceinline__ void phase_gateup(Frame& F, int l) {
    const MoeOrderT<false> S = moe_order_setup<false>(F, l, D * 2);
    EpiGateUp E{(bf16*)(F.ws + WS_HID), (const float*)(F.ws + WS_GWT), (const float*)(F.ws + WS_RSTD), S.idx, S.tcnt};
    pg8::gemm_phase<EpiGateUp, MoeOrderT<false>, true>(F.lds + RING_OFF, F.wave0, (const bf16*)(F.ws + WS_HN), (const bf16*)(F.ws + WS_WGU), D, S, E);
}
__device__ __forceinline__ void phase_down(Frame& F, int l) {
    const MoeOrderT<true> S = moe_order_setup<true>(F, l, FF * 2);
    EpiDown E{(bf16*)(F.ws + WS_Y), S.idx};
    pg8::gemm_phase<EpiDown, MoeOrderT<true>, true>(F.lds + RING_OFF, F.wave0, (const bf16*)(F.ws + WS_HID), (const bf16*)(F.ws + WS_WDN), FF, S, E);
}
#include <hip/hip_bf16.h>
namespace attn_body {
using bf16=__hip_bfloat16;
using bf16x8=__attribute__((ext_vector_type(8)))short;
using s16x4=__attribute__((ext_vector_type(4)))short;
using f32x16=__attribute__((ext_vector_type(16)))float;
using u32x4=__attribute__((ext_vector_type(4)))unsigned;
constexpr int SEQ=8192,D=64,DM=5120;
constexpr int NW=8,QBLK=32,QB=QBLK*NW,KVBLK=64,NQB=SEQ/QB;
constexpr int ATTN_UNIT_ROWS=QB;
__device__ __forceinline__ int crow(int r,int hi){return (r&3)+8*(r>>2)+4*hi;}
#define SBAR() __builtin_amdgcn_sched_barrier(0)
__device__ __forceinline__ void cmask(f32x16&p0,f32x16&p1,int jb,int qrel,int hi){
  const float NEG=-INFINITY; int kb=64*jb+4*hi;
  #pragma unroll
  for(int r=0;r<16;++r){int kv=kb+(r&3)+8*(r>>2); if(kv>qrel)p0[r]=NEG; if(kv+32>qrel)p1[r]=NEG;}
}

constexpr int NSLOT=3, SLOTB=8192;
constexpr int LDS_K=0, LDS_V=NSLOT*SLOTB;
template<int DV> struct Lay { static constexpr int VM=DV/64, WS=LDS_V+NSLOT*SLOTB*VM, OST=WS+NW*64*4, CK=OST+NW*4096, BYTES=CK+(DV==64?SEQ*4+512:0); };
constexpr float C2=0.125f*1.4426950408889634f;
__device__ __forceinline__ void glds16(const void*gsrc,unsigned lds_dst){unsigned keep;
  asm volatile("s_mov_b32 %0, m0\n\ts_mov_b32 m0, %2\n\ts_nop 0\n\tglobal_load_lds_dwordx4 %1, off\n\ts_mov_b32 m0, %0":"=&s"(keep):"v"(gsrc),"s"(lds_dst):"memory");}
__device__ __forceinline__ float max3f(float a,float b,float c){float r;asm("v_max3_f32 %0, %1, %2, %3":"=v"(r):"v"(a),"v"(b),"v"(c));return r;}
__device__ __forceinline__ float max2f(float a,float b){float r;asm("v_max_f32_e32 %0, %1, %2":"=v"(r):"v"(a),"v"(b));return r;}
__device__ __forceinline__ float fadd_s(float a,float b){float r;asm("v_add_f32_e32 %0, %1, %2":"=v"(r):"v"(a),"v"(b));return r;}
__device__ __forceinline__ float fsub_s(float a,float b){float r;asm("v_sub_f32_e32 %0, %1, %2":"=v"(r):"v"(a),"v"(b));return r;}
typedef float f32x2_t __attribute__((ext_vector_type(2))); typedef __bf16 bf16x2_t __attribute__((ext_vector_type(2)));
__device__ __forceinline__ unsigned cvtpk_s(float lo,float hi){f32x2_t v={lo,hi};bf16x2_t b=__builtin_convertvector(v,bf16x2_t);return __builtin_bit_cast(unsigned,b);}
#define WAIT_BAR(N) asm volatile("s_waitcnt vmcnt(" #N ") lgkmcnt(0)\n\ts_barrier":::"memory")

__device__ __forceinline__ void qkt(f32x16&p0,f32x16&p1,const char*Kslot,const bf16x8*qr,int r32,int hi){
  const char*kb=Kslot+hi*1024+r32*16;
  #pragma unroll
  for(int d0=0;d0<4;++d0){
    const bf16x8 b0=*reinterpret_cast<const bf16x8*>(kb+d0*2048);
    const bf16x8 b1=*reinterpret_cast<const bf16x8*>(kb+d0*2048+512);
    if(d0==0){p0=__builtin_amdgcn_mfma_f32_32x32x16_bf16(b0,qr[0],p0,0,0,0);p1=__builtin_amdgcn_mfma_f32_32x32x16_bf16(b1,qr[0],p1,0,0,0);}
    else{p0=__builtin_amdgcn_mfma_f32_32x32x16_bf16(b0,qr[d0],p0,0,0,0);p1=__builtin_amdgcn_mfma_f32_32x32x16_bf16(b1,qr[d0],p1,0,0,0);}}
}
typedef __attribute__((address_space(3))) const char* lds_cptr;
typedef short v4i16_t __attribute__((ext_vector_type(4)));
__device__ __forceinline__ void kload8(bf16x8*kf,lds_cptr kp){
  kf[0]=*(const __attribute__((address_space(3))) bf16x8*)(kp);      kf[1]=*(const __attribute__((address_space(3))) bf16x8*)(kp+512);
  kf[2]=*(const __attribute__((address_space(3))) bf16x8*)(kp+2048); kf[3]=*(const __attribute__((address_space(3))) bf16x8*)(kp+2560);
  kf[4]=*(const __attribute__((address_space(3))) bf16x8*)(kp+4096); kf[5]=*(const __attribute__((address_space(3))) bf16x8*)(kp+4608);
  kf[6]=*(const __attribute__((address_space(3))) bf16x8*)(kp+6144); kf[7]=*(const __attribute__((address_space(3))) bf16x8*)(kp+6656);
}
__device__ __forceinline__ void kload2(bf16x8*kf,lds_cptr kp,int j){ kf[2*j]=*(const __attribute__((address_space(3))) bf16x8*)(kp+j*2048); kf[2*j+1]=*(const __attribute__((address_space(3))) bf16x8*)(kp+j*2048+512); }
__device__ __forceinline__ s16x4 vtr(lds_cptr p){ return __builtin_bit_cast(s16x4,__builtin_amdgcn_ds_read_tr16_b64_v4i16((__attribute__((address_space(3))) v4i16_t*)p)); }
__device__ __forceinline__ float rowmax(const f32x16&p0,const f32x16&p1){
  float a=max3f(p0[0],p0[1],p1[0]),b=max3f(p0[2],p0[3],p1[1]);a=max3f(a,p1[2],p1[3]);
  #pragma unroll
  for(int r=4;r<16;r+=4){a=max3f(a,p0[r],p0[r+1]);b=max3f(b,p0[r+2],p0[r+3]);a=max3f(a,p1[r],p1[r+1]);b=max3f(b,p1[r+2],p1[r+3]);}
  const float m=max2f(a,b);
  auto rr=__builtin_amdgcn_permlane32_swap(__float_as_uint(m),__float_as_uint(m),false,false);
  return max2f(__uint_as_float(rr[0]),__uint_as_float(rr[1]));
}
template<int NO> __device__ __forceinline__ void pv(f32x16*o,int vb,bf16x8 pa0,bf16x8 pa1,bf16x8 pa2,bf16x8 pa3){
  #pragma unroll
  for(int d0=0;d0<NO;++d0){s16x4 lo[4],hi[4];
    #pragma unroll
    for(int ks=0;ks<4;++ks){
      asm volatile("ds_read_b64_tr_b16 %0,%1 offset:%c2":"=&v"(lo[ks]):"v"(vb),"i"(d0*4096+ks*1024):"memory");
      asm volatile("ds_read_b64_tr_b16 %0,%1 offset:%c2":"=&v"(hi[ks]):"v"(vb),"i"(d0*4096+ks*1024+512):"memory");}
    asm volatile("s_waitcnt lgkmcnt(0)":::"memory");SBAR();
    #define PK(k) (bf16x8){lo[k][0],lo[k][1],lo[k][2],lo[k][3],hi[k][0],hi[k][1],hi[k][2],hi[k][3]}
    o[d0]=__builtin_amdgcn_mfma_f32_32x32x16_bf16(pa0,PK(0),o[d0],0,0,0);
    o[d0]=__builtin_amdgcn_mfma_f32_32x32x16_bf16(pa1,PK(1),o[d0],0,0,0);
    o[d0]=__builtin_amdgcn_mfma_f32_32x32x16_bf16(pa2,PK(2),o[d0],0,0,0);
    o[d0]=__builtin_amdgcn_mfma_f32_32x32x16_bf16(pa3,PK(3),o[d0],0,0,0);
    #undef PK
  }
}

typedef float f32x4_t __attribute__((ext_vector_type(4)));
__device__ __forceinline__ void bias_fill(f32x16&c0,f32x16&c1,float base,const __attribute__((address_space(3))) float*ck,int hi){
  #pragma unroll
  for(int g=0;g<4;++g){const f32x4_t a=*(const __attribute__((address_space(3))) f32x4_t*)(ck+8*g+4*hi),b=*(const __attribute__((address_space(3))) f32x4_t*)(ck+32+8*g+4*hi);
    #pragma unroll
    for(int e=0;e<4;++e){c0[4*g+e]=base-a[e];c1[4*g+e]=base-b[e];}}
}
typedef __attribute__((address_space(3))) const float* lds_fptr;
__device__ __forceinline__ void ck_load(f32x4_t (&ka)[4],f32x4_t (&kb)[4],lds_fptr ck,int hi){
  #pragma unroll
  for(int g=0;g<4;++g){ka[g]=*(const __attribute__((address_space(3))) f32x4_t*)(ck+8*g+4*hi);kb[g]=*(const __attribute__((address_space(3))) f32x4_t*)(ck+32+8*g+4*hi);}
}
__device__ __forceinline__ void ck_apply(f32x16&c0,f32x16&c1,const f32x4_t (&ka)[4],const f32x4_t (&kb)[4],float add){
  #pragma unroll
  for(int g=0;g<4;++g){
    #pragma unroll
    for(int e=0;e<4;++e){c0[4*g+e]=(c0[4*g+e]-ka[g][e])+add;c1[4*g+e]=(c1[4*g+e]-kb[g][e])+add;}}
}
__device__ __forceinline__ void ck_sub(f32x16&c0,f32x16&c1,const f32x4_t (&ka)[4],const f32x4_t (&kb)[4]){
  #pragma unroll
  for(int g=0;g<4;++g){
    #pragma unroll
    for(int e=0;e<4;++e){c0[4*g+e]-=ka[g][e];c1[4*g+e]-=kb[g][e];}}
}
template<bool BIAS> __device__ __forceinline__ void cfill(f32x16&c0,f32x16&c1,float base,const __attribute__((address_space(3))) float*ck,int hi){
  if(BIAS)bias_fill(c0,c1,base,ck,hi);
  else{
    #pragma unroll
    for(int r=0;r<16;++r){c0[r]=base;c1[r]=base;} }
}
#ifndef ATTN_STORE16
#define ATTN_STORE16(p,v) (*(u32x4*)(p)=(v))
#endif
__device__ __forceinline__ int fox_t0(int qb,const float*cum,float thr,int lane){
  const int q0=qb*QB,NTf=(q0+QB)/KVBLK; const float cq0=cum[q0];
  const int t1=lane,t2=lane+64;
  const bool ok1=(t1>=NTf-4)||(cq0-cum[64*t1+63]>=-thr), ok2=(t2>=NTf-4)||(cq0-cum[(t2<NTf?64*t2+63:q0)]>=-thr);
  const unsigned long long m1=__ballot(ok1),m2=__ballot(ok2);
  int T0=m1?__builtin_ctzll(m1):(m2?64+__builtin_ctzll(m2):NTf-4); T0&=~1; if(T0>NTf-4)T0=NTf-4; return __builtin_amdgcn_readfirstlane(T0);
}
template<int THRL,bool BIAS,int OP,int DV,bool NOREF> __device__ __forceinline__ void attn_unit(int qb,const bf16*Qb,const bf16*__restrict__ Kh0,const bf16*__restrict__ Vh0,bf16*Ob,const float*cum,float thr,char*shm,const int wave0,const int T0in=-1){
  constexpr int NO=DV/32, VM=DV/64; static_assert(DV==64||(DV==128&&!BIAS),"DV"); static_assert(!(NOREF&&BIAS),"NOREF");
  const int tid=fresh_tid(wave0); const int lane=tid&63,r32=lane&31,hi=lane>>5; const int wid=__builtin_amdgcn_readfirstlane(tid>>6);
  const int q0=qb*QB;
  const bf16*Qw=Qb+(long)(q0+wid*QBLK)*DM;
  int T0=0;
  if(BIAS){ T0=T0in>=0?T0in:fox_t0(qb,cum,thr,lane); }
  const bf16*Kh=Kh0+(long)T0*KVBLK*DM; const bf16*Vh=Vh0+(long)T0*KVBLK*DM;
  const unsigned lds0=(unsigned)(uintptr_t)shm;
  float*wsf=(float*)(shm+Lay<DV>::WS)+wid*64;
  const bf16*ksrc=Kh+(long)lane*DM+wid*8;
  const bf16*vsrc=Vh+(long)(16*(wid&3)+(lane>>2))*DM+(wid>>2)*32+(lane&3)*8;
  const unsigned kdst=lds0+LDS_K+wid*1024, vdst=lds0+LDS_V+wid*1024;
  #define DMA_K(t,slot) glds16(ksrc+(long)(t)*KVBLK*DM,(unsigned)__builtin_amdgcn_readfirstlane(kdst+(slot)))
  #define DMA_V(t,slot) do{ glds16(vsrc+(long)(t)*KVBLK*DM,(unsigned)__builtin_amdgcn_readfirstlane(vdst+(slot)*VM)); if(DV==128)glds16(vsrc+64+(long)(t)*KVBLK*DM,(unsigned)__builtin_amdgcn_readfirstlane(vdst+(slot)*VM+8192)); }while(0)
  const int vb0=(int)(lds0+LDS_V)+((lane>>4)&1)*32+(lane&3)*8+(4*hi+((lane&15)>>2))*64;
  const char*Kbase=shm+LDS_K; bf16x8 kf[8];
  const lds_cptr shm3=(lds_cptr)shm; const lds_cptr kp0=shm3+LDS_K+hi*1024+r32*16; const lds_cptr vp0=shm3+LDS_V+((lane>>4)&1)*32+(lane&3)*8+(4*hi+((lane&15)>>2))*64;
  const int NT=(q0+QB)/KVBLK-T0;
  const __attribute__((address_space(3))) float*ckl=(const __attribute__((address_space(3))) float*)(shm3+Lay<DV>::CK); float cq=0.f,cqm=0.f;
  const lds_fptr cl=ckl+NT*64; float fu=1.f;
  DMA_K(0,0);DMA_V(0,0);DMA_K(1,SLOTB);
  bf16x8 qr[4];
  #pragma unroll
  for(int d0=0;d0<4;++d0)qr[d0]=*reinterpret_cast<const bf16x8*>(&Qw[(long)r32*DM+d0*16+hi*8]);
  if(BIAS){ __attribute__((address_space(3))) f32x4_t*cw=(__attribute__((address_space(3))) f32x4_t*)(shm3+Lay<DV>::CK);
    for(int i=tid;i<NT*16;i+=NW*64){ const f32x4_t v=*(const f32x4_t*)(cum+64*T0+4*i); const float last=cum[64*T0+(i>>4)*64+63]; cw[i]=v-last; }
    __attribute__((address_space(3))) float*clw=(__attribute__((address_space(3))) float*)(shm3+Lay<DV>::CK)+NT*64;
    for(int t_=tid;t_<NT;t_+=NW*64)clw[t_]=cum[64*(T0+t_)+63];
    cq=cum[q0+wid*QBLK+r32]; cqm=cq; }
  float mhat=0.f,l_reg=0.f;f32x16 o[NO];
  #pragma unroll
  for(int d_=0;d_<NO;++d_)o[d_]=f32x16{};

  const int qrel=wid*QBLK+r32;
  #define CMASK(P0,P1,t) do{int jb_=(t)-(NT-4); if(jb_>=0)cmask(P0,P1,jb_,qrel,hi);}while(0)
  int resc=0;
  #define START(P0,P1) do{ resc=0; if constexpr(!NOREF&&!BIAS) { const float rm=rowmax(P0,P1); const float dl=rm; mhat=fadd_s(mhat,dl); \
      _Pragma("unroll") for(int r=0;r<16;++r){P0[r]=fsub_s(P0[r],dl);P1[r]=fsub_s(P1[r],dl);} \
      cqm=cq-mhat; } \
    _Pragma("unroll") for(int r=0;r<16;++r)P0[r]=__builtin_amdgcn_exp2f(P0[r]); }while(0)
  #define RESC() do{ if constexpr(!NOREF){ if(BIAS&&resc==1){ _Pragma("unroll") for(int d_=0;d_<NO;++d_) _Pragma("unroll") for(int r=0;r<16;++r)o[d_][r]*=fu; } \
    else if(resc){ asm volatile("s_waitcnt lgkmcnt(0)":::"memory"); \
      _Pragma("unroll") for(int d_=0;d_<NO;++d_) _Pragma("unroll") for(int r=0;r<16;++r)o[d_][r]*=wsf[crow(r,hi)]; } } }while(0)
  f32x16 pA0,pA1,pB0,pB1;
  int sl_prev=0,sl_cur=0,sl_next=SLOTB;
  #define ROT() do{sl_prev=sl_cur;sl_cur=sl_next;sl_next=(sl_next==(NSLOT-1)*SLOTB)?0:sl_next+SLOTB;}while(0)
  DMA_K(2,2*SLOTB);
  if constexpr(DV==128){WAIT_BAR(4);}else{WAIT_BAR(3);}
  if constexpr(NOREF||BIAS){pA0=f32x16{};pA1=f32x16{};}else{cfill<BIAS>(pA0,pA1,cqm,ckl,hi);}
  qkt(pA0,pA1,Kbase,qr,r32,hi);asm volatile("s_nop 15\n\ts_nop 7":"+v"(pA0),"+v"(pA1));
  if constexpr(BIAS){ f32x4_t ka_[4],kb_[4]; ck_load(ka_,kb_,ckl,hi); ck_apply(pA0,pA1,ka_,kb_,NT==4?cq-cl[0]:0.f); }
  CMASK(pA0,pA1,0);
  START(pA0,pA1);
  _Pragma("unroll") for(int r=0;r<16;++r)pA1[r]=__builtin_amdgcn_exp2f(pA1[r]);
  WAIT_BAR(0);
  DMA_K(3,0);DMA_V(1,SLOTB);
  ROT();
  kload8(kf,kp0+sl_cur);
  if constexpr(DV==128){WAIT_BAR(3);}else{WAIT_BAR(2);}
  s16x4 vlo[8],vhi[8]; u32x4 pw0,pw1,pw2,pw3;
  #define PKW(P,B) cvtpk_s(P[B],P[B+1])
  #define PAF(k) __builtin_bit_cast(bf16x8,pw##k)
  #define VFR(i) (bf16x8){vlo[i][0],vlo[i][1],vlo[i][2],vlo[i][3],vhi[i][0],vhi[i][1],vhi[i][2],vhi[i][3]}
  #define PIN(x) asm volatile("":"+v"(x))
  #define MX3(a,b,c) __builtin_fmaxf(__builtin_fmaxf((a),(b)),(c))
  #define GAPA(MF,A0,A1,A2,A3,W0,W1,PW) do{ MF; sacc+=A0; sacc+=A1; sacc+=A2; sacc+=A3; PIN(sacc); W0; W1; PIN(PW); SBAR(); }while(0)
  #define EX(v) __builtin_amdgcn_exp2f(v)
  #define GAPB(MF,X,B) do{ MF; X[B]=EX(X[B]); X[B+1]=EX(X[B+1]); X[B+2]=EX(X[B+2]); X[B+3]=EX(X[B+3]); PIN(X); SBAR(); }while(0)
  #define GAPC(MF,X,B,RL) do{ MF; X[B]=EX(X[B]); X[B+1]=EX(X[B+1]); PIN(X); RL; SBAR(); }while(0)
  #define VRD2(i) do{ vlo[i]=vtr(vp_+((((i)>>2)+2)*4096+((i)&3)*1024)); vhi[i]=vtr(vp_+((((i)>>2)+2)*4096+((i)&3)*1024+512)); }while(0)
  #define VRD(i) do{ vlo[i]=vtr(vp_+(((i)>>2)*4096+((i)&3)*1024)); vhi[i]=vtr(vp_+(((i)>>2)*4096+((i)&3)*1024+512)); }while(0)
  #define KRD(G,j) do{ if(G){ kload2(kf,kp0+sl_next,j); SBAR(); } }while(0)
  #define CIN(X) (X)
  #define STEP(C0,C1,P0,P1,t,GK,GV,GL,BND) do{ SBAR(); \
    const lds_cptr vp_=vp0+sl_prev*VM; \
    f32x4_t ka_[4],kb_[4]; \
    if constexpr(NOREF||BIAS){C0=f32x16{};C1=f32x16{};}else{cfill<BIAS>(C0,C1,cqm,ckl+64*(t),hi);} SBAR(); \
    VRD(0); SBAR(); float sacc=(P0[0]+P0[1]); \
    GAPA(C0=__builtin_amdgcn_mfma_f32_32x32x16_bf16(kf[0],qr[0],CIN(C0),0,0,0), P0[2],P0[3],P0[4],P0[5],     pw0[0]=PKW(P0,0), pw0[1]=PKW(P0,2), pw0); \
    VRD(4); SBAR(); GAPA(C1=__builtin_amdgcn_mfma_f32_32x32x16_bf16(kf[1],qr[0],CIN(C1),0,0,0), P0[6],P0[7],P0[8],P0[9],     pw0[2]=PKW(P0,4), pw0[3]=PKW(P0,6), pw0); \
    VRD(1); SBAR(); GAPA(C0=__builtin_amdgcn_mfma_f32_32x32x16_bf16(kf[2],qr[1],C0,0,0,0),   P0[10],P0[11],P0[12],P0[13], pw1[0]=PKW(P0,8), pw1[1]=PKW(P0,10), pw1); \
    VRD(5); SBAR(); GAPA(C1=__builtin_amdgcn_mfma_f32_32x32x16_bf16(kf[3],qr[1],C1,0,0,0),   P0[14],P0[15],P1[0],P1[1],   pw1[2]=PKW(P0,12),pw1[3]=PKW(P0,14), pw1); \
    VRD(2); SBAR(); GAPA(C0=__builtin_amdgcn_mfma_f32_32x32x16_bf16(kf[4],qr[2],C0,0,0,0),   P1[2],P1[3],P1[4],P1[5],     pw2[0]=PKW(P1,0), pw2[1]=PKW(P1,2), pw2); \
    if constexpr(BIAS){ck_load(ka_,kb_,ckl+64*(t),hi); SBAR();} \
    VRD(6); SBAR(); GAPA(C1=__builtin_amdgcn_mfma_f32_32x32x16_bf16(kf[5],qr[2],C1,0,0,0),   P1[6],P1[7],P1[8],P1[9],     pw2[2]=PKW(P1,4), pw2[3]=PKW(P1,6), pw2); \
    VRD(3); SBAR(); GAPA(C0=__builtin_amdgcn_mfma_f32_32x32x16_bf16(kf[6],qr[3],C0,0,0,0),   P1[10],P1[11],P1[12],P1[13], pw3[0]=PKW(P1,8), pw3[1]=PKW(P1,10), pw3); \
    VRD(7); SBAR(); GAPA(C1=__builtin_amdgcn_mfma_f32_32x32x16_bf16(kf[7],qr[3],C1,0,0,0),   P1[14],P1[15],0.f,0.f,       pw3[2]=PKW(P1,12),pw3[3]=PKW(P1,14), pw3); \
    l_reg+=sacc; \
    if(GK){DMA_K((t)+3,sl_cur);} if(GV){DMA_V((t)+1,sl_next);} \
    if constexpr(BIAS){ const bool bnd_=(BND)&&((t)>=NT-4); if constexpr((BND)==0){ck_sub(C0,C1,ka_,kb_);}else{ck_apply(C0,C1,ka_,kb_,bnd_?cq-cl[(t)]:0.f);} \
      if(!bnd_){ fu=__builtin_amdgcn_exp2f(cl[(t)]-cl[(t)-1]); l_reg*=fu; resc=1; } \
      else if((t)==NT-4){ const float f_=__builtin_amdgcn_exp2f(cq-cl[(t)-1]); l_reg*=f_; if(hi==0)wsf[r32]=f_; resc=2; } \
      else resc=0; } \
    CMASK(C0,C1,t); \
    if constexpr(!NOREF&&!BIAS){ float a=MX3(C0[0],C0[1],C1[0]),b=MX3(C0[2],C0[3],C1[1]); a=MX3(a,C1[2],C1[3]); \
      _Pragma("unroll") for(int r=4;r<16;r+=4){a=MX3(a,C0[r],C0[r+1]);b=MX3(b,C0[r+2],C0[r+3]);a=MX3(a,C1[r],C1[r+1]);b=MX3(b,C1[r+2],C1[r+3]);} \
      float rm=__builtin_fmaxf(a,b); { auto rr=__builtin_amdgcn_permlane32_swap(__float_as_uint(rm),__float_as_uint(rm),false,false); rm=__builtin_fmaxf(__uint_as_float(rr[0]),__uint_as_float(rr[1])); } \
      resc=0; \
      if(__builtin_expect(__any(rm>(float)THRL),0)){ const float dl=__builtin_fmaxf(rm,0.f); mhat+=dl; \
        _Pragma("unroll") for(int r=0;r<16;++r){C0[r]-=dl;C1[r]-=dl;} \
        cqm=cq-mhat; \
        const float f=__builtin_amdgcn_exp2f(-dl); l_reg*=f; if(hi==0)wsf[r32]=f; resc=2; } } \
    SBAR(); \
    if constexpr(DV==64){ \
    GAPB(o[0]=__builtin_amdgcn_mfma_f32_32x32x16_bf16(PAF(0),VFR(0),o[0],0,0,0), C0,0); \
    GAPB(o[1]=__builtin_amdgcn_mfma_f32_32x32x16_bf16(PAF(0),VFR(4),o[1],0,0,0), C0,4); \
    KRD(GL,0); GAPB(o[0]=__builtin_amdgcn_mfma_f32_32x32x16_bf16(PAF(1),VFR(1),o[0],0,0,0), C0,8); \
    KRD(GL,1); GAPB(o[1]=__builtin_amdgcn_mfma_f32_32x32x16_bf16(PAF(1),VFR(5),o[1],0,0,0), C0,12); \
    KRD(GL,2); GAPB(o[0]=__builtin_amdgcn_mfma_f32_32x32x16_bf16(PAF(2),VFR(2),o[0],0,0,0), C1,0); \
    KRD(GL,3); GAPB(o[1]=__builtin_amdgcn_mfma_f32_32x32x16_bf16(PAF(2),VFR(6),o[1],0,0,0), C1,4); \
    GAPB(o[0]=__builtin_amdgcn_mfma_f32_32x32x16_bf16(PAF(3),VFR(3),o[0],0,0,0), C1,8); \
    GAPB(o[1]=__builtin_amdgcn_mfma_f32_32x32x16_bf16(PAF(3),VFR(7),o[1],0,0,0), C1,12); \
    } else { \
    GAPC(o[0]=__builtin_amdgcn_mfma_f32_32x32x16_bf16(PAF(0),VFR(0),o[0],0,0,0), C0,0, VRD2(0)); \
    GAPC(o[1]=__builtin_amdgcn_mfma_f32_32x32x16_bf16(PAF(0),VFR(4),o[1],0,0,0), C0,2, VRD2(4)); \
    GAPC(o[0]=__builtin_amdgcn_mfma_f32_32x32x16_bf16(PAF(1),VFR(1),o[0],0,0,0), C0,4, VRD2(1)); \
    GAPC(o[1]=__builtin_amdgcn_mfma_f32_32x32x16_bf16(PAF(1),VFR(5),o[1],0,0,0), C0,6, VRD2(5)); \
    GAPC(o[0]=__builtin_amdgcn_mfma_f32_32x32x16_bf16(PAF(2),VFR(2),o[0],0,0,0), C0,8, VRD2(2)); \
    GAPC(o[1]=__builtin_amdgcn_mfma_f32_32x32x16_bf16(PAF(2),VFR(6),o[1],0,0,0), C0,10, VRD2(6)); \
    GAPC(o[0]=__builtin_amdgcn_mfma_f32_32x32x16_bf16(PAF(3),VFR(3),o[0],0,0,0), C0,12, VRD2(3)); \
    GAPC(o[1]=__builtin_amdgcn_mfma_f32_32x32x16_bf16(PAF(3),VFR(7),o[1],0,0,0), C0,14, VRD2(7)); \
    GAPC(o[2]=__builtin_amdgcn_mfma_f32_32x32x16_bf16(PAF(0),VFR(0),o[2],0,0,0), C1,0, (void)0); \
    KRD(GL,0); GAPC(o[3]=__builtin_amdgcn_mfma_f32_32x32x16_bf16(PAF(0),VFR(4),o[3],0,0,0), C1,2, (void)0); \
    KRD(GL,1); GAPC(o[2]=__builtin_amdgcn_mfma_f32_32x32x16_bf16(PAF(1),VFR(1),o[2],0,0,0), C1,4, (void)0); \
    KRD(GL,2); GAPC(o[3]=__builtin_amdgcn_mfma_f32_32x32x16_bf16(PAF(1),VFR(5),o[3],0,0,0), C1,6, (void)0); \
    KRD(GL,3); GAPC(o[2]=__builtin_amdgcn_mfma_f32_32x32x16_bf16(PAF(2),VFR(2),o[2],0,0,0), C1,8, (void)0); \
    GAPC(o[3]=__builtin_amdgcn_mfma_f32_32x32x16_bf16(PAF(2),VFR(6),o[3],0,0,0), C1,10, (void)0); \
    GAPC(o[2]=__builtin_amdgcn_mfma_f32_32x32x16_bf16(PAF(3),VFR(3),o[2],0,0,0), C1,12, (void)0); \
    GAPC(o[3]=__builtin_amdgcn_mfma_f32_32x32x16_bf16(PAF(3),VFR(7),o[3],0,0,0), C1,14, (void)0); \
    } \
    }while(0)
  #define WB_FULL() do{ if constexpr(DV==128){WAIT_BAR(3);}else{WAIT_BAR(2);} }while(0)
  int t=1;
  #undef CMASK
  #define CMASK(P0,P1,t) do{}while(0)
  for(;t+5<NT;t+=2){
    STEP(pB0,pB1,pA0,pA1,t,true,true,true,0);     WB_FULL(); RESC(); ROT();
    STEP(pA0,pA1,pB0,pB1,t+1,true,true,true,0);   WB_FULL(); RESC(); ROT();
  }
  #undef CMASK
  #define CMASK(P0,P1,t) do{int jb_=(t)-(NT-4); if(jb_>=0)cmask(P0,P1,jb_,qrel,hi);}while(0)
  #define ENDW(tt) do{ if((tt)+3<NT){WB_FULL();} else if((tt)+2<NT){ if constexpr(DV==128){WAIT_BAR(2);}else{WAIT_BAR(1);} } else {WAIT_BAR(0);} }while(0)
  for(;t+1<NT;t+=2){
    STEP(pB0,pB1,pA0,pA1,t,(t+3<NT),(t+1<NT),(t+1<NT),1);       ENDW(t);   RESC(); ROT();
    STEP(pA0,pA1,pB0,pB1,t+1,(t+4<NT),(t+2<NT),(t+2<NT),1);     ENDW(t+1); RESC(); ROT();
  }
  STEP(pB0,pB1,pA0,pA1,NT-1,false,false,false,1); RESC();
  { float sacc=pB0[0]+pB0[1]; _Pragma("unroll") for(int r=2;r<16;++r)sacc+=pB0[r]; _Pragma("unroll") for(int r=0;r<16;++r)sacc+=pB1[r]; l_reg+=sacc;
    pw0=(u32x4){PKW(pB0,0),PKW(pB0,2),PKW(pB0,4),PKW(pB0,6)};pw1=(u32x4){PKW(pB0,8),PKW(pB0,10),PKW(pB0,12),PKW(pB0,14)};pw2=(u32x4){PKW(pB1,0),PKW(pB1,2),PKW(pB1,4),PKW(pB1,6)};pw3=(u32x4){PKW(pB1,8),PKW(pB1,10),PKW(pB1,12),PKW(pB1,14)};
    SBAR(); pv<NO>(o,vb0+sl_cur*VM,PAF(0),PAF(1),PAF(2),PAF(3)); }
  #undef PKW
  #undef PAF
  #undef VFR
  #undef PIN
  #undef MX3
  #undef GAPA
  #undef GAPB
  #undef EX
  #undef VRD
  #undef VRD2
  #undef GAPC
  #undef KRD
  #undef STEP
  #undef CIN
  #undef ENDW
  #undef WB_FULL
  {auto rr=__builtin_amdgcn_permlane32_swap(__float_as_uint(l_reg),__float_as_uint(l_reg),false,false);l_reg=__uint_as_float(rr[0])+__uint_as_float(rr[1]);}
  if(hi==0)wsf[32+r32]=l_reg;asm volatile("s_waitcnt lgkmcnt(0)":::"memory");
  float rli[16];
  #pragma unroll
  for(int r=0;r<16;++r)rli[r]=__builtin_amdgcn_rcpf(wsf[32+crow(r,hi)]);
  bf16*Ow=Ob+(long)(q0+wid*QBLK)*OP;
  { bf16*stg=(bf16*)(shm+Lay<DV>::OST)+wid*2048;
    #pragma unroll
    for(int ps=0;ps<NO/2;++ps){
    #pragma unroll
    for(int r=0;r<16;++r){const int orow=crow(r,hi);
      #pragma unroll
      for(int d0=0;d0<2;++d0)stg[orow*64+d0*32+r32]=__float2bfloat16(o[2*ps+d0][r]*rli[r]);}
    asm volatile("s_waitcnt lgkmcnt(0)":::"memory");
    #pragma unroll
    for(int i=0;i<4;++i){const int row=i*8+(lane>>3),ch=lane&7; const u32x4 v=*(const u32x4*)(stg+row*64+ch*8); ATTN_STORE16(Ow+(long)row*OP+ps*64+ch*8,v);}
    asm volatile("s_waitcnt lgkmcnt(0)":::"memory"); } }
  asm volatile("s_waitcnt lgkmcnt(0)\n\ts_barrier":::"memory");
  #undef DMA_K
  #undef DMA_V
  #undef CMASK
  #undef START
  #undef RESC
  #undef ROT
}
constexpr int ATTN_LDS_BYTES=Lay<64>::BYTES>Lay<128>::BYTES?Lay<64>::BYTES:Lay<128>::BYTES;
#undef SBAR
#undef WAIT_BAR
}
__device__ __forceinline__ void diffc_item(Frame& F, int l, int b, int h, int qb) {
    const int lane = fresh_lane(); int w = F.wave0; asm volatile("" : "+s"(w));
    const float* lq1 = (const float*)F.in[I_LQ1] + l * 64; const float* lk1 = (const float*)F.in[I_LK1] + l * 64;
    const float* lq2 = (const float*)F.in[I_LQ2] + l * 64; const float* lk2 = (const float*)F.in[I_LK2] + l * 64;
    int ll = l; asm volatile("" : "+s"(ll));
    const float li = lambda_init_of(ll); const float oml = ll == 0 ? 1.0f - lambda_init_of(0) : 1.0f - lambda_init_of(1);
    const float lamv = __builtin_amdgcn_exp2f(LOG2E * wave_sum(lq1[lane] * lk1[lane], lane)) - __builtin_amdgcn_exp2f(LOG2E * wave_sum(lq2[lane] * lk2[lane], lane)) + li;
    const float lam = __builtin_bit_cast(float, __builtin_amdgcn_readfirstlane(__builtin_bit_cast(int, lamv)));
    const float* sub = (const float*)F.in[I_SUBLN] + l * 128;
    const bf16* OA = (const bf16*)(F.ws + WS_OA); bf16* AD = (bf16*)(F.ws + WS_AD);
    const int d0 = (lane & 15) * 8;
    float sg[8];
#pragma unroll
    for (int e = 0; e < 8; ++e) sg[e] = sub[d0 + e] * oml;
    const size_t row0 = (size_t)b * SEQ + (size_t)qb * 256 + w * 32 + (lane >> 4);
    v4u a_[8], b_[8];
#pragma unroll
    for (int q = 0; q < 8; ++q) { const bf16* src = OA + (row0 + q * 4) * 1024 + h * 128 + d0;
        asm volatile("global_load_dwordx4 %0, %2, off sc1\n\tglobal_load_dwordx4 %1, %2, off offset:1024 sc1" : "=&v"(a_[q]), "=&v"(b_[q]) : "v"(src) : "memory"); }
    asm volatile("s_waitcnt vmcnt(0)" : "+v"(a_[0]), "+v"(a_[1]), "+v"(a_[2]), "+v"(a_[3]), "+v"(a_[4]), "+v"(a_[5]), "+v"(a_[6]), "+v"(a_[7]), "+v"(b_[0]), "+v"(b_[1]), "+v"(b_[2]), "+v"(b_[3]), "+v"(b_[4]), "+v"(b_[5]), "+v"(b_[6]), "+v"(b_[7]) :: "memory");
#pragma unroll
    for (int q = 0; q < 8; ++q) { const v4u a = a_[q], bb = b_[q];
        typedef float f32x2_ __attribute__((ext_vector_type(2)));
        f32x2_ vv[4]; float ss = 0.f;
#pragma unroll
        for (int k = 0; k < 4; ++k) { const f32x2_ av = {bflo(a[k]), bfhi(a[k])}, bv = {bflo(bb[k]), bfhi(bb[k])}; vv[k] = av - lam * bv; ss += vv[k].x * vv[k].x + vv[k].y * vv[k].y; }
        ss += shx(ss, 1, lane); ss += shx(ss, 2, lane); ss += shx(ss, 4, lane); ss += shx(ss, 8, lane);
        const float r = __builtin_amdgcn_rsqf(ss * (1.0f / 128.0f) + EPS);
        v4u o;
#pragma unroll
        for (int k = 0; k < 4; ++k) o[k] = pk2(vv[k].x * r * sg[2 * k], vv[k].y * r * sg[2 * k + 1]);
        *(v4u*)(AD + (row0 + q * 4) * 512 + h * 128 + d0) = o; }
}
#define DIFF_HANDOFF(qb_) do { VM_WAIT(); __syncthreads(); volatile LAS unsigned* qw_ = F.MISC + 16; \
        if (fresh_tid(F.wave0) == 0) { __builtin_amdgcn_fence(__ATOMIC_RELEASE, "agent"); asm volatile("s_waitcnt vmcnt(0)" ::: "memory"); \
            qw_[0] = __hip_atomic_fetch_add(F.ctl + CW_DCNT + ((((l * BATCH + b) * 4 + (m & 3)) * 32 + (qb_)) * DCNT_STRIDE), 1u, __ATOMIC_RELAXED, __HIP_MEMORY_SCOPE_AGENT); } \
        __syncthreads(); const unsigned old_ = qw_[0]; __syncthreads(); \
        if (old_ == 1u) diffc_item(F, l, b, m & 3, (qb_)); } while (0)
template <int AVAR = 0> __device__ __forceinline__ void phase_attn(Frame& F, int l) {
    const attn_body::bf16* QKVG = (const attn_body::bf16*)(F.ws + WS_QKVG);
    attn_body::bf16* OA = (attn_body::bf16*)(F.ws + WS_OA); attn_body::bf16* OFp = (attn_body::bf16*)(F.ws + WS_OF);
    const float* CUM = (const float*)(F.ws + WS_CUM);
    char* shm = (char*)(F.lds + RING_OFF);
    bool noref;
    { const int ln = fresh_lane();
      const float* gtd = (const float*)(F.ws + WS_GT) + l * 256; float gq = fabsf(gtd[ln]), gk = fabsf(gtd[64 + ln]);
#pragma unroll
      for (int o = 1; o < 64; o <<= 1) { gq = fmaxf(gq, shx(gq, o, ln)); gk = fmaxf(gk, shx(gk, o, ln)); }
      noref = __builtin_amdgcn_readfirstlane((int)(1.02f * 64.0f * gq * gk < 100.0f)) != 0; }
    if (AVAR & 1) {} else if (noref) {
        for (int p = F.vcu; p < 256; p += F.G) {
            const int he = p >> 4, x = p & 15, b = he >> 3, m = he & 7;
            const attn_body::bf16* base = QKVG + (size_t)b * SEQ * NP;
#pragma unroll 1
            for (int s2 = 0; s2 < 2; ++s2) {
                attn_body::attn_unit<8, false, 1024, 128, true>(s2 == 0 ? 31 - x : x, base + C_QA + m * 64, base + C_KA + m * 64, base + C_VA + (m & 3) * 128, OA + (size_t)b * SEQ * 1024 + m * 128, nullptr, 0.f, shm, F.wave0);
                DIFF_HANDOFF(s2 == 0 ? 31 - x : x);
            }
        }
    } else {
        for (int p = F.vcu; p < 256; p += F.G) {
            const int he = p >> 4, x = p & 15, b = he >> 3, m = he & 7;
            const attn_body::bf16* base = QKVG + (size_t)b * SEQ * NP;
#pragma unroll 1
            for (int s2 = 0; s2 < 2; ++s2) {
                attn_body::attn_unit<8, false, 1024, 128, false>(s2 == 0 ? 31 - x : x, base + C_QA + m * 64, base + C_KA + m * 64, base + C_VA + (m & 3) * 128, OA + (size_t)b * SEQ * 1024 + m * 128, nullptr, 0.f, shm, F.wave0);
                DIFF_HANDOFF(s2 == 0 ? 31 - x : x);
            }
        }
    }
    float thr2;
    { const int ln = fresh_lane();
      const float* gtf = (const float*)(F.ws + WS_GT) + l * 256 + 128; float gq = fabsf(gtf[ln]), gk = fabsf(gtf[64 + ln]);
#pragma unroll
      for (int o = 1; o < 64; o <<= 1) { gq = fmaxf(gq, shx(gq, o, ln)); gk = fmaxf(gk, shx(gk, o, ln)); }
      thr2 = __builtin_bit_cast(float, __builtin_amdgcn_readfirstlane(__builtin_bit_cast(int, 150.0f + 2.0f * 1.02f * 64.0f * gq * gk + 8.0f))); }
    if (!(AVAR & 2)) {
        unsigned* qctr = F.ctl + CW_FOXQ + 16 * l; volatile LAS unsigned* qw = F.MISC + 16;
        for (;;) {
            if (fresh_tid(F.wave0) == 0) qw[0] = __hip_atomic_fetch_add(qctr, 1u, __ATOMIC_RELAXED, __HIP_MEMORY_SCOPE_AGENT);
            __syncthreads();
            const int u = (int)qw[0];
            __syncthreads();
            if (u >= 512) break;
            const int qb = 31 - (u >> 4), hf = u & 15, b = hf >> 3, h = hf & 7;
            const attn_body::bf16* base = QKVG + (size_t)b * SEQ * NP;
            attn_body::attn_unit<8, true, 512, 64, false>(qb, base + C_QF + h * 64, base + C_KF + h * 64, base + C_VF + h * 64, OFp + (size_t)b * SEQ * 512 + h * 64, CUM + ((size_t)b * 8 + h) * SEQ, (AVAR & 4) ? 1e30f : thr2, shm, F.wave0, -1);
        }
    }
}
#if BUILD_ORACLE
namespace orc {
__device__ __forceinline__ void tile_mm(const bf16* A, int lda, const int* arow  , const bf16* B, int ldb, int brow0, int K, float (*sA)[68], float (*sB)[68], float (&acc)[4][4]) {
    const int tid = threadIdx.x, ty = tid >> 4, tx = tid & 15, lr = tid >> 2, lc = (tid & 3) * 8;
    for (int k0 = 0; k0 < K; k0 += 32) {
        __syncthreads();
        { const int ar = arow[lr]; v4u a = (v4u){0u, 0u, 0u, 0u}; if (ar >= 0) a = *(const v4u*)(A + (size_t)ar * lda + k0 + lc);
          const v4u b = *(const v4u*)(B + (size_t)(brow0 + lr) * ldb + k0 + lc);
          sA[lc + 0][lr] = bflo(a.x); sA[lc + 1][lr] = bfhi(a.x); sA[lc + 2][lr] = bflo(a.y); sA[lc + 3][lr] = bfhi(a.y); sA[lc + 4][lr] = bflo(a.z); sA[lc + 5][lr] = bfhi(a.z); sA[lc + 6][lr] = bflo(a.w); sA[lc + 7][lr] = bfhi(a.w);
          sB[lc + 0][lr] = bflo(b.x); sB[lc + 1][lr] = bfhi(b.x); sB[lc + 2][lr] = bflo(b.y); sB[lc + 3][lr] = bfhi(b.y); sB[lc + 4][lr] = bflo(b.z); sB[lc + 5][lr] = bfhi(b.z); sB[lc + 6][lr] = bflo(b.w); sB[lc + 7][lr] = bfhi(b.w); }
        __syncthreads();
#pragma unroll 8
        for (int kk = 0; kk < 32; ++kk) { const f32x4 a = *(const f32x4*)&sA[kk][ty * 4], b = *(const f32x4*)&sB[kk][tx * 4];
#pragma unroll
            for (int i = 0; i < 4; ++i)
#pragma unroll
                for (int j = 0; j < 4; ++j) acc[i][j] += a[i] * b[j]; }
    }
}
__device__ __forceinline__ void put_tile(float (*Ct)[65], const float (&acc)[4][4]) {
    const int tid = threadIdx.x, ty = tid >> 4, tx = tid & 15;
#pragma unroll
    for (int i = 0; i < 4; ++i)
#pragma unroll
        for (int j = 0; j < 4; ++j) Ct[ty * 4 + i][tx * 4 + j] = acc[i][j];
}
#define ORC_SHARED __shared__ float sA[32][68]; __shared__ float sB[32][68]; __shared__ float Ct[64][65]; __shared__ int arow[64];
#define ZACC(a) _Pragma("unroll") for (int i_ = 0; i_ < 4; ++i_) _Pragma("unroll") for (int j_ = 0; j_ < 4; ++j_) a[i_][j_] = 0.f

__global__ void __launch_bounds__(256) inproj(Args a, int l) {
    ORC_SHARED
    const int n0 = blockIdx.x * 64, m0 = blockIdx.y * 64, tid = threadIdx.x;
    const bf16* HN = (const bf16*)(a.ws + WS_HN); const bf16* W = (const bf16*)(a.ws + WS_WIN) + (size_t)l * NP * D; bf16* QKVG = (bf16*)(a.ws + WS_QKVG);
    if (tid < 64) arow[tid] = m0 + tid;
    float acc[4][4]; ZACC(acc);
    tile_mm(HN, D, arow, W, D, n0, D, sA, sB, acc);
    put_tile(Ct, acc); __syncthreads();
    if (tid < 64) {
        const int row = m0 + tid, seg = n0 / 512; float v[64];
#pragma unroll
        for (int s = 0; s < 64; ++s) v[s] = Ct[tid][s];
        if (seg == 0 || seg == 1 || seg == 3 || seg == 4) {
            float ss = 0.f;
#pragma unroll
            for (int s = 0; s < 64; ++s) ss += v[s] * v[s];
            const float rs = 1.0f / sqrtf(ss * (1.0f / 64.0f) + EPS);
            const float* g = (const float*)a.in[seg == 0 ? I_QND : seg == 1 ? I_KND : seg == 3 ? I_QNF : I_KNF] + l * 64;
            const bool diff = seg < 2;
#pragma unroll
            for (int s = 0; s < 64; ++s) { const int d = (diff && s < 32) ? pi32(s) : s; v[s] = v[s] * rs * g[d]; }
            if (diff) { const float* cs = (const float*)(a.ws + WS_COSSIN) + (size_t)row * 16;
#pragma unroll
                for (int i = 0; i < 8; ++i) { const int s1 = pi32(i), s2 = pi32(i + 8); const float t1 = v[s1], t2 = v[s2], c = cs[i], sn = cs[8 + i]; v[s1] = t1 * c - t2 * sn; v[s2] = t2 * c + t1 * sn; } }
            if (seg == 0 || seg == 3) {
#pragma unroll
                for (int s = 0; s < 64; ++s) v[s] *= C2; }
        } else if (seg >= 6) {
#pragma unroll
            for (int s = 0; s < 64; ++s) v[s] = 1.0f / (1.0f + expf(-v[s]));
        }
#pragma unroll
        for (int s = 0; s < 64; s += 2) *(unsigned*)(QKVG + (size_t)row * NP + n0 + s) = pk2(v[s], v[s + 1]);
    }
}
struct AttnP { const bf16* Q; const bf16* K; const bf16* V; bf16* O; int qc, kc, vc, oc, opitch; int bias; };
__global__ void __launch_bounds__(256) attn(Args a, int mode  ) {
    __shared__ float sK[64][64]; __shared__ float sV[64][64]; __shared__ float sC[64];
    const int qb = blockIdx.x, he = blockIdx.y, tid = threadIdx.x;
    const bf16* QKVG = (const bf16*)(a.ws + WS_QKVG);
    int b, qc, kc, vc, oc, opitch; bf16* O; const float* cum = nullptr;
    if (mode == 0) { b = he / 16; const int r = he % 16, m = r >> 1, vh = r & 1; qc = C_QA + m * 64; kc = C_KA + m * 64; vc = C_VA + (m & 3) * 128 + vh * 64; O = (bf16*)(a.ws + WS_OA); oc = m * 128 + vh * 64; opitch = 1024; }
    else { b = he / 8; const int h = he % 8; qc = C_QF + h * 64; kc = C_KF + h * 64; vc = C_VF + h * 64; O = (bf16*)(a.ws + WS_OF); oc = h * 64; opitch = 512; cum = (const float*)(a.ws + WS_CUM) + ((size_t)b * 8 + h) * SEQ; }
    const int q0 = qb * 256, qi = q0 + tid; const size_t rowg = (size_t)b * SEQ + qi;
    float q[64], o[64];
#pragma unroll
    for (int d = 0; d < 64; ++d) { q[d] = bf2f(QKVG[rowg * NP + qc + d]); o[d] = 0.f; }
    const float cq = cum ? cum[qi] : 0.f;
    float m = -INFINITY, lsum = 0.f;
    const int nkt = (q0 + 256) / 64;
    for (int kt = 0; kt < nkt; ++kt) {
        __syncthreads();
        { const int r = tid >> 2, c0 = (tid & 3) * 16; const size_t kr = (size_t)b * SEQ + kt * 64 + r;
#pragma unroll
          for (int c = 0; c < 16; ++c) { sK[r][c0 + c] = bf2f(QKVG[kr * NP + kc + c0 + c]); sV[r][c0 + c] = bf2f(QKVG[kr * NP + vc + c0 + c]); }
          if (tid < 64) sC[tid] = cum ? cum[kt * 64 + tid] : 0.f; }
        __syncthreads();
        for (int j = 0; j < 64; ++j) {
            const int key = kt * 64 + j;
            if (key <= qi) {
                float s = 0.f;
#pragma unroll
                for (int d = 0; d < 64; ++d) s += q[d] * sK[j][d];
                s += cq - sC[j];
                if (s > m) { const float corr = exp2f(m - s); lsum *= corr;
#pragma unroll
                    for (int d = 0; d < 64; ++d) o[d] *= corr;
                    m = s; }
                const float p = exp2f(s - m); lsum += p;
#pragma unroll
                for (int d = 0; d < 64; ++d) o[d] += p * sV[j][d];
            }
        }
    }
    const float inv = 1.0f / lsum;
#pragma unroll
    for (int d = 0; d < 64; d += 2) *(unsigned*)(O + rowg * opitch + oc + d) = pk2(o[d] * inv, o[d + 1] * inv);
}
__global__ void __launch_bounds__(256) yz(Args a, int l) {
    ORC_SHARED
    __shared__ float Ct2[64][65];
    const int n0 = blockIdx.x * 64, m0 = blockIdx.y * 64, tid = threadIdx.x;
    if (tid < 64) arow[tid] = m0 + tid;
    float acc[4][4], acc2[4][4]; ZACC(acc); ZACC(acc2);
    tile_mm((const bf16*)(a.ws + WS_AD), 512, arow, (const bf16*)(a.ws + WS_WD) + (size_t)l * D * 512, 512, n0, 512, sA, sB, acc);
    tile_mm((const bf16*)(a.ws + WS_OF), 512, arow, (const bf16*)(a.ws + WS_WF) + (size_t)l * D * 512, 512, n0, 512, sA, sB, acc2);
    put_tile(Ct, acc); put_tile(Ct2, acc2); __syncthreads();
    const bf16* QKVG = (const bf16*)(a.ws + WS_QKVG); bf16* Z = (bf16*)(a.ws + WS_Z);
    if (tid < 64) { const int row = m0 + tid;
        for (int s = 0; s < 64; ++s) { const float ga = bf2f(QKVG[(size_t)row * NP + C_GA + n0 + s]), gf = bf2f(QKVG[(size_t)row * NP + C_GF + n0 + s]);
            Z[(size_t)row * D + n0 + s] = (bf16)f2bf(ga * Ct[tid][s] + gf * Ct2[tid][s]); } }
}
__global__ void __launch_bounds__(256) wo(Args a, int l) {
    ORC_SHARED
    const int n0 = blockIdx.x * 64, m0 = blockIdx.y * 64, tid = threadIdx.x;
    if (tid < 64) arow[tid] = m0 + tid;
    float acc[4][4]; ZACC(acc);
    tile_mm((const bf16*)(a.ws + WS_Z), D, arow, (const bf16*)(a.ws + WS_WO) + (size_t)l * D * D, D, n0, D, sA, sB, acc);
    put_tile(Ct, acc); __syncthreads();
    if (tid < 64) { const int row = m0 + tid; for (int s = 0; s < 64; ++s) a.out[(size_t)row * D + n0 + s] += Ct[tid][s]; }
}
__device__ __forceinline__ int find_expert(const unsigned* cnt, int t256, int& tile_in_e, int& cnt_e) {
    int off = 0;
    for (int e = 0; e < NEXP; ++e) { const int c = (int)cnt[e * CNT_STRIDE], nt = (c + 255) >> 8; if (t256 < off + nt) { tile_in_e = t256 - off; cnt_e = c; return e; } off += nt; }
    return -1;
}
__global__ void __launch_bounds__(256) gateup(Args a, int l) {
    ORC_SHARED
    __shared__ float Ct2[64][65]; __shared__ int asg[64];
    const int f0 = blockIdx.x * 64, m64 = blockIdx.y, tid = threadIdx.x;
    const unsigned* cnt = (const unsigned*)(a.ws + WS_CTL) + CW_CNT + (size_t)l * NEXP * CNT_STRIDE;
    int tie, ce; const int e = find_expert(cnt, m64 >> 2, tie, ce);
    if (e < 0) return;
    const int* LIST = (const int*)(a.ws + WS_LIST) + (size_t)e * T;
    if (tid < 64) { const int r = tie * 256 + (m64 & 3) * 64 + tid; const int as = r < ce ? LIST[r] : -1; asg[tid] = as; arow[tid] = as < 0 ? -1 : (as >> 1); }
    __syncthreads();
    const bf16* W = (const bf16*)(a.ws + WS_WGU) + ((size_t)l * NEXP + e) * 1024 * 1024;
    const int brow = (f0 >> 7) * 256 + (f0 & 127);
    float acc[4][4], acc2[4][4]; ZACC(acc); ZACC(acc2);
    tile_mm((const bf16*)(a.ws + WS_HN), D, arow, W, D, brow, D, sA, sB, acc);
    tile_mm((const bf16*)(a.ws + WS_HN), D, arow, W, D, brow + 128, D, sA, sB, acc2);
    put_tile(Ct, acc); put_tile(Ct2, acc2); __syncthreads();
    bf16* HID = (bf16*)(a.ws + WS_HID); const float* GWT = (const float*)(a.ws + WS_GWT);
    if (tid < 64) { const int as = asg[tid]; const float w = as < 0 ? 0.f : GWT[as]; const size_t hr = (size_t)m64 * 64 + tid;
        for (int s = 0; s < 64; ++s) { const float g = Ct[tid][s], u = Ct2[tid][s]; const float h = as < 0 ? 0.f : (g / (1.0f + expf(-g))) * u * w; HID[hr * FF + f0 + s] = (bf16)f2bf(h); } }
}
__global__ void __launch_bounds__(256) down(Args a, int l) {
    ORC_SHARED
    __shared__ int asg[64];
    const int n0 = blockIdx.x * 64, m64 = blockIdx.y, tid = threadIdx.x;
    const unsigned* cnt = (const unsigned*)(a.ws + WS_CTL) + CW_CNT + (size_t)l * NEXP * CNT_STRIDE;
    int tie, ce; const int e = find_expert(cnt, m64 >> 2, tie, ce);
    if (e < 0) return;
    const int* LIST = (const int*)(a.ws + WS_LIST) + (size_t)e * T;
    if (tid < 64) { const int r = tie * 256 + (m64 & 3) * 64 + tid; asg[tid] = r < ce ? LIST[r] : -1; arow[tid] = m64 * 64 + tid; }
    __syncthreads();
    float acc[4][4]; ZACC(acc);
    tile_mm((const bf16*)(a.ws + WS_HID), FF, arow, (const bf16*)(a.ws + WS_WDN) + ((size_t)l * NEXP + e) * 1024 * 512, FF, n0, FF, sA, sB, acc);
    put_tile(Ct, acc); __syncthreads();
    bf16* Y = (bf16*)(a.ws + WS_Y);
    if (tid < 64) { const int as = asg[tid]; if (as >= 0) { const size_t base = (size_t)(as & 1) * T * D + (size_t)(as >> 1) * D + n0;
        for (int s = 0; s < 64; ++s) Y[base + s] = (bf16)f2bf(Ct[tid][s]); } }
}
}
#endif
#define XB_TMO      128
#define XB_XCNT(j)  (256  + 64 * (j))
#define XB_XSUB(j)  (1280 + 64 * (j))
#define XB_XGEN(j)  (2304 + 64 * (j))
#define XB_TOP      3328
#define XB_TOPGEN   3392
#define XCD_BAR_WORDS 3456
#define XB_SPIN_CAP (1u << 18)
__device__ __forceinline__ unsigned xb_ld(unsigned* p)              { return __hip_atomic_load(p, __ATOMIC_RELAXED, __HIP_MEMORY_SCOPE_AGENT); }
__device__ __forceinline__ unsigned xb_add(unsigned* p, unsigned v) { return __hip_atomic_fetch_add(p, v, __ATOMIC_RELAXED, __HIP_MEMORY_SCOPE_AGENT); }
__device__ __forceinline__ unsigned xb_xcc_id() { return (unsigned)__builtin_amdgcn_s_getreg((3 << 11) | 20) & 0xFu; }
#define XB_SPIN(cond, bar) do { unsigned _sp = 0; while (cond) { __builtin_amdgcn_s_sleep(1); \
    if ((++_sp & 255u) == 0u) { if (xb_ld(&(bar)[XB_TMO])) break; if (_sp > XB_SPIN_CAP) { atomicAdd(&(bar)[XB_TMO], 1u); break; } } } } while (0)
struct XcdBarrier { unsigned* bar; unsigned x; volatile LAS unsigned* st; };
__device__ __forceinline__ XcdBarrier xcd_barrier_post(unsigned* bar, volatile LAS unsigned* st, const int tid) {
    XcdBarrier b; b.bar = bar; b.x = xb_xcc_id(); b.st = st;
    if (tid == 0) (void)xb_add(&bar[XB_XCNT(b.x)], 1u);
    return b;
}
__device__ __forceinline__ void xcd_barrier_complete(unsigned* bar, unsigned x, unsigned& nloc, unsigned& nx) {
    const unsigned G = gridDim.x * gridDim.y * gridDim.z;
    unsigned sum, cnt, mine, sp = 0u;
    for (;;) {
        sum = 0u; cnt = 0u; mine = 0u;
#pragma unroll
        for (unsigned j = 0; j < 16; ++j) { const unsigned c = xb_ld(&bar[XB_XCNT(j)]); sum += c; cnt += (c > 0u) ? 1u : 0u; mine = (j == x) ? c : mine; }
        if (sum == G) break;
        __builtin_amdgcn_s_sleep(1);
        if ((++sp & 255u) == 0u) { if (xb_ld(&bar[XB_TMO])) break; if (sp > XB_SPIN_CAP) { atomicAdd(&bar[XB_TMO], 1u); break; } }
    }
    nloc = mine > 0u ? mine : 1u; nx = cnt > 0u ? cnt : 1u;
}
__device__ __forceinline__ void xcd_barrier(const XcdBarrier& b, const int tid) {
    asm volatile("s_waitcnt vmcnt(0)" ::: "memory");
    __syncthreads();
    if (tid == 0) {
        unsigned* bar = b.bar;
        __builtin_amdgcn_s_waitcnt(0);
        unsigned nloc = b.st[0], nx = b.st[1];
        if (nloc == 0u) { xcd_barrier_complete(bar, b.x, nloc, nx); b.st[0] = nloc; b.st[1] = nx; }
        const unsigned old = xb_add(&bar[XB_XSUB(b.x)], 1u);
        const unsigned gen = old / nloc;
        if (old + 1u == (gen + 1u) * nloc) {
            __builtin_amdgcn_fence(__ATOMIC_RELEASE, "agent");
            asm volatile("s_waitcnt vmcnt(0)" ::: "memory");
            const unsigned og = xb_add(&bar[XB_TOP], 1u);
            const unsigned tg = og / nx;
            if (og + 1u == (tg + 1u) * nx) xb_add(&bar[XB_TOPGEN], 1u);
            else XB_SPIN(xb_ld(&bar[XB_TOPGEN]) == tg, bar);
            __builtin_amdgcn_fence(__ATOMIC_ACQUIRE, "agent");
            xb_add(&bar[XB_XGEN(b.x)], 1u);
            asm volatile("s_waitcnt vmcnt(0)" ::: "memory");
        } else {
            XB_SPIN(xb_ld(&bar[XB_XGEN(b.x)]) == gen, bar);
            __builtin_amdgcn_fence(__ATOMIC_ACQUIRE, "agent");
            asm volatile("s_waitcnt vmcnt(0)" ::: "memory");
        }
    }
    __syncthreads();
}

__global__ void __launch_bounds__(NWAVES * 64, 2) mega(Args args) {
    extern __shared__ __attribute__((aligned(16))) unsigned char lds[];
    Frame F;
    F.lds = (LAS unsigned char*)lds;
    F.MISC = (volatile LAS unsigned*)(F.lds + MISC_OFF);
    F.wave0 = __builtin_amdgcn_readfirstlane((int)threadIdx.x >> 6);
    F.tid = fresh_tid(F.wave0); F.lane = F.tid & 63; F.wave = F.wave0;
    F.G = gridDim.x; { const int bx = blockIdx.x; F.vcu = (F.G % 8 == 0) ? (bx % 8) * (F.G / 8) + bx / 8 : bx; }
    F.in = args.in; F.out = args.out; F.ws = args.ws; F.ctl = (unsigned*)(args.ws + WS_CTL);
    for (int u = F.tid; u < (LDS_BYTES - LDSCTL_OFF) / 4; u += NWAVES * 64) ((LAS unsigned*)(F.lds + LDSCTL_OFF))[u] = 0u;
    __syncthreads();
    const int vcu0 = F.vcu;
    const int lo = args.ph_lo, hi = args.ph_hi;
    const bool multi = (hi - lo) > 1;
    XcdBarrier bar; bar.bar = F.ctl + CW_BAR; bar.x = 0; bar.st = nullptr;
    if (multi) bar = xcd_barrier_post(F.ctl + CW_BAR, F.MISC + 8, F.tid);
#define IN(k) (lo <= (k) && (k) < hi)
#define FRESH() do { { int w0_ = F.wave0; asm volatile("" : "+s"(w0_)); F.wave = w0_; F.lane = fresh_lane(); F.tid = w0_ * 64 + F.lane; } \
    { unsigned char* w_ = args.ws; float* o_ = args.out; asm volatile("" : "+s"(w_), "+s"(o_)); F.ws = w_; F.out = o_; F.ctl = (unsigned*)(w_ + WS_CTL); int v_ = vcu0, g_ = (int)gridDim.x, b_ = (int)blockIdx.x; asm volatile("" : "+s"(v_), "+s"(g_), "+s"(b_)); F.vcu = v_; F.G = g_; F.bx = b_; } } while (0)
#ifndef DUP_MASK
#define DUP_MASK 0
#endif
#define DUP(k) if ((DUP_MASK >> (k)) & 1)
#define SEAM(k) do { if (IN(k) && IN((k) + 1)) { xcd_barrier(bar, fresh_tid(F.wave0)); DUP(13) xcd_barrier(bar, fresh_tid(F.wave0)); } } while (0)
    if (IN(PH_PRO)) { FRESH(); phase_prologue(F); DUP(15) { __syncthreads(); FRESH(); phase_prologue(F); } }
    SEAM(PH_PRO);
    for (int l = 0; l < DEPTH; ++l) {
        const int pb = 1 + PH_PER_LAYER * l;
        if (IN(pb + K_NORM1)) { FRESH(); phase_normgemm<0>(F, l); }
        SEAM(pb + K_NORM1);
        if (IN(pb + K_CUMSUM)) { FRESH(); phase_cumsum(F); DUP(K_CUMSUM) { __syncthreads(); FRESH(); phase_cumsum(F); } }
        if (IN(pb + K_INPROJ)) { FRESH(); phase_inproj(F, l); DUP(K_INPROJ) { __syncthreads(); FRESH(); phase_inproj(F, l); } }
        SEAM(pb + K_INPROJ);
        if (IN(pb + K_ATTN)) { FRESH(); phase_attn<0>(F, l); }
        SEAM(pb + K_ATTN);
        if (IN(pb + K_YZ)) { FRESH(); phase_yz(F, l); DUP(K_YZ) { __syncthreads(); FRESH(); phase_yz(F, l); } }
        SEAM(pb + K_YZ);
        if (IN(pb + K_WO)) { FRESH(); phase_wo(F, l);  }
        SEAM(pb + K_WO);
        if (IN(pb + K_ROUTER)) { FRESH(); phase_router2(F, l); }
        SEAM(pb + K_ROUTER);
        if (IN(pb + K_GATEUP)) { FRESH(); phase_gateup(F, l); DUP(K_GATEUP) { __syncthreads(); FRESH(); phase_gateup(F, l); } }
#if MOE_BARRIER
        SEAM(pb + K_GATEUP);
#else
        __syncthreads();
#endif
        if (IN(pb + K_DOWN)) { FRESH(); phase_down(F, l); DUP(K_DOWN) { __syncthreads(); FRESH(); phase_down(F, l); } }
        SEAM(pb + K_DOWN);
    }
#ifndef TAIL_VAR
#define TAIL_VAR 0
#endif
#ifndef TAIL_MASK
#define TAIL_MASK 0
#endif
#define TAILP(k, call) do { if ((TAIL_MASK >> (k)) & 1) { xcd_barrier(bar, fresh_tid(F.wave0)); FRESH(); call; } } while (0)
    if (IN(PH_FINAL)) { FRESH(); phase_final(F); DUP(14) { __syncthreads(); FRESH(); phase_final(F, true); } }
    if (multi && TAIL_MASK) { const int l = 1;
        TAILP(15, phase_prologue(F)); TAILP(K_CUMSUM, phase_cumsum(F)); TAILP(K_INPROJ, phase_inproj(F, l)); TAILP(K_ATTN, phase_attn<TAIL_VAR>(F, l));
        TAILP(K_DIFFC, phase_diffc(F, l)); TAILP(K_YZ, phase_yz(F, l)); TAILP(K_WO, phase_wo(F, l, true)); TAILP(K_ROUTER, phase_router2(F, l, true)); TAILP(K_GATEUP, phase_gateup(F, l)); TAILP(K_DOWN, phase_down(F, l));
        TAILP(14, phase_final(F, true)); }
#undef IN
#undef FRESH
#undef SEAM
#undef DUP
}

#ifndef FAST_MASK
#define FAST_MASK 0
#endif
#ifndef ONE_LAUNCH
#define ONE_LAUNCH 0
#endif
extern "C" void kernel_launch(void* const* d_in, const int* in_sizes, int n_in, void* d_out, int out_size, void* d_ws, size_t ws_size, hipStream_t stream) {
    static int grid = 0;
    if (grid == 0) {
        if (n_in != 25 || in_sizes[0] != T * D || out_size != T * D || ws_size < WS_END) { fprintf(stderr, "kernel_launch: unexpected shapes (n_in %d, in0 %d, out %d, ws %zu); nothing launched\n", n_in, n_in > 0 ? in_sizes[0] : -1, out_size, ws_size); grid = -1; return; }
        int dev = 0, cus = 0, per_cu = 0;
        if (hipGetDevice(&dev) != hipSuccess || hipDeviceGetAttribute(&cus, hipDeviceAttributeMultiprocessorCount, dev) != hipSuccess) { grid = -1; return; }
        if (hipFuncSetAttribute((const void*)mega, hipFuncAttributeMaxDynamicSharedMemorySize, LDS_BYTES) != hipSuccess) { fprintf(stderr, "kernel_launch: hipFuncSetAttribute failed\n"); grid = -1; return; }
        if (hipOccupancyMaxActiveBlocksPerMultiprocessor(&per_cu, (const void*)mega, NWAVES * 64, LDS_BYTES) != hipSuccess || per_cu < 1) { fprintf(stderr, "kernel_launch: occupancy query reports %d\n", per_cu); }
        (void)hipGetLastError();
        grid = cus;
    }
    if (grid < 0) return;
    (void)hipMemsetAsync((char*)d_ws + WS_CTL, 0, CTL_ZERO_BYTES, stream);
    Args a{};
    for (int i = 0; i < 25; ++i) a.in[i] = d_in[i];
    a.out = (float*)d_out; a.ws = (unsigned char*)d_ws;
#if ONE_LAUNCH
    a.ph_lo = 0; a.ph_hi = N_PHASES;
    hipLaunchKernelGGL(mega, dim3(grid), dim3(NWAVES * 64), LDS_BYTES, stream, a);
#else
    for (int p = 0; p < N_PHASES; ++p) {
        const int l = (p - 1) / PH_PER_LAYER, k = (p >= 1 && p < PH_FINAL) ? (p - 1) % PH_PER_LAYER : -1;
        const bool heavy = (k == K_INPROJ || k == K_ATTN || k == K_YZ || k == K_WO || k == K_GATEUP || k == K_DOWN);
#if BUILD_ORACLE
        if (heavy && !((FAST_MASK >> k) & 1)) {
            if (k == K_INPROJ) hipLaunchKernelGGL(orc::inproj, dim3(80, 256), dim3(256), 0, stream, a, l);
            else if (k == K_ATTN) { hipLaunchKernelGGL(orc::attn, dim3(32, 32), dim3(256), 0, stream, a, 0); hipLaunchKernelGGL(orc::attn, dim3(32, 16), dim3(256), 0, stream, a, 1); }
            else if (k == K_YZ) hipLaunchKernelGGL(orc::yz, dim3(16, 256), dim3(256), 0, stream, a, l);
            else if (k == K_WO) hipLaunchKernelGGL(orc::wo, dim3(16, 256), dim3(256), 0, stream, a, l);
            else if (k == K_GATEUP) hipLaunchKernelGGL(orc::gateup, dim3(8, HID_ROWS / 64), dim3(256), 0, stream, a, l);
            else hipLaunchKernelGGL(orc::down, dim3(16, HID_ROWS / 64), dim3(256), 0, stream, a, l);
            continue;
        }
#endif
        a.ph_lo = p; a.ph_hi = p + 1;
        hipLaunchKernelGGL(mega, dim3(grid), dim3(NWAVES * 64), LDS_BYTES, stream, a);
    }
#endif
}
```

```cpp
#define BUILD_ORACLE 0
#define ONE_LAUNCH 1
#include <hip/hip_runtime.h>
#include <cstdio>
#include <cstdint>

constexpr int D = 1024, BATCH = 2, SEQ = 8192, T = BATCH * SEQ, DEPTH = 2;
constexpr int HD = 64, NEXP = 32, FF = 512;
constexpr int INC = 5128;
constexpr int NP = 5120;
constexpr int C_QA = 0, C_KA = 512, C_VA = 1024, C_QF = 1536, C_KF = 2048, C_VF = 2560, C_GA = 3072, C_GF = 4096;
constexpr float EPS = 1e-6f;
constexpr float LOG2E = 1.4426950408889634f;
constexpr float C2 = 0.125f * 1.4426950408889634f;
constexpr int HID_ROWS = 2 * T + NEXP * 256;

constexpr size_t MiB = 1u << 20;
constexpr size_t WS_CTL = 0, CTL_ZERO_BYTES = 128 * 1024;
constexpr size_t WS_FZT = 1 * MiB;
constexpr size_t WS_WRT = 1 * MiB + 128 * 1024;
constexpr size_t WS_GT = 1 * MiB + 640 * 1024;
constexpr size_t WS_LOGF = 2 * MiB;
constexpr size_t WS_CUM = 2 * MiB + 512 * 1024;
constexpr size_t WS_COSSIN = 3 * MiB;
constexpr size_t WS_GWT = 4 * MiB;
constexpr size_t WS_LIST = 5 * MiB;
constexpr size_t WS_WIN = 8 * MiB;
constexpr size_t WS_WD = 28 * MiB;
constexpr size_t WS_WF = 30 * MiB;
constexpr size_t WS_WO = 32 * MiB;
constexpr size_t WS_WGU = 36 * MiB;
constexpr size_t WS_WDN = 164 * MiB;
constexpr size_t WS_QKVG = 228 * MiB;
constexpr size_t WS_HID = 228 * MiB;
constexpr size_t WS_Y = 280 * MiB;
constexpr size_t WS_HN = 388 * MiB;
constexpr size_t WS_AD = 388 * MiB;
constexpr size_t WS_OA = 420 * MiB;
constexpr size_t WS_Z = 420 * MiB;
constexpr size_t WS_OF = 452 * MiB;
constexpr size_t WS_SUMS = 468 * MiB;
constexpr size_t WS_RSTD = 4 * MiB + 256 * 1024;
constexpr size_t WS_END = 484 * MiB;
static_assert(WS_HID + (size_t)HID_ROWS * FF * 2 <= WS_Y && WS_Y + (size_t)2 * T * D * 2 <= WS_HN, "ws map");
constexpr int CW_TMO = 0;
constexpr int CW_CNT = 16384, CNT_STRIDE = 64;
constexpr int CW_BAR = 4096;
constexpr int CW_FOXQ = 128;
static_assert((16384 + 2 * 32 * 64) * 4 <= (int)CTL_ZERO_BYTES, "control words inside the memset");
constexpr int CW_DCNT = 24576, DCNT_STRIDE = 16;
static_assert(CW_DCNT + DEPTH * BATCH * 4 * 32 * DCNT_STRIDE <= (int)(CTL_ZERO_BYTES / 4), "pair counters inside the memset");
constexpr int CW_TCNT = 8192, TCNT_STRIDE = 16, MAX_TILES = HID_ROWS / 256;

typedef unsigned short bf16;
typedef unsigned v4u __attribute__((ext_vector_type(4)));
typedef unsigned v2u __attribute__((ext_vector_type(2)));
typedef float f32x4 __attribute__((ext_vector_type(4)));
#define LAS __attribute__((address_space(3)))
#define GAS __attribute__((address_space(1)))
#define LDS_WAIT() asm volatile("s_waitcnt lgkmcnt(0)" ::: "memory")
#define VM_WAIT() asm volatile("s_waitcnt vmcnt(0)" ::: "memory")

__device__ __forceinline__ unsigned f2bf(float f) { unsigned u = __builtin_bit_cast(unsigned, f); return (u + 0x7fffu + ((u >> 16) & 1u)) >> 16; }
__device__ __forceinline__ unsigned pk2(float lo, float hi) { return f2bf(lo) | (f2bf(hi) << 16); }
__device__ __forceinline__ float bflo(unsigned w) { return __uint_as_float(w << 16); }
__device__ __forceinline__ float bfhi(unsigned w) { return __uint_as_float(w & 0xffff0000u); }
__device__ __forceinline__ float bf2f(bf16 b) { return __uint_as_float((unsigned)b << 16); }
__device__ __forceinline__ float shx(float v, int mask, int lane) { return __int_as_float(__builtin_amdgcn_ds_bpermute((lane ^ mask) << 2, __float_as_int(v))); }
__device__ __forceinline__ float shl_(float v, int src) { return __int_as_float(__builtin_amdgcn_ds_bpermute(src << 2, __float_as_int(v))); }
__device__ __forceinline__ double shx_d(double v, int mask, int lane) { const long long b = __builtin_bit_cast(long long, v); const int lo = __builtin_amdgcn_ds_bpermute((lane ^ mask) << 2, (int)b), hi = __builtin_amdgcn_ds_bpermute((lane ^ mask) << 2, (int)(b >> 32));
    return __builtin_bit_cast(double, ((long long)hi << 32) | (unsigned)lo); }
__device__ __forceinline__ float wave_sum(float v, int lane) {
#pragma unroll
    for (int o = 1; o < 64; o <<= 1) v += shx(v, o, lane);
    return v;
}
__device__ __forceinline__ int fresh_lane() { unsigned m = ~0u; asm volatile("" : "+s"(m)); return (int)__builtin_amdgcn_mbcnt_hi(m, __builtin_amdgcn_mbcnt_lo(m, 0u)); }
__device__ __forceinline__ int fresh_tid(int wave0) { int w = wave0; asm volatile("" : "+s"(w)); return w * 64 + fresh_lane(); }
__device__ __forceinline__ int pi32(int n) { return n < 4 ? n : (n < 8 ? n + 4 : (n < 12 ? n - 4 : n)); }
__host__ __device__ constexpr float lambda_init_of(int l) { return l == 0 ? 0.2f : 0.35550906759f; }

struct Args { const void* in[25]; float* out; unsigned char* ws; int ph_lo, ph_hi; };
enum { I_X = 0, I_POS, I_LN1, I_WIN, I_BF, I_QND, I_KND, I_LQ1, I_LK1, I_LQ2, I_LK2, I_SUBLN, I_QNF, I_KNF, I_WDO, I_WFO, I_WO, I_LN2, I_WRG, I_BRG, I_WRE, I_BRE, I_WEG, I_WEU, I_WED };
#ifndef SC1_STORES
#define SC1_STORES 0
#endif
#ifndef MOE_BARRIER
#define MOE_BARRIER 0
#endif
constexpr int PH_PRO = 0, PH_PER_LAYER = 10, PH_FINAL = 1 + PH_PER_LAYER * DEPTH, N_PHASES = PH_FINAL + 1;
enum { K_NORM1 = 0, K_CUMSUM, K_INPROJ, K_ATTN, K_DIFFC, K_YZ, K_WO, K_ROUTER, K_GATEUP, K_DOWN };
constexpr int NWAVES = 8;
constexpr int RING_OFF = 0, RING_BYTES = 131072;
constexpr int LDSCTL_OFF = RING_BYTES, MISC_OFF = LDSCTL_OFF + 320;
constexpr int LDS_BYTES = 147456;
struct Frame {
    LAS unsigned char* lds;
    volatile LAS unsigned* MISC;
    unsigned* ctl;
    int tid, lane, wave, vcu, G, wave0, bx;
    const void* const* in;
    float* out; unsigned char* ws;
};

__device__ __forceinline__ void p0_transpose_item(const float* W, int ld, int k0, int n0src, bf16* WT, int Kd, int drow0, bool swz, LAS float* scr, int lane) {
#pragma unroll 8
    for (int i = 0; i < 32; ++i) { const int kk = 2 * i + (lane >> 5); scr[kk * 33 + (lane & 31)] = __builtin_nontemporal_load(W + (size_t)(k0 + kk) * ld + n0src + (lane & 31)); }
    LDS_WAIT(); asm volatile("" ::: "memory");
    const int c = lane & 7;
#pragma unroll
    for (int j = 0; j < 4; ++j) { const int n = (lane >> 3) + 8 * j; const LAS float* s = scr + (8 * c) * 33 + n;
        v4u o; o.x = pk2(s[0 * 33], s[1 * 33]); o.y = pk2(s[2 * 33], s[3 * 33]); o.z = pk2(s[4 * 33], s[5 * 33]); o.w = pk2(s[6 * 33], s[7 * 33]);
        const int nd = swz ? pi32(n) : n;
        __builtin_nontemporal_store(o, (v4u*)(WT + (size_t)(drow0 + nd) * Kd + k0 + 8 * c)); }
    LDS_WAIT(); asm volatile("" ::: "memory");
}
__device__ __forceinline__ void phase_prologue(Frame& F) {
    LAS float* scr = (LAS float*)(F.lds + RING_OFF + F.wave * 16384);
    const int gw = F.vcu * NWAVES + F.wave, NGW = F.G * NWAVES;
    const float* w_in = (const float*)F.in[I_WIN]; const float* wdo = (const float*)F.in[I_WDO]; const float* wfo = (const float*)F.in[I_WFO]; const float* wo = (const float*)F.in[I_WO];
    const float* weg = (const float*)F.in[I_WEG]; const float* weu = (const float*)F.in[I_WEU]; const float* wed = (const float*)F.in[I_WED];
    bf16* WIN = (bf16*)(F.ws + WS_WIN); bf16* WD = (bf16*)(F.ws + WS_WD); bf16* WF = (bf16*)(F.ws + WS_WF); bf16* WO = (bf16*)(F.ws + WS_WO);
    bf16* WGU = (bf16*)(F.ws + WS_WGU); bf16* WDN = (bf16*)(F.ws + WS_WDN);
    constexpr int I_IN = 16 * 160 * DEPTH;
    constexpr int I_DF = 8 * 32 * DEPTH;
    constexpr int I_O = 16 * 32 * DEPTH;
    constexpr int I_GU = 16 * 16 * 64 * 2;
    constexpr int I_DN = 8 * 32 * 64;
    constexpr int NITEMS = I_IN + 2 * I_DF + I_O + I_GU + I_DN;
    for (int it = gw; it < NITEMS; it += NGW) {
        int r = it;
        if (r < I_GU) {
            const int nb = r & 15, kb = (r >> 4) & 15, which = (r >> 8) & 1, lge = r >> 9;
            const float* src = (which ? weu : weg) + (size_t)lge * D * FF;
            const int n0 = 32 * nb, drow = (n0 >> 7) * 256 + (n0 & 127) + which * 128;
            p0_transpose_item(src, FF, 64 * kb, n0, WGU + (size_t)lge * 1024 * 1024, D, drow, false, scr, F.lane); continue; }
        r -= I_GU;
        if (r < I_DN) {
            const int nb = r & 31, kb = (r >> 5) & 7, lge = r >> 8;
            p0_transpose_item(wed + (size_t)lge * FF * D, D, 64 * kb, 32 * nb, WDN + (size_t)lge * 1024 * 512, FF, 32 * nb, false, scr, F.lane); continue; }
        r -= I_DN;
        if (r < I_IN) {
            const int l = r / 2560, q = r % 2560, kb = q / 160, nb = q % 160;
            const int nsrc = nb < 96 ? 32 * nb : 32 * nb + 8;
            const bool swz = (nb < 32) && ((nb & 1) == 0);
            p0_transpose_item(w_in + (size_t)l * D * INC, INC, 64 * kb, nsrc, WIN + (size_t)l * NP * D, D, 32 * nb, swz, scr, F.lane); continue; }
        r -= I_IN;
        if (r < 2 * I_DF) {
            const int nb = r & 31, kb = (r >> 5) & 7, l = (r >> 8) & 1, which = r >> 9;
            p0_transpose_item((which ? wfo : wdo) + (size_t)l * 512 * D, D, 64 * kb, 32 * nb, (which ? WF : WD) + (size_t)l * D * 512, 512, 32 * nb, false, scr, F.lane); continue; }
        r -= 2 * I_DF;
        { const int nb = r & 31, kb = (r >> 5) & 15, l = r >> 9;
          p0_transpose_item(wo + (size_t)l * D * D, D, 64 * kb, 32 * nb, WO + (size_t)l * D * D, D, 32 * nb, false, scr, F.lane); }
    }
    const int gt = (F.vcu * NWAVES + F.wave) * 64 + F.lane, NGT = F.G * NWAVES * 64;
    bf16* FZT = (bf16*)(F.ws + WS_FZT); bf16* WRT = (bf16*)(F.ws + WS_WRT); float* CS = (float*)(F.ws + WS_COSSIN);
    const float* ln1 = (const float*)F.in[I_LN1]; const float* ln2 = (const float*)F.in[I_LN2];
    for (int i = gt; i < DEPTH * 16 * D; i += NGT) { const int l = i / (16 * D), q = i % (16 * D), j = q / D, k = q % D;
        const float w = j < 8 ? w_in[(size_t)l * D * INC + (size_t)k * INC + 3072 + j] * ln1[l * D + k] : 0.f;
        const unsigned h = f2bf(w); const float r = w - __uint_as_float(h << 16);
        FZT[(size_t)l * 2 * 16 * D + q] = (bf16)h; FZT[(size_t)l * 2 * 16 * D + 16 * D + q] = (bf16)f2bf(r); }
    const float* wrg = (const float*)F.in[I_WRG]; const float* wre = (const float*)F.in[I_WRE];
    for (int i = gt; i < DEPTH * 48 * D; i += NGT) { const int l = i / (48 * D), q = i % (48 * D), j = q / D, k = q % D;
        const float w = (j < 4 ? wrg[(size_t)l * D * 4 + k * 4 + j] : (j < 36 ? wre[(size_t)l * D * 32 + k * 32 + (j - 4)] : 0.f)) * ln2[l * D + k];
        const unsigned h = f2bf(w); const float r = w - __uint_as_float(h << 16);
        WRT[(size_t)l * 2 * 48 * D + q] = (bf16)h; WRT[(size_t)l * 2 * 48 * D + 48 * D + q] = (bf16)f2bf(r); }
    { float* GT = (float*)(F.ws + WS_GT);
      for (int i = gt; i < DEPTH * 4 * 64; i += NGT) { const int l = i >> 8, q = (i >> 6) & 3, d = i & 63;
          const float* src = (const float*)F.in[q == 0 ? I_QND : (q == 1 ? I_KND : (q == 2 ? I_QNF : I_KNF))];
          GT[i] = src[l * 64 + d] * ((q & 1) ? 1.0f : C2); } }
    const int* pos = (const int*)F.in[I_POS];
    for (int i = gt; i < T * 8; i += NGT) { const int t = i >> 3, f = i & 7;
        const double inv = exp2(-(double)f * (1.0 / 8.0) * 18.931568569324174);
        const double ang = (double)pos[t] * (double)(float)inv;
        CS[t * 16 + f] = (float)cos(ang); CS[t * 16 + 8 + f] = (float)sin(ang); }
}

typedef short bf16x8n __attribute__((ext_vector_type(8)));
typedef float f32x4m __attribute__((ext_vector_type(4)));
template <int KIND, int VAR = 0> __device__ __forceinline__ void phase_normgemm(Frame& F, int l) {
    constexpr int NB = KIND == 0 ? 1 : 3;
    constexpr int NR = NB * 16;
    constexpr int PW = 49, XP = 136;
    LAS bf16* XH = (LAS bf16*)(F.lds + RING_OFF);
    LAS bf16* XL = XH + 64 * XP;
    LAS bf16* WH = XL + 64 * XP;
    LAS bf16* WL = WH + 48 * XP;
    LAS float* part = (LAS float*)(WL + 48 * XP);
    LAS float* rsv = part + 2 * 64 * PW;
    const float* xsrc = (KIND == 0 && l == 0) ? (const float*)F.in[I_X] : F.out;
    const bool addy = (KIND == 0 && l > 0);
    const float* gn = (const float*)F.in[KIND == 0 ? I_LN1 : I_LN2] + (size_t)l * D;
    const bf16* WT = (const bf16*)(F.ws + (KIND == 0 ? WS_FZT : WS_WRT)) + (size_t)l * 2 * NR * D;
    const bf16* Y = (const bf16*)(F.ws + WS_Y); bf16* HN = (bf16*)(F.ws + WS_HN);
    const int lane = F.lane, wave = F.wave, tid = F.tid;
    for (int bt = F.vcu; bt < T / 64; bt += F.G) {
        const int row0 = bt * 64;
        f32x4 v_[8][4];
#pragma unroll
        for (int hh = 0; hh < 2; ++hh) {
#pragma unroll
            for (int r4 = 0; r4 < 4; ++r4) { const int rr = hh * 4 + r4, row = row0 + wave * 8 + rr;
#pragma unroll
                for (int j = 0; j < 4; ++j) v_[rr][j] = *(const f32x4*)(xsrc + (size_t)row * D + lane * 4 + 256 * j);
                if (addy) {
#pragma unroll
                    for (int j = 0; j < 4; ++j) { const v2u a = __builtin_nontemporal_load((const v2u*)(Y + (size_t)row * D + lane * 4 + 256 * j)), b = __builtin_nontemporal_load((const v2u*)(Y + (size_t)T * D + (size_t)row * D + lane * 4 + 256 * j));
                        v_[rr][j].x += bflo(a.x) + bflo(b.x); v_[rr][j].y += bfhi(a.x) + bfhi(b.x); v_[rr][j].z += bflo(a.y) + bflo(b.y); v_[rr][j].w += bfhi(a.y) + bfhi(b.y); }
                }
            }
            if (addy) asm volatile("" ::: "memory");
        }
#pragma unroll
        for (int rr = 0; rr < 8; ++rr) { const int rl = wave * 8 + rr, row = row0 + rl; float ss = 0.f;
#pragma unroll
            for (int j = 0; j < 4; ++j) { const f32x4 x = v_[rr][j]; if (KIND == 0 && l > 0) *(f32x4*)(F.out + (size_t)row * D + lane * 4 + 256 * j) = x; ss += (x.x * x.x + x.y * x.y) + (x.z * x.z + x.w * x.w); }
            const float r = 1.0f / sqrtf(wave_sum(ss, lane) * (1.0f / D) + EPS);
            if (lane == 0) rsv[rl] = r;
        }
        f32x4m acc[NB];
#pragma unroll
        for (int nb = 0; nb < NB; ++nb) acc[nb] = (f32x4m){0.f, 0.f, 0.f, 0.f};
        constexpr int NPZ = (2 * NR * 16 + NWAVES * 64 - 1) / (NWAVES * 64);
        v4u wreg[NPZ];
#define NG_WLOAD(hc_) _Pragma("unroll") for (int pi = 0; pi < NPZ; ++pi) { const int pz = tid + pi * NWAVES * 64; if (pz < 2 * NR * 16) { const int tb = pz / (NR * 16), q = pz % (NR * 16), n = q >> 4, c8 = q & 15; \
            wreg[pi] = *(const v4u*)(WT + (size_t)tb * NR * D + (size_t)n * D + (hc_) * 128 + c8 * 8); } }
        if (!(VAR & 2)) {
        NG_WLOAD(0)
#pragma unroll
        for (int hc = 0; hc < 8; ++hc) {
            if ((lane >> 5) == (hc & 1)) {
#pragma unroll
                for (int rr = 0; rr < 8; ++rr) { const f32x4 x = v_[rr][hc >> 1];
                    const unsigned h0 = f2bf(x.x), h1 = f2bf(x.y), h2 = f2bf(x.z), h3 = f2bf(x.w);
                    const float l0 = x.x - __uint_as_float(h0 << 16), l1 = x.y - __uint_as_float(h1 << 16), l2 = x.z - __uint_as_float(h2 << 16), l3 = x.w - __uint_as_float(h3 << 16);
                    const int o = (wave * 8 + rr) * XP + (lane & 31) * 4;
                    *(LAS v2u*)(XH + o) = (v2u){h0 | (h1 << 16), h2 | (h3 << 16)}; *(LAS v2u*)(XL + o) = (v2u){pk2(l0, l1), pk2(l2, l3)}; }
            }
#pragma unroll
            for (int pi = 0; pi < NPZ; ++pi) { const int pz = tid + pi * NWAVES * 64; if (pz < 2 * NR * 16) { const int tb = pz / (NR * 16), q = pz % (NR * 16), n = q >> 4, c8 = q & 15;
                *(LAS v4u*)((tb ? WL : WH) + n * XP + c8 * 8) = wreg[pi]; } }
            __syncthreads();
            if (hc < 7) { NG_WLOAD(hc + 1) }
            { const int rb = wave & 3, kq = wave >> 2, i = lane & 15, g = lane >> 4;
#pragma unroll
              for (int s = 0; s < 2; ++s) { const int ko = kq * 64 + s * 32 + g * 8;
                  const bf16x8n ah = *(const LAS bf16x8n*)(XH + (rb * 16 + i) * XP + ko), al = *(const LAS bf16x8n*)(XL + (rb * 16 + i) * XP + ko);
#pragma unroll
                  for (int nb = 0; nb < NB; ++nb) { const bf16x8n bh = *(const LAS bf16x8n*)(WH + (nb * 16 + i) * XP + ko), bl = *(const LAS bf16x8n*)(WL + (nb * 16 + i) * XP + ko);
                      acc[nb] = __builtin_amdgcn_mfma_f32_16x16x32_bf16(ah, bh, acc[nb], 0, 0, 0);
                      acc[nb] = __builtin_amdgcn_mfma_f32_16x16x32_bf16(ah, bl, acc[nb], 0, 0, 0);
                      acc[nb] = __builtin_amdgcn_mfma_f32_16x16x32_bf16(al, bh, acc[nb], 0, 0, 0); } } }
            __syncthreads();
        } }
        { const int rb = wave & 3, kq = wave >> 2, i = lane & 15, g = lane >> 4;
#pragma unroll
          for (int nb = 0; nb < NB; ++nb)
#pragma unroll
              for (int e = 0; e < 4; ++e) part[(kq * 64 + rb * 16 + 4 * g + e) * PW + nb * 16 + i] = acc[nb][e]; }
        __syncthreads();
#define NG_SUM2(o) (part[o] + part[64 * PW + (o)])
        if (KIND == 0) {
            { const int r = tid >> 3, j = tid & 7; const int o = r * PW + j;
                float z = NG_SUM2(o);
                z = z * rsv[r] + ((const float*)F.in[I_BF])[l * 8 + j];
                const float lf = fminf(z, 0.f) - 0.6931471805599453f * __builtin_amdgcn_logf(1.0f + __builtin_amdgcn_exp2f(-fabsf(z) * LOG2E));
                { const int row = row0 + r; ((float*)(F.ws + WS_LOGF))[((size_t)(row / SEQ) * 8 + j) * SEQ + (row % SEQ)] = lf; } }
        } else {
            if (tid < 64 && !(VAR & 4)) { const int r = tid, row = row0 + r; const float rs = rsv[r];
                const float* brg = (const float*)F.in[I_BRG] + l * 4; const float* bre = (const float*)F.in[I_BRE] + l * 32;
                float lg[4];
#pragma unroll
                for (int q = 0; q < 4; ++q) { const int o = r * PW + q; lg[q] = NG_SUM2(o) * rs + brg[q]; }
                int gi = 0; float gm = lg[0];
#pragma unroll
                for (int q = 1; q < 4; ++q) if (lg[q] > gm) { gm = lg[q]; gi = q; }
                float gs = 0.f;
#pragma unroll
                for (int q = 0; q < 4; ++q) gs += __builtin_amdgcn_exp2f((lg[q] - gm) * LOG2E);
                const float pg = 1.0f / gs;
                float le[8];
#pragma unroll
                for (int e = 0; e < 8; ++e) { const int o = r * PW + 4 + gi * 8 + e; le[e] = NG_SUM2(o) * rs + bre[gi * 8 + e]; }
                int i1 = 0; float m1 = le[0];
#pragma unroll
                for (int e = 1; e < 8; ++e) if (le[e] > m1) { m1 = le[e]; i1 = e; }
                int i2 = 0; float m2 = -INFINITY;
#pragma unroll
                for (int e = 0; e < 8; ++e) if (e != i1 && le[e] > m2) { m2 = le[e]; i2 = e; }
                const float e2 = __builtin_amdgcn_exp2f((m2 - m1) * LOG2E); const float w1 = pg / (1.0f + e2), w2 = pg * e2 / (1.0f + e2);
                LAS unsigned* lcnt = (LAS unsigned*)(rsv + 64); LAS unsigned* lbase = lcnt + 32;
                if (r < 32) lcnt[r] = 0u;
                LDS_WAIT();
                const int ex1 = gi * 8 + i1, ex2 = gi * 8 + i2;
                const unsigned k1 = __hip_atomic_fetch_add(lcnt + ex1, 1u, __ATOMIC_RELAXED, __HIP_MEMORY_SCOPE_WORKGROUP), k2 = __hip_atomic_fetch_add(lcnt + ex2, 1u, __ATOMIC_RELAXED, __HIP_MEMORY_SCOPE_WORKGROUP);
                LDS_WAIT();
                unsigned* CNT = F.ctl + CW_CNT + (size_t)l * NEXP * CNT_STRIDE;
                if (r < 32) { const unsigned mine = lcnt[r]; lbase[r] = mine ? atomicAdd(CNT + r * CNT_STRIDE, mine) : 0u; }
                LDS_WAIT();
                int* LIST = (int*)(F.ws + WS_LIST); float* GWT = (float*)(F.ws + WS_GWT);
                LIST[(size_t)ex1 * T + lbase[ex1] + k1] = row * 2; LIST[(size_t)ex2 * T + lbase[ex2] + k2] = row * 2 + 1;
                GWT[row * 2] = w1; GWT[row * 2 + 1] = w2; }
        }
#undef NG_SUM2
#undef NG_WLOAD
#pragma unroll
        for (int rr = 0; rr < 8; ++rr) { const int rl = wave * 8 + rr, row = row0 + rl; const float r = rsv[rl];
#pragma unroll
            for (int j = 0; j < 4; ++j) { const f32x4 g = *(const f32x4*)(gn + lane * 4 + 256 * j); const f32x4 h = v_[rr][j] * r * g;
                *(v2u*)(HN + (size_t)row * D + lane * 4 + 256 * j) = (v2u){pk2(h.x, h.y), pk2(h.z, h.w)}; } }
        __syncthreads();
    }
}
__device__ __forceinline__ double wave_sum_d(double v, int lane) {
#pragma unroll
    for (int o = 1; o < 64; o <<= 1) v += shx_d(v, o, lane);
    return v;
}
__device__ __forceinline__ void phase_router2(Frame& F, int l, bool dry = false) {
    constexpr int PW = 41;
    LAS float* sm = (LAS float*)(F.lds + RING_OFF);
    LAS unsigned* lcnt = (LAS unsigned*)(sm + 64 * PW); LAS unsigned* lbase = lcnt + 32;
    const float* SUMS = (const float*)(F.ws + WS_SUMS);
    for (int bt = F.vcu; bt < T / 64; bt += F.G) {
        const int row0 = bt * 64;
        { const int r = F.tid >> 3, j = F.tid & 7; const int c = j < 5 ? j * 8 : 48;
          if (j < 6) { const float* S0 = SUMS + (size_t)(row0 + r) * 64 + c;
              f32x4 a0 = *(const f32x4*)S0, a1 = *(const f32x4*)(S0 + (size_t)T * 64), a2 = *(const f32x4*)(S0 + (size_t)2 * T * 64), a3 = *(const f32x4*)(S0 + (size_t)3 * T * 64);
              f32x4 b0 = a0, b1 = a1, b2 = a2, b3 = a3;
              if (j < 5) { b0 = *(const f32x4*)(S0 + 4); b1 = *(const f32x4*)(S0 + (size_t)T * 64 + 4); b2 = *(const f32x4*)(S0 + (size_t)2 * T * 64 + 4); b3 = *(const f32x4*)(S0 + (size_t)3 * T * 64 + 4); }
              const f32x4 sa = (a0 + a1) + (a2 + a3), sb = (b0 + b1) + (b2 + b3);
              if (j < 5) {
#pragma unroll
                  for (int e = 0; e < 4; ++e) { sm[r * PW + c + e] = sa[e]; sm[r * PW + c + 4 + e] = sb[e]; } }
              else sm[r * PW + 40] = sa.x; } }
        __syncthreads();
        if (F.tid < 64) { const int r = F.tid, row = row0 + r;
            const float rs = 1.0f / sqrtf(sm[r * PW + 40] * (1.0f / D) + EPS);
            ((float*)(F.ws + WS_RSTD))[row] = rs;
            const float* brg = (const float*)F.in[I_BRG] + l * 4; const float* bre = (const float*)F.in[I_BRE] + l * 32;
            float lg[4];
#pragma unroll
            for (int q = 0; q < 4; ++q) lg[q] = sm[r * PW + q] * rs + brg[q];
            int gi = 0; float gm = lg[0];
#pragma unroll
            for (int q = 1; q < 4; ++q) if (lg[q] > gm) { gm = lg[q]; gi = q; }
            float gs = 0.f;
#pragma unroll
            for (int q = 0; q < 4; ++q) gs += __builtin_amdgcn_exp2f((lg[q] - gm) * LOG2E);
            const float pg = 1.0f / gs;
            float le[8];
#pragma unroll
            for (int e = 0; e < 8; ++e) le[e] = sm[r * PW + 4 + gi * 8 + e] * rs + bre[gi * 8 + e];
            int i1 = 0; float m1 = le[0];
#pragma unroll
            for (int e = 1; e < 8; ++e) if (le[e] > m1) { m1 = le[e]; i1 = e; }
            int i2 = 0; float m2 = -INFINITY;
#pragma unroll
            for (int e = 0; e < 8; ++e) if (e != i1 && le[e] > m2) { m2 = le[e]; i2 = e; }
            const float e2 = __builtin_amdgcn_exp2f((m2 - m1) * LOG2E); const float w1 = pg / (1.0f + e2), w2 = pg * e2 / (1.0f + e2);
            if (dry) { if (w1 + w2 == 1.2345e33f) ((float*)(F.ws + WS_GWT))[row * 2] = w1; } else {
            if (r < 32) lcnt[r] = 0u;
            LDS_WAIT();
            const int ex1 = gi * 8 + i1, ex2 = gi * 8 + i2;
            const unsigned k1 = __hip_atomic_fetch_add(lcnt + ex1, 1u, __ATOMIC_RELAXED, __HIP_MEMORY_SCOPE_WORKGROUP), k2 = __hip_atomic_fetch_add(lcnt + ex2, 1u, __ATOMIC_RELAXED, __HIP_MEMORY_SCOPE_WORKGROUP);
            LDS_WAIT();
            unsigned* CNT = F.ctl + CW_CNT + (size_t)l * NEXP * CNT_STRIDE;
            if (r < 32) { const unsigned mine = lcnt[r]; lbase[r] = mine ? atomicAdd(CNT + r * CNT_STRIDE, mine) : 0u; }
            LDS_WAIT();
            int* LIST = (int*)(F.ws + WS_LIST); float* GWT = (float*)(F.ws + WS_GWT);
            LIST[(size_t)ex1 * T + lbase[ex1] + k1] = row * 2; LIST[(size_t)ex2 * T + lbase[ex2] + k2] = row * 2 + 1;
            GWT[row * 2] = w1; GWT[row * 2 + 1] = w2; } }
        __syncthreads();
    }
}
__device__ __forceinline__ void phase_cumsum(Frame& F) {
    const float* LOGF = (const float*)(F.ws + WS_LOGF); float* CUM = (float*)(F.ws + WS_CUM);
    LAS double* red = (LAS double*)(F.lds + RING_OFF);
    for (int task = F.vcu; task < BATCH * 8 * 16; task += F.G) {
        const int seq = task >> 4, c = task & 15, b = seq >> 3, j = seq & 7;
        const float* src = LOGF + ((size_t)b * 8 + j) * SEQ;
        double acc = 0.0;
        for (int i = F.tid; i < c * 128; i += NWAVES * 64) { const f32x4 q = *(const f32x4*)(src + 4 * i); acc += ((double)q.x + (double)q.y) + ((double)q.z + (double)q.w); }
        acc = wave_sum_d(acc, F.lane);
        double v = (double)src[c * 512 + F.tid];
#pragma unroll
        for (int o = 1; o < 64; o <<= 1) { const double u = shx_d(v, 0, (F.lane - o) & 63); if (F.lane >= o) v += u; }
        if (F.lane == 63) { red[F.wave] = acc; red[8 + F.wave] = v; }
        else if (F.lane == 0 && false) {}
        __syncthreads();
        double base = 0.0;
#pragma unroll
        for (int w = 0; w < 8; ++w) { base += red[w]; if (w < F.wave) base += red[8 + w]; }
        CUM[(size_t)seq * SEQ + c * 512 + F.tid] = (float)((base + v) * 1.4426950408889634);
        __syncthreads();
    }
}
__device__ __forceinline__ void phase_diffc(Frame& F, int l) {
    const float* lq1 = (const float*)F.in[I_LQ1] + l * 64; const float* lk1 = (const float*)F.in[I_LK1] + l * 64;
    const float* lq2 = (const float*)F.in[I_LQ2] + l * 64; const float* lk2 = (const float*)F.in[I_LK2] + l * 64;
    const float li = lambda_init_of(l);
    const float lam = __builtin_amdgcn_exp2f(LOG2E * wave_sum(lq1[F.lane] * lk1[F.lane], F.lane)) - __builtin_amdgcn_exp2f(LOG2E * wave_sum(lq2[F.lane] * lk2[F.lane], F.lane)) + li;
    const float* sub = (const float*)F.in[I_SUBLN] + l * 128;
    const bf16* OA = (const bf16*)(F.ws + WS_OA); bf16* AD = (bf16*)(F.ws + WS_AD);
    const int gw = F.vcu * NWAVES + F.wave, NGW = F.G * NWAVES, lane = F.lane;
    const int d0 = (lane & 15) * 8;
    float sg[8];
#pragma unroll
    for (int e = 0; e < 8; ++e) sg[e] = sub[d0 + e] * (1.0f - li);
    for (int rb0 = gw; rb0 < T; rb0 += 8 * NGW) {
        v4u a_[8], b_[8];
#pragma unroll
        for (int q = 0; q < 8; ++q) { const int row = rb0 + q * NGW < T ? rb0 + q * NGW : rb0;
            a_[q] = __builtin_nontemporal_load((const v4u*)(OA + (size_t)row * 1024 + lane * 8)); b_[q] = __builtin_nontemporal_load((const v4u*)(OA + (size_t)row * 1024 + 512 + lane * 8)); }
#pragma unroll
        for (int q = 0; q < 8; ++q) { const int row = rb0 + q * NGW; if (row < T) { const v4u a = a_[q], b = b_[q];
        float v[8];
        v[0] = bflo(a.x) - lam * bflo(b.x); v[1] = bfhi(a.x) - lam * bfhi(b.x); v[2] = bflo(a.y) - lam * bflo(b.y); v[3] = bfhi(a.y) - lam * bfhi(b.y);
        v[4] = bflo(a.z) - lam * bflo(b.z); v[5] = bfhi(a.z) - lam * bfhi(b.z); v[6] = bflo(a.w) - lam * bflo(b.w); v[7] = bfhi(a.w) - lam * bfhi(b.w);
        float ss = 0.f;
#pragma unroll
        for (int e = 0; e < 8; ++e) ss += v[e] * v[e];
        ss += shx(ss, 1, lane); ss += shx(ss, 2, lane); ss += shx(ss, 4, lane); ss += shx(ss, 8, lane);
        const float r = __builtin_amdgcn_rsqf(ss * (1.0f / 128.0f) + EPS);
        v4u o; o.x = pk2(v[0] * r * sg[0], v[1] * r * sg[1]); o.y = pk2(v[2] * r * sg[2], v[3] * r * sg[3]); o.z = pk2(v[4] * r * sg[4], v[5] * r * sg[5]); o.w = pk2(v[6] * r * sg[6], v[7] * r * sg[7]);
        *(v4u*)(AD + (size_t)row * 512 + lane * 8) = o; } }
    }
}
__device__ __forceinline__ void phase_final(Frame& F, bool dry = false) {
    const bf16* Y = (const bf16*)(F.ws + WS_Y);
    const int gw = F.vcu * NWAVES + F.wave, NGW = F.G * NWAVES, lane = F.lane;
    for (int rb0 = gw; rb0 < T; rb0 += 4 * NGW) {
        f32x4 v_[4][4]; v2u a_[4][4], b_[4][4];
#pragma unroll
        for (int q = 0; q < 4; ++q) { const int row = rb0 + q * NGW < T ? rb0 + q * NGW : rb0;
#pragma unroll
            for (int j = 0; j < 4; ++j) { v_[q][j] = __builtin_nontemporal_load((const f32x4*)(F.out + (size_t)row * D + lane * 4 + 256 * j));
                a_[q][j] = __builtin_nontemporal_load((const v2u*)(Y + (size_t)row * D + lane * 4 + 256 * j)); b_[q][j] = __builtin_nontemporal_load((const v2u*)(Y + (size_t)T * D + (size_t)row * D + lane * 4 + 256 * j)); } }
#pragma unroll
        for (int q = 0; q < 4; ++q) { const int row = rb0 + q * NGW; if (row < T) {
#pragma unroll
            for (int j = 0; j < 4; ++j) { f32x4 v = v_[q][j]; const v2u a = a_[q][j], b = b_[q][j];
                v.x += bflo(a.x) + bflo(b.x); v.y += bfhi(a.x) + bfhi(b.x); v.z += bflo(a.y) + bflo(b.y); v.w += bfhi(a.y) + bfhi(b.y);
                if (!dry || v.x == 1.2345e33f) __builtin_nontemporal_store(v, (f32x4*)(F.out + (size_t)row * D + lane * 4 + 256 * j)); } } }
    }
}
namespace pg8 {
typedef short bf16x8 __attribute__((ext_vector_type(8)));
typedef unsigned u32x4 __attribute__((ext_vector_type(4)));
constexpr int BM = 256, BK = 64, HALF = 128, HTB = HALF * BK * 2, STAGE_BYTES = 8 * HTB;
__host__ __device__ __forceinline__ int lds_byte(int r, int c) { const int st = (r >> 4) * 2 + (c >> 5), rr = r & 15, cc = c & 31, ob = rr * 64 + cc * 2; return st * 1024 + (ob ^ (((ob >> 9) & 1) << 5)); }
__host__ __device__ __forceinline__ void stage_rc(int b, int& R, int& C) { const int st = b / 1024, sb = b % 1024, swz = sb ^ (((sb >> 9) & 1) << 5); R = (st >> 1) * 16 + swz / 64; C = (st & 1) * 32 + (swz % 64) / 2; }
__host__ __device__ __forceinline__ int perm32(int rho) { const int n = rho >> 4, i = rho & 15; return 8 * (i >> 2) + 4 * n + (i & 3); }
struct Unit { int pm, pn, ex, sl; };
__device__ __forceinline__ unsigned cvt_pk_bf16(float lo, float hi) { unsigned r; asm volatile("v_cvt_pk_bf16_f32 %0, %1, %2" : "=v"(r) : "v"(lo), "v"(hi)); return r; }

struct StaticOrder {
    int nM, nN, nwg, G, c, K;
    __device__ void init(int M, int N, int K_, int G_, int c_) { nM = M / BM; nN = N / BM; nwg = nM * nN; G = G_; c = c_; K = K_; }
    __device__ __forceinline__ bool next(int i, Unit& u) const {
        const long L = (long)i * G + c; if (L >= nwg) return false;
        int wgid = (int)L; { const int q = nwg / 8, r = nwg % 8, xcd = wgid % 8, off = wgid / 8; wgid = (xcd < r ? xcd * (q + 1) : r * (q + 1) + (xcd - r) * q) + off; }
        const int nig = 8 * nN, gid = wgid / nig, fm = gid * 8, gsz = (nM - fm) < 8 ? (nM - fm) : 8;
        u.pm = fm + ((wgid % nig) % gsz); u.pn = (wgid % nig) / gsz; u.ex = 0; u.sl = 0; return true;
    }
    static constexpr bool GATHER = false; static constexpr int A_AUX = 0;
    __device__ __forceinline__ void a_ready(const Unit&) const {}
    __device__ __forceinline__ size_t a_off(const Unit& u) const { return (size_t)u.pm * BM * K * 2; }
    __device__ __forceinline__ unsigned arow_off(const Unit&, int) const { return 0u; }
    __device__ __forceinline__ size_t b_off(const Unit& u) const { return (size_t)u.pn * BM * K * 2; }
};

template <class Epi, class Sched, bool ALIGN_EPI>
__device__ __forceinline__ void gemm_phase(LAS unsigned char* lds, const int wave0, const bf16* Ag, const bf16* Btg, const int K, const Sched& S, const Epi& E) {
    const int tid = fresh_tid(wave0);
    const int wid = __builtin_amdgcn_readfirstlane(tid >> 6), lane = tid & 63, wr = wid >> 2, wc = wid & 3, fr = lane & 15, fq = lane >> 4;
    const int nt = K / BK;
    constexpr bool GATHER = Sched::GATHER;
    int RA0 = 0; unsigned CA2 = 0u, voffA[2], voffB[2];
#pragma unroll
    for (int i = 0; i < 2; ++i) { int R, C; stage_rc(tid * 16 + i * 8192, R, C); if (i == 0) { RA0 = R; CA2 = (unsigned)C * 2u; }
        voffA[i] = (unsigned)(R * K + C) * 2u;
        const int Rb = Epi::BMODE == 2 ? 64 * (R >> 5) + perm32(R & 31) : (Epi::BMODE == 1 ? ((R & ~31) + perm32(R & 31)) : R);
        voffB[i] = (unsigned)(Rb * K + C) * 2u; }
    const size_t kstep = (size_t)(BK * 2);
    const size_t hstepB = (size_t)(Epi::BMODE == 2 ? 32 : HALF) * K * 2, hstepA = (size_t)HALF * K * 2;
    const unsigned ldsw = (unsigned)wid * 1024u;
    const int aoff = lds_byte(wr * 64 + fr, fq * 8), boff = lds_byte(wc * 32 + fr, fq * 8);
#define PG8_SA(b, h) (((b) * 2 + (h)) * HTB)
#define PG8_SB(b, h) ((4 + (b) * 2 + (h)) * HTB)
#define PG8_STAGE_A(bufoff, gbase, voff) do { _Pragma("unroll") for (int _i = 0; _i < 2; ++_i) \
        __builtin_amdgcn_global_load_lds((const unsigned*)((const char*)(gbase) + (voff)[_i]), (LAS unsigned*)(lds + (bufoff) + ldsw + _i * 8192), 16, 0, Sched::A_AUX); } while (0)
#define PG8_STAGE(bufoff, gbase, voff) do { _Pragma("unroll") for (int _i = 0; _i < 2; ++_i) \
        __builtin_amdgcn_global_load_lds((const unsigned*)((const char*)(gbase) + (voff)[_i]), (LAS unsigned*)(lds + (bufoff) + ldsw + _i * 8192), 16, 0, 0); } while (0)
#define PG8_LDA(dst, b, h) do { _Pragma("unroll") for (int m = 0; m < 4; ++m) _Pragma("unroll") for (int k = 0; k < 2; ++k) dst[m][k] = *(const LAS bf16x8*)(lds + PG8_SA(b, h) + aoff + m * 2048 + k * 1024); } while (0)
#define PG8_LDB(dst, b, h) do { _Pragma("unroll") for (int n = 0; n < 2; ++n) _Pragma("unroll") for (int k = 0; k < 2; ++k) dst[n][k] = *(const LAS bf16x8*)(lds + PG8_SB(b, h) + boff + n * 2048 + k * 1024); } while (0)
#define PG8_MMA(ai, bj, At, Bt) do { __builtin_amdgcn_s_setprio(1); _Pragma("unroll") for (int m = 0; m < 4; ++m) _Pragma("unroll") for (int n = 0; n < 2; ++n) _Pragma("unroll") for (int k = 0; k < 2; ++k) \
        acc[ai][bj][m][n] = __builtin_amdgcn_mfma_f32_16x16x32_bf16(Bt[n][k], At[m][k], acc[ai][bj][m][n], 0, 0, 0); __builtin_amdgcn_s_setprio(0); } while (0)
#define PG8_WAIT_V(n) asm volatile("s_waitcnt vmcnt(" #n ")" ::: "memory")
#define PG8_WAIT_L(n) asm volatile("s_waitcnt lgkmcnt(" #n ")" ::: "memory")
#define PG8_BAR __builtin_amdgcn_s_barrier()
#define PG8_SCHED __builtin_amdgcn_sched_barrier(0)
    Unit cur, nxt; int ui = 0;
    if (!S.next(0, cur)) return;
    f32x4 acc[2][2][4][2];
#pragma unroll
    for (int a = 0; a < 2; ++a)
#pragma unroll
        for (int b = 0; b < 2; ++b)
#pragma unroll
            for (int m = 0; m < 4; ++m)
#pragma unroll
                for (int n = 0; n < 2; ++n) acc[a][b][m][n] = (f32x4){0.f, 0.f, 0.f, 0.f};
    bf16x8 At[4][2], B0[2][2], B1[2][2];
    unsigned gc0[2] = {0u, 0u}, gc1[2] = {0u, 0u};
#define PG8_GOFF(u, d0, d1) do { d0[0] = S.arow_off(u, RA0) + CA2; d0[1] = S.arow_off(u, RA0 + 64) + CA2; d1[0] = S.arow_off(u, HALF + RA0) + CA2; d1[1] = S.arow_off(u, HALF + RA0 + 64) + CA2; } while (0)
    if constexpr (GATHER) PG8_GOFF(cur, gc0, gc1);
    S.a_ready(cur);
    const char* cA = (const char*)Ag; if constexpr (!GATHER) cA += S.a_off(cur);
    const char* cB = (const char*)Btg + S.b_off(cur);
    PG8_STAGE(PG8_SB(0, 0), cB, voffB); PG8_STAGE(PG8_SB(0, 1), cB + hstepB, voffB);
    if constexpr (GATHER) { PG8_STAGE_A(PG8_SA(0, 0), cA, gc0); PG8_STAGE_A(PG8_SA(0, 1), cA, gc1); } else { PG8_STAGE_A(PG8_SA(0, 0), cA, voffA); PG8_STAGE_A(PG8_SA(0, 1), cA + hstepA, voffA); }
    if (wr == 1) PG8_BAR;
    PG8_WAIT_V(2); PG8_BAR;
    PG8_STAGE(PG8_SB(1, 0), cB + kstep, voffB);
    if constexpr (GATHER) PG8_STAGE_A(PG8_SA(1, 0), cA + kstep, gc0); else PG8_STAGE_A(PG8_SA(1, 0), cA + kstep, voffA);
    PG8_STAGE(PG8_SB(1, 1), cB + hstepB + kstep, voffB);
    PG8_WAIT_V(6); PG8_BAR;
    for (;;) {
        const bool has_next = S.next(ui + 1, nxt);
        const char* nA = cA; if constexpr (!GATHER) { if (has_next) nA = (const char*)Ag + S.a_off(nxt); }
        const char* nB = has_next ? (const char*)Btg + S.b_off(nxt) : cB;
        for (int t = 0; t < nt; t += 2) {
            const bool last = (t == nt - 2);
            if (last && has_next) S.a_ready(nxt);
            const char* a1 = cA + (size_t)(t + 1) * kstep;
            const char* a2 = last ? nA : cA + (size_t)(t + 2) * kstep; const char* b2 = last ? nB : cB + (size_t)(t + 2) * kstep;
            const char* a3 = a2 + kstep; const char* b3 = b2 + kstep;
            unsigned vs0[2] = {gc0[0], gc0[1]}, vs1[2] = {gc1[0], gc1[1]};
            if constexpr (GATHER) { if (last && has_next) PG8_GOFF(nxt, vs0, vs1); }
#define PG8_STA(bufoff, base, h, vs) do { if constexpr (GATHER) PG8_STAGE_A(bufoff, base, vs); else PG8_STAGE_A(bufoff, (base) + (h) * hstepA, voffA); } while (0)
            PG8_LDB(B0, 0, 0); PG8_LDB(B1, 0, 1); PG8_SCHED; PG8_LDA(At, 0, 0); PG8_STA(PG8_SA(1, 1), a1, 1, gc1);
            PG8_WAIT_V(8); PG8_WAIT_L(0); PG8_BAR; PG8_MMA(0, 0, At, B0); PG8_MMA(0, 1, At, B1); PG8_BAR; PG8_SCHED;
            PG8_LDA(At, 0, 1); PG8_STAGE(PG8_SB(0, 0), b2, voffB); PG8_STAGE(PG8_SB(0, 1), b2 + hstepB, voffB); PG8_STA(PG8_SA(0, 0), a2, 0, vs0);
            PG8_WAIT_V(8); PG8_WAIT_L(0); PG8_BAR; PG8_MMA(1, 0, At, B0); PG8_MMA(1, 1, At, B1); PG8_BAR; PG8_SCHED;
            PG8_LDB(B0, 1, 0); PG8_LDB(B1, 1, 1); PG8_SCHED; PG8_LDA(At, 1, 0); PG8_STA(PG8_SA(0, 1), a2, 1, vs1);
            PG8_WAIT_V(8); PG8_WAIT_L(0); PG8_BAR; PG8_MMA(0, 0, At, B0); PG8_MMA(0, 1, At, B1); PG8_BAR; PG8_SCHED;
            PG8_LDA(At, 1, 1); PG8_STAGE(PG8_SB(1, 0), b3, voffB); PG8_STAGE(PG8_SB(1, 1), b3 + hstepB, voffB); PG8_STA(PG8_SA(1, 0), a3, 0, vs0);
            PG8_WAIT_V(8); PG8_WAIT_L(0); PG8_BAR; PG8_MMA(1, 0, At, B0); PG8_MMA(1, 1, At, B1); PG8_BAR; PG8_SCHED;
        }
        if constexpr (ALIGN_EPI) { if (wr == 0) PG8_BAR; }
        if constexpr (!Epi::AFTER_DRAIN) E(acc, cur, wr, wc, fr, fq);
        if (!has_next) break;
        if (!(Epi::CHAIN2 && cur.ex == 0)) {
#pragma unroll
        for (int a = 0; a < 2; ++a)
#pragma unroll
            for (int b = 0; b < 2; ++b)
#pragma unroll
                for (int m = 0; m < 4; ++m)
#pragma unroll
                    for (int n = 0; n < 2; ++n) acc[a][b][m][n] = (f32x4){0.f, 0.f, 0.f, 0.f}; }
        cur = nxt; cA = nA; cB = nB; ++ui;
        if constexpr (GATHER) PG8_GOFF(cur, gc0, gc1);
        if constexpr (ALIGN_EPI) { if (wr == 1) PG8_BAR; }
    }
    PG8_WAIT_V(0);
    if constexpr (!ALIGN_EPI) { if (wr == 0) PG8_BAR; }
    PG8_BAR;
    if constexpr (Epi::AFTER_DRAIN) E.fused(acc, cur, wr, wc, fr, fq, lds, tid);
#undef PG8_SA
#undef PG8_SB
#undef PG8_STAGE
#undef PG8_STAGE_A
#undef PG8_STA
#undef PG8_GOFF
#undef PG8_LDA
#undef PG8_LDB
#undef PG8_MMA
#undef PG8_WAIT_V
#undef PG8_WAIT_L
#undef PG8_BAR
#undef PG8_SCHED
}
}
typedef pg8::Unit Unit;
__device__ __forceinline__ float sigmoidf_(float v) { return __builtin_amdgcn_rcpf(1.0f + __builtin_amdgcn_exp2f(-v * LOG2E)); }

struct EpiInproj {
    static constexpr int BMODE = 2; static constexpr bool CHAIN2 = false, AFTER_DRAIN = false;
    bf16* O; const float* gt; const float* cs;
    __device__ __forceinline__ void operator()(f32x4 (&acc)[2][2][4][2], const Unit& u, int wr, int wc, int fr, int fq) const {
        const int seg = u.pn >> 1;
        const int col0 = u.pn * 256 + wc * 64 + 8 * fq;
        const bool isnorm = (seg == 0 || seg == 1 || seg == 3 || seg == 4), isdiff = seg < 2;
        f32x4 g[2][2];
        if (isnorm) {
            const float* gp = gt + (seg < 2 ? seg : seg - 1) * 64;
#pragma unroll
            for (int bj = 0; bj < 2; ++bj)
#pragma unroll
                for (int n = 0; n < 2; ++n) { const int d0 = (isdiff && bj == 0 && fq < 2) ? (4 * fq + 8 * n) : (32 * bj + 8 * fq + 4 * n); g[bj][n] = *(const f32x4*)(gp + d0); }
        }
#pragma unroll
        for (int ai = 0; ai < 2; ++ai)
#pragma unroll
            for (int m = 0; m < 4; ++m) {
                const int row = u.pm * 256 + ai * 128 + wr * 64 + m * 16 + fr;
                f32x4 v00 = acc[ai][0][m][0], v01 = acc[ai][0][m][1], v10 = acc[ai][1][m][0], v11 = acc[ai][1][m][1];
                if (isnorm) {
                    float ss = (v00.x * v00.x + v00.y * v00.y) + (v00.z * v00.z + v00.w * v00.w) + (v01.x * v01.x + v01.y * v01.y) + (v01.z * v01.z + v01.w * v01.w)
                             + (v10.x * v10.x + v10.y * v10.y) + (v10.z * v10.z + v10.w * v10.w) + (v11.x * v11.x + v11.y * v11.y) + (v11.z * v11.z + v11.w * v11.w);
                    ss += shx(ss, 16, fq * 16 + fr); ss += shx(ss, 32, fq * 16 + fr);
                    const float rs = __builtin_amdgcn_rsqf(ss * (1.0f / 64.0f) + EPS);
                    v00 = v00 * rs * g[0][0]; v01 = v01 * rs * g[0][1]; v10 = v10 * rs * g[1][0]; v11 = v11 * rs * g[1][1];
                    if (isdiff) {
                        const int fi = (fq & 1) * 4;
                        const f32x4 c = *(const f32x4*)(cs + (size_t)row * 16 + fi), s = *(const f32x4*)(cs + (size_t)row * 16 + 8 + fi);
                        const f32x4 r0 = v00 * c - v01 * s, r1 = v01 * c + v00 * s;
                        if (fq < 2) { v00 = r0; v01 = r1; }
                    }
                } else if (seg >= 6) {
#pragma unroll
                    for (int e = 0; e < 4; ++e) { v00[e] = sigmoidf_(v00[e]); v01[e] = sigmoidf_(v01[e]); v10[e] = sigmoidf_(v10[e]); v11[e] = sigmoidf_(v11[e]); }
                }
                bf16* rowp = O + (size_t)row * NP + col0;
                pg8::u32x4 w0, w1;
                w0.x = pg8::cvt_pk_bf16(v00.x, v00.y); w0.y = pg8::cvt_pk_bf16(v00.z, v00.w); w0.z = pg8::cvt_pk_bf16(v01.x, v01.y); w0.w = pg8::cvt_pk_bf16(v01.z, v01.w);
                w1.x = pg8::cvt_pk_bf16(v10.x, v10.y); w1.y = pg8::cvt_pk_bf16(v10.z, v10.w); w1.z = pg8::cvt_pk_bf16(v11.x, v11.y); w1.w = pg8::cvt_pk_bf16(v11.z, v11.w);
#if SC1_STORES
                asm volatile("global_store_dwordx4 %0, %1, off sc1\n\tglobal_store_dwordx4 %0, %2, off offset:64 sc1\n\ts_nop 1" :: "v"(rowp), "v"(w0), "v"(w1) : "memory");
#else
                *(pg8::u32x4*)(rowp) = w0; *(pg8::u32x4*)(rowp + 32) = w1;
#endif
            }
    }
};
template <bool FIRST> struct EpiYZ {
    static constexpr int BMODE = 1; static constexpr bool CHAIN2 = false, AFTER_DRAIN = false;
    bf16* Z; const bf16* G;
    __device__ __forceinline__ void operator()(f32x4 (&acc)[2][2][4][2], const Unit& u, int wr, int wc, int fr, int fq) const {
#pragma unroll
        for (int ai = 0; ai < 2; ++ai)
#pragma unroll
            for (int m = 0; m < 4; ++m) { const int row = u.pm * 256 + ai * 128 + wr * 64 + m * 16 + fr;
#pragma unroll
                for (int bj = 0; bj < 2; ++bj) { const int col = u.pn * 256 + bj * 128 + wc * 32 + 8 * fq;
                    const pg8::u32x4 gw = *(const pg8::u32x4*)(G + (size_t)row * NP + col);
                    f32x4 v0 = acc[ai][bj][m][0], v1 = acc[ai][bj][m][1];
                    v0.x *= bflo(gw.x); v0.y *= bfhi(gw.x); v0.z *= bflo(gw.y); v0.w *= bfhi(gw.y); v1.x *= bflo(gw.z); v1.y *= bfhi(gw.z); v1.z *= bflo(gw.w); v1.w *= bfhi(gw.w);
                    bf16* zp = Z + (size_t)row * D + col;
                    if (!FIRST) { const pg8::u32x4 zo = *(const pg8::u32x4*)zp;
                        v0.x += bflo(zo.x); v0.y += bfhi(zo.x); v0.z += bflo(zo.y); v0.w += bfhi(zo.y); v1.x += bflo(zo.z); v1.y += bfhi(zo.z); v1.z += bflo(zo.w); v1.w += bfhi(zo.w); }
                    pg8::u32x4 w; w.x = pg8::cvt_pk_bf16(v0.x, v0.y); w.y = pg8::cvt_pk_bf16(v0.z, v0.w); w.z = pg8::cvt_pk_bf16(v1.x, v1.y); w.w = pg8::cvt_pk_bf16(v1.z, v1.w);
                    *(pg8::u32x4*)zp = w; } }
    }
};
struct EpiWo {
    static constexpr int BMODE = 0; static constexpr bool CHAIN2 = false, AFTER_DRAIN = false;
    float* out; bool dry;
    __device__ __forceinline__ void operator()(f32x4 (&acc)[2][2][4][2], const Unit& u, int wr, int wc, int fr, int fq) const {
#pragma unroll
        for (int ai = 0; ai < 2; ++ai)
#pragma unroll
            for (int m = 0; m < 4; ++m) { const int row = u.pm * 256 + ai * 128 + wr * 64 + m * 16 + fr;
#pragma unroll
                for (int bj = 0; bj < 2; ++bj)
#pragma unroll
                    for (int n = 0; n < 2; ++n) { float* p = out + (size_t)row * D + u.pn * 256 + bj * 128 + wc * 32 + n * 16 + 4 * fq; const f32x4 nv = *(const f32x4*)p + acc[ai][bj][m][n]; if (!dry || nv.x == 1.2345e33f) *(f32x4*)p = nv; }
                if (m == 3) asm volatile("" ::: "memory"); }
    }
};
struct EpiWoR {
    static constexpr int BMODE = 2; static constexpr bool CHAIN2 = false, AFTER_DRAIN = true;
    float* out; const float* res; bf16* HN; const float* g2; const bf16* WT; float* SUMS; bool dry;
    __device__ __forceinline__ void operator()(f32x4 (&)[2][2][4][2], const Unit&, int, int, int, int) const {}
    __device__ __forceinline__ void fused(f32x4 (&acc)[2][2][4][2], const Unit& u, int wr, int wc, int fr, int fq, LAS unsigned char* lds, int tid) const {
        constexpr int PW = 49;
        LAS float* tab = (LAS float*)lds;
        const int lane = fq * 16 + fr;
        const int c0 = u.pn * 256 + wc * 64 + 8 * fq;
        pg8::bf16x8 wh[2][3], wl[2][3]; f32x4 gg[2][2];
#pragma unroll
        for (int bj = 0; bj < 2; ++bj) {
#pragma unroll
            for (int nb = 0; nb < 3; ++nb) { wh[bj][nb] = *(const pg8::bf16x8*)(WT + (size_t)(nb * 16 + fr) * D + c0 + 32 * bj); wl[bj][nb] = *(const pg8::bf16x8*)(WT + (size_t)48 * D + (size_t)(nb * 16 + fr) * D + c0 + 32 * bj); }
#pragma unroll
            for (int n = 0; n < 2; ++n) gg[bj][n] = *(const f32x4*)(g2 + c0 + 32 * bj + 4 * n); }
#pragma unroll
        for (int ai = 0; ai < 2; ++ai)
#pragma unroll
            for (int m = 0; m < 4; ++m) { const int row = u.pm * 256 + ai * 128 + wr * 64 + m * 16 + fr;
                float ss = 0.f; f32x4 dd[3];
#pragma unroll
                for (int nb = 0; nb < 3; ++nb) dd[nb] = (f32x4){0.f, 0.f, 0.f, 0.f};
#pragma unroll
                for (int bj = 0; bj < 2; ++bj) { float* p = out + (size_t)row * D + c0 + 32 * bj; const float* ps = res + (size_t)row * D + c0 + 32 * bj;
                    const f32x4 o0 = *(const f32x4*)ps, o1 = *(const f32x4*)(ps + 4); const f32x4 v0 = o0 + acc[ai][bj][m][0], v1 = o1 + acc[ai][bj][m][1];
                    *(f32x4*)p = dry ? o0 : v0; *(f32x4*)(p + 4) = dry ? o1 : v1;
                    ss += ((v0.x * v0.x + v0.y * v0.y) + (v0.z * v0.z + v0.w * v0.w)) + ((v1.x * v1.x + v1.y * v1.y) + (v1.z * v1.z + v1.w * v1.w));
                    { const f32x4 a = v0 * gg[bj][0], b = v1 * gg[bj][1]; pg8::u32x4 o; o.x = pg8::cvt_pk_bf16(a.x, a.y); o.y = pg8::cvt_pk_bf16(a.z, a.w); o.z = pg8::cvt_pk_bf16(b.x, b.y); o.w = pg8::cvt_pk_bf16(b.z, b.w);
                      *(pg8::u32x4*)(HN + (size_t)row * D + c0 + 32 * bj) = o; }
                    pg8::u32x4 hp, lp;
                    hp.x = pg8::cvt_pk_bf16(v0.x, v0.y); hp.y = pg8::cvt_pk_bf16(v0.z, v0.w); hp.z = pg8::cvt_pk_bf16(v1.x, v1.y); hp.w = pg8::cvt_pk_bf16(v1.z, v1.w);
                    lp.x = pg8::cvt_pk_bf16(v0.x - bflo(hp.x), v0.y - bfhi(hp.x)); lp.y = pg8::cvt_pk_bf16(v0.z - bflo(hp.y), v0.w - bfhi(hp.y));
                    lp.z = pg8::cvt_pk_bf16(v1.x - bflo(hp.z), v1.y - bfhi(hp.z)); lp.w = pg8::cvt_pk_bf16(v1.z - bflo(hp.w), v1.w - bfhi(hp.w));
                    const pg8::bf16x8 ah = __builtin_bit_cast(pg8::bf16x8, hp), al = __builtin_bit_cast(pg8::bf16x8, lp);
#pragma unroll
                    for (int nb = 0; nb < 3; ++nb) { dd[nb] = __builtin_amdgcn_mfma_f32_16x16x32_bf16(ah, wh[bj][nb], dd[nb], 0, 0, 0); dd[nb] = __builtin_amdgcn_mfma_f32_16x16x32_bf16(ah, wl[bj][nb], dd[nb], 0, 0, 0);
                        dd[nb] = __builtin_amdgcn_mfma_f32_16x16x32_bf16(al, wh[bj][nb], dd[nb], 0, 0, 0); } }
                ss += shx(ss, 16, lane); ss += shx(ss, 32, lane);
                acc[ai][0][m][0] = dd[0]; acc[ai][0][m][1] = dd[1]; acc[ai][1][m][0] = dd[2]; acc[ai][1][m][1].x = ss; }
#pragma unroll 1
        for (int ph = 0; ph < 2; ++ph) {
            if ((wc >> 1) == ph) { LAS float* tb = tab + (wc & 1) * 256 * PW;
#pragma unroll
                for (int ai = 0; ai < 2; ++ai)
#pragma unroll
                    for (int m = 0; m < 4; ++m) { const int rb = ai * 128 + wr * 64 + m * 16;
#pragma unroll
                        for (int nb = 0; nb < 3; ++nb) { const f32x4 d = nb == 0 ? acc[ai][0][m][0] : (nb == 1 ? acc[ai][0][m][1] : acc[ai][1][m][0]);
#pragma unroll
                            for (int e = 0; e < 4; ++e) { LAS float* q = tb + (rb + 4 * fq + e) * PW + nb * 16 + fr; if (ph == 0) *q = d[e]; else *q += d[e]; } }
                        if (fq == 0) { LAS float* q = tb + (rb + fr) * PW + 48; const float s = acc[ai][1][m][1].x; if (ph == 0) *q = s; else *q += s; } }
            }
            LDS_WAIT(); __builtin_amdgcn_s_barrier();
        }
        float* dst = SUMS + ((size_t)u.pn * T + (size_t)u.pm * 256) * 64;
#pragma unroll 4
        for (int i = tid; i < 256 * 64; i += 512) { const int r = i >> 6, c = i & 63; if (c < PW) dst[(size_t)r * 64 + c] = tab[r * PW + c] + tab[256 * PW + r * PW + c]; }
    }
};
constexpr int MOE_LDS = MISC_OFF + 128;
constexpr int MOE_SLOTS = 8;
template <bool DOWN_> struct MoeOrderT {
    static constexpr bool GATHER = !DOWN_; static constexpr int A_AUX = 0;
    const LAS int* toff; const LAS int* ulist; const LAS int* idx;
    int Kb, l, wave0;
    unsigned* tcnt; unsigned* tmo;
    __device__ __forceinline__ bool next(int i, Unit& u) const {
        if (i >= ulist[8]) return false;
        const int L = ulist[i]; u.pm = L >> 2; u.pn = L & 3; u.sl = i; int e = 0;
#pragma unroll 1
        for (int q = 1; q < NEXP; ++q) if (u.pm >= toff[q]) e = q;
        u.ex = e; return true;
    }
    __device__ __forceinline__ void a_ready(const Unit& u) const {
        if constexpr (DOWN_ && !MOE_BARRIER) {
            if (wave0 == 0) {
                unsigned* w = tcnt + u.pm * TCNT_STRIDE; unsigned sp = 0;
                while ((unsigned)__builtin_amdgcn_readfirstlane(__hip_atomic_load(w, __ATOMIC_RELAXED, __HIP_MEMORY_SCOPE_AGENT)) < 32u) {
                    __builtin_amdgcn_s_sleep(2);
                    if ((++sp & 255u) == 0u) { if (__hip_atomic_load(tmo, __ATOMIC_RELAXED, __HIP_MEMORY_SCOPE_AGENT) != 0u) break;
                        if (sp > (1u << 20)) { if (fresh_lane() == 0) __hip_atomic_store(tmo, 1u, __ATOMIC_RELAXED, __HIP_MEMORY_SCOPE_AGENT); break; } } }
                __builtin_amdgcn_fence(__ATOMIC_ACQUIRE, "agent");
                asm volatile("s_waitcnt vmcnt(0)" ::: "memory");
            }
            asm volatile("" ::: "memory"); __builtin_amdgcn_s_barrier(); asm volatile("" ::: "memory");
        }
    }
    __device__ __forceinline__ unsigned arow_off(const Unit& u, int r) const { const int as = idx[u.sl * 256 + r]; return (unsigned)(as < 0 ? 0 : (as >> 1)) * (unsigned)Kb; }
    __device__ __forceinline__ size_t a_off(const Unit& u) const { return (size_t)u.pm * 256 * (size_t)Kb; }
    __device__ __forceinline__ size_t b_off(const Unit& u) const { return ((size_t)(l * NEXP + u.ex) * 1024 + (size_t)u.pn * 256) * (size_t)Kb; }
};
template <bool DOWN_> __device__ __forceinline__ MoeOrderT<DOWN_> moe_order_setup(Frame& F, int l, int Kb) {
    LAS int* toff = (LAS int*)(F.lds + MOE_LDS); LAS int* ulist = toff + 40; LAS int* idx = (LAS int*)(F.lds + MOE_LDS + 256);
    const unsigned* cnt = F.ctl + CW_CNT + (size_t)l * NEXP * CNT_STRIDE;
    if (F.wave == 0) {
        const int ln = F.lane; int nt = ln < NEXP ? ((int)cnt[ln * CNT_STRIDE] + 255) >> 8 : 0, inc = nt;
#pragma unroll
        for (int o = 1; o < 64; o <<= 1) { const int u = __builtin_amdgcn_ds_bpermute(((ln - o) & 63) << 2, inc); if (ln >= o) inc += u; }
        if (ln < NEXP) toff[ln] = inc - nt;
        if (ln == NEXP - 1) toff[NEXP] = inc;
        const int U = __builtin_amdgcn_readlane(inc, NEXP - 1) * 4, G = F.G, c = F.vcu;
        if (ln == 0) { int n = 0;
#ifndef MOE_OLD_DEAL
#define MOE_OLD_DEAL 0
#endif
        if (!DOWN_ || MOE_OLD_DEAL) { for (int L = c; L < U && n < MOE_SLOTS; L += G) ulist[n++] = L; }
        else {
            const int r = U % G, NL = G - r, a = U < 2 * NL ? U : 2 * NL, base_low = a / NL, extra_low = a % NL, R = U - a, base_all = R / G, extra_all = R % G;
            const int ord = c >= r ? c - r : NL + c;
            const int nd = (ord < NL ? base_low + (ord < extra_low ? 1 : 0) : 0) + base_all + (ord < extra_all ? 1 : 0);
            int bp[5] = {0, extra_low < NL ? extra_low : NL, extra_all, NL, G};
            if (bp[1] > bp[2]) { const int t_ = bp[1]; bp[1] = bp[2]; bp[2] = t_; }
            if (bp[2] > bp[3]) { const int t_ = bp[2]; bp[2] = bp[3]; bp[3] = t_; }
            if (bp[1] > bp[2]) { const int t_ = bp[1]; bp[1] = bp[2]; bp[2] = t_; }
            int S = 0;
            for (int k = 0; k < nd && n < MOE_SLOTS; ++k) {
                ulist[n++] = S + ord;
                int cntk = 0;
#pragma unroll
                for (int q = 0; q < 4; ++q) { const int o = bp[q], oe = bp[q + 1]; const int ndo = (o < NL ? base_low + (o < extra_low ? 1 : 0) : 0) + base_all + (o < extra_all ? 1 : 0); if (oe > o && ndo > k) cntk += oe - o; }
                S += cntk; }
        }
        ulist[8] = n; }
    }
    __syncthreads();
    MoeOrderT<DOWN_> S; S.toff = toff; S.ulist = ulist; S.idx = idx; S.Kb = Kb; S.l = l; S.wave0 = F.wave0;
    S.tcnt = F.ctl + CW_TCNT + (size_t)l * MAX_TILES * TCNT_STRIDE; S.tmo = F.ctl + CW_TMO;
    const int* LIST = (const int*)(F.ws + WS_LIST);
    Unit u;
    for (int i = 0; S.next(i, u); ++i) {
        if (F.tid < 256) { const int r = (u.pm - toff[u.ex]) * 256 + F.tid; idx[i * 256 + F.tid] = r < (int)cnt[u.ex * CNT_STRIDE] ? LIST[(size_t)u.ex * T + r] : -1; }
    }
    __syncthreads();
    return S;
}
#ifndef HID_PLAIN
#define HID_PLAIN 0
#endif
struct EpiGateUp {
    static constexpr int BMODE = 1; static constexpr bool CHAIN2 = false, AFTER_DRAIN = false;
    bf16* HID; const float* GWT; const float* RSTD; const LAS int* idx; unsigned* tcnt;
    __device__ __forceinline__ void operator()(f32x4 (&acc)[2][2][4][2], const Unit& u, int wr, int wc, int fr, int fq) const {
#pragma unroll
        for (int ai = 0; ai < 2; ++ai)
#pragma unroll
            for (int m = 0; m < 4; ++m) { const int r = ai * 128 + wr * 64 + m * 16 + fr; const int as = idx[u.sl * 256 + r];
                const float w = as < 0 ? 0.f : GWT[as]; const float rs = as < 0 ? 0.f : RSTD[as >> 1];
                const f32x4 g0 = acc[ai][0][m][0] * rs, g1 = acc[ai][0][m][1] * rs, u0 = acc[ai][1][m][0] * rs, u1 = acc[ai][1][m][1] * rs;
                f32x4 h0, h1;
#pragma unroll
                for (int e = 0; e < 4; ++e) { h0[e] = g0[e] * sigmoidf_(g0[e]) * u0[e] * w; h1[e] = g1[e] * sigmoidf_(g1[e]) * u1[e] * w; }
                if (as < 0) { h0 = (f32x4){0.f, 0.f, 0.f, 0.f}; h1 = h0; }
                pg8::u32x4 o; o.x = pg8::cvt_pk_bf16(h0.x, h0.y); o.y = pg8::cvt_pk_bf16(h0.z, h0.w); o.z = pg8::cvt_pk_bf16(h1.x, h1.y); o.w = pg8::cvt_pk_bf16(h1.z, h1.w);
#if HID_PLAIN
                *(pg8::u32x4*)(HID + (size_t)(u.pm * 256 + r) * FF + u.pn * 128 + wc * 32 + 8 * fq) = o; }
#else
                asm volatile("global_store_dwordx4 %0, %1, off sc1\n\ts_nop 1" :: "v"(HID + (size_t)(u.pm * 256 + r) * FF + u.pn * 128 + wc * 32 + 8 * fq), "v"(o) : "memory"); }
#endif
#if !MOE_BARRIER
        asm volatile("s_waitcnt vmcnt(0)" ::: "memory");
        if (fr == 0 && fq == 0) __hip_atomic_fetch_add(tcnt + u.pm * TCNT_STRIDE, 1u, __ATOMIC_RELAXED, __HIP_MEMORY_SCOPE_AGENT);
#endif
    }
};
struct EpiDown {
    static constexpr int BMODE = 2; static constexpr bool CHAIN2 = false, AFTER_DRAIN = false;
    bf16* Y; const LAS int* idx;
    __device__ __forceinline__ void operator()(f32x4 (&acc)[2][2][4][2], const Unit& u, int wr, int wc, int fr, int fq) const {
#pragma unroll
        for (int ai = 0; ai < 2; ++ai)
#pragma unroll
            for (int m = 0; m < 4; ++m) { const int r = ai * 128 + wr * 64 + m * 16 + fr; const int as = idx[u.sl * 256 + r];
                if (as >= 0) { bf16* yp = Y + (size_t)(as & 1) * T * D + (size_t)(as >> 1) * D + u.pn * 256 + wc * 64 + 8 * fq;
#pragma unroll
                    for (int bj = 0; bj < 2; ++bj) { const f32x4 v0 = acc[ai][bj][m][0], v1 = acc[ai][bj][m][1];
                        pg8::u32x4 o; o.x = pg8::cvt_pk_bf16(v0.x, v0.y); o.y = pg8::cvt_pk_bf16(v0.z, v0.w); o.z = pg8::cvt_pk_bf16(v1.x, v1.y); o.w = pg8::cvt_pk_bf16(v1.z, v1.w);
                        *(pg8::u32x4*)(yp + bj * 32) = o; } } }
    }
};

__device__ __forceinline__ void phase_inproj(Frame& F, int l) {
    pg8::StaticOrder S; S.init(T, NP, D, F.G, F.bx);
    EpiInproj E{(bf16*)(F.ws + WS_QKVG), (const float*)(F.ws + WS_GT) + l * 256, (const float*)(F.ws + WS_COSSIN)};
    pg8::gemm_phase<EpiInproj, pg8::StaticOrder, true>(F.lds + RING_OFF, F.wave0, (const bf16*)(F.ws + WS_HN), (const bf16*)(F.ws + WS_WIN) + (size_t)l * NP * D, D, S, E);
}
struct YZOrder : pg8::StaticOrder {
    size_t aof, bof;
    __device__ __forceinline__ bool next(int i, Unit& u) const { const bool ok = pg8::StaticOrder::next(i >> 1, u); u.ex = i & 1; return ok; }
    __device__ __forceinline__ size_t a_off(const Unit& u) const { return pg8::StaticOrder::a_off(u) + (u.ex ? aof : (size_t)0); }
    __device__ __forceinline__ size_t b_off(const Unit& u) const { return pg8::StaticOrder::b_off(u) + (u.ex ? bof : (size_t)0); }
};
struct EpiYZm {
    static constexpr int BMODE = 2; static constexpr bool CHAIN2 = true, AFTER_DRAIN = false;
    bf16* Z; const bf16* GA; const bf16* GF;
    __device__ __forceinline__ void operator()(f32x4 (&acc)[2][2][4][2], const Unit& u, int wr, int wc, int fr, int fq) const {
#pragma unroll
        for (int ai = 0; ai < 2; ++ai)
#pragma unroll
            for (int m = 0; m < 4; ++m) { const int row = u.pm * 256 + ai * 128 + wr * 64 + m * 16 + fr;
#pragma unroll
                for (int bj = 0; bj < 2; ++bj) { const int col = u.pn * 256 + wc * 64 + bj * 32 + 8 * fq;
                    const pg8::u32x4 fw = *(const pg8::u32x4*)(GF + (size_t)row * NP + col);
                    f32x4 f0 = (f32x4){bflo(fw.x), bfhi(fw.x), bflo(fw.y), bfhi(fw.y)}, f1 = (f32x4){bflo(fw.z), bfhi(fw.z), bflo(fw.w), bfhi(fw.w)};
#pragma unroll
                    for (int e = 0; e < 4; ++e) { f0[e] = fmaxf(f0[e], 1e-20f); f1[e] = fmaxf(f1[e], 1e-20f); }
                    if (u.ex == 0) {
                        const pg8::u32x4 aw = *(const pg8::u32x4*)(GA + (size_t)row * NP + col);
                        const f32x4 a0 = (f32x4){bflo(aw.x), bfhi(aw.x), bflo(aw.y), bfhi(aw.y)}, a1 = (f32x4){bflo(aw.z), bfhi(aw.z), bflo(aw.w), bfhi(aw.w)};
#pragma unroll
                        for (int e = 0; e < 4; ++e) { acc[ai][bj][m][0][e] *= a0[e] * __builtin_amdgcn_rcpf(f0[e]); acc[ai][bj][m][1][e] *= a1[e] * __builtin_amdgcn_rcpf(f1[e]); }
                    } else {
                        const f32x4 v0 = acc[ai][bj][m][0] * f0, v1 = acc[ai][bj][m][1] * f1;
                        pg8::u32x4 w; w.x = pg8::cvt_pk_bf16(v0.x, v0.y); w.y = pg8::cvt_pk_bf16(v0.z, v0.w); w.z = pg8::cvt_pk_bf16(v1.x, v1.y); w.w = pg8::cvt_pk_bf16(v1.z, v1.w);
                        *(pg8::u32x4*)(Z + (size_t)row * D + col) = w; } } }
    }
};
__device__ __forceinline__ void phase_yz(Frame& F, int l) {
    YZOrder S; S.init(T, D, 512, F.G, F.bx);
    S.aof = (size_t)((const char*)(F.ws + WS_OF) - (const char*)(F.ws + WS_AD)); S.bof = (size_t)((const char*)(F.ws + WS_WF) - (const char*)(F.ws + WS_WD));
    EpiYZm E{(bf16*)(F.ws + WS_Z), (const bf16*)(F.ws + WS_QKVG) + C_GA, (const bf16*)(F.ws + WS_QKVG) + C_GF};
    pg8::gemm_phase<EpiYZm, YZOrder, true>(F.lds + RING_OFF, F.wave0, (const bf16*)(F.ws + WS_AD), (const bf16*)(F.ws + WS_WD) + (size_t)l * D * 512, 512, S, E);
}
__device__ __forceinline__ void phase_wo(Frame& F, int l, bool dry = false) {
    pg8::StaticOrder S; S.init(T, D, D, F.G, F.bx);
    EpiWoR E{F.out, (l == 0 && !dry) ? (const float*)F.in[I_X] : (const float*)F.out, (bf16*)(F.ws + WS_HN), (const float*)F.in[I_LN2] + (size_t)l * D, (const bf16*)(F.ws + WS_WRT) + (size_t)l * 2 * 48 * D, (float*)(F.ws + WS_SUMS), dry};
    pg8::gemm_phase<EpiWoR, pg8::StaticOrder, true>(F.lds + RING_OFF, F.wave0, (const bf16*)(F.ws + WS_Z), (const bf16*)(F.ws + WS_WO) + (size_t)l * D * D, D, S, E);
}
__device__ __forceinline__ void phase_gateup(Frame& F, int l) {
    const MoeOrderT<false> S = moe_order_setup<false>(F, l, D * 2);
    EpiGateUp E{(bf16*)(F.ws + WS_HID), (const float*)(F.ws + WS_GWT), (const float*)(F.ws + WS_RSTD), S.idx, S.tcnt};
    pg8::gemm_phase<EpiGateUp, MoeOrderT<false>, true>(F.lds + RING_OFF, F.wave0, (const bf16*)(F.ws + WS_HN), (const bf16*)(F.ws + WS_WGU), D, S, E);
}
__device__ __forceinline__ void phase_down(Frame& F, int l) {
    const MoeOrderT<true> S = moe_order_setup<true>(F, l, FF * 2);
    EpiDown E{(bf16*)(F.ws + WS_Y), S.idx};
    pg8::gemm_phase<EpiDown, MoeOrderT<true>, true>(F.lds + RING_OFF, F.wave0, (const bf16*)(F.ws + WS_HID), (const bf16*)(F.ws + WS_WDN), FF, S, E);
}
#include <hip/hip_bf16.h>
namespace attn_body {
using bf16=__hip_bfloat16;
using bf16x8=__attribute__((ext_vector_type(8)))short;
using s16x4=__attribute__((ext_vector_type(4)))short;
using f32x16=__attribute__((ext_vector_type(16)))float;
using u32x4=__attribute__((ext_vector_type(4)))unsigned;
constexpr int SEQ=8192,D=64,DM=5120;
constexpr int NW=8,QBLK=32,QB=QBLK*NW,KVBLK=64,NQB=SEQ/QB;
constexpr int ATTN_UNIT_ROWS=QB;
__device__ __forceinline__ int crow(int r,int hi){return (r&3)+8*(r>>2)+4*hi;}
#define SBAR() __builtin_amdgcn_sched_barrier(0)
__device__ __forceinline__ void cmask(f32x16&p0,f32x16&p1,int jb,int qrel,int hi){
  const float NEG=-INFINITY; int kb=64*jb+4*hi;
  #pragma unroll
  for(int r=0;r<16;++r){int kv=kb+(r&3)+8*(r>>2); if(kv>qrel)p0[r]=NEG; if(kv+32>qrel)p1[r]=NEG;}
}

constexpr int NSLOT=3, SLOTB=8192;
constexpr int LDS_K=0, LDS_V=NSLOT*SLOTB;
template<int DV> struct Lay { static constexpr int VM=DV/64, WS=LDS_V+NSLOT*SLOTB*VM, OST=WS+NW*64*4, CK=OST+NW*4096, BYTES=CK+(DV==64?SEQ*4+512:0); };
constexpr float C2=0.125f*1.4426950408889634f;
__device__ __forceinline__ void glds16(const void*gsrc,unsigned lds_dst){unsigned keep;
  asm volatile("s_mov_b32 %0, m0\n\ts_mov_b32 m0, %2\n\ts_nop 0\n\tglobal_load_lds_dwordx4 %1, off\n\ts_mov_b32 m0, %0":"=&s"(keep):"v"(gsrc),"s"(lds_dst):"memory");}
__device__ __forceinline__ float max3f(float a,float b,float c){float r;asm("v_max3_f32 %0, %1, %2, %3":"=v"(r):"v"(a),"v"(b),"v"(c));return r;}
__device__ __forceinline__ float max2f(float a,float b){float r;asm("v_max_f32_e32 %0, %1, %2":"=v"(r):"v"(a),"v"(b));return r;}
__device__ __forceinline__ float fadd_s(float a,float b){float r;asm("v_add_f32_e32 %0, %1, %2":"=v"(r):"v"(a),"v"(b));return r;}
__device__ __forceinline__ float fsub_s(float a,float b){float r;asm("v_sub_f32_e32 %0, %1, %2":"=v"(r):"v"(a),"v"(b));return r;}
typedef float f32x2_t __attribute__((ext_vector_type(2))); typedef __bf16 bf16x2_t __attribute__((ext_vector_type(2)));
__device__ __forceinline__ unsigned cvtpk_s(float lo,float hi){f32x2_t v={lo,hi};bf16x2_t b=__builtin_convertvector(v,bf16x2_t);return __builtin_bit_cast(unsigned,b);}
#define WAIT_BAR(N) asm volatile("s_waitcnt vmcnt(" #N ") lgkmcnt(0)\n\ts_barrier":::"memory")

__device__ __forceinline__ void qkt(f32x16&p0,f32x16&p1,const char*Kslot,const bf16x8*qr,int r32,int hi){
  const char*kb=Kslot+hi*1024+r32*16;
  #pragma unroll
  for(int d0=0;d0<4;++d0){
    const bf16x8 b0=*reinterpret_cast<const bf16x8*>(kb+d0*2048);
    const bf16x8 b1=*reinterpret_cast<const bf16x8*>(kb+d0*2048+512);
    if(d0==0){p0=__builtin_amdgcn_mfma_f32_32x32x16_bf16(b0,qr[0],p0,0,0,0);p1=__builtin_amdgcn_mfma_f32_32x32x16_bf16(b1,qr[0],p1,0,0,0);}
    else{p0=__builtin_amdgcn_mfma_f32_32x32x16_bf16(b0,qr[d0],p0,0,0,0);p1=__builtin_amdgcn_mfma_f32_32x32x16_bf16(b1,qr[d0],p1,0,0,0);}}
}
typedef __attribute__((address_space(3))) const char* lds_cptr;
typedef short v4i16_t __attribute__((ext_vector_type(4)));
__device__ __forceinline__ void kload8(bf16x8*kf,lds_cptr kp){
  kf[0]=*(const __attribute__((address_space(3))) bf16x8*)(kp);      kf[1]=*(const __attribute__((address_space(3))) bf16x8*)(kp+512);
  kf[2]=*(const __attribute__((address_space(3))) bf16x8*)(kp+2048); kf[3]=*(const __attribute__((address_space(3))) bf16x8*)(kp+2560);
  kf[4]=*(const __attribute__((address_space(3))) bf16x8*)(kp+4096); kf[5]=*(const __attribute__((address_space(3))) bf16x8*)(kp+4608);
  kf[6]=*(const __attribute__((address_space(3))) bf16x8*)(kp+6144); kf[7]=*(const __attribute__((address_space(3))) bf16x8*)(kp+6656);
}
__device__ __forceinline__ void kload2(bf16x8*kf,lds_cptr kp,int j){ kf[2*j]=*(const __attribute__((address_space(3))) bf16x8*)(kp+j*2048); kf[2*j+1]=*(const __attribute__((address_space(3))) bf16x8*)(kp+j*2048+512); }
__device__ __forceinline__ s16x4 vtr(lds_cptr p){ return __builtin_bit_cast(s16x4,__builtin_amdgcn_ds_read_tr16_b64_v4i16((__attribute__((address_space(3))) v4i16_t*)p)); }
__device__ __forceinline__ float rowmax(const f32x16&p0,const f32x16&p1){
  float a=max3f(p0[0],p0[1],p1[0]),b=max3f(p0[2],p0[3],p1[1]);a=max3f(a,p1[2],p1[3]);
  #pragma unroll
  for(int r=4;r<16;r+=4){a=max3f(a,p0[r],p0[r+1]);b=max3f(b,p0[r+2],p0[r+3]);a=max3f(a,p1[r],p1[r+1]);b=max3f(b,p1[r+2],p1[r+3]);}
  const float m=max2f(a,b);
  auto rr=__builtin_amdgcn_permlane32_swap(__float_as_uint(m),__float_as_uint(m),false,false);
  return max2f(__uint_as_float(rr[0]),__uint_as_float(rr[1]));
}
template<int NO> __device__ __forceinline__ void pv(f32x16*o,int vb,bf16x8 pa0,bf16x8 pa1,bf16x8 pa2,bf16x8 pa3){
  #pragma unroll
  for(int d0=0;d0<NO;++d0){s16x4 lo[4],hi[4];
    #pragma unroll
    for(int ks=0;ks<4;++ks){
      asm volatile("ds_read_b64_tr_b16 %0,%1 offset:%c2":"=&v"(lo[ks]):"v"(vb),"i"(d0*4096+ks*1024):"memory");
      asm volatile("ds_read_b64_tr_b16 %0,%1 offset:%c2":"=&v"(hi[ks]):"v"(vb),"i"(d0*4096+ks*1024+512):"memory");}
    asm volatile("s_waitcnt lgkmcnt(0)":::"memory");SBAR();
    #define PK(k) (bf16x8){lo[k][0],lo[k][1],lo[k][2],lo[k][3],hi[k][0],hi[k][1],hi[k][2],hi[k][3]}
    o[d0]=__builtin_amdgcn_mfma_f32_32x32x16_bf16(pa0,PK(0),o[d0],0,0,0);
    o[d0]=__builtin_amdgcn_mfma_f32_32x32x16_bf16(pa1,PK(1),o[d0],0,0,0);
    o[d0]=__builtin_amdgcn_mfma_f32_32x32x16_bf16(pa2,PK(2),o[d0],0,0,0);
    o[d0]=__builtin_amdgcn_mfma_f32_32x32x16_bf16(pa3,PK(3),o[d0],0,0,0);
    #undef PK
  }
}

typedef float f32x4_t __attribute__((ext_vector_type(4)));
__device__ __forceinline__ void bias_fill(f32x16&c0,f32x16&c1,float base,const __attribute__((address_space(3))) float*ck,int hi){
  #pragma unroll
  for(int g=0;g<4;++g){const f32x4_t a=*(const __attribute__((address_space(3))) f32x4_t*)(ck+8*g+4*hi),b=*(const __attribute__((address_space(3))) f32x4_t*)(ck+32+8*g+4*hi);
    #pragma unroll
    for(int e=0;e<4;++e){c0[4*g+e]=base-a[e];c1[4*g+e]=base-b[e];}}
}
typedef __attribute__((address_space(3))) const float* lds_fptr;
__device__ __forceinline__ void ck_load(f32x4_t (&ka)[4],f32x4_t (&kb)[4],lds_fptr ck,int hi){
  #pragma unroll
  for(int g=0;g<4;++g){ka[g]=*(const __attribute__((address_space(3))) f32x4_t*)(ck+8*g+4*hi);kb[g]=*(const __attribute__((address_space(3))) f32x4_t*)(ck+32+8*g+4*hi);}
}
__device__ __forceinline__ void ck_apply(f32x16&c0,f32x16&c1,const f32x4_t (&ka)[4],const f32x4_t (&kb)[4],float add){
  #pragma unroll
  for(int g=0;g<4;++g){
    #pragma unroll
    for(int e=0;e<4;++e){c0[4*g+e]=(c0[4*g+e]-ka[g][e])+add;c1[4*g+e]=(c1[4*g+e]-kb[g][e])+add;}}
}
__device__ __forceinline__ void ck_sub(f32x16&c0,f32x16&c1,const f32x4_t (&ka)[4],const f32x4_t (&kb)[4]){
  #pragma unroll
  for(int g=0;g<4;++g){
    #pragma unroll
    for(int e=0;e<4;++e){c0[4*g+e]-=ka[g][e];c1[4*g+e]-=kb[g][e];}}
}
template<bool BIAS> __device__ __forceinline__ void cfill(f32x16&c0,f32x16&c1,float base,const __attribute__((address_space(3))) float*ck,int hi){
  if(BIAS)bias_fill(c0,c1,base,ck,hi);
  else{
    #pragma unroll
    for(int r=0;r<16;++r){c0[r]=base;c1[r]=base;} }
}
#ifndef ATTN_STORE16
#define ATTN_STORE16(p,v) asm volatile("global_store_dwordx4 %0, %1, off sc1\n\ts_nop 1"::"v"(p),"v"(v):"memory")
#endif
__device__ __forceinline__ int fox_t0(int qb,const float*cum,float thr,int lane){
  const int q0=qb*QB,NTf=(q0+QB)/KVBLK; const float cq0=cum[q0];
  const int t1=lane,t2=lane+64;
  const bool ok1=(t1>=NTf-4)||(cq0-cum[64*t1+63]>=-thr), ok2=(t2>=NTf-4)||(cq0-cum[(t2<NTf?64*t2+63:q0)]>=-thr);
  const unsigned long long m1=__ballot(ok1),m2=__ballot(ok2);
  int T0=m1?__builtin_ctzll(m1):(m2?64+__builtin_ctzll(m2):NTf-4); T0&=~1; if(T0>NTf-4)T0=NTf-4; return __builtin_amdgcn_readfirstlane(T0);
}
template<int THRL,bool BIAS,int OP,int DV,bool NOREF> __device__ __forceinline__ void attn_unit(int qb,const bf16*Qb,const bf16*__restrict__ Kh0,const bf16*__restrict__ Vh0,bf16*Ob,const float*cum,float thr,char*shm,const int wave0,const int T0in=-1){
  constexpr int NO=DV/32, VM=DV/64; static_assert(DV==64||(DV==128&&!BIAS),"DV"); static_assert(!(NOREF&&BIAS),"NOREF");
  const int tid=fresh_tid(wave0); const int lane=tid&63,r32=lane&31,hi=lane>>5; const int wid=__builtin_amdgcn_readfirstlane(tid>>6);
  const int q0=qb*QB;
  const bf16*Qw=Qb+(long)(q0+wid*QBLK)*DM;
  int T0=0;
  if(BIAS){ T0=T0in>=0?T0in:fox_t0(qb,cum,thr,lane); }
  const bf16*Kh=Kh0+(long)T0*KVBLK*DM; const bf16*Vh=Vh0+(long)T0*KVBLK*DM;
  const unsigned lds0=(unsigned)(uintptr_t)shm;
  float*wsf=(float*)(shm+Lay<DV>::WS)+wid*64;
  const bf16*ksrc=Kh+(long)lane*DM+wid*8;
  const bf16*vsrc=Vh+(long)(16*(wid&3)+(lane>>2))*DM+(wid>>2)*32+(lane&3)*8;
  const unsigned kdst=lds0+LDS_K+wid*1024, vdst=lds0+LDS_V+wid*1024;
  #define DMA_K(t,slot) glds16(ksrc+(long)(t)*KVBLK*DM,(unsigned)__builtin_amdgcn_readfirstlane(kdst+(slot)))
  #define DMA_V(t,slot) do{ glds16(vsrc+(long)(t)*KVBLK*DM,(unsigned)__builtin_amdgcn_readfirstlane(vdst+(slot)*VM)); if(DV==128)glds16(vsrc+64+(long)(t)*KVBLK*DM,(unsigned)__builtin_amdgcn_readfirstlane(vdst+(slot)*VM+8192)); }while(0)
  const int vb0=(int)(lds0+LDS_V)+((lane>>4)&1)*32+(lane&3)*8+(4*hi+((lane&15)>>2))*64;
  const char*Kbase=shm+LDS_K; bf16x8 kf[8];
  const lds_cptr shm3=(lds_cptr)shm; const lds_cptr kp0=shm3+LDS_K+hi*1024+r32*16; const lds_cptr vp0=shm3+LDS_V+((lane>>4)&1)*32+(lane&3)*8+(4*hi+((lane&15)>>2))*64;
  const int NT=(q0+QB)/KVBLK-T0;
  const __attribute__((address_space(3))) float*ckl=(const __attribute__((address_space(3))) float*)(shm3+Lay<DV>::CK); float cq=0.f,cqm=0.f;
  const lds_fptr cl=ckl+NT*64; float fu=1.f;
  DMA_K(0,0);DMA_V(0,0);DMA_K(1,SLOTB);
  bf16x8 qr[4];
  #pragma unroll
  for(int d0=0;d0<4;++d0)qr[d0]=*reinterpret_cast<const bf16x8*>(&Qw[(long)r32*DM+d0*16+hi*8]);
  if(BIAS){ __attribute__((address_space(3))) f32x4_t*cw=(__attribute__((address_space(3))) f32x4_t*)(shm3+Lay<DV>::CK);
    for(int i=tid;i<NT*16;i+=NW*64){ const f32x4_t v=*(const f32x4_t*)(cum+64*T0+4*i); const float last=cum[64*T0+(i>>4)*64+63]; cw[i]=v-last; }
    __attribute__((address_space(3))) float*clw=(__attribute__((address_space(3))) float*)(shm3+Lay<DV>::CK)+NT*64;
    for(int t_=tid;t_<NT;t_+=NW*64)clw[t_]=cum[64*(T0+t_)+63];
    cq=cum[q0+wid*QBLK+r32]; cqm=cq; }
  float mhat=0.f,l_reg=0.f;f32x16 o[NO];
  #pragma unroll
  for(int d_=0;d_<NO;++d_)o[d_]=f32x16{};

  const int qrel=wid*QBLK+r32;
  #define CMASK(P0,P1,t) do{int jb_=(t)-(NT-4); if(jb_>=0)cmask(P0,P1,jb_,qrel,hi);}while(0)
  int resc=0;
  #define START(P0,P1) do{ resc=0; if constexpr(!NOREF&&!BIAS) { const float rm=rowmax(P0,P1); const float dl=rm; mhat=fadd_s(mhat,dl); \
      _Pragma("unroll") for(int r=0;r<16;++r){P0[r]=fsub_s(P0[r],dl);P1[r]=fsub_s(P1[r],dl);} \
      cqm=cq-mhat; } \
    _Pragma("unroll") for(int r=0;r<16;++r)P0[r]=__builtin_amdgcn_exp2f(P0[r]); }while(0)
  #define RESC() do{ if constexpr(!NOREF){ if(BIAS&&resc==1){ _Pragma("unroll") for(int d_=0;d_<NO;++d_) _Pragma("unroll") for(int r=0;r<16;++r)o[d_][r]*=fu; } \
    else if(resc){ asm volatile("s_waitcnt lgkmcnt(0)":::"memory"); \
      _Pragma("unroll") for(int d_=0;d_<NO;++d_) _Pragma("unroll") for(int r=0;r<16;++r)o[d_][r]*=wsf[crow(r,hi)]; } } }while(0)
  f32x16 pA0,pA1,pB0,pB1;
  int sl_prev=0,sl_cur=0,sl_next=SLOTB;
  #define ROT() do{sl_prev=sl_cur;sl_cur=sl_next;sl_next=(sl_next==(NSLOT-1)*SLOTB)?0:sl_next+SLOTB;}while(0)
  DMA_K(2,2*SLOTB);
  if constexpr(DV==128){WAIT_BAR(4);}else{WAIT_BAR(3);}
  if constexpr(NOREF||BIAS){pA0=f32x16{};pA1=f32x16{};}else{cfill<BIAS>(pA0,pA1,cqm,ckl,hi);}
  qkt(pA0,pA1,Kbase,qr,r32,hi);asm volatile("s_nop 15\n\ts_nop 7":"+v"(pA0),"+v"(pA1));
  if constexpr(BIAS){ f32x4_t ka_[4],kb_[4]; ck_load(ka_,kb_,ckl,hi); ck_apply(pA0,pA1,ka_,kb_,NT==4?cq-cl[0]:0.f); }
  CMASK(pA0,pA1,0);
  START(pA0,pA1);
  _Pragma("unroll") for(int r=0;r<16;++r)pA1[r]=__builtin_amdgcn_exp2f(pA1[r]);
  WAIT_BAR(0);
  DMA_K(3,0);DMA_V(1,SLOTB);
  ROT();
  kload8(kf,kp0+sl_cur);
  if constexpr(DV==128){WAIT_BAR(3);}else{WAIT_BAR(2);}
  s16x4 vlo[8],vhi[8]; u32x4 pw0,pw1,pw2,pw3;
  #define PKW(P,B) cvtpk_s(P[B],P[B+1])
  #define PAF(k) __builtin_bit_cast(bf16x8,pw##k)
  #define VFR(i) (bf16x8){vlo[i][0],vlo[i][1],vlo[i][2],vlo[i][3],vhi[i][0],vhi[i][1],vhi[i][2],vhi[i][3]}
  #define PIN(x) asm volatile("":"+v"(x))
  #define MX3(a,b,c) __builtin_fmaxf(__builtin_fmaxf((a),(b)),(c))
  #define GAPA(MF,A0,A1,A2,A3,W0,W1,PW) do{ MF; sacc+=A0; sacc+=A1; sacc+=A2; sacc+=A3; PIN(sacc); W0; W1; PIN(PW); SBAR(); }while(0)
  #define EX(v) __builtin_amdgcn_exp2f(v)
  #define GAPB(MF,X,B) do{ MF; X[B]=EX(X[B]); X[B+1]=EX(X[B+1]); X[B+2]=EX(X[B+2]); X[B+3]=EX(X[B+3]); PIN(X); SBAR(); }while(0)
  #define GAPC(MF,X,B,RL) do{ MF; X[B]=EX(X[B]); X[B+1]=EX(X[B+1]); PIN(X); RL; SBAR(); }while(0)
  #define VRD2(i) do{ vlo[i]=vtr(vp_+((((i)>>2)+2)*4096+((i)&3)*1024)); vhi[i]=vtr(vp_+((((i)>>2)+2)*4096+((i)&3)*1024+512)); }while(0)
  #define VRD(i) do{ vlo[i]=vtr(vp_+(((i)>>2)*4096+((i)&3)*1024)); vhi[i]=vtr(vp_+(((i)>>2)*4096+((i)&3)*1024+512)); }while(0)
  #define KRD(G,j) do{ if(G){ kload2(kf,kp0+sl_next,j); SBAR(); } }while(0)
  #define CIN(X) (X)
  #define STEP(C0,C1,P0,P1,t,GK,GV,GL,BND) do{ SBAR(); \
    const lds_cptr vp_=vp0+sl_prev*VM; \
    f32x4_t ka_[4],kb_[4]; \
    if constexpr(NOREF||BIAS){C0=f32x16{};C1=f32x16{};}else{cfill<BIAS>(C0,C1,cqm,ckl+64*(t),hi);} SBAR(); \
    VRD(0); SBAR(); float sacc=(P0[0]+P0[1]); \
    GAPA(C0=__builtin_amdgcn_mfma_f32_32x32x16_bf16(kf[0],qr[0],CIN(C0),0,0,0), P0[2],P0[3],P0[4],P0[5],     pw0[0]=PKW(P0,0), pw0[1]=PKW(P0,2), pw0); \
    VRD(4); SBAR(); GAPA(C1=__builtin_amdgcn_mfma_f32_32x32x16_bf16(kf[1],qr[0],CIN(C1),0,0,0), P0[6],P0[7],P0[8],P0[9],     pw0[2]=PKW(P0,4), pw0[3]=PKW(P0,6), pw0); \
    VRD(1); SBAR(); GAPA(C0=__builtin_amdgcn_mfma_f32_32x32x16_bf16(kf[2],qr[1],C0,0,0,0),   P0[10],P0[11],P0[12],P0[13], pw1[0]=PKW(P0,8), pw1[1]=PKW(P0,10), pw1); \
    VRD(5); SBAR(); GAPA(C1=__builtin_amdgcn_mfma_f32_32x32x16_bf16(kf[3],qr[1],C1,0,0,0),   P0[14],P0[15],P1[0],P1[1],   pw1[2]=PKW(P0,12),pw1[3]=PKW(P0,14), pw1); \
    VRD(2); SBAR(); GAPA(C0=__builtin_amdgcn_mfma_f32_32x32x16_bf16(kf[4],qr[2],C0,0,0,0),   P1[2],P1[3],P1[4],P1[5],     pw2[0]=PKW(P1,0), pw2[1]=PKW(P1,2), pw2); \
    if constexpr(BIAS){ck_load(ka_,kb_,ckl+64*(t),hi); SBAR();} \
    VRD(6); SBAR(); GAPA(C1=__builtin_amdgcn_mfma_f32_32x32x16_bf16(kf[5],qr[2],C1,0,0,0),   P1[6],P1[7],P1[8],P1[9],     pw2[2]=PKW(P1,4), pw2[3]=PKW(P1,6), pw2); \
    VRD(3); SBAR(); GAPA(C0=__builtin_amdgcn_mfma_f32_32x32x16_bf16(kf[6],qr[3],C0,0,0,0),   P1[10],P1[11],P1[12],P1[13], pw3[0]=PKW(P1,8), pw3[1]=PKW(P1,10), pw3); \
    VRD(7); SBAR(); GAPA(C1=__builtin_amdgcn_mfma_f32_32x32x16_bf16(kf[7],qr[3],C1,0,0,0),   P1[14],P1[15],0.f,0.f,       pw3[2]=PKW(P1,12),pw3[3]=PKW(P1,14), pw3); \
    l_reg+=sacc; \
    if(GK){DMA_K((t)+3,sl_cur);} if(GV){DMA_V((t)+1,sl_next);} \
    if constexpr(BIAS){ const bool bnd_=(BND)&&((t)>=NT-4); if constexpr((BND)==0){ck_sub(C0,C1,ka_,kb_);}else{ck_apply(C0,C1,ka_,kb_,bnd_?cq-cl[(t)]:0.f);} \
      if(!bnd_){ fu=__builtin_amdgcn_exp2f(cl[(t)]-cl[(t)-1]); l_reg*=fu; resc=1; } \
      else if((t)==NT-4){ const float f_=__builtin_amdgcn_exp2f(cq-cl[(t)-1]); l_reg*=f_; if(hi==0)wsf[r32]=f_; resc=2; } \
      else resc=0; } \
    CMASK(C0,C1,t); \
    if constexpr(!NOREF&&!BIAS){ float a=MX3(C0[0],C0[1],C1[0]),b=MX3(C0[2],C0[3],C1[1]); a=MX3(a,C1[2],C1[3]); \
      _Pragma("unroll") for(int r=4;r<16;r+=4){a=MX3(a,C0[r],C0[r+1]);b=MX3(b,C0[r+2],C0[r+3]);a=MX3(a,C1[r],C1[r+1]);b=MX3(b,C1[r+2],C1[r+3]);} \
      float rm=__builtin_fmaxf(a,b); { auto rr=__builtin_amdgcn_permlane32_swap(__float_as_uint(rm),__float_as_uint(rm),false,false); rm=__builtin_fmaxf(__uint_as_float(rr[0]),__uint_as_float(rr[1])); } \
      resc=0; \
      if(__builtin_expect(__any(rm>(float)THRL),0)){ const float dl=__builtin_fmaxf(rm,0.f); mhat+=dl; \
        _Pragma("unroll") for(int r=0;r<16;++r){C0[r]-=dl;C1[r]-=dl;} \
        cqm=cq-mhat; \
        const float f=__builtin_amdgcn_exp2f(-dl); l_reg*=f; if(hi==0)wsf[r32]=f; resc=2; } } \
    SBAR(); \
    if constexpr(DV==64){ \
    GAPB(o[0]=__builtin_amdgcn_mfma_f32_32x32x16_bf16(PAF(0),VFR(0),o[0],0,0,0), C0,0); \
    GAPB(o[1]=__builtin_amdgcn_mfma_f32_32x32x16_bf16(PAF(0),VFR(4),o[1],0,0,0), C0,4); \
    KRD(GL,0); GAPB(o[0]=__builtin_amdgcn_mfma_f32_32x32x16_bf16(PAF(1),VFR(1),o[0],0,0,0), C0,8); \
    KRD(GL,1); GAPB(o[1]=__builtin_amdgcn_mfma_f32_32x32x16_bf16(PAF(1),VFR(5),o[1],0,0,0), C0,12); \
    KRD(GL,2); GAPB(o[0]=__builtin_amdgcn_mfma_f32_32x32x16_bf16(PAF(2),VFR(2),o[0],0,0,0), C1,0); \
    KRD(GL,3); GAPB(o[1]=__builtin_amdgcn_mfma_f32_32x32x16_bf16(PAF(2),VFR(6),o[1],0,0,0), C1,4); \
    GAPB(o[0]=__builtin_amdgcn_mfma_f32_32x32x16_bf16(PAF(3),VFR(3),o[0],0,0,0), C1,8); \
    GAPB(o[1]=__builtin_amdgcn_mfma_f32_32x32x16_bf16(PAF(3),VFR(7),o[1],0,0,0), C1,12); \
    } else { \
    GAPC(o[0]=__builtin_amdgcn_mfma_f32_32x32x16_bf16(PAF(0),VFR(0),o[0],0,0,0), C0,0, VRD2(0)); \
    GAPC(o[1]=__builtin_amdgcn_mfma_f32_32x32x16_bf16(PAF(0),VFR(4),o[1],0,0,0), C0,2, VRD2(4)); \
    GAPC(o[0]=__builtin_amdgcn_mfma_f32_32x32x16_bf16(PAF(1),VFR(1),o[0],0,0,0), C0,4, VRD2(1)); \
    GAPC(o[1]=__builtin_amdgcn_mfma_f32_32x32x16_bf16(PAF(1),VFR(5),o[1],0,0,0), C0,6, VRD2(5)); \
    GAPC(o[0]=__builtin_amdgcn_mfma_f32_32x32x16_bf16(PAF(2),VFR(2),o[0],0,0,0), C0,8, VRD2(2)); \
    GAPC(o[1]=__builtin_amdgcn_mfma_f32_32x32x16_bf16(PAF(2),VFR(6),o[1],0,0,0), C0,10, VRD2(6)); \
    GAPC(o[0]=__builtin_amdgcn_mfma_f32_32x32x16_bf16(PAF(3),VFR(3),o[0],0,0,0), C0,12, VRD2(3)); \
    GAPC(o[1]=__builtin_amdgcn_mfma_f32_32x32x16_bf16(PAF(3),VFR(7),o[1],0,0,0), C0,14, VRD2(7)); \
    GAPC(o[2]=__builtin_amdgcn_mfma_f32_32x32x16_bf16(PAF(0),VFR(0),o[2],0,0,0), C1,0, (void)0); \
    KRD(GL,0); GAPC(o[3]=__builtin_amdgcn_mfma_f32_32x32x16_bf16(PAF(0),VFR(4),o[3],0,0,0), C1,2, (void)0); \
    KRD(GL,1); GAPC(o[2]=__builtin_amdgcn_mfma_f32_32x32x16_bf16(PAF(1),VFR(1),o[2],0,0,0), C1,4, (void)0); \
    KRD(GL,2); GAPC(o[3]=__builtin_amdgcn_mfma_f32_32x32x16_bf16(PAF(1),VFR(5),o[3],0,0,0), C1,6, (void)0); \
    KRD(GL,3); GAPC(o[2]=__builtin_amdgcn_mfma_f32_32x32x16_bf16(PAF(2),VFR(2),o[2],0,0,0), C1,8, (void)0); \
    GAPC(o[3]=__builtin_amdgcn_mfma_f32_32x32x16_bf16(PAF(2),VFR(6),o[3],0,0,0), C1,10, (void)0); \
    GAPC(o[2]=__builtin_amdgcn_mfma_f32_32x32x16_bf16(PAF(3),VFR(3),o[2],0,0,0), C1,12, (void)0); \
    GAPC(o[3]=__builtin_amdgcn_mfma_f32_32x32x16_bf16(PAF(3),VFR(7),o[3],0,0,0), C1,14, (void)0); \
    } \
    }while(0)
  #define WB_FULL() do{ if constexpr(DV==128){WAIT_BAR(3);}else{WAIT_BAR(2);} }while(0)
  int t=1;
  #undef CMASK
  #define CMASK(P0,P1,t) do{}while(0)
  for(;t+5<NT;t+=2){
    STEP(pB0,pB1,pA0,pA1,t,true,true,true,0);     WB_FULL(); RESC(); ROT();
    STEP(pA0,pA1,pB0,pB1,t+1,true,true,true,0);   WB_FULL(); RESC(); ROT();
  }
  #undef CMASK
  #define CMASK(P0,P1,t) do{int jb_=(t)-(NT-4); if(jb_>=0)cmask(P0,P1,jb_,qrel,hi);}while(0)
  #define ENDW(tt) do{ if((tt)+3<NT){WB_FULL();} else if((tt)+2<NT){ if constexpr(DV==128){WAIT_BAR(2);}else{WAIT_BAR(1);} } else {WAIT_BAR(0);} }while(0)
  for(;t+1<NT;t+=2){
    STEP(pB0,pB1,pA0,pA1,t,(t+3<NT),(t+1<NT),(t+1<NT),1);       ENDW(t);   RESC(); ROT();
    STEP(pA0,pA1,pB0,pB1,t+1,(t+4<NT),(t+2<NT),(t+2<NT),1);     ENDW(t+1); RESC(); ROT();
  }
  STEP(pB0,pB1,pA0,pA1,NT-1,false,false,false,1); RESC();
  { float sacc=pB0[0]+pB0[1]; _Pragma("unroll") for(int r=2;r<16;++r)sacc+=pB0[r]; _Pragma("unroll") for(int r=0;r<16;++r)sacc+=pB1[r]; l_reg+=sacc;
    pw0=(u32x4){PKW(pB0,0),PKW(pB0,2),PKW(pB0,4),PKW(pB0,6)};pw1=(u32x4){PKW(pB0,8),PKW(pB0,10),PKW(pB0,12),PKW(pB0,14)};pw2=(u32x4){PKW(pB1,0),PKW(pB1,2),PKW(pB1,4),PKW(pB1,6)};pw3=(u32x4){PKW(pB1,8),PKW(pB1,10),PKW(pB1,12),PKW(pB1,14)};
    SBAR(); pv<NO>(o,vb0+sl_cur*VM,PAF(0),PAF(1),PAF(2),PAF(3)); }
  #undef PKW
  #undef PAF
  #undef VFR
  #undef PIN
  #undef MX3
  #undef GAPA
  #undef GAPB
  #undef EX
  #undef VRD
  #undef VRD2
  #undef GAPC
  #undef KRD
  #undef STEP
  #undef CIN
  #undef ENDW
  #undef WB_FULL
  {auto rr=__builtin_amdgcn_permlane32_swap(__float_as_uint(l_reg),__float_as_uint(l_reg),false,false);l_reg=__uint_as_float(rr[0])+__uint_as_float(rr[1]);}
  if(hi==0)wsf[32+r32]=l_reg;asm volatile("s_waitcnt lgkmcnt(0)":::"memory");
  float rli[16];
  #pragma unroll
  for(int r=0;r<16;++r)rli[r]=__builtin_amdgcn_rcpf(wsf[32+crow(r,hi)]);
  bf16*Ow=Ob+(long)(q0+wid*QBLK)*OP;
  { bf16*stg=(bf16*)(shm+Lay<DV>::OST)+wid*2048;
    #pragma unroll
    for(int ps=0;ps<NO/2;++ps){
    #pragma unroll
    for(int r=0;r<16;++r){const int orow=crow(r,hi);
      #pragma unroll
      for(int d0=0;d0<2;++d0)stg[orow*64+d0*32+r32]=__float2bfloat16(o[2*ps+d0][r]*rli[r]);}
    asm volatile("s_waitcnt lgkmcnt(0)":::"memory");
    #pragma unroll
    for(int i=0;i<4;++i){const int row=i*8+(lane>>3),ch=lane&7; const u32x4 v=*(const u32x4*)(stg+row*64+ch*8); ATTN_STORE16(Ow+(long)row*OP+ps*64+ch*8,v);}
    asm volatile("s_waitcnt lgkmcnt(0)":::"memory"); } }
  asm volatile("s_waitcnt lgkmcnt(0)\n\ts_barrier":::"memory");
  #undef DMA_K
  #undef DMA_V
  #undef CMASK
  #undef START
  #undef RESC
  #undef ROT
}
constexpr int ATTN_LDS_BYTES=Lay<64>::BYTES>Lay<128>::BYTES?Lay<64>::BYTES:Lay<128>::BYTES;
#undef SBAR
#undef WAIT_BAR
}
__device__ __forceinline__ void diffc_item(Frame& F, int l, int b, int h, int qb) {
    const int lane = fresh_lane(); int w = F.wave0; asm volatile("" : "+s"(w));
    const float* lq1 = (const float*)F.in[I_LQ1] + l * 64; const float* lk1 = (const float*)F.in[I_LK1] + l * 64;
    const float* lq2 = (const float*)F.in[I_LQ2] + l * 64; const float* lk2 = (const float*)F.in[I_LK2] + l * 64;
    int ll = l; asm volatile("" : "+s"(ll));
    const float li = lambda_init_of(ll); const float oml = ll == 0 ? 1.0f - lambda_init_of(0) : 1.0f - lambda_init_of(1);
    const float lamv = __builtin_amdgcn_exp2f(LOG2E * wave_sum(lq1[lane] * lk1[lane], lane)) - __builtin_amdgcn_exp2f(LOG2E * wave_sum(lq2[lane] * lk2[lane], lane)) + li;
    const float lam = __builtin_bit_cast(float, __builtin_amdgcn_readfirstlane(__builtin_bit_cast(int, lamv)));
    const float* sub = (const float*)F.in[I_SUBLN] + l * 128;
    const bf16* OA = (const bf16*)(F.ws + WS_OA); bf16* AD = (bf16*)(F.ws + WS_AD);
    const int d0 = (lane & 15) * 8;
    float sg[8];
#pragma unroll
    for (int e = 0; e < 8; ++e) sg[e] = sub[d0 + e] * oml;
    const size_t row0 = (size_t)b * SEQ + (size_t)qb * 256 + w * 32 + (lane >> 4);
    v4u a_[8], b_[8];
#pragma unroll
    for (int q = 0; q < 8; ++q) { const bf16* src = OA + (row0 + q * 4) * 1024 + h * 128 + d0;
        asm volatile("global_load_dwordx4 %0, %2, off sc1\n\tglobal_load_dwordx4 %1, %2, off offset:1024 sc1" : "=&v"(a_[q]), "=&v"(b_[q]) : "v"(src) : "memory"); }
    asm volatile("s_waitcnt vmcnt(0)" : "+v"(a_[0]), "+v"(a_[1]), "+v"(a_[2]), "+v"(a_[3]), "+v"(a_[4]), "+v"(a_[5]), "+v"(a_[6]), "+v"(a_[7]), "+v"(b_[0]), "+v"(b_[1]), "+v"(b_[2]), "+v"(b_[3]), "+v"(b_[4]), "+v"(b_[5]), "+v"(b_[6]), "+v"(b_[7]) :: "memory");
#pragma unroll
    for (int q = 0; q < 8; ++q) { const v4u a = a_[q], bb = b_[q];
        typedef float f32x2_ __attribute__((ext_vector_type(2)));
        f32x2_ vv[4]; float ss = 0.f;
#pragma unroll
        for (int k = 0; k < 4; ++k) { const f32x2_ av = {bflo(a[k]), bfhi(a[k])}, bv = {bflo(bb[k]), bfhi(bb[k])}; vv[k] = av - lam * bv; ss += vv[k].x * vv[k].x + vv[k].y * vv[k].y; }
        ss += shx(ss, 1, lane); ss += shx(ss, 2, lane); ss += shx(ss, 4, lane); ss += shx(ss, 8, lane);
        const float r = __builtin_amdgcn_rsqf(ss * (1.0f / 128.0f) + EPS);
        v4u o;
#pragma unroll
        for (int k = 0; k < 4; ++k) o[k] = pk2(vv[k].x * r * sg[2 * k], vv[k].y * r * sg[2 * k + 1]);
        *(v4u*)(AD + (row0 + q * 4) * 512 + h * 128 + d0) = o; }
}
#define DIFF_HANDOFF(qb_) do { VM_WAIT(); __syncthreads(); volatile LAS unsigned* qw_ = F.MISC + 16; \
        if (fresh_tid(F.wave0) == 0) { \
            qw_[0] = __hip_atomic_fetch_add(F.ctl + CW_DCNT + ((((l * BATCH + b) * 4 + (m & 3)) * 32 + (qb_)) * DCNT_STRIDE), 1u, __ATOMIC_RELAXED, __HIP_MEMORY_SCOPE_AGENT); } \
        __syncthreads(); const unsigned old_ = qw_[0]; __syncthreads(); \
        if (old_ == 1u) diffc_item(F, l, b, m & 3, (qb_)); } while (0)
template <int AVAR = 0> __device__ __forceinline__ void phase_attn(Frame& F, int l) {
    const attn_body::bf16* QKVG = (const attn_body::bf16*)(F.ws + WS_QKVG);
    attn_body::bf16* OA = (attn_body::bf16*)(F.ws + WS_OA); attn_body::bf16* OFp = (attn_body::bf16*)(F.ws + WS_OF);
    const float* CUM = (const float*)(F.ws + WS_CUM);
    char* shm = (char*)(F.lds + RING_OFF);
    bool noref;
    { const int ln = fresh_lane();
      const float* gtd = (const float*)(F.ws + WS_GT) + l * 256; float gq = fabsf(gtd[ln]), gk = fabsf(gtd[64 + ln]);
#pragma unroll
      for (int o = 1; o < 64; o <<= 1) { gq = fmaxf(gq, shx(gq, o, ln)); gk = fmaxf(gk, shx(gk, o, ln)); }
      noref = __builtin_amdgcn_readfirstlane((int)(1.02f * 64.0f * gq * gk < 100.0f)) != 0; }
    if (AVAR & 1) {} else if (noref) {
        for (int p = F.vcu; p < 256; p += F.G) {
            const int he = p >> 4, x = p & 15, b = he >> 3, m = he & 7;
            const attn_body::bf16* base = QKVG + (size_t)b * SEQ * NP;
#pragma unroll 1
            for (int s2 = 0; s2 < 2; ++s2) {
                attn_body::attn_unit<8, false, 1024, 128, true>(s2 == 0 ? 31 - x : x, base + C_QA + m * 64, base + C_KA + m * 64, base + C_VA + (m & 3) * 128, OA + (size_t)b * SEQ * 1024 + m * 128, nullptr, 0.f, shm, F.wave0);
                DIFF_HANDOFF(s2 == 0 ? 31 - x : x);
            }
        }
    } else {
        for (int p = F.vcu; p < 256; p += F.G) {
            const int he = p >> 4, x = p & 15, b = he >> 3, m = he & 7;
            const attn_body::bf16* base = QKVG + (size_t)b * SEQ * NP;
#pragma unroll 1
            for (int s2 = 0; s2 < 2; ++s2) {
                attn_body::attn_unit<8, false, 1024, 128, false>(s2 == 0 ? 31 - x : x, base + C_QA + m * 64, base + C_KA + m * 64, base + C_VA + (m & 3) * 128, OA + (size_t)b * SEQ * 1024 + m * 128, nullptr, 0.f, shm, F.wave0);
                DIFF_HANDOFF(s2 == 0 ? 31 - x : x);
            }
        }
    }
    float thr2;
    { const int ln = fresh_lane();
      const float* gtf = (const float*)(F.ws + WS_GT) + l * 256 + 128; float gq = fabsf(gtf[ln]), gk = fabsf(gtf[64 + ln]);
#pragma unroll
      for (int o = 1; o < 64; o <<= 1) { gq = fmaxf(gq, shx(gq, o, ln)); gk = fmaxf(gk, shx(gk, o, ln)); }
      thr2 = __builtin_bit_cast(float, __builtin_amdgcn_readfirstlane(__builtin_bit_cast(int, 150.0f + 2.0f * 1.02f * 64.0f * gq * gk + 8.0f))); }
    if (!(AVAR & 2)) {
        unsigned* qctr = F.ctl + CW_FOXQ + 16 * l; volatile LAS unsigned* qw = F.MISC + 16;
        for (;;) {
            if (fresh_tid(F.wave0) == 0) qw[0] = __hip_atomic_fetch_add(qctr, 1u, __ATOMIC_RELAXED, __HIP_MEMORY_SCOPE_AGENT);
            __syncthreads();
            const int u = (int)qw[0];
            __syncthreads();
            if (u >= 512) break;
            const int qb = 31 - (u >> 4), hf = u & 15, b = hf >> 3, h = hf & 7;
            const attn_body::bf16* base = QKVG + (size_t)b * SEQ * NP;
            attn_body::attn_unit<8, true, 512, 64, false>(qb, base + C_QF + h * 64, base + C_KF + h * 64, base + C_VF + h * 64, OFp + (size_t)b * SEQ * 512 + h * 64, CUM + ((size_t)b * 8 + h) * SEQ, (AVAR & 4) ? 1e30f : thr2, shm, F.wave0, -1);
        }
    }
}
#if BUILD_ORACLE
namespace orc {
__device__ __forceinline__ void tile_mm(const bf16* A, int lda, const int* arow  , const bf16* B, int ldb, int brow0, int K, float (*sA)[68], float (*sB)[68], float (&acc)[4][4]) {
    const int tid = threadIdx.x, ty = tid >> 4, tx = tid & 15, lr = tid >> 2, lc = (tid & 3) * 8;
    for (int k0 = 0; k0 < K; k0 += 32) {
        __syncthreads();
        { const int ar = arow[lr]; v4u a = (v4u){0u, 0u, 0u, 0u}; if (ar >= 0) a = *(const v4u*)(A + (size_t)ar * lda + k0 + lc);
          const v4u b = *(const v4u*)(B + (size_t)(brow0 + lr) * ldb + k0 + lc);
          sA[lc + 0][lr] = bflo(a.x); sA[lc + 1][lr] = bfhi(a.x); sA[lc + 2][lr] = bflo(a.y); sA[lc + 3][lr] = bfhi(a.y); sA[lc + 4][lr] = bflo(a.z); sA[lc + 5][lr] = bfhi(a.z); sA[lc + 6][lr] = bflo(a.w); sA[lc + 7][lr] = bfhi(a.w);
          sB[lc + 0][lr] = bflo(b.x); sB[lc + 1][lr] = bfhi(b.x); sB[lc + 2][lr] = bflo(b.y); sB[lc + 3][lr] = bfhi(b.y); sB[lc + 4][lr] = bflo(b.z); sB[lc + 5][lr] = bfhi(b.z); sB[lc + 6][lr] = bflo(b.w); sB[lc + 7][lr] = bfhi(b.w); }
        __syncthreads();
#pragma unroll 8
        for (int kk = 0; kk < 32; ++kk) { const f32x4 a = *(const f32x4*)&sA[kk][ty * 4], b = *(const f32x4*)&sB[kk][tx * 4];
#pragma unroll
            for (int i = 0; i < 4; ++i)
#pragma unroll
                for (int j = 0; j < 4; ++j) acc[i][j] += a[i] * b[j]; }
    }
}
__device__ __forceinline__ void put_tile(float (*Ct)[65], const float (&acc)[4][4]) {
    const int tid = threadIdx.x, ty = tid >> 4, tx = tid & 15;
#pragma unroll
    for (int i = 0; i < 4; ++i)
#pragma unroll
        for (int j = 0; j < 4; ++j) Ct[ty * 4 + i][tx * 4 + j] = acc[i][j];
}
#define ORC_SHARED __shared__ float sA[32][68]; __shared__ float sB[32][68]; __shared__ float Ct[64][65]; __shared__ int arow[64];
#define ZACC(a) _Pragma("unroll") for (int i_ = 0; i_ < 4; ++i_) _Pragma("unroll") for (int j_ = 0; j_ < 4; ++j_) a[i_][j_] = 0.f

__global__ void __launch_bounds__(256) inproj(Args a, int l) {
    ORC_SHARED
    const int n0 = blockIdx.x * 64, m0 = blockIdx.y * 64, tid = threadIdx.x;
    const bf16* HN = (const bf16*)(a.ws + WS_HN); const bf16* W = (const bf16*)(a.ws + WS_WIN) + (size_t)l * NP * D; bf16* QKVG = (bf16*)(a.ws + WS_QKVG);
    if (tid < 64) arow[tid] = m0 + tid;
    float acc[4][4]; ZACC(acc);
    tile_mm(HN, D, arow, W, D, n0, D, sA, sB, acc);
    put_tile(Ct, acc); __syncthreads();
    if (tid < 64) {
        const int row = m0 + tid, seg = n0 / 512; float v[64];
#pragma unroll
        for (int s = 0; s < 64; ++s) v[s] = Ct[tid][s];
        if (seg == 0 || seg == 1 || seg == 3 || seg == 4) {
            float ss = 0.f;
#pragma unroll
            for (int s = 0; s < 64; ++s) ss += v[s] * v[s];
            const float rs = 1.0f / sqrtf(ss * (1.0f / 64.0f) + EPS);
            const float* g = (const float*)a.in[seg == 0 ? I_QND : seg == 1 ? I_KND : seg == 3 ? I_QNF : I_KNF] + l * 64;
            const bool diff = seg < 2;
#pragma unroll
            for (int s = 0; s < 64; ++s) { const int d = (diff && s < 32) ? pi32(s) : s; v[s] = v[s] * rs * g[d]; }
            if (diff) { const float* cs = (const float*)(a.ws + WS_COSSIN) + (size_t)row * 16;
#pragma unroll
                for (int i = 0; i < 8; ++i) { const int s1 = pi32(i), s2 = pi32(i + 8); const float t1 = v[s1], t2 = v[s2], c = cs[i], sn = cs[8 + i]; v[s1] = t1 * c - t2 * sn; v[s2] = t2 * c + t1 * sn; } }
            if (seg == 0 || seg == 3) {
#pragma unroll
                for (int s = 0; s < 64; ++s) v[s] *= C2; }
        } else if (seg >= 6) {
#pragma unroll
            for (int s = 0; s < 64; ++s) v[s] = 1.0f / (1.0f + expf(-v[s]));
        }
#pragma unroll
        for (int s = 0; s < 64; s += 2) *(unsigned*)(QKVG + (size_t)row * NP + n0 + s) = pk2(v[s], v[s + 1]);
    }
}
struct AttnP { const bf16* Q; const bf16* K; const bf16* V; bf16* O; int qc, kc, vc, oc, opitch; int bias; };
__global__ void __launch_bounds__(256) attn(Args a, int mode  ) {
    __shared__ float sK[64][64]; __shared__ float sV[64][64]; __shared__ float sC[64];
    const int qb = blockIdx.x, he = blockIdx.y, tid = threadIdx.x;
    const bf16* QKVG = (const bf16*)(a.ws + WS_QKVG);
    int b, qc, kc, vc, oc, opitch; bf16* O; const float* cum = nullptr;
    if (mode == 0) { b = he / 16; const int r = he % 16, m = r >> 1, vh = r & 1; qc = C_QA + m * 64; kc = C_KA + m * 64; vc = C_VA + (m & 3) * 128 + vh * 64; O = (bf16*)(a.ws + WS_OA); oc = m * 128 + vh * 64; opitch = 1024; }
    else { b = he / 8; const int h = he % 8; qc = C_QF + h * 64; kc = C_KF + h * 64; vc = C_VF + h * 64; O = (bf16*)(a.ws + WS_OF); oc = h * 64; opitch = 512; cum = (const float*)(a.ws + WS_CUM) + ((size_t)b * 8 + h) * SEQ; }
    const int q0 = qb * 256, qi = q0 + tid; const size_t rowg = (size_t)b * SEQ + qi;
    float q[64], o[64];
#pragma unroll
    for (int d = 0; d < 64; ++d) { q[d] = bf2f(QKVG[rowg * NP + qc + d]); o[d] = 0.f; }
    const float cq = cum ? cum[qi] : 0.f;
    float m = -INFINITY, lsum = 0.f;
    const int nkt = (q0 + 256) / 64;
    for (int kt = 0; kt < nkt; ++kt) {
        __syncthreads();
        { const int r = tid >> 2, c0 = (tid & 3) * 16; const size_t kr = (size_t)b * SEQ + kt * 64 + r;
#pragma unroll
          for (int c = 0; c < 16; ++c) { sK[r][c0 + c] = bf2f(QKVG[kr * NP + kc + c0 + c]); sV[r][c0 + c] = bf2f(QKVG[kr * NP + vc + c0 + c]); }
          if (tid < 64) sC[tid] = cum ? cum[kt * 64 + tid] : 0.f; }
        __syncthreads();
        for (int j = 0; j < 64; ++j) {
            const int key = kt * 64 + j;
            if (key <= qi) {
                float s = 0.f;
#pragma unroll
                for (int d = 0; d < 64; ++d) s += q[d] * sK[j][d];
                s += cq - sC[j];
                if (s > m) { const float corr = exp2f(m - s); lsum *= corr;
#pragma unroll
                    for (int d = 0; d < 64; ++d) o[d] *= corr;
                    m = s; }
                const float p = exp2f(s - m); lsum += p;
#pragma unroll
                for (int d = 0; d < 64; ++d) o[d] += p * sV[j][d];
            }
        }
    }
    const float inv = 1.0f / lsum;
#pragma unroll
    for (int d = 0; d < 64; d += 2) *(unsigned*)(O + rowg * opitch + oc + d) = pk2(o[d] * inv, o[d + 1] * inv);
}
__global__ void __launch_bounds__(256) yz(Args a, int l) {
    ORC_SHARED
    __shared__ float Ct2[64][65];
    const int n0 = blockIdx.x * 64, m0 = blockIdx.y * 64, tid = threadIdx.x;
    if (tid < 64) arow[tid] = m0 + tid;
    float acc[4][4], acc2[4][4]; ZACC(acc); ZACC(acc2);
    tile_mm((const bf16*)(a.ws + WS_AD), 512, arow, (const bf16*)(a.ws + WS_WD) + (size_t)l * D * 512, 512, n0, 512, sA, sB, acc);
    tile_mm((const bf16*)(a.ws + WS_OF), 512, arow, (const bf16*)(a.ws + WS_WF) + (size_t)l * D * 512, 512, n0, 512, sA, sB, acc2);
    put_tile(Ct, acc); put_tile(Ct2, acc2); __syncthreads();
    const bf16* QKVG = (const bf16*)(a.ws + WS_QKVG); bf16* Z = (bf16*)(a.ws + WS_Z);
    if (tid < 64) { const int row = m0 + tid;
        for (int s = 0; s < 64; ++s) { const float ga = bf2f(QKVG[(size_t)row * NP + C_GA + n0 + s]), gf = bf2f(QKVG[(size_t)row * NP + C_GF + n0 + s]);
            Z[(size_t)row * D + n0 + s] = (bf16)f2bf(ga * Ct[tid][s] + gf * Ct2[tid][s]); } }
}
__global__ void __launch_bounds__(256) wo(Args a, int l) {
    ORC_SHARED
    const int n0 = blockIdx.x * 64, m0 = blockIdx.y * 64, tid = threadIdx.x;
    if (tid < 64) arow[tid] = m0 + tid;
    float acc[4][4]; ZACC(acc);
    tile_mm((const bf16*)(a.ws + WS_Z), D, arow, (const bf16*)(a.ws + WS_WO) + (size_t)l * D * D, D, n0, D, sA, sB, acc);
    put_tile(Ct, acc); __syncthreads();
    if (tid < 64) { const int row = m0 + tid; for (int s = 0; s < 64; ++s) a.out[(size_t)row * D + n0 + s] += Ct[tid][s]; }
}
__device__ __forceinline__ int find_expert(const unsigned* cnt, int t256, int& tile_in_e, int& cnt_e) {
    int off = 0;
    for (int e = 0; e < NEXP; ++e) { const int c = (int)cnt[e * CNT_STRIDE], nt = (c + 255) >> 8; if (t256 < off + nt) { tile_in_e = t256 - off; cnt_e = c; return e; } off += nt; }
    return -1;
}
__global__ void __launch_bounds__(256) gateup(Args a, int l) {
    ORC_SHARED
    __shared__ float Ct2[64][65]; __shared__ int asg[64];
    const int f0 = blockIdx.x * 64, m64 = blockIdx.y, tid = threadIdx.x;
    const unsigned* cnt = (const unsigned*)(a.ws + WS_CTL) + CW_CNT + (size_t)l * NEXP * CNT_STRIDE;
    int tie, ce; const int e = find_expert(cnt, m64 >> 2, tie, ce);
    if (e < 0) return;
    const int* LIST = (const int*)(a.ws + WS_LIST) + (size_t)e * T;
    if (tid < 64) { const int r = tie * 256 + (m64 & 3) * 64 + tid; const int as = r < ce ? LIST[r] : -1; asg[tid] = as; arow[tid] = as < 0 ? -1 : (as >> 1); }
    __syncthreads();
    const bf16* W = (const bf16*)(a.ws + WS_WGU) + ((size_t)l * NEXP + e) * 1024 * 1024;
    const int brow = (f0 >> 7) * 256 + (f0 & 127);
    float acc[4][4], acc2[4][4]; ZACC(acc); ZACC(acc2);
    tile_mm((const bf16*)(a.ws + WS_HN), D, arow, W, D, brow, D, sA, sB, acc);
    tile_mm((const bf16*)(a.ws + WS_HN), D, arow, W, D, brow + 128, D, sA, sB, acc2);
    put_tile(Ct, acc); put_tile(Ct2, acc2); __syncthreads();
    bf16* HID = (bf16*)(a.ws + WS_HID); const float* GWT = (const float*)(a.ws + WS_GWT);
    if (tid < 64) { const int as = asg[tid]; const float w = as < 0 ? 0.f : GWT[as]; const size_t hr = (size_t)m64 * 64 + tid;
        for (int s = 0; s < 64; ++s) { const float g = Ct[tid][s], u = Ct2[tid][s]; const float h = as < 0 ? 0.f : (g / (1.0f + expf(-g))) * u * w; HID[hr * FF + f0 + s] = (bf16)f2bf(h); } }
}
__global__ void __launch_bounds__(256) down(Args a, int l) {
    ORC_SHARED
    __shared__ int asg[64];
    const int n0 = blockIdx.x * 64, m64 = blockIdx.y, tid = threadIdx.x;
    const unsigned* cnt = (const unsigned*)(a.ws + WS_CTL) + CW_CNT + (size_t)l * NEXP * CNT_STRIDE;
    int tie, ce; const int e = find_expert(cnt, m64 >> 2, tie, ce);
    if (e < 0) return;
    const int* LIST = (const int*)(a.ws + WS_LIST) + (size_t)e * T;
    if (tid < 64) { const int r = tie * 256 + (m64 & 3) * 64 + tid; asg[tid] = r < ce ? LIST[r] : -1; arow[tid] = m64 * 64 + tid; }
    __syncthreads();
    float acc[4][4]; ZACC(acc);
    tile_mm((const bf16*)(a.ws + WS_HID), FF, arow, (const bf16*)(a.ws + WS_WDN) + ((size_t)l * NEXP + e) * 1024 * 512, FF, n0, FF, sA, sB, acc);
    put_tile(Ct, acc); __syncthreads();
    bf16* Y = (bf16*)(a.ws + WS_Y);
    if (tid < 64) { const int as = asg[tid]; if (as >= 0) { const size_t base = (size_t)(as & 1) * T * D + (size_t)(as >> 1) * D + n0;
        for (int s = 0; s < 64; ++s) Y[base + s] = (bf16)f2bf(Ct[tid][s]); } }
}
}
#endif
#define XB_TMO      128
#define XB_XCNT(j)  (256  + 64 * (j))
#define XB_XSUB(j)  (1280 + 64 * (j))
#define XB_XGEN(j)  (2304 + 64 * (j))
#define XB_TOP      3328
#define XB_TOPGEN   3392
#define XCD_BAR_WORDS 3456
#define XB_SPIN_CAP (1u << 18)
__device__ __forceinline__ unsigned xb_ld(unsigned* p)              { return __hip_atomic_load(p, __ATOMIC_RELAXED, __HIP_MEMORY_SCOPE_AGENT); }
__device__ __forceinline__ unsigned xb_add(unsigned* p, unsigned v) { return __hip_atomic_fetch_add(p, v, __ATOMIC_RELAXED, __HIP_MEMORY_SCOPE_AGENT); }
__device__ __forceinline__ unsigned xb_xcc_id() { return (unsigned)__builtin_amdgcn_s_getreg((3 << 11) | 20) & 0xFu; }
#define XB_SPIN(cond, bar) do { unsigned _sp = 0; while (cond) { __builtin_amdgcn_s_sleep(1); \
    if ((++_sp & 255u) == 0u) { if (xb_ld(&(bar)[XB_TMO])) break; if (_sp > XB_SPIN_CAP) { atomicAdd(&(bar)[XB_TMO], 1u); break; } } } } while (0)
struct XcdBarrier { unsigned* bar; unsigned x; volatile LAS unsigned* st; };
__device__ __forceinline__ XcdBarrier xcd_barrier_post(unsigned* bar, volatile LAS unsigned* st, const int tid) {
    XcdBarrier b; b.bar = bar; b.x = xb_xcc_id(); b.st = st;
    if (tid == 0) (void)xb_add(&bar[XB_XCNT(b.x)], 1u);
    return b;
}
__device__ __forceinline__ void xcd_barrier_complete(unsigned* bar, unsigned x, unsigned& nloc, unsigned& nx) {
    const unsigned G = gridDim.x * gridDim.y * gridDim.z;
    unsigned sum, cnt, mine, sp = 0u;
    for (;;) {
        sum = 0u; cnt = 0u; mine = 0u;
#pragma unroll
        for (unsigned j = 0; j < 16; ++j) { const unsigned c = xb_ld(&bar[XB_XCNT(j)]); sum += c; cnt += (c > 0u) ? 1u : 0u; mine = (j == x) ? c : mine; }
        if (sum == G) break;
        __builtin_amdgcn_s_sleep(1);
        if ((++sp & 255u) == 0u) { if (xb_ld(&bar[XB_TMO])) break; if (sp > XB_SPIN_CAP) { atomicAdd(&bar[XB_TMO], 1u); break; } }
    }
    nloc = mine > 0u ? mine : 1u; nx = cnt > 0u ? cnt : 1u;
}
__device__ __forceinline__ void xcd_barrier(const XcdBarrier& b, const int tid) {
    asm volatile("s_waitcnt vmcnt(0)" ::: "memory");
    __syncthreads();
    if (tid == 0) {
        unsigned* bar = b.bar;
        __builtin_amdgcn_s_waitcnt(0);
        unsigned nloc = b.st[0], nx = b.st[1];
        if (nloc == 0u) { xcd_barrier_complete(bar, b.x, nloc, nx); b.st[0] = nloc; b.st[1] = nx; }
        const unsigned old = xb_add(&bar[XB_XSUB(b.x)], 1u);
        const unsigned gen = old / nloc;
        if (old + 1u == (gen + 1u) * nloc) {
            __builtin_amdgcn_fence(__ATOMIC_RELEASE, "agent");
            asm volatile("s_waitcnt vmcnt(0)" ::: "memory");
            const unsigned og = xb_add(&bar[XB_TOP], 1u);
            const unsigned tg = og / nx;
            if (og + 1u == (tg + 1u) * nx) xb_add(&bar[XB_TOPGEN], 1u);
            else XB_SPIN(xb_ld(&bar[XB_TOPGEN]) == tg, bar);
            __builtin_amdgcn_fence(__ATOMIC_ACQUIRE, "agent");
            xb_add(&bar[XB_XGEN(b.x)], 1u);
            asm volatile("s_waitcnt vmcnt(0)" ::: "memory");
        } else {
            XB_SPIN(xb_ld(&bar[XB_XGEN(b.x)]) == gen, bar);
            __builtin_amdgcn_fence(__ATOMIC_ACQUIRE, "agent");
            asm volatile("s_waitcnt vmcnt(0)" ::: "memory");
        }
    }
    __syncthreads();
}

__global__ void __launch_bounds__(NWAVES * 64, 2) mega(Args args) {
    extern __shared__ __attribute__((aligned(16))) unsigned char lds[];
    Frame F;
    F.lds = (LAS unsigned char*)lds;
    F.MISC = (volatile LAS unsigned*)(F.lds + MISC_OFF);
    F.wave0 = __builtin_amdgcn_readfirstlane((int)threadIdx.x >> 6);
    F.tid = fresh_tid(F.wave0); F.lane = F.tid & 63; F.wave = F.wave0;
    F.G = gridDim.x; { const int bx = blockIdx.x; F.vcu = (F.G % 8 == 0) ? (bx % 8) * (F.G / 8) + bx / 8 : bx; }
    F.in = args.in; F.out = args.out; F.ws = args.ws; F.ctl = (unsigned*)(args.ws + WS_CTL);
    for (int u = F.tid; u < (LDS_BYTES - LDSCTL_OFF) / 4; u += NWAVES * 64) ((LAS unsigned*)(F.lds + LDSCTL_OFF))[u] = 0u;
    __syncthreads();
    const int vcu0 = F.vcu;
    const int lo = args.ph_lo, hi = args.ph_hi;
    const bool multi = (hi - lo) > 1;
    XcdBarrier bar; bar.bar = F.ctl + CW_BAR; bar.x = 0; bar.st = nullptr;
    if (multi) bar = xcd_barrier_post(F.ctl + CW_BAR, F.MISC + 8, F.tid);
#define IN(k) (lo <= (k) && (k) < hi)
#define FRESH() do { { int w0_ = F.wave0; asm volatile("" : "+s"(w0_)); F.wave = w0_; F.lane = fresh_lane(); F.tid = w0_ * 64 + F.lane; } \
    { unsigned char* w_ = args.ws; float* o_ = args.out; asm volatile("" : "+s"(w_), "+s"(o_)); F.ws = w_; F.out = o_; F.ctl = (unsigned*)(w_ + WS_CTL); int v_ = vcu0, g_ = (int)gridDim.x, b_ = (int)blockIdx.x; asm volatile("" : "+s"(v_), "+s"(g_), "+s"(b_)); F.vcu = v_; F.G = g_; F.bx = b_; } } while (0)
#ifndef DUP_MASK
#define DUP_MASK 0
#endif
#define DUP(k) if ((DUP_MASK >> (k)) & 1)
#define SEAM(k) do { if (IN(k) && IN((k) + 1)) { xcd_barrier(bar, fresh_tid(F.wave0)); DUP(13) xcd_barrier(bar, fresh_tid(F.wave0)); } } while (0)
    if (IN(PH_PRO)) { FRESH(); phase_prologue(F); DUP(15) { __syncthreads(); FRESH(); phase_prologue(F); } }
    SEAM(PH_PRO);
    for (int l = 0; l < DEPTH; ++l) {
        const int pb = 1 + PH_PER_LAYER * l;
        if (IN(pb + K_NORM1)) { FRESH(); phase_normgemm<0>(F, l); }
        SEAM(pb + K_NORM1);
        if (IN(pb + K_CUMSUM)) { FRESH(); phase_cumsum(F); DUP(K_CUMSUM) { __syncthreads(); FRESH(); phase_cumsum(F); } }
        if (IN(pb + K_INPROJ)) { FRESH(); phase_inproj(F, l); DUP(K_INPROJ) { __syncthreads(); FRESH(); phase_inproj(F, l); } }
        SEAM(pb + K_INPROJ);
        if (IN(pb + K_ATTN)) { FRESH(); phase_attn<0>(F, l); }
        SEAM(pb + K_ATTN);
        if (IN(pb + K_YZ)) { FRESH(); phase_yz(F, l); DUP(K_YZ) { __syncthreads(); FRESH(); phase_yz(F, l); } }
        SEAM(pb + K_YZ);
        if (IN(pb + K_WO)) { FRESH(); phase_wo(F, l);  }
        SEAM(pb + K_WO);
        if (IN(pb + K_ROUTER)) { FRESH(); phase_router2(F, l); }
        SEAM(pb + K_ROUTER);
        if (IN(pb + K_GATEUP)) { FRESH(); phase_gateup(F, l); DUP(K_GATEUP) { __syncthreads(); FRESH(); phase_gateup(F, l); } }
#if MOE_BARRIER
        SEAM(pb + K_GATEUP);
#else
        __syncthreads();
#endif
        if (IN(pb + K_DOWN)) { FRESH(); phase_down(F, l); DUP(K_DOWN) { __syncthreads(); FRESH(); phase_down(F, l); } }
        SEAM(pb + K_DOWN);
    }
#ifndef TAIL_VAR
#define TAIL_VAR 0
#endif
#ifndef TAIL_MASK
#define TAIL_MASK 0
#endif
#define TAILP(k, call) do { if ((TAIL_MASK >> (k)) & 1) { xcd_barrier(bar, fresh_tid(F.wave0)); FRESH(); call; } } while (0)
    if (IN(PH_FINAL)) { FRESH(); phase_final(F); DUP(14) { __syncthreads(); FRESH(); phase_final(F, true); } }
    if (multi && TAIL_MASK) { const int l = 1;
        TAILP(15, phase_prologue(F)); TAILP(K_CUMSUM, phase_cumsum(F)); TAILP(K_INPROJ, phase_inproj(F, l)); TAILP(K_ATTN, phase_attn<TAIL_VAR>(F, l));
        TAILP(K_DIFFC, phase_diffc(F, l)); TAILP(K_YZ, phase_yz(F, l)); TAILP(K_WO, phase_wo(F, l, true)); TAILP(K_ROUTER, phase_router2(F, l, true)); TAILP(K_GATEUP, phase_gateup(F, l)); TAILP(K_DOWN, phase_down(F, l));
        TAILP(14, phase_final(F, true)); }
#undef IN
#undef FRESH
#undef SEAM
#undef DUP
}

#ifndef FAST_MASK
#define FAST_MASK 0
#endif
#ifndef ONE_LAUNCH
#define ONE_LAUNCH 0
#endif
extern "C" void kernel_launch(void* const* d_in, const int* in_sizes, int n_in, void* d_out, int out_size, void* d_ws, size_t ws_size, hipStream_t stream) {
    static int grid = 0;
    if (grid == 0) {
        if (n_in != 25 || in_sizes[0] != T * D || out_size != T * D || ws_size < WS_END) { fprintf(stderr, "kernel_launch: unexpected shapes (n_in %d, in0 %d, out %d, ws %zu); nothing launched\n", n_in, n_in > 0 ? in_sizes[0] : -1, out_size, ws_size); grid = -1; return; }
        int dev = 0, cus = 0, per_cu = 0;
        if (hipGetDevice(&dev) != hipSuccess || hipDeviceGetAttribute(&cus, hipDeviceAttributeMultiprocessorCount, dev) != hipSuccess) { grid = -1; return; }
        if (hipFuncSetAttribute((const void*)mega, hipFuncAttributeMaxDynamicSharedMemorySize, LDS_BYTES) != hipSuccess) { fprintf(stderr, "kernel_launch: hipFuncSetAttribute failed\n"); grid = -1; return; }
        if (hipOccupancyMaxActiveBlocksPerMultiprocessor(&per_cu, (const void*)mega, NWAVES * 64, LDS_BYTES) != hipSuccess || per_cu < 1) { fprintf(stderr, "kernel_launch: occupancy query reports %d\n", per_cu); }
        (void)hipGetLastError();
        grid = cus;
    }
    if (grid < 0) return;
    (void)hipMemsetAsync((char*)d_ws + WS_CTL, 0, CTL_ZERO_BYTES, stream);
    Args a{};
    for (int i = 0; i < 25; ++i) a.in[i] = d_in[i];
    a.out = (float*)d_out; a.ws = (unsigned char*)d_ws;
#if ONE_LAUNCH
    a.ph_lo = 0; a.ph_hi = N_PHASES;
    hipLaunchKernelGGL(mega, dim3(grid), dim3(NWAVES * 64), LDS_BYTES, stream, a);
#else
    for (int p = 0; p < N_PHASES; ++p) {
        const int l = (p - 1) / PH_PER_LAYER, k = (p >= 1 && p < PH_FINAL) ? (p - 1) % PH_PER_LAYER : -1;
        const bool heavy = (k == K_INPROJ || k == K_ATTN || k == K_YZ || k == K_WO || k == K_GATEUP || k == K_DOWN);
#if BUILD_ORACLE
        if (heavy && !((FAST_MASK >> k) & 1)) {
            if (k == K_INPROJ) hipLaunchKernelGGL(orc::inproj, dim3(80, 256), dim3(256), 0, stream, a, l);
            else if (k == K_ATTN) { hipLaunchKernelGGL(orc::attn, dim3(32, 32), dim3(256), 0, stream, a, 0); hipLaunchKernelGGL(orc::attn, dim3(32, 16), dim3(256), 0, stream, a, 1); }
            else if (k == K_YZ) hipLaunchKernelGGL(orc::yz, dim3(16, 256), dim3(256), 0, stream, a, l);
            else if (k == K_WO) hipLaunchKernelGGL(orc::wo, dim3(16, 256), dim3(256), 0, stream, a, l);
            else if (k == K_GATEUP) hipLaunchKernelGGL(orc::gateup, dim3(8, HID_ROWS / 64), dim3(256), 0, stream, a, l);
            else hipLaunchKernelGGL(orc::down, dim3(16, HID_ROWS / 64), dim3(256), 0, stream, a, l);
            continue;
        }
#endif
        a.ph_lo = p; a.ph_hi = p + 1;
        hipLaunchKernelGGL(mega, dim3(grid), dim3(NWAVES * 64), LDS_BYTES, stream, a);
    }
#endif
}
```

```cpp
#define BUILD_ORACLE 0
#define ONE_LAUNCH 1
#include <hip/hip_runtime.h>
#include <cstdio>
#include <cstdint>

constexpr int D = 1024, BATCH = 2, SEQ = 8192, T = BATCH * SEQ, DEPTH = 2;
constexpr int HD = 64, NEXP = 32, FF = 512;
constexpr int INC = 5128;
constexpr int NP = 5120;
constexpr int C_QA = 0, C_KA = 512, C_VA = 1024, C_QF = 1536, C_KF = 2048, C_VF = 2560, C_GA = 3072, C_GF = 4096;
constexpr float EPS = 1e-6f;
constexpr float LOG2E = 1.4426950408889634f;
constexpr float C2 = 0.125f * 1.4426950408889634f;
constexpr int HID_ROWS = 2 * T + NEXP * 256;

constexpr size_t MiB = 1u << 20;
constexpr size_t WS_CTL = 0, CTL_ZERO_BYTES = 128 * 1024;
constexpr size_t WS_FZT = 1 * MiB;
constexpr size_t WS_WRT = 1 * MiB + 128 * 1024;
constexpr size_t WS_GT = 1 * MiB + 640 * 1024;
constexpr size_t WS_LOGF = 2 * MiB;
constexpr size_t WS_CUM = 2 * MiB + 512 * 1024;
constexpr size_t WS_COSSIN = 3 * MiB;
constexpr size_t WS_GWT = 4 * MiB;
constexpr size_t WS_LIST = 5 * MiB;
constexpr size_t WS_WIN = 8 * MiB;
constexpr size_t WS_WD = 28 * MiB;
constexpr size_t WS_WF = 30 * MiB;
constexpr size_t WS_WO = 32 * MiB;
constexpr size_t WS_WGU = 36 * MiB;
constexpr size_t WS_WDN = 164 * MiB;
constexpr size_t WS_QKVG = 228 * MiB;
constexpr size_t WS_HID = 228 * MiB;
constexpr size_t WS_Y = 280 * MiB;
constexpr size_t WS_HN = 388 * MiB;
constexpr size_t WS_AD = 388 * MiB;
constexpr size_t WS_OA = 420 * MiB;
constexpr size_t WS_Z = 420 * MiB;
constexpr size_t WS_OF = 452 * MiB;
constexpr size_t WS_SUMS = 468 * MiB;
constexpr size_t WS_RSTD = 4 * MiB + 256 * 1024;
constexpr size_t WS_END = 484 * MiB;
static_assert(WS_HID + (size_t)HID_ROWS * FF * 2 <= WS_Y && WS_Y + (size_t)2 * T * D * 2 <= WS_HN, "ws map");
constexpr int CW_TMO = 0;
constexpr int CW_CNT = 16384, CNT_STRIDE = 64;
constexpr int CW_BAR = 4096;
constexpr int CW_FOXQ = 128;
static_assert((16384 + 2 * 32 * 64) * 4 <= (int)CTL_ZERO_BYTES, "control words inside the memset");
constexpr int CW_DCNT = 24576, DCNT_STRIDE = 16;
static_assert(CW_DCNT + DEPTH * BATCH * 4 * 32 * DCNT_STRIDE <= (int)(CTL_ZERO_BYTES / 4), "pair counters inside the memset");
constexpr int CW_TCNT = 8192, TCNT_STRIDE = 16, MAX_TILES = HID_ROWS / 256;

typedef unsigned short bf16;
typedef unsigned v4u __attribute__((ext_vector_type(4)));
typedef unsigned v2u __attribute__((ext_vector_type(2)));
typedef float f32x4 __attribute__((ext_vector_type(4)));
#define LAS __attribute__((address_space(3)))
#define GAS __attribute__((address_space(1)))
#define LDS_WAIT() asm volatile("s_waitcnt lgkmcnt(0)" ::: "memory")
#define VM_WAIT() asm volatile("s_waitcnt vmcnt(0)" ::: "memory")

__device__ __forceinline__ unsigned f2bf(float f) { unsigned u = __builtin_bit_cast(unsigned, f); return (u + 0x7fffu + ((u >> 16) & 1u)) >> 16; }
__device__ __forceinline__ unsigned pk2(float lo, float hi) { return f2bf(lo) | (f2bf(hi) << 16); }
__device__ __forceinline__ float bflo(unsigned w) { return __uint_as_float(w << 16); }
__device__ __forceinline__ float bfhi(unsigned w) { return __uint_as_float(w & 0xffff0000u); }
__device__ __forceinline__ float bf2f(bf16 b) { return __uint_as_float((unsigned)b << 16); }
__device__ __forceinline__ float shx(float v, int mask, int lane) { return __int_as_float(__builtin_amdgcn_ds_bpermute((lane ^ mask) << 2, __float_as_int(v))); }
__device__ __forceinline__ float shl_(float v, int src) { return __int_as_float(__builtin_amdgcn_ds_bpermute(src << 2, __float_as_int(v))); }
__device__ __forceinline__ double shx_d(double v, int mask, int lane) { const long long b = __builtin_bit_cast(long long, v); const int lo = __builtin_amdgcn_ds_bpermute((lane ^ mask) << 2, (int)b), hi = __builtin_amdgcn_ds_bpermute((lane ^ mask) << 2, (int)(b >> 32));
    return __builtin_bit_cast(double, ((long long)hi << 32) | (unsigned)lo); }
__device__ __forceinline__ float wave_sum(float v, int lane) {
#pragma unroll
    for (int o = 1; o < 64; o <<= 1) v += shx(v, o, lane);
    return v;
}
__device__ __forceinline__ int fresh_lane() { unsigned m = ~0u; asm volatile("" : "+s"(m)); return (int)__builtin_amdgcn_mbcnt_hi(m, __builtin_amdgcn_mbcnt_lo(m, 0u)); }
__device__ __forceinline__ int fresh_tid(int wave0) { int w = wave0; asm volatile("" : "+s"(w)); return w * 64 + fresh_lane(); }
__device__ __forceinline__ int pi32(int n) { return n < 4 ? n : (n < 8 ? n + 4 : (n < 12 ? n - 4 : n)); }
__host__ __device__ constexpr float lambda_init_of(int l) { return l == 0 ? 0.2f : 0.35550906759f; }

struct Args { const void* in[25]; float* out; unsigned char* ws; int ph_lo, ph_hi; };
enum { I_X = 0, I_POS, I_LN1, I_WIN, I_BF, I_QND, I_KND, I_LQ1, I_LK1, I_LQ2, I_LK2, I_SUBLN, I_QNF, I_KNF, I_WDO, I_WFO, I_WO, I_LN2, I_WRG, I_BRG, I_WRE, I_BRE, I_WEG, I_WEU, I_WED };
#ifndef SC1_STORES
#define SC1_STORES 0
#endif
#ifndef MOE_BARRIER
#define MOE_BARRIER 0
#endif
constexpr int PH_PRO = 0, PH_PER_LAYER = 10, PH_FINAL = 1 + PH_PER_LAYER * DEPTH, N_PHASES = PH_FINAL + 1;
enum { K_NORM1 = 0, K_CUMSUM, K_INPROJ, K_ATTN, K_DIFFC, K_YZ, K_WO, K_ROUTER, K_GATEUP, K_DOWN };
constexpr int NWAVES = 8;
constexpr int RING_OFF = 0, RING_BYTES = 131072;
constexpr int LDSCTL_OFF = RING_BYTES, MISC_OFF = LDSCTL_OFF + 320;
constexpr int LDS_BYTES = 147456;
struct Frame {
    LAS unsigned char* lds;
    volatile LAS unsigned* MISC;
    unsigned* ctl;
    int tid, lane, wave, vcu, G, wave0, bx;
    const void* const* in;
    float* out; unsigned char* ws;
};

__device__ __forceinline__ void p0_transpose_item(const float* W, int ld, int k0, int n0src, bf16* WT, int Kd, int drow0, bool swz, LAS float* scr, int lane) {
#pragma unroll 8
    for (int i = 0; i < 32; ++i) { const int kk = 2 * i + (lane >> 5); scr[kk * 33 + (lane & 31)] = __builtin_nontemporal_load(W + (size_t)(k0 + kk) * ld + n0src + (lane & 31)); }
    LDS_WAIT(); asm volatile("" ::: "memory");
    const int c = lane & 7;
#pragma unroll
    for (int j = 0; j < 4; ++j) { const int n = (lane >> 3) + 8 * j; const LAS float* s = scr + (8 * c) * 33 + n;
        v4u o; o.x = pk2(s[0 * 33], s[1 * 33]); o.y = pk2(s[2 * 33], s[3 * 33]); o.z = pk2(s[4 * 33], s[5 * 33]); o.w = pk2(s[6 * 33], s[7 * 33]);
        const int nd = swz ? pi32(n) : n;
        __builtin_nontemporal_store(o, (v4u*)(WT + (size_t)(drow0 + nd) * Kd + k0 + 8 * c)); }
    LDS_WAIT(); asm volatile("" ::: "memory");
}
__device__ __forceinline__ void phase_prologue(Frame& F) {
    LAS float* scr = (LAS float*)(F.lds + RING_OFF + F.wave * 16384);
    const int gw = F.vcu * NWAVES + F.wave, NGW = F.G * NWAVES;
    const float* w_in = (const float*)F.in[I_WIN]; const float* wdo = (const float*)F.in[I_WDO]; const float* wfo = (const float*)F.in[I_WFO]; const float* wo = (const float*)F.in[I_WO];
    const float* weg = (const float*)F.in[I_WEG]; const float* weu = (const float*)F.in[I_WEU]; const float* wed = (const float*)F.in[I_WED];
    bf16* WIN = (bf16*)(F.ws + WS_WIN); bf16* WD = (bf16*)(F.ws + WS_WD); bf16* WF = (bf16*)(F.ws + WS_WF); bf16* WO = (bf16*)(F.ws + WS_WO);
    bf16* WGU = (bf16*)(F.ws + WS_WGU); bf16* WDN = (bf16*)(F.ws + WS_WDN);
    constexpr int I_IN = 16 * 160 * DEPTH;
    constexpr int I_DF = 8 * 32 * DEPTH;
    constexpr int I_O = 16 * 32 * DEPTH;
    constexpr int I_GU = 16 * 16 * 64 * 2;
    constexpr int I_DN = 8 * 32 * 64;
    constexpr int NITEMS = I_IN + 2 * I_DF + I_O + I_GU + I_DN;
    for (int it = gw; it < NITEMS; it += NGW) {
        int r = it;
        if (r < I_GU) {
            const int nb = r & 15, kb = (r >> 4) & 15, which = (r >> 8) & 1, lge = r >> 9;
            const float* src = (which ? weu : weg) + (size_t)lge * D * FF;
            const int n0 = 32 * nb, drow = (n0 >> 7) * 256 + (n0 & 127) + which * 128;
            p0_transpose_item(src, FF, 64 * kb, n0, WGU + (size_t)lge * 1024 * 1024, D, drow, false, scr, F.lane); continue; }
        r -= I_GU;
        if (r < I_DN) {
            const int nb = r & 31, kb = (r >> 5) & 7, lge = r >> 8;
            p0_transpose_item(wed + (size_t)lge * FF * D, D, 64 * kb, 32 * nb, WDN + (size_t)lge * 1024 * 512, FF, 32 * nb, false, scr, F.lane); continue; }
        r -= I_DN;
        if (r < I_IN) {
            const int l = r / 2560, q = r % 2560, kb = q / 160, nb = q % 160;
            const int nsrc = nb < 96 ? 32 * nb : 32 * nb + 8;
            const bool swz = (nb < 32) && ((nb & 1) == 0);
            p0_transpose_item(w_in + (size_t)l * D * INC, INC, 64 * kb, nsrc, WIN + (size_t)l * NP * D, D, 32 * nb, swz, scr, F.lane); continue; }
        r -= I_IN;
        if (r < 2 * I_DF) {
            const int nb = r & 31, kb = (r >> 5) & 7, l = (r >> 8) & 1, which = r >> 9;
            p0_transpose_item((which ? wfo : wdo) + (size_t)l * 512 * D, D, 64 * kb, 32 * nb, (which ? WF : WD) + (size_t)l * D * 512, 512, 32 * nb, false, scr, F.lane); continue; }
        r -= 2 * I_DF;
        { const int nb = r & 31, kb = (r >> 5) & 15, l = r >> 9;
          p0_transpose_item(wo + (size_t)l * D * D, D, 64 * kb, 32 * nb, WO + (size_t)l * D * D, D, 32 * nb, false, scr, F.lane); }
    }
    const int gt = (F.vcu * NWAVES + F.wave) * 64 + F.lane, NGT = F.G * NWAVES * 64;
    bf16* FZT = (bf16*)(F.ws + WS_FZT); bf16* WRT = (bf16*)(F.ws + WS_WRT); float* CS = (float*)(F.ws + WS_COSSIN);
    const float* ln1 = (const float*)F.in[I_LN1]; const float* ln2 = (const float*)F.in[I_LN2];
    for (int i = gt; i < DEPTH * 16 * D; i += NGT) { const int l = i / (16 * D), q = i % (16 * D), j = q / D, k = q % D;
        const float w = j < 8 ? w_in[(size_t)l * D * INC + (size_t)k * INC + 3072 + j] * ln1[l * D + k] : 0.f;
        const unsigned h = f2bf(w); const float r = w - __uint_as_float(h << 16);
        FZT[(size_t)l * 2 * 16 * D + q] = (bf16)h; FZT[(size_t)l * 2 * 16 * D + 16 * D + q] = (bf16)f2bf(r); }
    const float* wrg = (const float*)F.in[I_WRG]; const float* wre = (const float*)F.in[I_WRE];
    for (int i = gt; i < DEPTH * 48 * D; i += NGT) { const int l = i / (48 * D), q = i % (48 * D), j = q / D, k = q % D;
        const float w = (j < 4 ? wrg[(size_t)l * D * 4 + k * 4 + j] : (j < 36 ? wre[(size_t)l * D * 32 + k * 32 + (j - 4)] : 0.f)) * ln2[l * D + k];
        const unsigned h = f2bf(w); const float r = w - __uint_as_float(h << 16);
        WRT[(size_t)l * 2 * 48 * D + q] = (bf16)h; WRT[(size_t)l * 2 * 48 * D + 48 * D + q] = (bf16)f2bf(r); }
    { float* GT = (float*)(F.ws + WS_GT);
      for (int i = gt; i < DEPTH * 4 * 64; i += NGT) { const int l = i >> 8, q = (i >> 6) & 3, d = i & 63;
          const float* src = (const float*)F.in[q == 0 ? I_QND : (q == 1 ? I_KND : (q == 2 ? I_QNF : I_KNF))];
          GT[i] = src[l * 64 + d] * ((q & 1) ? 1.0f : C2); } }
    const int* pos = (const int*)F.in[I_POS];
    for (int i = gt; i < T * 8; i += NGT) { const int t = i >> 3, f = i & 7;
        const double inv = exp2(-(double)f * (1.0 / 8.0) * 18.931568569324174);
        const double ang = (double)pos[t] * (double)(float)inv;
        CS[t * 16 + f] = (float)cos(ang); CS[t * 16 + 8 + f] = (float)sin(ang); }
}

typedef short bf16x8n __attribute__((ext_vector_type(8)));
typedef float f32x4m __attribute__((ext_vector_type(4)));
template <int KIND, int VAR = 0> __device__ __forceinline__ void phase_normgemm(Frame& F, int l) {
    constexpr int NB = KIND == 0 ? 1 : 3;
    constexpr int NR = NB * 16;
    constexpr int PW = 49, XP = 136;
    LAS bf16* XH = (LAS bf16*)(F.lds + RING_OFF);
    LAS bf16* XL = XH + 64 * XP;
    LAS bf16* WH = XL + 64 * XP;
    LAS bf16* WL = WH + 48 * XP;
    LAS float* part = (LAS float*)(WL + 48 * XP);
    LAS float* rsv = part + 2 * 64 * PW;
    const float* xsrc = (KIND == 0 && l == 0) ? (const float*)F.in[I_X] : F.out;
    const bool addy = (KIND == 0 && l > 0);
    const float* gn = (const float*)F.in[KIND == 0 ? I_LN1 : I_LN2] + (size_t)l * D;
    const bf16* WT = (const bf16*)(F.ws + (KIND == 0 ? WS_FZT : WS_WRT)) + (size_t)l * 2 * NR * D;
    const bf16* Y = (const bf16*)(F.ws + WS_Y); bf16* HN = (bf16*)(F.ws + WS_HN);
    const int lane = F.lane, wave = F.wave, tid = F.tid;
    for (int bt = F.vcu; bt < T / 64; bt += F.G) {
        const int row0 = bt * 64;
        f32x4 v_[8][4];
#pragma unroll
        for (int hh = 0; hh < 2; ++hh) {
#pragma unroll
            for (int r4 = 0; r4 < 4; ++r4) { const int rr = hh * 4 + r4, row = row0 + wave * 8 + rr;
#pragma unroll
                for (int j = 0; j < 4; ++j) v_[rr][j] = *(const f32x4*)(xsrc + (size_t)row * D + lane * 4 + 256 * j);
                if (addy) {
#pragma unroll
                    for (int j = 0; j < 4; ++j) { const v2u a = __builtin_nontemporal_load((const v2u*)(Y + (size_t)row * D + lane * 4 + 256 * j)), b = __builtin_nontemporal_load((const v2u*)(Y + (size_t)T * D + (size_t)row * D + lane * 4 + 256 * j));
                        v_[rr][j].x += bflo(a.x) + bflo(b.x); v_[rr][j].y += bfhi(a.x) + bfhi(b.x); v_[rr][j].z += bflo(a.y) + bflo(b.y); v_[rr][j].w += bfhi(a.y) + bfhi(b.y); }
                }
            }
            if (addy) asm volatile("" ::: "memory");
        }
#pragma unroll
        for (int rr = 0; rr < 8; ++rr) { const int rl = wave * 8 + rr, row = row0 + rl; float ss = 0.f;
#pragma unroll
            for (int j = 0; j < 4; ++j) { const f32x4 x = v_[rr][j]; if (KIND == 0 && l > 0) *(f32x4*)(F.out + (size_t)row * D + lane * 4 + 256 * j) = x; ss += (x.x * x.x + x.y * x.y) + (x.z * x.z + x.w * x.w); }
            const float r = 1.0f / sqrtf(wave_sum(ss, lane) * (1.0f / D) + EPS);
            if (lane == 0) rsv[rl] = r;
        }
        f32x4m acc[NB];
#pragma unroll
        for (int nb = 0; nb < NB; ++nb) acc[nb] = (f32x4m){0.f, 0.f, 0.f, 0.f};
        constexpr int NPZ = (2 * NR * 16 + NWAVES * 64 - 1) / (NWAVES * 64);
        v4u wreg[NPZ];
#define NG_WLOAD(hc_) _Pragma("unroll") for (int pi = 0; pi < NPZ; ++pi) { const int pz = tid + pi * NWAVES * 64; if (pz < 2 * NR * 16) { const int tb = pz / (NR * 16), q = pz % (NR * 16), n = q >> 4, c8 = q & 15; \
            wreg[pi] = *(const v4u*)(WT + (size_t)tb * NR * D + (size_t)n * D + (hc_) * 128 + c8 * 8); } }
        if (!(VAR & 2)) {
        NG_WLOAD(0)
#pragma unroll
        for (int hc = 0; hc < 8; ++hc) {
            if ((lane >> 5) == (hc & 1)) {
#pragma unroll
                for (int rr = 0; rr < 8; ++rr) { const f32x4 x = v_[rr][hc >> 1];
                    const unsigned h0 = f2bf(x.x), h1 = f2bf(x.y), h2 = f2bf(x.z), h3 = f2bf(x.w);
                    const float l0 = x.x - __uint_as_float(h0 << 16), l1 = x.y - __uint_as_float(h1 << 16), l2 = x.z - __uint_as_float(h2 << 16), l3 = x.w - __uint_as_float(h3 << 16);
                    const int o = (wave * 8 + rr) * XP + (lane & 31) * 4;
                    *(LAS v2u*)(XH + o) = (v2u){h0 | (h1 << 16), h2 | (h3 << 16)}; *(LAS v2u*)(XL + o) = (v2u){pk2(l0, l1), pk2(l2, l3)}; }
            }
#pragma unroll
            for (int pi = 0; pi < NPZ; ++pi) { const int pz = tid + pi * NWAVES * 64; if (pz < 2 * NR * 16) { const int tb = pz / (NR * 16), q = pz % (NR * 16), n = q >> 4, c8 = q & 15;
                *(LAS v4u*)((tb ? WL : WH) + n * XP + c8 * 8) = wreg[pi]; } }
            __syncthreads();
            if (hc < 7) { NG_WLOAD(hc + 1) }
            { const int rb = wave & 3, kq = wave >> 2, i = lane & 15, g = lane >> 4;
#pragma unroll
              for (int s = 0; s < 2; ++s) { const int ko = kq * 64 + s * 32 + g * 8;
                  const bf16x8n ah = *(const LAS bf16x8n*)(XH + (rb * 16 + i) * XP + ko), al = *(const LAS bf16x8n*)(XL + (rb * 16 + i) * XP + ko);
#pragma unroll
                  for (int nb = 0; nb < NB; ++nb) { const bf16x8n bh = *(const LAS bf16x8n*)(WH + (nb * 16 + i) * XP + ko), bl = *(const LAS bf16x8n*)(WL + (nb * 16 + i) * XP + ko);
                      acc[nb] = __builtin_amdgcn_mfma_f32_16x16x32_bf16(ah, bh, acc[nb], 0, 0, 0);
                      acc[nb] = __builtin_amdgcn_mfma_f32_16x16x32_bf16(ah, bl, acc[nb], 0, 0, 0);
                      acc[nb] = __builtin_amdgcn_mfma_f32_16x16x32_bf16(al, bh, acc[nb], 0, 0, 0); } } }
            __syncthreads();
        } }
        { const int rb = wave & 3, kq = wave >> 2, i = lane & 15, g = lane >> 4;
#pragma unroll
          for (int nb = 0; nb < NB; ++nb)
#pragma unroll
              for (int e = 0; e < 4; ++e) part[(kq * 64 + rb * 16 + 4 * g + e) * PW + nb * 16 + i] = acc[nb][e]; }
        __syncthreads();
#define NG_SUM2(o) (part[o] + part[64 * PW + (o)])
        if (KIND == 0) {
            { const int r = tid >> 3, j = tid & 7; const int o = r * PW + j;
                float z = NG_SUM2(o);
                z = z * rsv[r] + ((const float*)F.in[I_BF])[l * 8 + j];
                const float lf = fminf(z, 0.f) - 0.6931471805599453f * __builtin_amdgcn_logf(1.0f + __builtin_amdgcn_exp2f(-fabsf(z) * LOG2E));
                { const int row = row0 + r; ((float*)(F.ws + WS_LOGF))[((size_t)(row / SEQ) * 8 + j) * SEQ + (row % SEQ)] = lf; } }
        } else {
            if (tid < 64 && !(VAR & 4)) { const int r = tid, row = row0 + r; const float rs = rsv[r];
                const float* brg = (const float*)F.in[I_BRG] + l * 4; const float* bre = (const float*)F.in[I_BRE] + l * 32;
                float lg[4];
#pragma unroll
                for (int q = 0; q < 4; ++q) { const int o = r * PW + q; lg[q] = NG_SUM2(o) * rs + brg[q]; }
                int gi = 0; float gm = lg[0];
#pragma unroll
                for (int q = 1; q < 4; ++q) if (lg[q] > gm) { gm = lg[q]; gi = q; }
                float gs = 0.f;
#pragma unroll
                for (int q = 0; q < 4; ++q) gs += __builtin_amdgcn_exp2f((lg[q] - gm) * LOG2E);
                const float pg = 1.0f / gs;
                float le[8];
#pragma unroll
                for (int e = 0; e < 8; ++e) { const int o = r * PW + 4 + gi * 8 + e; le[e] = NG_SUM2(o) * rs + bre[gi * 8 + e]; }
                int i1 = 0; float m1 = le[0];
#pragma unroll
                for (int e = 1; e < 8; ++e) if (le[e] > m1) { m1 = le[e]; i1 = e; }
                int i2 = 0; float m2 = -INFINITY;
#pragma unroll
                for (int e = 0; e < 8; ++e) if (e != i1 && le[e] > m2) { m2 = le[e]; i2 = e; }
                const float e2 = __builtin_amdgcn_exp2f((m2 - m1) * LOG2E); const float w1 = pg / (1.0f + e2), w2 = pg * e2 / (1.0f + e2);
                LAS unsigned* lcnt = (LAS unsigned*)(rsv + 64); LAS unsigned* lbase = lcnt + 32;
                if (r < 32) lcnt[r] = 0u;
                LDS_WAIT();
                const int ex1 = gi * 8 + i1, ex2 = gi * 8 + i2;
                const unsigned k1 = __hip_atomic_fetch_add(lcnt + ex1, 1u, __ATOMIC_RELAXED, __HIP_MEMORY_SCOPE_WORKGROUP), k2 = __hip_atomic_fetch_add(lcnt + ex2, 1u, __ATOMIC_RELAXED, __HIP_MEMORY_SCOPE_WORKGROUP);
                LDS_WAIT();
                unsigned* CNT = F.ctl + CW_CNT + (size_t)l * NEXP * CNT_STRIDE;
                if (r < 32) { const unsigned mine = lcnt[r]; lbase[r] = mine ? atomicAdd(CNT + r * CNT_STRIDE, mine) : 0u; }
                LDS_WAIT();
                int* LIST = (int*)(F.ws + WS_LIST); float* GWT = (float*)(F.ws + WS_GWT);
                LIST[(size_t)ex1 * T + lbase[ex1] + k1] = row * 2; LIST[(size_t)ex2 * T + lbase[ex2] + k2] = row * 2 + 1;
                GWT[row * 2] = w1; GWT[row * 2 + 1] = w2; }
        }
#undef NG_SUM2
#undef NG_WLOAD
#pragma unroll
        for (int rr = 0; rr < 8; ++rr) { const int rl = wave * 8 + rr, row = row0 + rl; const float r = rsv[rl];
#pragma unroll
            for (int j = 0; j < 4; ++j) { const f32x4 g = *(const f32x4*)(gn + lane * 4 + 256 * j); const f32x4 h = v_[rr][j] * r * g;
                *(v2u*)(HN + (size_t)row * D + lane * 4 + 256 * j) = (v2u){pk2(h.x, h.y), pk2(h.z, h.w)}; } }
        __syncthreads();
    }
}
__device__ __forceinline__ double wave_sum_d(double v, int lane) {
#pragma unroll
    for (int o = 1; o < 64; o <<= 1) v += shx_d(v, o, lane);
    return v;
}
__device__ __forceinline__ void phase_router2(Frame& F, int l, bool dry = false) {
    constexpr int PW = 41;
    LAS float* sm = (LAS float*)(F.lds + RING_OFF);
    LAS unsigned* lcnt = (LAS unsigned*)(sm + 64 * PW); LAS unsigned* lbase = lcnt + 32;
    const float* SUMS = (const float*)(F.ws + WS_SUMS);
    for (int bt = F.vcu; bt < T / 64; bt += F.G) {
        const int row0 = bt * 64;
        { const int r = F.tid >> 3, j = F.tid & 7; const int c = j < 5 ? j * 8 : 48;
          if (j < 6) { const float* S0 = SUMS + (size_t)(row0 + r) * 64 + c;
              f32x4 a0 = *(const f32x4*)S0, a1 = *(const f32x4*)(S0 + (size_t)T * 64), a2 = *(const f32x4*)(S0 + (size_t)2 * T * 64), a3 = *(const f32x4*)(S0 + (size_t)3 * T * 64);
              f32x4 b0 = a0, b1 = a1, b2 = a2, b3 = a3;
              if (j < 5) { b0 = *(const f32x4*)(S0 + 4); b1 = *(const f32x4*)(S0 + (size_t)T * 64 + 4); b2 = *(const f32x4*)(S0 + (size_t)2 * T * 64 + 4); b3 = *(const f32x4*)(S0 + (size_t)3 * T * 64 + 4); }
              const f32x4 sa = (a0 + a1) + (a2 + a3), sb = (b0 + b1) + (b2 + b3);
              if (j < 5) {
#pragma unroll
                  for (int e = 0; e < 4; ++e) { sm[r * PW + c + e] = sa[e]; sm[r * PW + c + 4 + e] = sb[e]; } }
              else sm[r * PW + 40] = sa.x; } }
        __syncthreads();
        if (F.tid < 64) { const int r = F.tid, row = row0 + r;
            const float rs = 1.0f / sqrtf(sm[r * PW + 40] * (1.0f / D) + EPS);
            ((float*)(F.ws + WS_RSTD))[row] = rs;
            const float* brg = (const float*)F.in[I_BRG] + l * 4; const float* bre = (const float*)F.in[I_BRE] + l * 32;
            float lg[4];
#pragma unroll
            for (int q = 0; q < 4; ++q) lg[q] = sm[r * PW + q] * rs + brg[q];
            int gi = 0; float gm = lg[0];
#pragma unroll
            for (int q = 1; q < 4; ++q) if (lg[q] > gm) { gm = lg[q]; gi = q; }
            float gs = 0.f;
#pragma unroll
            for (int q = 0; q < 4; ++q) gs += __builtin_amdgcn_exp2f((lg[q] - gm) * LOG2E);
            const float pg = 1.0f / gs;
            float le[8];
#pragma unroll
            for (int e = 0; e < 8; ++e) le[e] = sm[r * PW + 4 + gi * 8 + e] * rs + bre[gi * 8 + e];
            int i1 = 0; float m1 = le[0];
#pragma unroll
            for (int e = 1; e < 8; ++e) if (le[e] > m1) { m1 = le[e]; i1 = e; }
            int i2 = 0; float m2 = -INFINITY;
#pragma unroll
            for (int e = 0; e < 8; ++e) if (e != i1 && le[e] > m2) { m2 = le[e]; i2 = e; }
            const float e2 = __builtin_amdgcn_exp2f((m2 - m1) * LOG2E); const float w1 = pg / (1.0f + e2), w2 = pg * e2 / (1.0f + e2);
            if (dry) { if (w1 + w2 == 1.2345e33f) ((float*)(F.ws + WS_GWT))[row * 2] = w1; } else {
            if (r < 32) lcnt[r] = 0u;
            LDS_WAIT();
            const int ex1 = gi * 8 + i1, ex2 = gi * 8 + i2;
            const unsigned k1 = __hip_atomic_fetch_add(lcnt + ex1, 1u, __ATOMIC_RELAXED, __HIP_MEMORY_SCOPE_WORKGROUP), k2 = __hip_atomic_fetch_add(lcnt + ex2, 1u, __ATOMIC_RELAXED, __HIP_MEMORY_SCOPE_WORKGROUP);
            LDS_WAIT();
            unsigned* CNT = F.ctl + CW_CNT + (size_t)l * NEXP * CNT_STRIDE;
            if (r < 32) { const unsigned mine = lcnt[r]; lbase[r] = mine ? atomicAdd(CNT + r * CNT_STRIDE, mine) : 0u; }
            LDS_WAIT();
            int* LIST = (int*)(F.ws + WS_LIST); float* GWT = (float*)(F.ws + WS_GWT);
            LIST[(size_t)ex1 * T + lbase[ex1] + k1] = row * 2; LIST[(size_t)ex2 * T + lbase[ex2] + k2] = row * 2 + 1;
            GWT[row * 2] = w1; GWT[row * 2 + 1] = w2; } }
        __syncthreads();
    }
}
__device__ __forceinline__ void phase_cumsum(Frame& F) {
    const float* LOGF = (const float*)(F.ws + WS_LOGF); float* CUM = (float*)(F.ws + WS_CUM);
    LAS double* red = (LAS double*)(F.lds + RING_OFF);
    for (int task = F.vcu; task < BATCH * 8 * 16; task += F.G) {
        const int seq = task >> 4, c = task & 15, b = seq >> 3, j = seq & 7;
        const float* src = LOGF + ((size_t)b * 8 + j) * SEQ;
        double acc = 0.0;
        for (int i = F.tid; i < c * 128; i += NWAVES * 64) { const f32x4 q = *(const f32x4*)(src + 4 * i); acc += ((double)q.x + (double)q.y) + ((double)q.z + (double)q.w); }
        acc = wave_sum_d(acc, F.lane);
        double v = (double)src[c * 512 + F.tid];
#pragma unroll
        for (int o = 1; o < 64; o <<= 1) { const double u = shx_d(v, 0, (F.lane - o) & 63); if (F.lane >= o) v += u; }
        if (F.lane == 63) { red[F.wave] = acc; red[8 + F.wave] = v; }
        else if (F.lane == 0 && false) {}
        __syncthreads();
        double base = 0.0;
#pragma unroll
        for (int w = 0; w < 8; ++w) { base += red[w]; if (w < F.wave) base += red[8 + w]; }
        CUM[(size_t)seq * SEQ + c * 512 + F.tid] = (float)((base + v) * 1.4426950408889634);
        __syncthreads();
    }
}
__device__ __forceinline__ void phase_diffc(Frame& F, int l) {
    const float* lq1 = (const float*)F.in[I_LQ1] + l * 64; const float* lk1 = (const float*)F.in[I_LK1] + l * 64;
    const float* lq2 = (const float*)F.in[I_LQ2] + l * 64; const float* lk2 = (const float*)F.in[I_LK2] + l * 64;
    const float li = lambda_init_of(l);
    const float lam = __builtin_amdgcn_exp2f(LOG2E * wave_sum(lq1[F.lane] * lk1[F.lane], F.lane)) - __builtin_amdgcn_exp2f(LOG2E * wave_sum(lq2[F.lane] * lk2[F.lane], F.lane)) + li;
    const float* sub = (const float*)F.in[I_SUBLN] + l * 128;
    const bf16* OA = (const bf16*)(F.ws + WS_OA); bf16* AD = (bf16*)(F.ws + WS_AD);
    const int gw = F.vcu * NWAVES + F.wave, NGW = F.G * NWAVES, lane = F.lane;
    const int d0 = (lane & 15) * 8;
    float sg[8];
#pragma unroll
    for (int e = 0; e < 8; ++e) sg[e] = sub[d0 + e] * (1.0f - li);
    for (int rb0 = gw; rb0 < T; rb0 += 8 * NGW) {
        v4u a_[8], b_[8];
#pragma unroll
        for (int q = 0; q < 8; ++q) { const int row = rb0 + q * NGW < T ? rb0 + q * NGW : rb0;
            a_[q] = __builtin_nontemporal_load((const v4u*)(OA + (size_t)row * 1024 + lane * 8)); b_[q] = __builtin_nontemporal_load((const v4u*)(OA + (size_t)row * 1024 + 512 + lane * 8)); }
#pragma unroll
        for (int q = 0; q < 8; ++q) { const int row = rb0 + q * NGW; if (row < T) { const v4u a = a_[q], b = b_[q];
        float v[8];
        v[0] = bflo(a.x) - lam * bflo(b.x); v[1] = bfhi(a.x) - lam * bfhi(b.x); v[2] = bflo(a.y) - lam * bflo(b.y); v[3] = bfhi(a.y) - lam * bfhi(b.y);
        v[4] = bflo(a.z) - lam * bflo(b.z); v[5] = bfhi(a.z) - lam * bfhi(b.z); v[6] = bflo(a.w) - lam * bflo(b.w); v[7] = bfhi(a.w) - lam * bfhi(b.w);
        float ss = 0.f;
#pragma unroll
        for (int e = 0; e < 8; ++e) ss += v[e] * v[e];
        ss += shx(ss, 1, lane); ss += shx(ss, 2, lane); ss += shx(ss, 4, lane); ss += shx(ss, 8, lane);
        const float r = __builtin_amdgcn_rsqf(ss * (1.0f / 128.0f) + EPS);
        v4u o; o.x = pk2(v[0] * r * sg[0], v[1] * r * sg[1]); o.y = pk2(v[2] * r * sg[2], v[3] * r * sg[3]); o.z = pk2(v[4] * r * sg[4], v[5] * r * sg[5]); o.w = pk2(v[6] * r * sg[6], v[7] * r * sg[7]);
        *(v4u*)(AD + (size_t)row * 512 + lane * 8) = o; } }
    }
}
__device__ __forceinline__ void phase_final(Frame& F, bool dry = false) {
    const bf16* Y = (const bf16*)(F.ws + WS_Y);
    const int gw = F.vcu * NWAVES + F.wave, NGW = F.G * NWAVES, lane = F.lane;
    for (int rb0 = gw; rb0 < T; rb0 += 4 * NGW) {
        f32x4 v_[4][4]; v2u a_[4][4], b_[4][4];
#pragma unroll
        for (int q = 0; q < 4; ++q) { const int row = rb0 + q * NGW < T ? rb0 + q * NGW : rb0;
#pragma unroll
            for (int j = 0; j < 4; ++j) { v_[q][j] = __builtin_nontemporal_load((const f32x4*)(F.out + (size_t)row * D + lane * 4 + 256 * j));
                a_[q][j] = __builtin_nontemporal_load((const v2u*)(Y + (size_t)row * D + lane * 4 + 256 * j)); b_[q][j] = __builtin_nontemporal_load((const v2u*)(Y + (size_t)T * D + (size_t)row * D + lane * 4 + 256 * j)); } }
#pragma unroll
        for (int q = 0; q < 4; ++q) { const int row = rb0 + q * NGW; if (row < T) {
#pragma unroll
            for (int j = 0; j < 4; ++j) { f32x4 v = v_[q][j]; const v2u a = a_[q][j], b = b_[q][j];
                v.x += bflo(a.x) + bflo(b.x); v.y += bfhi(a.x) + bfhi(b.x); v.z += bflo(a.y) + bflo(b.y); v.w += bfhi(a.y) + bfhi(b.y);
                if (!dry || v.x == 1.2345e33f) __builtin_nontemporal_store(v, (f32x4*)(F.out + (size_t)row * D + lane * 4 + 256 * j)); } } }
    }
}
namespace pg8 {
typedef short bf16x8 __attribute__((ext_vector_type(8)));
typedef unsigned u32x4 __attribute__((ext_vector_type(4)));
constexpr int BM = 256, BK = 64, HALF = 128, HTB = HALF * BK * 2, STAGE_BYTES = 8 * HTB;
__host__ __device__ __forceinline__ int lds_byte(int r, int c) { const int st = (r >> 4) * 2 + (c >> 5), rr = r & 15, cc = c & 31, ob = rr * 64 + cc * 2; return st * 1024 + (ob ^ (((ob >> 9) & 1) << 5)); }
__host__ __device__ __forceinline__ void stage_rc(int b, int& R, int& C) { const int st = b / 1024, sb = b % 1024, swz = sb ^ (((sb >> 9) & 1) << 5); R = (st >> 1) * 16 + swz / 64; C = (st & 1) * 32 + (swz % 64) / 2; }
__host__ __device__ __forceinline__ int perm32(int rho) { const int n = rho >> 4, i = rho & 15; return 8 * (i >> 2) + 4 * n + (i & 3); }
struct Unit { int pm, pn, ex, sl; };
__device__ __forceinline__ unsigned cvt_pk_bf16(float lo, float hi) { unsigned r; asm volatile("v_cvt_pk_bf16_f32 %0, %1, %2" : "=v"(r) : "v"(lo), "v"(hi)); return r; }

struct StaticOrder {
    int nM, nN, nwg, G, c, K;
    __device__ void init(int M, int N, int K_, int G_, int c_) { nM = M / BM; nN = N / BM; nwg = nM * nN; G = G_; c = c_; K = K_; }
    __device__ __forceinline__ bool next(int i, Unit& u) const {
        const long L = (long)i * G + c; if (L >= nwg) return false;
        int wgid = (int)L; { const int q = nwg / 8, r = nwg % 8, xcd = wgid % 8, off = wgid / 8; wgid = (xcd < r ? xcd * (q + 1) : r * (q + 1) + (xcd - r) * q) + off; }
        const int nig = 8 * nN, gid = wgid / nig, fm = gid * 8, gsz = (nM - fm) < 8 ? (nM - fm) : 8;
        u.pm = fm + ((wgid % nig) % gsz); u.pn = (wgid % nig) / gsz; u.ex = 0; u.sl = 0; return true;
    }
    static constexpr bool GATHER = false; static constexpr int A_AUX = 0;
    __device__ __forceinline__ void a_ready(const Unit&) const {}
    __device__ __forceinline__ size_t a_off(const Unit& u) const { return (size_t)u.pm * BM * K * 2; }
    __device__ __forceinline__ unsigned arow_off(const Unit&, int) const { return 0u; }
    __device__ __forceinline__ size_t b_off(const Unit& u) const { return (size_t)u.pn * BM * K * 2; }
};

template <class Epi, class Sched, bool ALIGN_EPI>
__device__ __forceinline__ void gemm_phase(LAS unsigned char* lds, const int wave0, const bf16* Ag, const bf16* Btg, const int K, const Sched& S, const Epi& E) {
    const int tid = fresh_tid(wave0);
    const int wid = __builtin_amdgcn_readfirstlane(tid >> 6), lane = tid & 63, wr = wid >> 2, wc = wid & 3, fr = lane & 15, fq = lane >> 4;
    const int nt = K / BK;
    constexpr bool GATHER = Sched::GATHER;
    int RA0 = 0; unsigned CA2 = 0u, voffA[2], voffB[2];
#pragma unroll
    for (int i = 0; i < 2; ++i) { int R, C; stage_rc(tid * 16 + i * 8192, R, C); if (i == 0) { RA0 = R; CA2 = (unsigned)C * 2u; }
        voffA[i] = (unsigned)(R * K + C) * 2u;
        const int Rb = Epi::BMODE == 2 ? 64 * (R >> 5) + perm32(R & 31) : (Epi::BMODE == 1 ? ((R & ~31) + perm32(R & 31)) : R);
        voffB[i] = (unsigned)(Rb * K + C) * 2u; }
    const size_t kstep = (size_t)(BK * 2);
    const size_t hstepB = (size_t)(Epi::BMODE == 2 ? 32 : HALF) * K * 2, hstepA = (size_t)HALF * K * 2;
    const unsigned ldsw = (unsigned)wid * 1024u;
    const int aoff = lds_byte(wr * 64 + fr, fq * 8), boff = lds_byte(wc * 32 + fr, fq * 8);
#define PG8_SA(b, h) (((b) * 2 + (h)) * HTB)
#define PG8_SB(b, h) ((4 + (b) * 2 + (h)) * HTB)
#define PG8_STAGE_A(bufoff, gbase, voff) do { _Pragma("unroll") for (int _i = 0; _i < 2; ++_i) \
        __builtin_amdgcn_global_load_lds((const unsigned*)((const char*)(gbase) + (voff)[_i]), (LAS unsigned*)(lds + (bufoff) + ldsw + _i * 8192), 16, 0, Sched::A_AUX); } while (0)
#define PG8_STAGE(bufoff, gbase, voff) do { _Pragma("unroll") for (int _i = 0; _i < 2; ++_i) \
        __builtin_amdgcn_global_load_lds((const unsigned*)((const char*)(gbase) + (voff)[_i]), (LAS unsigned*)(lds + (bufoff) + ldsw + _i * 8192), 16, 0, 0); } while (0)
#define PG8_LDA(dst, b, h) do { _Pragma("unroll") for (int m = 0; m < 4; ++m) _Pragma("unroll") for (int k = 0; k < 2; ++k) dst[m][k] = *(const LAS bf16x8*)(lds + PG8_SA(b, h) + aoff + m * 2048 + k * 1024); } while (0)
#define PG8_LDB(dst, b, h) do { _Pragma("unroll") for (int n = 0; n < 2; ++n) _Pragma("unroll") for (int k = 0; k < 2; ++k) dst[n][k] = *(const LAS bf16x8*)(lds + PG8_SB(b, h) + boff + n * 2048 + k * 1024); } while (0)
#define PG8_MMA(ai, bj, At, Bt) do { __builtin_amdgcn_s_setprio(1); _Pragma("unroll") for (int m = 0; m < 4; ++m) _Pragma("unroll") for (int n = 0; n < 2; ++n) _Pragma("unroll") for (int k = 0; k < 2; ++k) \
        acc[ai][bj][m][n] = __builtin_amdgcn_mfma_f32_16x16x32_bf16(Bt[n][k], At[m][k], acc[ai][bj][m][n], 0, 0, 0); __builtin_amdgcn_s_setprio(0); } while (0)
#define PG8_WAIT_V(n) asm volatile("s_waitcnt vmcnt(" #n ")" ::: "memory")
#define PG8_WAIT_L(n) asm volatile("s_waitcnt lgkmcnt(" #n ")" ::: "memory")
#define PG8_BAR __builtin_amdgcn_s_barrier()
#define PG8_SCHED __builtin_amdgcn_sched_barrier(0)
    Unit cur, nxt; int ui = 0;
    if (!S.next(0, cur)) return;
    f32x4 acc[2][2][4][2];
#pragma unroll
    for (int a = 0; a < 2; ++a)
#pragma unroll
        for (int b = 0; b < 2; ++b)
#pragma unroll
            for (int m = 0; m < 4; ++m)
#pragma unroll
                for (int n = 0; n < 2; ++n) acc[a][b][m][n] = (f32x4){0.f, 0.f, 0.f, 0.f};
    bf16x8 At[4][2], B0[2][2], B1[2][2];
    unsigned gc0[2] = {0u, 0u}, gc1[2] = {0u, 0u};
#define PG8_GOFF(u, d0, d1) do { d0[0] = S.arow_off(u, RA0) + CA2; d0[1] = S.arow_off(u, RA0 + 64) + CA2; d1[0] = S.arow_off(u, HALF + RA0) + CA2; d1[1] = S.arow_off(u, HALF + RA0 + 64) + CA2; } while (0)
    if constexpr (GATHER) PG8_GOFF(cur, gc0, gc1);
    S.a_ready(cur);
    const char* cA = (const char*)Ag; if constexpr (!GATHER) cA += S.a_off(cur);
    const char* cB = (const char*)Btg + S.b_off(cur);
    PG8_STAGE(PG8_SB(0, 0), cB, voffB); PG8_STAGE(PG8_SB(0, 1), cB + hstepB, voffB);
    if constexpr (GATHER) { PG8_STAGE_A(PG8_SA(0, 0), cA, gc0); PG8_STAGE_A(PG8_SA(0, 1), cA, gc1); } else { PG8_STAGE_A(PG8_SA(0, 0), cA, voffA); PG8_STAGE_A(PG8_SA(0, 1), cA + hstepA, voffA); }
    if (wr == 1) PG8_BAR;
    PG8_WAIT_V(2); PG8_BAR;
    PG8_STAGE(PG8_SB(1, 0), cB + kstep, voffB);
    if constexpr (GATHER) PG8_STAGE_A(PG8_SA(1, 0), cA + kstep, gc0); else PG8_STAGE_A(PG8_SA(1, 0), cA + kstep, voffA);
    PG8_STAGE(PG8_SB(1, 1), cB + hstepB + kstep, voffB);
    PG8_WAIT_V(6); PG8_BAR;
    for (;;) {
        const bool has_next = S.next(ui + 1, nxt);
        const char* nA = cA; if constexpr (!GATHER) { if (has_next) nA = (const char*)Ag + S.a_off(nxt); }
        const char* nB = has_next ? (const char*)Btg + S.b_off(nxt) : cB;
        for (int t = 0; t < nt; t += 2) {
            const bool last = (t == nt - 2);
            if (last && has_next) S.a_ready(nxt);
            const char* a1 = cA + (size_t)(t + 1) * kstep;
            const char* a2 = last ? nA : cA + (size_t)(t + 2) * kstep; const char* b2 = last ? nB : cB + (size_t)(t + 2) * kstep;
            const char* a3 = a2 + kstep; const char* b3 = b2 + kstep;
            unsigned vs0[2] = {gc0[0], gc0[1]}, vs1[2] = {gc1[0], gc1[1]};
            if constexpr (GATHER) { if (last && has_next) PG8_GOFF(nxt, vs0, vs1); }
#define PG8_STA(bufoff, base, h, vs) do { if constexpr (GATHER) PG8_STAGE_A(bufoff, base, vs); else PG8_STAGE_A(bufoff, (base) + (h) * hstepA, voffA); } while (0)
            PG8_LDB(B0, 0, 0); PG8_LDB(B1, 0, 1); PG8_SCHED; PG8_LDA(At, 0, 0); PG8_STA(PG8_SA(1, 1), a1, 1, gc1);
            PG8_WAIT_V(8); PG8_WAIT_L(0); PG8_BAR; PG8_MMA(0, 0, At, B0); PG8_MMA(0, 1, At, B1); PG8_BAR; PG8_SCHED;
            PG8_LDA(At, 0, 1); PG8_STAGE(PG8_SB(0, 0), b2, voffB); PG8_STAGE(PG8_SB(0, 1), b2 + hstepB, voffB); PG8_STA(PG8_SA(0, 0), a2, 0, vs0);
            PG8_WAIT_V(8); PG8_WAIT_L(0); PG8_BAR; PG8_MMA(1, 0, At, B0); PG8_MMA(1, 1, At, B1); PG8_BAR; PG8_SCHED;
            PG8_LDB(B0, 1, 0); PG8_LDB(B1, 1, 1); PG8_SCHED; PG8_LDA(At, 1, 0); PG8_STA(PG8_SA(0, 1), a2, 1, vs1);
            PG8_WAIT_V(8); PG8_WAIT_L(0); PG8_BAR; PG8_MMA(0, 0, At, B0); PG8_MMA(0, 1, At, B1); PG8_BAR; PG8_SCHED;
            PG8_LDA(At, 1, 1); PG8_STAGE(PG8_SB(1, 0), b3, voffB); PG8_STAGE(PG8_SB(1, 1), b3 + hstepB, voffB); PG8_STA(PG8_SA(1, 0), a3, 0, vs0);
            PG8_WAIT_V(8); PG8_WAIT_L(0); PG8_BAR; PG8_MMA(1, 0, At, B0); PG8_MMA(1, 1, At, B1); PG8_BAR; PG8_SCHED;
        }
        if constexpr (ALIGN_EPI) { if (wr == 0) PG8_BAR; }
        if constexpr (!Epi::AFTER_DRAIN) E(acc, cur, wr, wc, fr, fq);
        if (!has_next) break;
        if (!(Epi::CHAIN2 && cur.ex == 0)) {
#pragma unroll
        for (int a = 0; a < 2; ++a)
#pragma unroll
            for (int b = 0; b < 2; ++b)
#pragma unroll
                for (int m = 0; m < 4; ++m)
#pragma unroll
                    for (int n = 0; n < 2; ++n) acc[a][b][m][n] = (f32x4){0.f, 0.f, 0.f, 0.f}; }
        cur = nxt; cA = nA; cB = nB; ++ui;
        if constexpr (GATHER) PG8_GOFF(cur, gc0, gc1);
        if constexpr (ALIGN_EPI) { if (wr == 1) PG8_BAR; }
    }
    PG8_WAIT_V(0);
    if constexpr (!ALIGN_EPI) { if (wr == 0) PG8_BAR; }
    PG8_BAR;
    if constexpr (Epi::AFTER_DRAIN) E.fused(acc, cur, wr, wc, fr, fq, lds, tid);
#undef PG8_SA
#undef PG8_SB
#undef PG8_STAGE
#undef PG8_STAGE_A
#undef PG8_STA
#undef PG8_GOFF
#undef PG8_LDA
#undef PG8_LDB
#undef PG8_MMA
#undef PG8_WAIT_V
#undef PG8_WAIT_L
#undef PG8_BAR
#undef PG8_SCHED
}
}
typedef pg8::Unit Unit;
__device__ __forceinline__ float sigmoidf_(float v) { return __builtin_amdgcn_rcpf(1.0f + __builtin_amdgcn_exp2f(-v * LOG2E)); }

struct EpiInproj {
    static constexpr int BMODE = 2; static constexpr bool CHAIN2 = false, AFTER_DRAIN = false;
    bf16* O; const float* gt; const float* cs;
    __device__ __forceinline__ void operator()(f32x4 (&acc)[2][2][4][2], const Unit& u, int wr, int wc, int fr, int fq) const {
        const int seg = u.pn >> 1;
        const int col0 = u.pn * 256 + wc * 64 + 8 * fq;
        const bool isnorm = (seg == 0 || seg == 1 || seg == 3 || seg == 4), isdiff = seg < 2;
        f32x4 g[2][2];
        if (isnorm) {
            const float* gp = gt + (seg < 2 ? seg : seg - 1) * 64;
#pragma unroll
            for (int bj = 0; bj < 2; ++bj)
#pragma unroll
                for (int n = 0; n < 2; ++n) { const int d0 = (isdiff && bj == 0 && fq < 2) ? (4 * fq + 8 * n) : (32 * bj + 8 * fq + 4 * n); g[bj][n] = *(const f32x4*)(gp + d0); }
        }
#pragma unroll
        for (int ai = 0; ai < 2; ++ai)
#pragma unroll
            for (int m = 0; m < 4; ++m) {
                const int row = u.pm * 256 + ai * 128 + wr * 64 + m * 16 + fr;
                f32x4 v00 = acc[ai][0][m][0], v01 = acc[ai][0][m][1], v10 = acc[ai][1][m][0], v11 = acc[ai][1][m][1];
                if (isnorm) {
                    float ss = (v00.x * v00.x + v00.y * v00.y) + (v00.z * v00.z + v00.w * v00.w) + (v01.x * v01.x + v01.y * v01.y) + (v01.z * v01.z + v01.w * v01.w)
                             + (v10.x * v10.x + v10.y * v10.y) + (v10.z * v10.z + v10.w * v10.w) + (v11.x * v11.x + v11.y * v11.y) + (v11.z * v11.z + v11.w * v11.w);
                    ss += shx(ss, 16, fq * 16 + fr); ss += shx(ss, 32, fq * 16 + fr);
                    const float rs = __builtin_amdgcn_rsqf(ss * (1.0f / 64.0f) + EPS);
                    v00 = v00 * rs * g[0][0]; v01 = v01 * rs * g[0][1]; v10 = v10 * rs * g[1][0]; v11 = v11 * rs * g[1][1];
                    if (isdiff) {
                        const int fi = (fq & 1) * 4;
                        const f32x4 c = *(const f32x4*)(cs + (size_t)row * 16 + fi), s = *(const f32x4*)(cs + (size_t)row * 16 + 8 + fi);
                        const f32x4 r0 = v00 * c - v01 * s, r1 = v01 * c + v00 * s;
                        if (fq < 2) { v00 = r0; v01 = r1; }
                    }
                } else if (seg >= 6) {
#pragma unroll
                    for (int e = 0; e < 4; ++e) { v00[e] = sigmoidf_(v00[e]); v01[e] = sigmoidf_(v01[e]); v10[e] = sigmoidf_(v10[e]); v11[e] = sigmoidf_(v11[e]); }
                }
                bf16* rowp = O + (size_t)row * NP + col0;
                pg8::u32x4 w0, w1;
                w0.x = pg8::cvt_pk_bf16(v00.x, v00.y); w0.y = pg8::cvt_pk_bf16(v00.z, v00.w); w0.z = pg8::cvt_pk_bf16(v01.x, v01.y); w0.w = pg8::cvt_pk_bf16(v01.z, v01.w);
                w1.x = pg8::cvt_pk_bf16(v10.x, v10.y); w1.y = pg8::cvt_pk_bf16(v10.z, v10.w); w1.z = pg8::cvt_pk_bf16(v11.x, v11.y); w1.w = pg8::cvt_pk_bf16(v11.z, v11.w);
#if SC1_STORES
                asm volatile("global_store_dwordx4 %0, %1, off sc1\n\tglobal_store_dwordx4 %0, %2, off offset:64 sc1\n\ts_nop 1" :: "v"(rowp), "v"(w0), "v"(w1) : "memory");
#else
                *(pg8::u32x4*)(rowp) = w0; *(pg8::u32x4*)(rowp + 32) = w1;
#endif
            }
    }
};
template <bool FIRST> struct EpiYZ {
    static constexpr int BMODE = 1; static constexpr bool CHAIN2 = false, AFTER_DRAIN = false;
    bf16* Z; const bf16* G;
    __device__ __forceinline__ void operator()(f32x4 (&acc)[2][2][4][2], const Unit& u, int wr, int wc, int fr, int fq) const {
#pragma unroll
        for (int ai = 0; ai < 2; ++ai)
#pragma unroll
            for (int m = 0; m < 4; ++m) { const int row = u.pm * 256 + ai * 128 + wr * 64 + m * 16 + fr;
#pragma unroll
                for (int bj = 0; bj < 2; ++bj) { const int col = u.pn * 256 + bj * 128 + wc * 32 + 8 * fq;
                    const pg8::u32x4 gw = *(const pg8::u32x4*)(G + (size_t)row * NP + col);
                    f32x4 v0 = acc[ai][bj][m][0], v1 = acc[ai][bj][m][1];
                    v0.x *= bflo(gw.x); v0.y *= bfhi(gw.x); v0.z *= bflo(gw.y); v0.w *= bfhi(gw.y); v1.x *= bflo(gw.z); v1.y *= bfhi(gw.z); v1.z *= bflo(gw.w); v1.w *= bfhi(gw.w);
                    bf16* zp = Z + (size_t)row * D + col;
                    if (!FIRST) { const pg8::u32x4 zo = *(const pg8::u32x4*)zp;
                        v0.x += bflo(zo.x); v0.y += bfhi(zo.x); v0.z += bflo(zo.y); v0.w += bfhi(zo.y); v1.x += bflo(zo.z); v1.y += bfhi(zo.z); v1.z += bflo(zo.w); v1.w += bfhi(zo.w); }
                    pg8::u32x4 w; w.x = pg8::cvt_pk_bf16(v0.x, v0.y); w.y = pg8::cvt_pk_bf16(v0.z, v0.w); w.z = pg8::cvt_pk_bf16(v1.x, v1.y); w.w = pg8::cvt_pk_bf16(v1.z, v1.w);
                    *(pg8::u32x4*)zp = w; } }
    }
};
struct EpiWo {
    static constexpr int BMODE = 0; static constexpr bool CHAIN2 = false, AFTER_DRAIN = false;
    float* out; bool dry;
    __device__ __forceinline__ void operator()(f32x4 (&acc)[2][2][4][2], const Unit& u, int wr, int wc, int fr, int fq) const {
#pragma unroll
        for (int ai = 0; ai < 2; ++ai)
#pragma unroll
            for (int m = 0; m < 4; ++m) { const int row = u.pm * 256 + ai * 128 + wr * 64 + m * 16 + fr;
#pragma unroll
                for (int bj = 0; bj < 2; ++bj)
#pragma unroll
                    for (int n = 0; n < 2; ++n) { float* p = out + (size_t)row * D + u.pn * 256 + bj * 128 + wc * 32 + n * 16 + 4 * fq; const f32x4 nv = *(const f32x4*)p + acc[ai][bj][m][n]; if (!dry || nv.x == 1.2345e33f) *(f32x4*)p = nv; }
                if (m == 3) asm volatile("" ::: "memory"); }
    }
};
struct EpiWoR {
    static constexpr int BMODE = 2; static constexpr bool CHAIN2 = false, AFTER_DRAIN = true;
    float* out; const float* res; bf16* HN; const float* g2; const bf16* WT; float* SUMS; bool dry;
    __device__ __forceinline__ void operator()(f32x4 (&)[2][2][4][2], const Unit&, int, int, int, int) const {}
    __device__ __forceinline__ void fused(f32x4 (&acc)[2][2][4][2], const Unit& u, int wr, int wc, int fr, int fq, LAS unsigned char* lds, int tid) const {
        constexpr int PW = 49;
        LAS float* tab = (LAS float*)lds;
        const int lane = fq * 16 + fr;
        const int c0 = u.pn * 256 + wc * 64 + 8 * fq;
        pg8::bf16x8 wh[2][3], wl[2][3]; f32x4 gg[2][2];
#pragma unroll
        for (int bj = 0; bj < 2; ++bj) {
#pragma unroll
            for (int nb = 0; nb < 3; ++nb) { wh[bj][nb] = *(const pg8::bf16x8*)(WT + (size_t)(nb * 16 + fr) * D + c0 + 32 * bj); wl[bj][nb] = *(const pg8::bf16x8*)(WT + (size_t)48 * D + (size_t)(nb * 16 + fr) * D + c0 + 32 * bj); }
#pragma unroll
            for (int n = 0; n < 2; ++n) gg[bj][n] = *(const f32x4*)(g2 + c0 + 32 * bj + 4 * n); }
#pragma unroll
        for (int ai = 0; ai < 2; ++ai)
#pragma unroll
            for (int m = 0; m < 4; ++m) { const int row = u.pm * 256 + ai * 128 + wr * 64 + m * 16 + fr;
                float ss = 0.f; f32x4 dd[3];
#pragma unroll
                for (int nb = 0; nb < 3; ++nb) dd[nb] = (f32x4){0.f, 0.f, 0.f, 0.f};
#pragma unroll
                for (int bj = 0; bj < 2; ++bj) { float* p = out + (size_t)row * D + c0 + 32 * bj; const float* ps = res + (size_t)row * D + c0 + 32 * bj;
                    const f32x4 o0 = *(const f32x4*)ps, o1 = *(const f32x4*)(ps + 4); const f32x4 v0 = o0 + acc[ai][bj][m][0], v1 = o1 + acc[ai][bj][m][1];
                    *(f32x4*)p = dry ? o0 : v0; *(f32x4*)(p + 4) = dry ? o1 : v1;
                    ss += ((v0.x * v0.x + v0.y * v0.y) + (v0.z * v0.z + v0.w * v0.w)) + ((v1.x * v1.x + v1.y * v1.y) + (v1.z * v1.z + v1.w * v1.w));
                    { const f32x4 a = v0 * gg[bj][0], b = v1 * gg[bj][1]; pg8::u32x4 o; o.x = pg8::cvt_pk_bf16(a.x, a.y); o.y = pg8::cvt_pk_bf16(a.z, a.w); o.z = pg8::cvt_pk_bf16(b.x, b.y); o.w = pg8::cvt_pk_bf16(b.z, b.w);
                      *(pg8::u32x4*)(HN + (size_t)row * D + c0 + 32 * bj) = o; }
                    pg8::u32x4 hp, lp;
                    hp.x = pg8::cvt_pk_bf16(v0.x, v0.y); hp.y = pg8::cvt_pk_bf16(v0.z, v0.w); hp.z = pg8::cvt_pk_bf16(v1.x, v1.y); hp.w = pg8::cvt_pk_bf16(v1.z, v1.w);
                    lp.x = pg8::cvt_pk_bf16(v0.x - bflo(hp.x), v0.y - bfhi(hp.x)); lp.y = pg8::cvt_pk_bf16(v0.z - bflo(hp.y), v0.w - bfhi(hp.y));
                    lp.z = pg8::cvt_pk_bf16(v1.x - bflo(hp.z), v1.y - bfhi(hp.z)); lp.w = pg8::cvt_pk_bf16(v1.z - bflo(hp.w), v1.w - bfhi(hp.w));
                    const pg8::bf16x8 ah = __builtin_bit_cast(pg8::bf16x8, hp), al = __builtin_bit_cast(pg8::bf16x8, lp);
#pragma unroll
                    for (int nb = 0; nb < 3; ++nb) { dd[nb] = __builtin_amdgcn_mfma_f32_16x16x32_bf16(ah, wh[bj][nb], dd[nb], 0, 0, 0); dd[nb] = __builtin_amdgcn_mfma_f32_16x16x32_bf16(ah, wl[bj][nb], dd[nb], 0, 0, 0);
                        dd[nb] = __builtin_amdgcn_mfma_f32_16x16x32_bf16(al, wh[bj][nb], dd[nb], 0, 0, 0); } }
                ss += shx(ss, 16, lane); ss += shx(ss, 32, lane);
                acc[ai][0][m][0] = dd[0]; acc[ai][0][m][1] = dd[1]; acc[ai][1][m][0] = dd[2]; acc[ai][1][m][1].x = ss; }
#pragma unroll 1
        for (int ph = 0; ph < 2; ++ph) {
            if ((wc >> 1) == ph) { LAS float* tb = tab + (wc & 1) * 256 * PW;
#pragma unroll
                for (int ai = 0; ai < 2; ++ai)
#pragma unroll
                    for (int m = 0; m < 4; ++m) { const int rb = ai * 128 + wr * 64 + m * 16;
#pragma unroll
                        for (int nb = 0; nb < 3; ++nb) { const f32x4 d = nb == 0 ? acc[ai][0][m][0] : (nb == 1 ? acc[ai][0][m][1] : acc[ai][1][m][0]);
#pragma unroll
                            for (int e = 0; e < 4; ++e) { LAS float* q = tb + (rb + 4 * fq + e) * PW + nb * 16 + fr; if (ph == 0) *q = d[e]; else *q += d[e]; } }
                        if (fq == 0) { LAS float* q = tb + (rb + fr) * PW + 48; const float s = acc[ai][1][m][1].x; if (ph == 0) *q = s; else *q += s; } }
            }
            LDS_WAIT(); __builtin_amdgcn_s_barrier();
        }
        float* dst = SUMS + ((size_t)u.pn * T + (size_t)u.pm * 256) * 64;
#pragma unroll 4
        for (int i = tid; i < 256 * 64; i += 512) { const int r = i >> 6, c = i & 63; if (c < PW) dst[(size_t)r * 64 + c] = tab[r * PW + c] + tab[256 * PW + r * PW + c]; }
    }
};
constexpr int MOE_LDS = MISC_OFF + 128;
constexpr int MOE_SLOTS = 8;
template <bool DOWN_> struct MoeOrderT {
    static constexpr bool GATHER = !DOWN_; static constexpr int A_AUX = 0;
    const LAS int* toff; const LAS int* ulist; const LAS int* idx;
    int Kb, l, wave0;
    unsigned* tcnt; unsigned* tmo;
    __device__ __forceinline__ bool next(int i, Unit& u) const {
        if (i >= ulist[8]) return false;
        const int L = ulist[i]; u.pm = L >> 2; u.pn = L & 3; u.sl = i; int e = 0;
#pragma unroll 1
        for (int q = 1; q < NEXP; ++q) if (u.pm >= toff[q]) e = q;
        u.ex = e; return true;
    }
    __device__ __forceinline__ void a_ready(const Unit& u) const {
        if constexpr (DOWN_ && !MOE_BARRIER) {
            if (wave0 == 0) {
                unsigned* w = tcnt + u.pm * TCNT_STRIDE; unsigned sp = 0;
                while ((unsigned)__builtin_amdgcn_readfirstlane(__hip_atomic_load(w, __ATOMIC_RELAXED, __HIP_MEMORY_SCOPE_AGENT)) < 32u) {
                    __builtin_amdgcn_s_sleep(2);
                    if ((++sp & 255u) == 0u) { if (__hip_atomic_load(tmo, __ATOMIC_RELAXED, __HIP_MEMORY_SCOPE_AGENT) != 0u) break;
                        if (sp > (1u << 20)) { if (fresh_lane() == 0) __hip_atomic_store(tmo, 1u, __ATOMIC_RELAXED, __HIP_MEMORY_SCOPE_AGENT); break; } } }
                __builtin_amdgcn_fence(__ATOMIC_ACQUIRE, "agent");
                asm volatile("s_waitcnt vmcnt(0)" ::: "memory");
            }
            asm volatile("" ::: "memory"); __builtin_amdgcn_s_barrier(); asm volatile("" ::: "memory");
        }
    }
    __device__ __forceinline__ unsigned arow_off(const Unit& u, int r) const { const int as = idx[u.sl * 256 + r]; return (unsigned)(as < 0 ? 0 : (as >> 1)) * (unsigned)Kb; }
    __device__ __forceinline__ size_t a_off(const Unit& u) const { return (size_t)u.pm * 256 * (size_t)Kb; }
    __device__ __forceinline__ size_t b_off(const Unit& u) const { return ((size_t)(l * NEXP + u.ex) * 1024 + (size_t)u.pn * 256) * (size_t)Kb; }
};
template <bool DOWN_> __device__ __forceinline__ MoeOrderT<DOWN_> moe_order_setup(Frame& F, int l, int Kb) {
    LAS int* toff = (LAS int*)(F.lds + MOE_LDS); LAS int* ulist = toff + 40; LAS int* idx = (LAS int*)(F.lds + MOE_LDS + 256);
    const unsigned* cnt = F.ctl + CW_CNT + (size_t)l * NEXP * CNT_STRIDE;
    if (F.wave == 0) {
        const int ln = F.lane; int nt = ln < NEXP ? ((int)cnt[ln * CNT_STRIDE] + 255) >> 8 : 0, inc = nt;
#pragma unroll
        for (int o = 1; o < 64; o <<= 1) { const int u = __builtin_amdgcn_ds_bpermute(((ln - o) & 63) << 2, inc); if (ln >= o) inc += u; }
        if (ln < NEXP) toff[ln] = inc - nt;
        if (ln == NEXP - 1) toff[NEXP] = inc;
        const int U = __builtin_amdgcn_readlane(inc, NEXP - 1) * 4, G = F.G, c = F.vcu;
        if (ln == 0) { int n = 0;
#ifndef MOE_OLD_DEAL
#define MOE_OLD_DEAL 0
#endif
        if (!DOWN_ || MOE_OLD_DEAL) { for (int L = c; L < U && n < MOE_SLOTS; L += G) ulist[n++] = L; }
        else {
            const int r = U % G, NL = G - r, a = U < 2 * NL ? U : 2 * NL, base_low = a / NL, extra_low = a % NL, R = U - a, base_all = R / G, extra_all = R % G;
            const int ord = c >= r ? c - r : NL + c;
            const int nd = (ord < NL ? base_low + (ord < extra_low ? 1 : 0) : 0) + base_all + (ord < extra_all ? 1 : 0);
            int bp[5] = {0, extra_low < NL ? extra_low : NL, extra_all, NL, G};
            if (bp[1] > bp[2]) { const int t_ = bp[1]; bp[1] = bp[2]; bp[2] = t_; }
            if (bp[2] > bp[3]) { const int t_ = bp[2]; bp[2] = bp[3]; bp[3] = t_; }
            if (bp[1] > bp[2]) { const int t_ = bp[1]; bp[1] = bp[2]; bp[2] = t_; }
            int S = 0;
            for (int k = 0; k < nd && n < MOE_SLOTS; ++k) {
                ulist[n++] = S + ord;
                int cntk = 0;
#pragma unroll
                for (int q = 0; q < 4; ++q) { const int o = bp[q], oe = bp[q + 1]; const int ndo = (o < NL ? base_low + (o < extra_low ? 1 : 0) : 0) + base_all + (o < extra_all ? 1 : 0); if (oe > o && ndo > k) cntk += oe - o; }
                S += cntk; }
        }
        ulist[8] = n; }
    }
    __syncthreads();
    MoeOrderT<DOWN_> S; S.toff = toff; S.ulist = ulist; S.idx = idx; S.Kb = Kb; S.l = l; S.wave0 = F.wave0;
    S.tcnt = F.ctl + CW_TCNT + (size_t)l * MAX_TILES * TCNT_STRIDE; S.tmo = F.ctl + CW_TMO;
    const int* LIST = (const int*)(F.ws + WS_LIST);
    Unit u;
    for (int i = 0; S.next(i, u); ++i) {
        if (F.tid < 256) { const int r = (u.pm - toff[u.ex]) * 256 + F.tid; idx[i * 256 + F.tid] = r < (int)cnt[u.ex * CNT_STRIDE] ? LIST[(size_t)u.ex * T + r] : -1; }
    }
    __syncthreads();
    return S;
}
#ifndef HID_PLAIN
#define HID_PLAIN 0
#endif
struct EpiGateUp {
    static constexpr int BMODE = 1; static constexpr bool CHAIN2 = false, AFTER_DRAIN = false;
    bf16* HID; const float* GWT; const float* RSTD; const LAS int* idx; unsigned* tcnt;
    __device__ __forceinline__ void operator()(f32x4 (&acc)[2][2][4][2], const Unit& u, int wr, int wc, int fr, int fq) const {
#pragma unroll
        for (int ai = 0; ai < 2; ++ai)
#pragma unroll
            for (int m = 0; m < 4; ++m) { const int r = ai * 128 + wr * 64 + m * 16 + fr; const int as = idx[u.sl * 256 + r];
                const float w = as < 0 ? 0.f : GWT[as]; const float rs = as < 0 ? 0.f : RSTD[as >> 1];
                const f32x4 g0 = acc[ai][0][m][0] * rs, g1 = acc[ai][0][m][1] * rs, u0 = acc[ai][1][m][0] * rs, u1 = acc[ai][1][m][1] * rs;
                f32x4 h0, h1;
#pragma unroll
                for (int e = 0; e < 4; ++e) { h0[e] = g0[e] * sigmoidf_(g0[e]) * u0[e] * w; h1[e] = g1[e] * sigmoidf_(g1[e]) * u1[e] * w; }
                if (as < 0) { h0 = (f32x4){0.f, 0.f, 0.f, 0.f}; h1 = h0; }
                pg8::u32x4 o; o.x = pg8::cvt_pk_bf16(h0.x, h0.y); o.y = pg8::cvt_pk_bf16(h0.z, h0.w); o.z = pg8::cvt_pk_bf16(h1.x, h1.y); o.w = pg8::cvt_pk_bf16(h1.z, h1.w);
#if HID_PLAIN
                *(pg8::u32x4*)(HID + (size_t)(u.pm * 256 + r) * FF + u.pn * 128 + wc * 32 + 8 * fq) = o; }
#else
                asm volatile("global_store_dwordx4 %0, %1, off sc1\n\ts_nop 1" :: "v"(HID + (size_t)(u.pm * 256 + r) * FF + u.pn * 128 + wc * 32 + 8 * fq), "v"(o) : "memory"); }
#endif
#if !MOE_BARRIER
        asm volatile("s_waitcnt vmcnt(0)" ::: "memory");
        if (fr == 0 && fq == 0) __hip_atomic_fetch_add(tcnt + u.pm * TCNT_STRIDE, 1u, __ATOMIC_RELAXED, __HIP_MEMORY_SCOPE_AGENT);
#endif
    }
};
struct EpiDown {
    static constexpr int BMODE = 2; static constexpr bool CHAIN2 = false, AFTER_DRAIN = false;
    bf16* Y; const LAS int* idx;
    __device__ __forceinline__ void operator()(f32x4 (&acc)[2][2][4][2], const Unit& u, int wr, int wc, int fr, int fq) const {
#pragma unroll
        for (int ai = 0; ai < 2; ++ai)
#pragma unroll
            for (int m = 0; m < 4; ++m) { const int r = ai * 128 + wr * 64 + m * 16 + fr; const int as = idx[u.sl * 256 + r];
                if (as >= 0) { bf16* yp = Y + (size_t)(as & 1) * T * D + (size_t)(as >> 1) * D + u.pn * 256 + wc * 64 + 8 * fq;
#pragma unroll
                    for (int bj = 0; bj < 2; ++bj) { const f32x4 v0 = acc[ai][bj][m][0], v1 = acc[ai][bj][m][1];
                        pg8::u32x4 o; o.x = pg8::cvt_pk_bf16(v0.x, v0.y); o.y = pg8::cvt_pk_bf16(v0.z, v0.w); o.z = pg8::cvt_pk_bf16(v1.x, v1.y); o.w = pg8::cvt_pk_bf16(v1.z, v1.w);
                        *(pg8::u32x4*)(yp + bj * 32) = o; } } }
    }
};

__device__ __forceinline__ void phase_inproj(Frame& F, int l) {
    pg8::StaticOrder S; S.init(T, NP, D, F.G, F.bx);
    EpiInproj E{(bf16*)(F.ws + WS_QKVG), (const float*)(F.ws + WS_GT) + l * 256, (const float*)(F.ws + WS_COSSIN)};
    pg8::gemm_phase<EpiInproj, pg8::StaticOrder, true>(F.lds + RING_OFF, F.wave0, (const bf16*)(F.ws + WS_HN), (const bf16*)(F.ws + WS_WIN) + (size_t)l * NP * D, D, S, E);
}
struct YZOrder : pg8::StaticOrder {
    size_t aof, bof;
    __device__ __forceinline__ bool next(int i, Unit& u) const { const bool ok = pg8::StaticOrder::next(i >> 1, u); u.ex = i & 1; return ok; }
    __device__ __forceinline__ size_t a_off(const Unit& u) const { return pg8::StaticOrder::a_off(u) + (u.ex ? aof : (size_t)0); }
    __device__ __forceinline__ size_t b_off(const Unit& u) const { return pg8::StaticOrder::b_off(u) + (u.ex ? bof : (size_t)0); }
};
struct EpiYZm {
    static constexpr int BMODE = 2; static constexpr bool CHAIN2 = true, AFTER_DRAIN = false;
    bf16* Z; const bf16* GA; const bf16* GF;
    __device__ __forceinline__ void operator()(f32x4 (&acc)[2][2][4][2], const Unit& u, int wr, int wc, int fr, int fq) const {
#pragma unroll
        for (int ai = 0; ai < 2; ++ai)
#pragma unroll
            for (int m = 0; m < 4; ++m) { const int row = u.pm * 256 + ai * 128 + wr * 64 + m * 16 + fr;
#pragma unroll
                for (int bj = 0; bj < 2; ++bj) { const int col = u.pn * 256 + wc * 64 + bj * 32 + 8 * fq;
                    const pg8::u32x4 fw = *(const pg8::u32x4*)(GF + (size_t)row * NP + col);
                    f32x4 f0 = (f32x4){bflo(fw.x), bfhi(fw.x), bflo(fw.y), bfhi(fw.y)}, f1 = (f32x4){bflo(fw.z), bfhi(fw.z), bflo(fw.w), bfhi(fw.w)};
#pragma unroll
                    for (int e = 0; e < 4; ++e) { f0[e] = fmaxf(f0[e], 1e-20f); f1[e] = fmaxf(f1[e], 1e-20f); }
                    if (u.ex == 0) {
                        const pg8::u32x4 aw = *(const pg8::u32x4*)(GA + (size_t)row * NP + col);
                        const f32x4 a0 = (f32x4){bflo(aw.x), bfhi(aw.x), bflo(aw.y), bfhi(aw.y)}, a1 = (f32x4){bflo(aw.z), bfhi(aw.z), bflo(aw.w), bfhi(aw.w)};
#pragma unroll
                        for (int e = 0; e < 4; ++e) { acc[ai][bj][m][0][e] *= a0[e] * __builtin_amdgcn_rcpf(f0[e]); acc[ai][bj][m][1][e] *= a1[e] * __builtin_amdgcn_rcpf(f1[e]); }
                    } else {
                        const f32x4 v0 = acc[ai][bj][m][0] * f0, v1 = acc[ai][bj][m][1] * f1;
                        pg8::u32x4 w; w.x = pg8::cvt_pk_bf16(v0.x, v0.y); w.y = pg8::cvt_pk_bf16(v0.z, v0.w); w.z = pg8::cvt_pk_bf16(v1.x, v1.y); w.w = pg8::cvt_pk_bf16(v1.z, v1.w);
                        *(pg8::u32x4*)(Z + (size_t)row * D + col) = w; } } }
    }
};
__device__ __forceinline__ void phase_yz(Frame& F, int l) {
    YZOrder S; S.init(T, D, 512, F.G, F.bx);
    S.aof = (size_t)((const char*)(F.ws + WS_OF) - (const char*)(F.ws + WS_AD)); S.bof = (size_t)((const char*)(F.ws + WS_WF) - (const char*)(F.ws + WS_WD));
    EpiYZm E{(bf16*)(F.ws + WS_Z), (const bf16*)(F.ws + WS_QKVG) + C_GA, (const bf16*)(F.ws + WS_QKVG) + C_GF};
    pg8::gemm_phase<EpiYZm, YZOrder, true>(F.lds + RING_OFF, F.wave0, (const bf16*)(F.ws + WS_AD), (const bf16*)(F.ws + WS_WD) + (size_t)l * D * 512, 512, S, E);
}
__device__ __forceinline__ void phase_wo(Frame& F, int l, bool dry = false) {
    pg8::StaticOrder S; S.init(T, D, D, F.G, F.bx);
    EpiWoR E{F.out, (l == 0 && !dry) ? (const float*)F.in[I_X] : (const float*)F.out, (bf16*)(F.ws + WS_HN), (const float*)F.in[I_LN2] + (size_t)l * D, (const bf16*)(F.ws + WS_WRT) + (size_t)l * 2 * 48 * D, (float*)(F.ws + WS_SUMS), dry};
    pg8::gemm_phase<EpiWoR, pg8::StaticOrder, true>(F.lds + RING_OFF, F.wave0, (const bf16*)(F.ws + WS_Z), (const bf16*)(F.ws + WS_WO) + (size_t)l * D * D, D, S, E);
}
__device__ __forceinline__ void phase_gateup(Frame& F, int l) {
    const MoeOrderT<false> S = moe_order_setup<false>(F, l, D * 2);
    EpiGateUp E{(bf16*)(F.ws + WS_HID), (const float*)(F.ws + WS_GWT), (const float*)(F.ws + WS_RSTD), S.idx, S.tcnt};
    pg8::gemm_phase<EpiGateUp, MoeOrderT<false>, true>(F.lds + RING_OFF, F.wave0, (const bf16*)(F.ws + WS_HN), (const bf16*)(F.ws + WS_WGU), D, S, E);
}
__device__ __forceinline__ void phase_down(Frame& F, int l) {
    const MoeOrderT<true> S = moe_order_setup<true>(F, l, FF * 2);
    EpiDown E{(bf16*)(F.ws + WS_Y), S.idx};
    pg8::gemm_phase<EpiDown, MoeOrderT<true>, true>(F.lds + RING_OFF, F.wave0, (const bf16*)(F.ws + WS_HID), (const bf16*)(F.ws + WS_WDN), FF, S, E);
}
#include <hip/hip_bf16.h>
namespace attn_body {
using bf16=__hip_bfloat16;
using bf16x8=__attribute__((ext_vector_type(8)))short;
using s16x4=__attribute__((ext_vector_type(4)))short;
using f32x16=__attribute__((ext_vector_type(16)))float;
using u32x4=__attribute__((ext_vector_type(4)))unsigned;
constexpr int SEQ=8192,D=64,DM=5120;
constexpr int NW=8,QBLK=32,QB=QBLK*NW,KVBLK=64,NQB=SEQ/QB;
constexpr int ATTN_UNIT_ROWS=QB;
__device__ __forceinline__ int crow(int r,int hi){return (r&3)+8*(r>>2)+4*hi;}
#define SBAR() __builtin_amdgcn_sched_barrier(0)
__device__ __forceinline__ void cmask(f32x16&p0,f32x16&p1,int jb,int qrel,int hi){
  const float NEG=-INFINITY; int kb=64*jb+4*hi;
  #pragma unroll
  for(int r=0;r<16;++r){int kv=kb+(r&3)+8*(r>>2); if(kv>qrel)p0[r]=NEG; if(kv+32>qrel)p1[r]=NEG;}
}

constexpr int NSLOT=3, SLOTB=8192;
constexpr int LDS_K=0, LDS_V=NSLOT*SLOTB;
template<int DV> struct Lay { static constexpr int VM=DV/64, WS=LDS_V+NSLOT*SLOTB*VM, OST=WS+NW*64*4, CK=OST+NW*4096, BYTES=CK+(DV==64?SEQ*4+512:0); };
constexpr float C2=0.125f*1.4426950408889634f;
__device__ __forceinline__ void glds16(const void*gsrc,unsigned lds_dst){unsigned keep;
  asm volatile("s_mov_b32 %0, m0\n\ts_mov_b32 m0, %2\n\ts_nop 0\n\tglobal_load_lds_dwordx4 %1, off\n\ts_mov_b32 m0, %0":"=&s"(keep):"v"(gsrc),"s"(lds_dst):"memory");}
__device__ __forceinline__ float max3f(float a,float b,float c){float r;asm("v_max3_f32 %0, %1, %2, %3":"=v"(r):"v"(a),"v"(b),"v"(c));return r;}
__device__ __forceinline__ float max2f(float a,float b){float r;asm("v_max_f32_e32 %0, %1, %2":"=v"(r):"v"(a),"v"(b));return r;}
__device__ __forceinline__ float fadd_s(float a,float b){float r;asm("v_add_f32_e32 %0, %1, %2":"=v"(r):"v"(a),"v"(b));return r;}
__device__ __forceinline__ float fsub_s(float a,float b){float r;asm("v_sub_f32_e32 %0, %1, %2":"=v"(r):"v"(a),"v"(b));return r;}
typedef float f32x2_t __attribute__((ext_vector_type(2))); typedef __bf16 bf16x2_t __attribute__((ext_vector_type(2)));
__device__ __forceinline__ unsigned cvtpk_s(float lo,float hi){f32x2_t v={lo,hi};bf16x2_t b=__builtin_convertvector(v,bf16x2_t);return __builtin_bit_cast(unsigned,b);}
#define WAIT_BAR(N) asm volatile("s_waitcnt vmcnt(" #N ") lgkmcnt(0)\n\ts_barrier":::"memory")

__device__ __forceinline__ void qkt(f32x16&p0,f32x16&p1,const char*Kslot,const bf16x8*qr,int r32,int hi){
  const char*kb=Kslot+hi*1024+r32*16;
  #pragma unroll
  for(int d0=0;d0<4;++d0){
    const bf16x8 b0=*reinterpret_cast<const bf16x8*>(kb+d0*2048);
    const bf16x8 b1=*reinterpret_cast<const bf16x8*>(kb+d0*2048+512);
    if(d0==0){p0=__builtin_amdgcn_mfma_f32_32x32x16_bf16(b0,qr[0],p0,0,0,0);p1=__builtin_amdgcn_mfma_f32_32x32x16_bf16(b1,qr[0],p1,0,0,0);}
    else{p0=__builtin_amdgcn_mfma_f32_32x32x16_bf16(b0,qr[d0],p0,0,0,0);p1=__builtin_amdgcn_mfma_f32_32x32x16_bf16(b1,qr[d0],p1,0,0,0);}}
}
typedef __attribute__((address_space(3))) const char* lds_cptr;
typedef short v4i16_t __attribute__((ext_vector_type(4)));
__device__ __forceinline__ void kload8(bf16x8*kf,lds_cptr kp){
  kf[0]=*(const __attribute__((address_space(3))) bf16x8*)(kp);      kf[1]=*(const __attribute__((address_space(3))) bf16x8*)(kp+512);
  kf[2]=*(const __attribute__((address_space(3))) bf16x8*)(kp+2048); kf[3]=*(const __attribute__((address_space(3))) bf16x8*)(kp+2560);
  kf[4]=*(const __attribute__((address_space(3))) bf16x8*)(kp+4096); kf[5]=*(const __attribute__((address_space(3))) bf16x8*)(kp+4608);
  kf[6]=*(const __attribute__((address_space(3))) bf16x8*)(kp+6144); kf[7]=*(const __attribute__((address_space(3))) bf16x8*)(kp+6656);
}
__device__ __forceinline__ void kload2(bf16x8*kf,lds_cptr kp,int j){ kf[2*j]=*(const __attribute__((address_space(3))) bf16x8*)(kp+j*2048); kf[2*j+1]=*(const __attribute__((address_space(3))) bf16x8*)(kp+j*2048+512); }
__device__ __forceinline__ s16x4 vtr(lds_cptr p){ return __builtin_bit_cast(s16x4,__builtin_amdgcn_ds_read_tr16_b64_v4i16((__attribute__((address_space(3))) v4i16_t*)p)); }
__device__ __forceinline__ float rowmax(const f32x16&p0,const f32x16&p1){
  float a=max3f(p0[0],p0[1],p1[0]),b=max3f(p0[2],p0[3],p1[1]);a=max3f(a,p1[2],p1[3]);
  #pragma unroll
  for(int r=4;r<16;r+=4){a=max3f(a,p0[r],p0[r+1]);b=max3f(b,p0[r+2],p0[r+3]);a=max3f(a,p1[r],p1[r+1]);b=max3f(b,p1[r+2],p1[r+3]);}
  const float m=max2f(a,b);
  auto rr=__builtin_amdgcn_permlane32_swap(__float_as_uint(m),__float_as_uint(m),false,false);
  return max2f(__uint_as_float(rr[0]),__uint_as_float(rr[1]));
}
template<int NO> __device__ __forceinline__ void pv(f32x16*o,int vb,bf16x8 pa0,bf16x8 pa1,bf16x8 pa2,bf16x8 pa3){
  #pragma unroll
  for(int d0=0;d0<NO;++d0){s16x4 lo[4],hi[4];
    #pragma unroll
    for(int ks=0;ks<4;++ks){
      asm volatile("ds_read_b64_tr_b16 %0,%1 offset:%c2":"=&v"(lo[ks]):"v"(vb),"i"(d0*4096+ks*1024):"memory");
      asm volatile("ds_read_b64_tr_b16 %0,%1 offset:%c2":"=&v"(hi[ks]):"v"(vb),"i"(d0*4096+ks*1024+512):"memory");}
    asm volatile("s_waitcnt lgkmcnt(0)":::"memory");SBAR();
    #define PK(k) (bf16x8){lo[k][0],lo[k][1],lo[k][2],lo[k][3],hi[k][0],hi[k][1],hi[k][2],hi[k][3]}
    o[d0]=__builtin_amdgcn_mfma_f32_32x32x16_bf16(pa0,PK(0),o[d0],0,0,0);
    o[d0]=__builtin_amdgcn_mfma_f32_32x32x16_bf16(pa1,PK(1),o[d0],0,0,0);
    o[d0]=__builtin_amdgcn_mfma_f32_32x32x16_bf16(pa2,PK(2),o[d0],0,0,0);
    o[d0]=__builtin_amdgcn_mfma_f32_32x32x16_bf16(pa3,PK(3),o[d0],0,0,0);
    #undef PK
  }
}

typedef float f32x4_t __attribute__((ext_vector_type(4)));
__device__ __forceinline__ void bias_fill(f32x16&c0,f32x16&c1,float base,const __attribute__((address_space(3))) float*ck,int hi){
  #pragma unroll
  for(int g=0;g<4;++g){const f32x4_t a=*(const __attribute__((address_space(3))) f32x4_t*)(ck+8*g+4*hi),b=*(const __attribute__((address_space(3))) f32x4_t*)(ck+32+8*g+4*hi);
    #pragma unroll
    for(int e=0;e<4;++e){c0[4*g+e]=base-a[e];c1[4*g+e]=base-b[e];}}
}
typedef __attribute__((address_space(3))) const float* lds_fptr;
__device__ __forceinline__ void ck_load(f32x4_t (&ka)[4],f32x4_t (&kb)[4],lds_fptr ck,int hi){
  #pragma unroll
  for(int g=0;g<4;++g){ka[g]=*(const __attribute__((address_space(3))) f32x4_t*)(ck+8*g+4*hi);kb[g]=*(const __attribute__((address_space(3))) f32x4_t*)(ck+32+8*g+4*hi);}
}
__device__ __forceinline__ void ck_apply(f32x16&c0,f32x16&c1,const f32x4_t (&ka)[4],const f32x4_t (&kb)[4],float add){
  #pragma unroll
  for(int g=0;g<4;++g){
    #pragma unroll
    for(int e=0;e<4;++e){c0[4*g+e]=(c0[4*g+e]-ka[g][e])+add;c1[4*g+e]=(c1[4*g+e]-kb[g][e])+add;}}
}
__device__ __forceinline__ void ck_sub(f32x16&c0,f32x16&c1,const f32x4_t (&ka)[4],const f32x4_t (&kb)[4]){
  #pragma unroll
  for(int g=0;g<4;++g){
    #pragma unroll
    for(int e=0;e<4;++e){c0[4*g+e]-=ka[g][e];c1[4*g+e]-=kb[g][e];}}
}
template<bool BIAS> __device__ __forceinline__ void cfill(f32x16&c0,f32x16&c1,float base,const __attribute__((address_space(3))) float*ck,int hi){
  if(BIAS)bias_fill(c0,c1,base,ck,hi);
  else{
    #pragma unroll
    for(int r=0;r<16;++r){c0[r]=base;c1[r]=base;} }
}
#ifndef ATTN_STORE16
#define ATTN_STORE16(p,v) asm volatile("global_store_dwordx4 %0, %1, off sc1\n\ts_nop 1"::"v"(p),"v"(v):"memory")
#endif
__device__ __forceinline__ int fox_t0(int qb,const float*cum,float thr,int lane){
  const int q0=qb*QB,NTf=(q0+QB)/KVBLK; const float cq0=cum[q0];
  const int t1=lane,t2=lane+64;
  const bool ok1=(t1>=NTf-4)||(cq0-cum[64*t1+63]>=-thr), ok2=(t2>=NTf-4)||(cq0-cum[(t2<NTf?64*t2+63:q0)]>=-thr);
  const unsigned long long m1=__ballot(ok1),m2=__ballot(ok2);
  int T0=m1?__builtin_ctzll(m1):(m2?64+__builtin_ctzll(m2):NTf-4); T0&=~1; if(T0>NTf-4)T0=NTf-4; return __builtin_amdgcn_readfirstlane(T0);
}
template<int THRL,bool BIAS,int OP,int DV,bool NOREF> __device__ __forceinline__ void attn_unit(int qb,const bf16*Qb,const bf16*__restrict__ Kh0,const bf16*__restrict__ Vh0,bf16*Ob,const float*cum,float thr,char*shm,const int wave0,const int T0in=-1){
  constexpr int NO=DV/32, VM=DV/64; static_assert(DV==64||(DV==128&&!BIAS),"DV"); static_assert(!(NOREF&&BIAS),"NOREF");
  const int tid=fresh_tid(wave0); const int lane=tid&63,r32=lane&31,hi=lane>>5; const int wid=__builtin_amdgcn_readfirstlane(tid>>6);
  const int q0=qb*QB;
  const bf16*Qw=Qb+(long)(q0+wid*QBLK)*DM;
  int T0=0;
  if(BIAS){ T0=T0in>=0?T0in:fox_t0(qb,cum,thr,lane); }
  const bf16*Kh=Kh0+(long)T0*KVBLK*DM; const bf16*Vh=Vh0+(long)T0*KVBLK*DM;
  const unsigned lds0=(unsigned)(uintptr_t)shm;
  float*wsf=(float*)(shm+Lay<DV>::WS)+wid*64;
  const bf16*ksrc=Kh+(long)lane*DM+wid*8;
  const bf16*vsrc=Vh+(long)(16*(wid&3)+(lane>>2))*DM+(wid>>2)*32+(lane&3)*8;
  const unsigned kdst=lds0+LDS_K+wid*1024, vdst=lds0+LDS_V+wid*1024;
  #define DMA_K(t,slot) glds16(ksrc+(long)(t)*KVBLK*DM,(unsigned)__builtin_amdgcn_readfirstlane(kdst+(slot)))
  #define DMA_V(t,slot) do{ glds16(vsrc+(long)(t)*KVBLK*DM,(unsigned)__builtin_amdgcn_readfirstlane(vdst+(slot)*VM)); if(DV==128)glds16(vsrc+64+(long)(t)*KVBLK*DM,(unsigned)__builtin_amdgcn_readfirstlane(vdst+(slot)*VM+8192)); }while(0)
  const int vb0=(int)(lds0+LDS_V)+((lane>>4)&1)*32+(lane&3)*8+(4*hi+((lane&15)>>2))*64;
  const char*Kbase=shm+LDS_K; bf16x8 kf[8];
  const lds_cptr shm3=(lds_cptr)shm; const lds_cptr kp0=shm3+LDS_K+hi*1024+r32*16; const lds_cptr vp0=shm3+LDS_V+((lane>>4)&1)*32+(lane&3)*8+(4*hi+((lane&15)>>2))*64;
  const int NT=(q0+QB)/KVBLK-T0;
  const __attribute__((address_space(3))) float*ckl=(const __attribute__((address_space(3))) float*)(shm3+Lay<DV>::CK); float cq=0.f,cqm=0.f;
  const lds_fptr cl=ckl+NT*64; float fu=1.f;
  DMA_K(0,0);DMA_V(0,0);DMA_K(1,SLOTB);
  bf16x8 qr[4];
  #pragma unroll
  for(int d0=0;d0<4;++d0)qr[d0]=*reinterpret_cast<const bf16x8*>(&Qw[(long)r32*DM+d0*16+hi*8]);
  if(BIAS){ __attribute__((address_space(3))) f32x4_t*cw=(__attribute__((address_space(3))) f32x4_t*)(shm3+Lay<DV>::CK);
    for(int i=tid;i<NT*16;i+=NW*64){ const f32x4_t v=*(const f32x4_t*)(cum+64*T0+4*i); const float last=cum[64*T0+(i>>4)*64+63]; cw[i]=v-last; }
    __attribute__((address_space(3))) float*clw=(__attribute__((address_space(3))) float*)(shm3+Lay<DV>::CK)+NT*64;
    for(int t_=tid;t_<NT;t_+=NW*64)clw[t_]=cum[64*(T0+t_)+63];
    cq=cum[q0+wid*QBLK+r32]; cqm=cq; }
  float mhat=0.f,l_reg=0.f;f32x16 o[NO];
  #pragma unroll
  for(int d_=0;d_<NO;++d_)o[d_]=f32x16{};

  const int qrel=wid*QBLK+r32;
  #define CMASK(P0,P1,t) do{int jb_=(t)-(NT-4); if(jb_>=0)cmask(P0,P1,jb_,qrel,hi);}while(0)
  int resc=0;
  #define START(P0,P1) do{ resc=0; if constexpr(!NOREF&&!BIAS) { const float rm=rowmax(P0,P1); const float dl=rm; mhat=fadd_s(mhat,dl); \
      _Pragma("unroll") for(int r=0;r<16;++r){P0[r]=fsub_s(P0[r],dl);P1[r]=fsub_s(P1[r],dl);} \
      cqm=cq-mhat; } \
    _Pragma("unroll") for(int r=0;r<16;++r)P0[r]=__builtin_amdgcn_exp2f(P0[r]); }while(0)
  #define RESC() do{ if constexpr(!NOREF){ if(BIAS&&resc==1){ _Pragma("unroll") for(int d_=0;d_<NO;++d_) _Pragma("unroll") for(int r=0;r<16;++r)o[d_][r]*=fu; } \
    else if(resc){ asm volatile("s_waitcnt lgkmcnt(0)":::"memory"); \
      _Pragma("unroll") for(int d_=0;d_<NO;++d_) _Pragma("unroll") for(int r=0;r<16;++r)o[d_][r]*=wsf[crow(r,hi)]; } } }while(0)
  f32x16 pA0,pA1,pB0,pB1;
  int sl_prev=0,sl_cur=0,sl_next=SLOTB;
  #define ROT() do{sl_prev=sl_cur;sl_cur=sl_next;sl_next=(sl_next==(NSLOT-1)*SLOTB)?0:sl_next+SLOTB;}while(0)
  DMA_K(2,2*SLOTB);
  if constexpr(DV==128){WAIT_BAR(4);}else{WAIT_BAR(3);}
  if constexpr(NOREF||BIAS){pA0=f32x16{};pA1=f32x16{};}else{cfill<BIAS>(pA0,pA1,cqm,ckl,hi);}
  qkt(pA0,pA1,Kbase,qr,r32,hi);asm volatile("s_nop 15\n\ts_nop 7":"+v"(pA0),"+v"(pA1));
  if constexpr(BIAS){ f32x4_t ka_[4],kb_[4]; ck_load(ka_,kb_,ckl,hi); ck_apply(pA0,pA1,ka_,kb_,NT==4?cq-cl[0]:0.f); }
  CMASK(pA0,pA1,0);
  START(pA0,pA1);
  _Pragma("unroll") for(int r=0;r<16;++r)pA1[r]=__builtin_amdgcn_exp2f(pA1[r]);
  WAIT_BAR(0);
  DMA_K(3,0);DMA_V(1,SLOTB);
  ROT();
  kload8(kf,kp0+sl_cur);
  if constexpr(DV==128){WAIT_BAR(3);}else{WAIT_BAR(2);}
  s16x4 vlo[8],vhi[8]; u32x4 pw0,pw1,pw2,pw3;
  #define PKW(P,B) cvtpk_s(P[B],P[B+1])
  #define PAF(k) __builtin_bit_cast(bf16x8,pw##k)
  #define VFR(i) (bf16x8){vlo[i][0],vlo[i][1],vlo[i][2],vlo[i][3],vhi[i][0],vhi[i][1],vhi[i][2],vhi[i][3]}
  #define PIN(x) asm volatile("":"+v"(x))
  #define MX3(a,b,c) __builtin_fmaxf(__builtin_fmaxf((a),(b)),(c))
  #define GAPA(MF,A0,A1,A2,A3,W0,W1,PW) do{ MF; sacc+=A0; sacc+=A1; sacc+=A2; sacc+=A3; PIN(sacc); W0; W1; PIN(PW); SBAR(); }while(0)
  #define EX(v) __builtin_amdgcn_exp2f(v)
  #define GAPB(MF,X,B) do{ MF; X[B]=EX(X[B]); X[B+1]=EX(X[B+1]); X[B+2]=EX(X[B+2]); X[B+3]=EX(X[B+3]); PIN(X); SBAR(); }while(0)
  #define GAPC(MF,X,B,RL) do{ MF; X[B]=EX(X[B]); X[B+1]=EX(X[B+1]); PIN(X); RL; SBAR(); }while(0)
  #define VRD2(i) do{ vlo[i]=vtr(vp_+((((i)>>2)+2)*4096+((i)&3)*1024)); vhi[i]=vtr(vp_+((((i)>>2)+2)*4096+((i)&3)*1024+512)); }while(0)
  #define VRD(i) do{ vlo[i]=vtr(vp_+(((i)>>2)*4096+((i)&3)*1024)); vhi[i]=vtr(vp_+(((i)>>2)*4096+((i)&3)*1024+512)); }while(0)
  #define KRD(G,j) do{ if(G){ kload2(kf,kp0+sl_next,j); SBAR(); } }while(0)
  #define CIN(X) (X)
  #define STEP(C0,C1,P0,P1,t,GK,GV,GL,BND) do{ SBAR(); \
    const lds_cptr vp_=vp0+sl_prev*VM; \
    f32x4_t ka_[4],kb_[4]; \
    if constexpr(NOREF||BIAS){C0=f32x16{};C1=f32x16{};}else{cfill<BIAS>(C0,C1,cqm,ckl+64*(t),hi);} SBAR(); \
    VRD(0); SBAR(); float sacc=(P0[0]+P0[1]); \
    GAPA(C0=__builtin_amdgcn_mfma_f32_32x32x16_bf16(kf[0],qr[0],CIN(C0),0,0,0), P0[2],P0[3],P0[4],P0[5],     pw0[0]=PKW(P0,0), pw0[1]=PKW(P0,2), pw0); \
    VRD(4); SBAR(); GAPA(C1=__builtin_amdgcn_mfma_f32_32x32x16_bf16(kf[1],qr[0],CIN(C1),0,0,0), P0[6],P0[7],P0[8],P0[9],     pw0[2]=PKW(P0,4), pw0[3]=PKW(P0,6), pw0); \
    VRD(1); SBAR(); GAPA(C0=__builtin_amdgcn_mfma_f32_32x32x16_bf16(kf[2],qr[1],C0,0,0,0),   P0[10],P0[11],P0[12],P0[13], pw1[0]=PKW(P0,8), pw1[1]=PKW(P0,10), pw1); \
    VRD(5); SBAR(); GAPA(C1=__builtin_amdgcn_mfma_f32_32x32x16_bf16(kf[3],qr[1],C1,0,0,0),   P0[14],P0[15],P1[0],P1[1],   pw1[2]=PKW(P0,12),pw1[3]=PKW(P0,14), pw1); \
    VRD(2); SBAR(); GAPA(C0=__builtin_amdgcn_mfma_f32_32x32x16_bf16(kf[4],qr[2],C0,0,0,0),   P1[2],P1[3],P1[4],P1[5],     pw2[0]=PKW(P1,0), pw2[1]=PKW(P1,2), pw2); \
    if constexpr(BIAS){ck_load(ka_,kb_,ckl+64*(t),hi); SBAR();} \
    VRD(6); SBAR(); GAPA(C1=__builtin_amdgcn_mfma_f32_32x32x16_bf16(kf[5],qr[2],C1,0,0,0),   P1[6],P1[7],P1[8],P1[9],     pw2[2]=PKW(P1,4), pw2[3]=PKW(P1,6), pw2); \
    VRD(3); SBAR(); GAPA(C0=__builtin_amdgcn_mfma_f32_32x32x16_bf16(kf[6],qr[3],C0,0,0,0),   P1[10],P1[11],P1[12],P1[13], pw3[0]=PKW(P1,8), pw3[1]=PKW(P1,10), pw3); \
    VRD(7); SBAR(); GAPA(C1=__builtin_amdgcn_mfma_f32_32x32x16_bf16(kf[7],qr[3],C1,0,0,0),   P1[14],P1[15],0.f,0.f,       pw3[2]=PKW(P1,12),pw3[3]=PKW(P1,14), pw3); \
    l_reg+=sacc; \
    if(GK){DMA_K((t)+3,sl_cur);} if(GV){DMA_V((t)+1,sl_next);} \
    if constexpr(BIAS){ const bool bnd_=(BND)&&((t)>=NT-4); if constexpr((BND)==0){ck_sub(C0,C1,ka_,kb_);}else{ck_apply(C0,C1,ka_,kb_,bnd_?cq-cl[(t)]:0.f);} \
      if(!bnd_){ fu=__builtin_amdgcn_exp2f(cl[(t)]-cl[(t)-1]); l_reg*=fu; resc=1; } \
      else if((t)==NT-4){ const float f_=__builtin_amdgcn_exp2f(cq-cl[(t)-1]); l_reg*=f_; if(hi==0)wsf[r32]=f_; resc=2; } \
      else resc=0; } \
    CMASK(C0,C1,t); \
    if constexpr(!NOREF&&!BIAS){ float a=MX3(C0[0],C0[1],C1[0]),b=MX3(C0[2],C0[3],C1[1]); a=MX3(a,C1[2],C1[3]); \
      _Pragma("unroll") for(int r=4;r<16;r+=4){a=MX3(a,C0[r],C0[r+1]);b=MX3(b,C0[r+2],C0[r+3]);a=MX3(a,C1[r],C1[r+1]);b=MX3(b,C1[r+2],C1[r+3]);} \
      float rm=__builtin_fmaxf(a,b); { auto rr=__builtin_amdgcn_permlane32_swap(__float_as_uint(rm),__float_as_uint(rm),false,false); rm=__builtin_fmaxf(__uint_as_float(rr[0]),__uint_as_float(rr[1])); } \
      resc=0; \
      if(__builtin_expect(__any(rm>(float)THRL),0)){ const float dl=__builtin_fmaxf(rm,0.f); mhat+=dl; \
        _Pragma("unroll") for(int r=0;r<16;++r){C0[r]-=dl;C1[r]-=dl;} \
        cqm=cq-mhat; \
        const float f=__builtin_amdgcn_exp2f(-dl); l_reg*=f; if(hi==0)wsf[r32]=f; resc=2; } } \
    SBAR(); \
    if constexpr(DV==64){ \
    GAPB(o[0]=__builtin_amdgcn_mfma_f32_32x32x16_bf16(PAF(0),VFR(0),o[0],0,0,0), C0,0); \
    GAPB(o[1]=__builtin_amdgcn_mfma_f32_32x32x16_bf16(PAF(0),VFR(4),o[1],0,0,0), C0,4); \
    KRD(GL,0); GAPB(o[0]=__builtin_amdgcn_mfma_f32_32x32x16_bf16(PAF(1),VFR(1),o[0],0,0,0), C0,8); \
    KRD(GL,1); GAPB(o[1]=__builtin_amdgcn_mfma_f32_32x32x16_bf16(PAF(1),VFR(5),o[1],0,0,0), C0,12); \
    KRD(GL,2); GAPB(o[0]=__builtin_amdgcn_mfma_f32_32x32x16_bf16(PAF(2),VFR(2),o[0],0,0,0), C1,0); \
    KRD(GL,3); GAPB(o[1]=__builtin_amdgcn_mfma_f32_32x32x16_bf16(PAF(2),VFR(6),o[1],0,0,0), C1,4); \
    GAPB(o[0]=__builtin_amdgcn_mfma_f32_32x32x16_bf16(PAF(3),VFR(3),o[0],0,0,0), C1,8); \
    GAPB(o[1]=__builtin_amdgcn_mfma_f32_32x32x16_bf16(PAF(3),VFR(7),o[1],0,0,0), C1,12); \
    } else { \
    GAPC(o[0]=__builtin_amdgcn_mfma_f32_32x32x16_bf16(PAF(0),VFR(0),o[0],0,0,0), C0,0, VRD2(0)); \
    GAPC(o[1]=__builtin_amdgcn_mfma_f32_32x32x16_bf16(PAF(0),VFR(4),o[1],0,0,0), C0,2, VRD2(4)); \
    GAPC(o[0]=__builtin_amdgcn_mfma_f32_32x32x16_bf16(PAF(1),VFR(1),o[0],0,0,0), C0,4, VRD2(1)); \
    GAPC(o[1]=__builtin_amdgcn_mfma_f32_32x32x16_bf16(PAF(1),VFR(5),o[1],0,0,0), C0,6, VRD2(5)); \
    GAPC(o[0]=__builtin_amdgcn_mfma_f32_32x32x16_bf16(PAF(2),VFR(2),o[0],0,0,0), C0,8, VRD2(2)); \
    GAPC(o[1]=__builtin_amdgcn_mfma_f32_32x32x16_bf16(PAF(2),VFR(6),o[1],0,0,0), C0,10, VRD2(6)); \
    GAPC(o[0]=__builtin_amdgcn_mfma_f32_32x32x16_bf16(PAF(3),VFR(3),o[0],0,0,0), C0,12, VRD2(3)); \
    GAPC(o[1]=__builtin_amdgcn_mfma_f32_32x32x16_bf16(PAF(3),VFR(7),o[1],0,0,0), C0,14, VRD2(7)); \
    GAPC(o[2]=__builtin_amdgcn_mfma_f32_32x32x16_bf16(PAF(0),VFR(0),o[2],0,0,0), C1,0, (void)0); \
    KRD(GL,0); GAPC(o[3]=__builtin_amdgcn_mfma_f32_32x32x16_bf16(PAF(0),VFR(4),o[3],0,0,0), C1,2, (void)0); \
    KRD(GL,1); GAPC(o[2]=__builtin_amdgcn_mfma_f32_32x32x16_bf16(PAF(1),VFR(1),o[2],0,0,0), C1,4, (void)0); \
    KRD(GL,2); GAPC(o[3]=__builtin_amdgcn_mfma_f32_32x32x16_bf16(PAF(1),VFR(5),o[3],0,0,0), C1,6, (void)0); \
    KRD(GL,3); GAPC(o[2]=__builtin_amdgcn_mfma_f32_32x32x16_bf16(PAF(2),VFR(2),o[2],0,0,0), C1,8, (void)0); \
    GAPC(o[3]=__builtin_amdgcn_mfma_f32_32x32x16_bf16(PAF(2),VFR(6),o[3],0,0,0), C1,10, (void)0); \
    GAPC(o[2]=__builtin_amdgcn_mfma_f32_32x32x16_bf16(PAF(3),VFR(3),o[2],0,0,0), C1,12, (void)0); \
    GAPC(o[3]=__builtin_amdgcn_mfma_f32_32x32x16_bf16(PAF(3),VFR(7),o[3],0,0,0), C1,14, (void)0); \
    } \
    }while(0)
  #define WB_FULL() do{ if constexpr(DV==128){WAIT_BAR(3);}else{WAIT_BAR(2);} }while(0)
  int t=1;
  #undef CMASK
  #define CMASK(P0,P1,t) do{}while(0)
  for(;t+5<NT;t+=2){
    STEP(pB0,pB1,pA0,pA1,t,true,true,true,0);     WB_FULL(); RESC(); ROT();
    STEP(pA0,pA1,pB0,pB1,t+1,true,true,true,0);   WB_FULL(); RESC(); ROT();
  }
  #undef CMASK
  #define CMASK(P0,P1,t) do{int jb_=(t)-(NT-4); if(jb_>=0)cmask(P0,P1,jb_,qrel,hi);}while(0)
  #define ENDW(tt) do{ if((tt)+3<NT){WB_FULL();} else if((tt)+2<NT){ if constexpr(DV==128){WAIT_BAR(2);}else{WAIT_BAR(1);} } else {WAIT_BAR(0);} }while(0)
  for(;t+1<NT;t+=2){
    STEP(pB0,pB1,pA0,pA1,t,(t+3<NT),(t+1<NT),(t+1<NT),1);       ENDW(t);   RESC(); ROT();
    STEP(pA0,pA1,pB0,pB1,t+1,(t+4<NT),(t+2<NT),(t+2<NT),1);     ENDW(t+1); RESC(); ROT();
  }
  STEP(pB0,pB1,pA0,pA1,NT-1,false,false,false,1); RESC();
  { float sacc=pB0[0]+pB0[1]; _Pragma("unroll") for(int r=2;r<16;++r)sacc+=pB0[r]; _Pragma("unroll") for(int r=0;r<16;++r)sacc+=pB1[r]; l_reg+=sacc;
    pw0=(u32x4){PKW(pB0,0),PKW(pB0,2),PKW(pB0,4),PKW(pB0,6)};pw1=(u32x4){PKW(pB0,8),PKW(pB0,10),PKW(pB0,12),PKW(pB0,14)};pw2=(u32x4){PKW(pB1,0),PKW(pB1,2),PKW(pB1,4),PKW(pB1,6)};pw3=(u32x4){PKW(pB1,8),PKW(pB1,10),PKW(pB1,12),PKW(pB1,14)};
    SBAR(); pv<NO>(o,vb0+sl_cur*VM,PAF(0),PAF(1),PAF(2),PAF(3)); }
  #undef PKW
  #undef PAF
  #undef VFR
  #undef PIN
  #undef MX3
  #undef GAPA
  #undef GAPB
  #undef EX
  #undef VRD
  #undef VRD2
  #undef GAPC
  #undef KRD
  #undef STEP
  #undef CIN
  #undef ENDW
  #undef WB_FULL
  {auto rr=__builtin_amdgcn_permlane32_swap(__float_as_uint(l_reg),__float_as_uint(l_reg),false,false);l_reg=__uint_as_float(rr[0])+__uint_as_float(rr[1]);}
  if(hi==0)wsf[32+r32]=l_reg;asm volatile("s_waitcnt lgkmcnt(0)":::"memory");
  float rli[16];
  #pragma unroll
  for(int r=0;r<16;++r)rli[r]=__builtin_amdgcn_rcpf(wsf[32+crow(r,hi)]);
  bf16*Ow=Ob+(long)(q0+wid*QBLK)*OP;
  { bf16*stg=(bf16*)(shm+Lay<DV>::OST)+wid*2048;
    #pragma unroll
    for(int ps=0;ps<NO/2;++ps){
    #pragma unroll
    for(int r=0;r<16;++r){const int orow=crow(r,hi);
      #pragma unroll
      for(int d0=0;d0<2;++d0)stg[orow*64+d0*32+r32]=__float2bfloat16(o[2*ps+d0][r]*rli[r]);}
    asm volatile("s_waitcnt lgkmcnt(0)":::"memory");
    #pragma unroll
    for(int i=0;i<4;++i){const int row=i*8+(lane>>3),ch=lane&7; const u32x4 v=*(const u32x4*)(stg+row*64+ch*8); ATTN_STORE16(Ow+(long)row*OP+ps*64+ch*8,v);}
    asm volatile("s_waitcnt lgkmcnt(0)":::"memory"); } }
  asm volatile("s_waitcnt lgkmcnt(0)\n\ts_barrier":::"memory");
  #undef DMA_K
  #undef DMA_V
  #undef CMASK
  #undef START
  #undef RESC
  #undef ROT
}
constexpr int ATTN_LDS_BYTES=Lay<64>::BYTES>Lay<128>::BYTES?Lay<64>::BYTES:Lay<128>::BYTES;
#undef SBAR
#undef WAIT_BAR
}
__device__ __forceinline__ void diffc_item(Frame& F, int l, int b, int h, int qb) {
    const int lane = fresh_lane(); int w = F.wave0; asm volatile("" : "+s"(w));
    const float* lq1 = (const float*)F.in[I_LQ1] + l * 64; const float* lk1 = (const float*)F.in[I_LK1] + l * 64;
    const float* lq2 = (const float*)F.in[I_LQ2] + l * 64; const float* lk2 = (const float*)F.in[I_LK2] + l * 64;
    int ll = l; asm volatile("" : "+s"(ll));
    const float li = lambda_init_of(ll); const float oml = ll == 0 ? 1.0f - lambda_init_of(0) : 1.0f - lambda_init_of(1);
    const float lamv = __builtin_amdgcn_exp2f(LOG2E * wave_sum(lq1[lane] * lk1[lane], lane)) - __builtin_amdgcn_exp2f(LOG2E * wave_sum(lq2[lane] * lk2[lane], lane)) + li;
    const float lam = __builtin_bit_cast(float, __builtin_amdgcn_readfirstlane(__builtin_bit_cast(int, lamv)));
    const float* sub = (const float*)F.in[I_SUBLN] + l * 128;
    const bf16* OA = (const bf16*)(F.ws + WS_OA); bf16* AD = (bf16*)(F.ws + WS_AD);
    const int d0 = (lane & 15) * 8;
    float sg[8];
#pragma unroll
    for (int e = 0; e < 8; ++e) sg[e] = sub[d0 + e] * oml;
    const size_t row0 = (size_t)b * SEQ + (size_t)qb * 256 + w * 32 + (lane >> 4);
    v4u a_[8], b_[8];
#pragma unroll
    for (int q = 0; q < 8; ++q) { const bf16* src = OA + (row0 + q * 4) * 1024 + h * 128 + d0;
        asm volatile("global_load_dwordx4 %0, %2, off sc1\n\tglobal_load_dwordx4 %1, %2, off offset:1024 sc1" : "=&v"(a_[q]), "=&v"(b_[q]) : "v"(src) : "memory"); }
    asm volatile("s_waitcnt vmcnt(0)" : "+v"(a_[0]), "+v"(a_[1]), "+v"(a_[2]), "+v"(a_[3]), "+v"(a_[4]), "+v"(a_[5]), "+v"(a_[6]), "+v"(a_[7]), "+v"(b_[0]), "+v"(b_[1]), "+v"(b_[2]), "+v"(b_[3]), "+v"(b_[4]), "+v"(b_[5]), "+v"(b_[6]), "+v"(b_[7]) :: "memory");
#pragma unroll
    for (int q = 0; q < 8; ++q) { const v4u a = a_[q], bb = b_[q];
        typedef float f32x2_ __attribute__((ext_vector_type(2)));
        f32x2_ vv[4]; float ss = 0.f;
#pragma unroll
        for (int k = 0; k < 4; ++k) { const f32x2_ av = {bflo(a[k]), bfhi(a[k])}, bv = {bflo(bb[k]), bfhi(bb[k])}; vv[k] = av - lam * bv; ss += vv[k].x * vv[k].x + vv[k].y * vv[k].y; }
        ss += shx(ss, 1, lane); ss += shx(ss, 2, lane); ss += shx(ss, 4, lane); ss += shx(ss, 8, lane);
        const float r = __builtin_amdgcn_rsqf(ss * (1.0f / 128.0f) + EPS);
        v4u o;
#pragma unroll
        for (int k = 0; k < 4; ++k) o[k] = pk2(vv[k].x * r * sg[2 * k], vv[k].y * r * sg[2 * k + 1]);
        *(v4u*)(AD + (row0 + q * 4) * 512 + h * 128 + d0) = o; }
}
#define DIFF_HANDOFF(qb_) do { VM_WAIT(); __syncthreads(); volatile LAS unsigned* qw_ = F.MISC + 16; \
        if (fresh_tid(F.wave0) == 0) { \
            qw_[0] = __hip_atomic_fetch_add(F.ctl + CW_DCNT + ((((l * BATCH + b) * 4 + (m & 3)) * 32 + (qb_)) * DCNT_STRIDE), 1u, __ATOMIC_RELAXED, __HIP_MEMORY_SCOPE_AGENT); } \
        __syncthreads(); const unsigned old_ = qw_[0]; __syncthreads(); \
        if (old_ == 1u) diffc_item(F, l, b, m & 3, (qb_)); } while (0)
template <int AVAR = 0> __device__ __forceinline__ void phase_attn(Frame& F, int l) {
    const attn_body::bf16* QKVG = (const attn_body::bf16*)(F.ws + WS_QKVG);
    attn_body::bf16* OA = (attn_body::bf16*)(F.ws + WS_OA); attn_body::bf16* OFp = (attn_body::bf16*)(F.ws + WS_OF);
    const float* CUM = (const float*)(F.ws + WS_CUM);
    char* shm = (char*)(F.lds + RING_OFF);
    bool noref;
    { const int ln = fresh_lane();
      const float* gtd = (const float*)(F.ws + WS_GT) + l * 256; float gq = fabsf(gtd[ln]), gk = fabsf(gtd[64 + ln]);
#pragma unroll
      for (int o = 1; o < 64; o <<= 1) { gq = fmaxf(gq, shx(gq, o, ln)); gk = fmaxf(gk, shx(gk, o, ln)); }
      noref = __builtin_amdgcn_readfirstlane((int)(1.02f * 64.0f * gq * gk < 100.0f)) != 0; }
    if (AVAR & 1) {} else if (noref) {
        for (int p = F.vcu; p < 256; p += F.G) {
            const int he = p >> 4, x = p & 15, b = he >> 3, m = he & 7;
            const attn_body::bf16* base = QKVG + (size_t)b * SEQ * NP;
#pragma unroll 1
            for (int s2 = 0; s2 < 2; ++s2) {
                attn_body::attn_unit<8, false, 1024, 128, true>(s2 == 0 ? 31 - x : x, base + C_QA + m * 64, base + C_KA + m * 64, base + C_VA + (m & 3) * 128, OA + (size_t)b * SEQ * 1024 + m * 128, nullptr, 0.f, shm, F.wave0);
                DIFF_HANDOFF(s2 == 0 ? 31 - x : x);
            }
        }
    } else {
        for (int p = F.vcu; p < 256; p += F.G) {
            const int he = p >> 4, x = p & 15, b = he >> 3, m = he & 7;
            const attn_body::bf16* base = QKVG + (size_t)b * SEQ * NP;
#pragma unroll 1
            for (int s2 = 0; s2 < 2; ++s2) {
                attn_body::attn_unit<8, false, 1024, 128, false>(s2 == 0 ? 31 - x : x, base + C_QA + m * 64, base + C_KA + m * 64, base + C_VA + (m & 3) * 128, OA + (size_t)b * SEQ * 1024 + m * 128, nullptr, 0.f, shm, F.wave0);
                DIFF_HANDOFF(s2 == 0 ? 31 - x : x);
            }
        }
    }
    float thr2;
    { const int ln = fresh_lane();
      const float* gtf = (const float*)(F.ws + WS_GT) + l * 256 + 128; float gq = fabsf(gtf[ln]), gk = fabsf(gtf[64 + ln]);
#pragma unroll
      for (int o = 1; o < 64; o <<= 1) { gq = fmaxf(gq, shx(gq, o, ln)); gk = fmaxf(gk, shx(gk, o, ln)); }
      thr2 = __builtin_bit_cast(float, __builtin_amdgcn_readfirstlane(__builtin_bit_cast(int, 150.0f + 2.0f * 1.02f * 64.0f * gq * gk + 8.0f))); }
    if (!(AVAR & 2)) {
        unsigned* qctr = F.ctl + CW_FOXQ + 16 * l; volatile LAS unsigned* qw = F.MISC + 16;
        for (;;) {
            if (fresh_tid(F.wave0) == 0) qw[0] = __hip_atomic_fetch_add(qctr, 1u, __ATOMIC_RELAXED, __HIP_MEMORY_SCOPE_AGENT);
            __syncthreads();
            const int u = (int)qw[0];
            __syncthreads();
            if (u >= 512) break;
            const int qb = 31 - (u >> 4), hf = u & 15, b = hf >> 3, h = hf & 7;
            const attn_body::bf16* base = QKVG + (size_t)b * SEQ * NP;
            attn_body::attn_unit<8, true, 512, 64, false>(qb, base + C_QF + h * 64, base + C_KF + h * 64, base + C_VF + h * 64, OFp + (size_t)b * SEQ * 512 + h * 64, CUM + ((size_t)b * 8 + h) * SEQ, (AVAR & 4) ? 1e30f : thr2, shm, F.wave0, -1);
        }
    }
}
#if BUILD_ORACLE
namespace orc {
__device__ __forceinline__ void tile_mm(const bf16* A, int lda, const int* arow  , const bf16* B, int ldb, int brow0, int K, float (*sA)[68], float (*sB)[68], float (&acc)[4][4]) {
    const int tid = threadIdx.x, ty = tid >> 4, tx = tid & 15, lr = tid >> 2, lc = (tid & 3) * 8;
    for (int k0 = 0; k0 < K; k0 += 32) {
        __syncthreads();
        { const int ar = arow[lr]; v4u a = (v4u){0u, 0u, 0u, 0u}; if (ar >= 0) a = *(const v4u*)(A + (size_t)ar * lda + k0 + lc);
          const v4u b = *(const v4u*)(B + (size_t)(brow0 + lr) * ldb + k0 + lc);
          sA[lc + 0][lr] = bflo(a.x); sA[lc + 1][lr] = bfhi(a.x); sA[lc + 2][lr] = bflo(a.y); sA[lc + 3][lr] = bfhi(a.y); sA[lc + 4][lr] = bflo(a.z); sA[lc + 5][lr] = bfhi(a.z); sA[lc + 6][lr] = bflo(a.w); sA[lc + 7][lr] = bfhi(a.w);
          sB[lc + 0][lr] = bflo(b.x); sB[lc + 1][lr] = bfhi(b.x); sB[lc + 2][lr] = bflo(b.y); sB[lc + 3][lr] = bfhi(b.y); sB[lc + 4][lr] = bflo(b.z); sB[lc + 5][lr] = bfhi(b.z); sB[lc + 6][lr] = bflo(b.w); sB[lc + 7][lr] = bfhi(b.w); }
        __syncthreads();
#pragma unroll 8
        for (int kk = 0; kk < 32; ++kk) { const f32x4 a = *(const f32x4*)&sA[kk][ty * 4], b = *(const f32x4*)&sB[kk][tx * 4];
#pragma unroll
            for (int i = 0; i < 4; ++i)
#pragma unroll
                for (int j = 0; j < 4; ++j) acc[i][j] += a[i] * b[j]; }
    }
}
__device__ __forceinline__ void put_tile(float (*Ct)[65], const float (&acc)[4][4]) {
    const int tid = threadIdx.x, ty = tid >> 4, tx = tid & 15;
#pragma unroll
    for (int i = 0; i < 4; ++i)
#pragma unroll
        for (int j = 0; j < 4; ++j) Ct[ty * 4 + i][tx * 4 + j] = acc[i][j];
}
#define ORC_SHARED __shared__ float sA[32][68]; __shared__ float sB[32][68]; __shared__ float Ct[64][65]; __shared__ int arow[64];
#define ZACC(a) _Pragma("unroll") for (int i_ = 0; i_ < 4; ++i_) _Pragma("unroll") for (int j_ = 0; j_ < 4; ++j_) a[i_][j_] = 0.f

__global__ void __launch_bounds__(256) inproj(Args a, int l) {
    ORC_SHARED
    const int n0 = blockIdx.x * 64, m0 = blockIdx.y * 64, tid = threadIdx.x;
    const bf16* HN = (const bf16*)(a.ws + WS_HN); const bf16* W = (const bf16*)(a.ws + WS_WIN) + (size_t)l * NP * D; bf16* QKVG = (bf16*)(a.ws + WS_QKVG);
    if (tid < 64) arow[tid] = m0 + tid;
    float acc[4][4]; ZACC(acc);
    tile_mm(HN, D, arow, W, D, n0, D, sA, sB, acc);
    put_tile(Ct, acc); __syncthreads();
    if (tid < 64) {
        const int row = m0 + tid, seg = n0 / 512; float v[64];
#pragma unroll
        for (int s = 0; s < 64; ++s) v[s] = Ct[tid][s];
        if (seg == 0 || seg == 1 || seg == 3 || seg == 4) {
            float ss = 0.f;
#pragma unroll
            for (int s = 0; s < 64; ++s) ss += v[s] * v[s];
            const float rs = 1.0f / sqrtf(ss * (1.0f / 64.0f) + EPS);
            const float* g = (const float*)a.in[seg == 0 ? I_QND : seg == 1 ? I_KND : seg == 3 ? I_QNF : I_KNF] + l * 64;
            const bool diff = seg < 2;
#pragma unroll
            for (int s = 0; s < 64; ++s) { const int d = (diff && s < 32) ? pi32(s) : s; v[s] = v[s] * rs * g[d]; }
            if (diff) { const float* cs = (const float*)(a.ws + WS_COSSIN) + (size_t)row * 16;
#pragma unroll
                for (int i = 0; i < 8; ++i) { const int s1 = pi32(i), s2 = pi32(i + 8); const float t1 = v[s1], t2 = v[s2], c = cs[i], sn = cs[8 + i]; v[s1] = t1 * c - t2 * sn; v[s2] = t2 * c + t1 * sn; } }
            if (seg == 0 || seg == 3) {
#pragma unroll
                for (int s = 0; s < 64; ++s) v[s] *= C2; }
        } else if (seg >= 6) {
#pragma unroll
            for (int s = 0; s < 64; ++s) v[s] = 1.0f / (1.0f + expf(-v[s]));
        }
#pragma unroll
        for (int s = 0; s < 64; s += 2) *(unsigned*)(QKVG + (size_t)row * NP + n0 + s) = pk2(v[s], v[s + 1]);
    }
}
struct AttnP { const bf16* Q; const bf16* K; const bf16* V; bf16* O; int qc, kc, vc, oc, opitch; int bias; };
__global__ void __launch_bounds__(256) attn(Args a, int mode  ) {
    __shared__ float sK[64][64]; __shared__ float sV[64][64]; __shared__ float sC[64];
    const int qb = blockIdx.x, he = blockIdx.y, tid = threadIdx.x;
    const bf16* QKVG = (const bf16*)(a.ws + WS_QKVG);
    int b, qc, kc, vc, oc, opitch; bf16* O; const float* cum = nullptr;
    if (mode == 0) { b = he / 16; const int r = he % 16, m = r >> 1, vh = r & 1; qc = C_QA + m * 64; kc = C_KA + m * 64; vc = C_VA + (m & 3) * 128 + vh * 64; O = (bf16*)(a.ws + WS_OA); oc = m * 128 + vh * 64; opitch = 1024; }
    else { b = he / 8; const int h = he % 8; qc = C_QF + h * 64; kc = C_KF + h * 64; vc = C_VF + h * 64; O = (bf16*)(a.ws + WS_OF); oc = h * 64; opitch = 512; cum = (const float*)(a.ws + WS_CUM) + ((size_t)b * 8 + h) * SEQ; }
    const int q0 = qb * 256, qi = q0 + tid; const size_t rowg = (size_t)b * SEQ + qi;
    float q[64], o[64];
#pragma unroll
    for (int d = 0; d < 64; ++d) { q[d] = bf2f(QKVG[rowg * NP + qc + d]); o[d] = 0.f; }
    const float cq = cum ? cum[qi] : 0.f;
    float m = -INFINITY, lsum = 0.f;
    const int nkt = (q0 + 256) / 64;
    for (int kt = 0; kt < nkt; ++kt) {
        __syncthreads();
        { const int r = tid >> 2, c0 = (tid & 3) * 16; const size_t kr = (size_t)b * SEQ + kt * 64 + r;
#pragma unroll
          for (int c = 0; c < 16; ++c) { sK[r][c0 + c] = bf2f(QKVG[kr * NP + kc + c0 + c]); sV[r][c0 + c] = bf2f(QKVG[kr * NP + vc + c0 + c]); }
          if (tid < 64) sC[tid] = cum ? cum[kt * 64 + tid] : 0.f; }
        __syncthreads();
        for (int j = 0; j < 64; ++j) {
            const int key = kt * 64 + j;
            if (key <= qi) {
                float s = 0.f;
#pragma unroll
                for (int d = 0; d < 64; ++d) s += q[d] * sK[j][d];
                s += cq - sC[j];
                if (s > m) { const float corr = exp2f(m - s); lsum *= corr;
#pragma unroll
                    for (int d = 0; d < 64; ++d) o[d] *= corr;
                    m = s; }
                const float p = exp2f(s - m); lsum += p;
#pragma unroll
                for (int d = 0; d < 64; ++d) o[d] += p * sV[j][d];
            }
        }
    }
    const float inv = 1.0f / lsum;
#pragma unroll
    for (int d = 0; d < 64; d += 2) *(unsigned*)(O + rowg * opitch + oc + d) = pk2(o[d] * inv, o[d + 1] * inv);
}
__global__ void __launch_bounds__(256) yz(Args a, int l) {
    ORC_SHARED
    __shared__ float Ct2[64][65];
    const int n0 = blockIdx.x * 64, m0 = blockIdx.y * 64, tid = threadIdx.x;
    if (tid < 64) arow[tid] = m0 + tid;
    float acc[4][4], acc2[4][4]; ZACC(acc); ZACC(acc2);
    tile_mm((const bf16*)(a.ws + WS_AD), 512, arow, (const bf16*)(a.ws + WS_WD) + (size_t)l * D * 512, 512, n0, 512, sA, sB, acc);
    tile_mm((const bf16*)(a.ws + WS_OF), 512, arow, (const bf16*)(a.ws + WS_WF) + (size_t)l * D * 512, 512, n0, 512, sA, sB, acc2);
    put_tile(Ct, acc); put_tile(Ct2, acc2); __syncthreads();
    const bf16* QKVG = (const bf16*)(a.ws + WS_QKVG); bf16* Z = (bf16*)(a.ws + WS_Z);
    if (tid < 64) { const int row = m0 + tid;
        for (int s = 0; s < 64; ++s) { const float ga = bf2f(QKVG[(size_t)row * NP + C_GA + n0 + s]), gf = bf2f(QKVG[(size_t)row * NP + C_GF + n0 + s]);
            Z[(size_t)row * D + n0 + s] = (bf16)f2bf(ga * Ct[tid][s] + gf * Ct2[tid][s]); } }
}
__global__ void __launch_bounds__(256) wo(Args a, int l) {
    ORC_SHARED
    const int n0 = blockIdx.x * 64, m0 = blockIdx.y * 64, tid = threadIdx.x;
    if (tid < 64) arow[tid] = m0 + tid;
    float acc[4][4]; ZACC(acc);
    tile_mm((const bf16*)(a.ws + WS_Z), D, arow, (const bf16*)(a.ws + WS_WO) + (size_t)l * D * D, D, n0, D, sA, sB, acc);
    put_tile(Ct, acc); __syncthreads();
    if (tid < 64) { const int row = m0 + tid; for (int s = 0; s < 64; ++s) a.out[(size_t)row * D + n0 + s] += Ct[tid][s]; }
}
__device__ __forceinline__ int find_expert(const unsigned* cnt, int t256, int& tile_in_e, int& cnt_e) {
    int off = 0;
    for (int e = 0; e < NEXP; ++e) { const int c = (int)cnt[e * CNT_STRIDE], nt = (c + 255) >> 8; if (t256 < off + nt) { tile_in_e = t256 - off; cnt_e = c; return e; } off += nt; }
    return -1;
}
__global__ void __launch_bounds__(256) gateup(Args a, int l) {
    ORC_SHARED
    __shared__ float Ct2[64][65]; __shared__ int asg[64];
    const int f0 = blockIdx.x * 64, m64 = blockIdx.y, tid = threadIdx.x;
    const unsigned* cnt = (const unsigned*)(a.ws + WS_CTL) + CW_CNT + (size_t)l * NEXP * CNT_STRIDE;
    int tie, ce; const int e = find_expert(cnt, m64 >> 2, tie, ce);
    if (e < 0) return;
    const int* LIST = (const int*)(a.ws + WS_LIST) + (size_t)e * T;
    if (tid < 64) { const int r = tie * 256 + (m64 & 3) * 64 + tid; const int as = r < ce ? LIST[r] : -1; asg[tid] = as; arow[tid] = as < 0 ? -1 : (as >> 1); }
    __syncthreads();
    const bf16* W = (const bf16*)(a.ws + WS_WGU) + ((size_t)l * NEXP + e) * 1024 * 1024;
    const int brow = (f0 >> 7) * 256 + (f0 & 127);
    float acc[4][4], acc2[4][4]; ZACC(acc); ZACC(acc2);
    tile_mm((const bf16*)(a.ws + WS_HN), D, arow, W, D, brow, D, sA, sB, acc);
    tile_mm((const bf16*)(a.ws + WS_HN), D, arow, W, D, brow + 128, D, sA, sB, acc2);
    put_tile(Ct, acc); put_tile(Ct2, acc2); __syncthreads();
    bf16* HID = (bf16*)(a.ws + WS_HID); const float* GWT = (const float*)(a.ws + WS_GWT);
    if (tid < 64) { const int as = asg[tid]; const float w = as < 0 ? 0.f : GWT[as]; const size_t hr = (size_t)m64 * 64 + tid;
        for (int s = 0; s < 64; ++s) { const float g = Ct[tid][s], u = Ct2[tid][s]; const float h = as < 0 ? 0.f : (g / (1.0f + expf(-g))) * u * w; HID[hr * FF + f0 + s] = (bf16)f2bf(h); } }
}
__global__ void __launch_bounds__(256) down(Args a, int l) {
    ORC_SHARED
    __shared__ int asg[64];
    const int n0 = blockIdx.x * 64, m64 = blockIdx.y, tid = threadIdx.x;
    const unsigned* cnt = (const unsigned*)(a.ws + WS_CTL) + CW_CNT + (size_t)l * NEXP * CNT_STRIDE;
    int tie, ce; const int e = find_expert(cnt, m64 >> 2, tie, ce);
    if (e < 0) return;
    const int* LIST = (const int*)(a.ws + WS_LIST) + (size_t)e * T;
    if (tid < 64) { const int r = tie * 256 + (m64 & 3) * 64 + tid; asg[tid] = r < ce ? LIST[r] : -1; arow[tid] = m64 * 64 + tid; }
    __syncthreads();
    float acc[4][4]; ZACC(acc);
    tile_mm((const bf16*)(a.ws + WS_HID), FF, arow, (const bf16*)(a.ws + WS_WDN) + ((size_t)l * NEXP + e) * 1024 * 512, FF, n0, FF, sA, sB, acc);
    put_tile(Ct, acc); __syncthreads();
    bf16* Y = (bf16*)(a.ws + WS_Y);
    if (tid < 64) { const int as = asg[tid]; if (as >= 0) { const size_t base = (size_t)(as & 1) * T * D + (size_t)(as >> 1) * D + n0;
        for (int s = 0; s < 64; ++s) Y[base + s] = (bf16)f2bf(Ct[tid][s]); } }
}
}
#endif
#define XB_TMO      128
#define XB_XCNT(j)  (256  + 64 * (j))
#define XB_XSUB(j)  (1280 + 64 * (j))
#define XB_XGEN(j)  (2304 + 64 * (j))
#define XB_TOP      3328
#define XB_TOPGEN   3392
#define XCD_BAR_WORDS 3456
#define XB_SPIN_CAP (1u << 18)
__device__ __forceinline__ unsigned xb_ld(unsigned* p)              { return __hip_atomic_load(p, __ATOMIC_RELAXED, __HIP_MEMORY_SCOPE_AGENT); }
__device__ __forceinline__ unsigned xb_add(unsigned* p, unsigned v) { return __hip_atomic_fetch_add(p, v, __ATOMIC_RELAXED, __HIP_MEMORY_SCOPE_AGENT); }
__device__ __forceinline__ unsigned xb_xcc_id() { return (unsigned)__builtin_amdgcn_s_getreg((3 << 11) | 20) & 0xFu; }
#define XB_SPIN(cond, bar) do { unsigned _sp = 0; while (cond) { __builtin_amdgcn_s_sleep(1); \
    if ((++_sp & 255u) == 0u) { if (xb_ld(&(bar)[XB_TMO])) break; if (_sp > XB_SPIN_CAP) { atomicAdd(&(bar)[XB_TMO], 1u); break; } } } } while (0)
struct XcdBarrier { unsigned* bar; unsigned x; volatile LAS unsigned* st; };
__device__ __forceinline__ XcdBarrier xcd_barrier_post(unsigned* bar, volatile LAS unsigned* st, const int tid) {
    XcdBarrier b; b.bar = bar; b.x = xb_xcc_id(); b.st = st;
    if (tid == 0) (void)xb_add(&bar[XB_XCNT(b.x)], 1u);
    return b;
}
__device__ __forceinline__ void xcd_barrier_complete(unsigned* bar, unsigned x, unsigned& nloc, unsigned& nx) {
    const unsigned G = gridDim.x * gridDim.y * gridDim.z;
    unsigned sum, cnt, mine, sp = 0u;
    for (;;) {
        sum = 0u; cnt = 0u; mine = 0u;
#pragma unroll
        for (unsigned j = 0; j < 16; ++j) { const unsigned c = xb_ld(&bar[XB_XCNT(j)]); sum += c; cnt += (c > 0u) ? 1u : 0u; mine = (j == x) ? c : mine; }
        if (sum == G) break;
        __builtin_amdgcn_s_sleep(1);
        if ((++sp & 255u) == 0u) { if (xb_ld(&bar[XB_TMO])) break; if (sp > XB_SPIN_CAP) { atomicAdd(&bar[XB_TMO], 1u); break; } }
    }
    nloc = mine > 0u ? mine : 1u; nx = cnt > 0u ? cnt : 1u;
}
__device__ __forceinline__ void xcd_barrier(const XcdBarrier& b, const int tid) {
    asm volatile("s_waitcnt vmcnt(0)" ::: "memory");
    __syncthreads();
    if (tid == 0) {
        unsigned* bar = b.bar;
        __builtin_amdgcn_s_waitcnt(0);
        unsigned nloc = b.st[0], nx = b.st[1];
        if (nloc == 0u) { xcd_barrier_complete(bar, b.x, nloc, nx); b.st[0] = nloc; b.st[1] = nx; }
        const unsigned old = xb_add(&bar[XB_XSUB(b.x)], 1u);
        const unsigned gen = old / nloc;
        asm volatile("buffer_inv sc1" ::: "memory");
        if (old + 1u == (gen + 1u) * nloc) {
            __builtin_amdgcn_fence(__ATOMIC_RELEASE, "agent");
            asm volatile("s_waitcnt vmcnt(0)" ::: "memory");
            const unsigned og = xb_add(&bar[XB_TOP], 1u);
            const unsigned tg = og / nx;
            if (og + 1u == (tg + 1u) * nx) xb_add(&bar[XB_TOPGEN], 1u);
            else XB_SPIN(xb_ld(&bar[XB_TOPGEN]) == tg, bar);
            asm volatile("" ::: "memory");
            xb_add(&bar[XB_XGEN(b.x)], 1u);
            asm volatile("s_waitcnt vmcnt(0)" ::: "memory");
        } else {
            XB_SPIN(xb_ld(&bar[XB_XGEN(b.x)]) == gen, bar);
            asm volatile("s_waitcnt vmcnt(0)" ::: "memory");
        }
    }
    __syncthreads();
}

__global__ void __launch_bounds__(NWAVES * 64, 2) mega(Args args) {
    extern __shared__ __attribute__((aligned(16))) unsigned char lds[];
    Frame F;
    F.lds = (LAS unsigned char*)lds;
    F.MISC = (volatile LAS unsigned*)(F.lds + MISC_OFF);
    F.wave0 = __builtin_amdgcn_readfirstlane((int)threadIdx.x >> 6);
    F.tid = fresh_tid(F.wave0); F.lane = F.tid & 63; F.wave = F.wave0;
    F.G = gridDim.x; { const int bx = blockIdx.x; F.vcu = (F.G % 8 == 0) ? (bx % 8) * (F.G / 8) + bx / 8 : bx; }
    F.in = args.in; F.out = args.out; F.ws = args.ws; F.ctl = (unsigned*)(args.ws + WS_CTL);
    for (int u = F.tid; u < (LDS_BYTES - LDSCTL_OFF) / 4; u += NWAVES * 64) ((LAS unsigned*)(F.lds + LDSCTL_OFF))[u] = 0u;
    __syncthreads();
    const int vcu0 = F.vcu;
    const int lo = args.ph_lo, hi = args.ph_hi;
    const bool multi = (hi - lo) > 1;
    XcdBarrier bar; bar.bar = F.ctl + CW_BAR; bar.x = 0; bar.st = nullptr;
    if (multi) bar = xcd_barrier_post(F.ctl + CW_BAR, F.MISC + 8, F.tid);
#define IN(k) (lo <= (k) && (k) < hi)
#define FRESH() do { { int w0_ = F.wave0; asm volatile("" : "+s"(w0_)); F.wave = w0_; F.lane = fresh_lane(); F.tid = w0_ * 64 + F.lane; } \
    { unsigned char* w_ = args.ws; float* o_ = args.out; asm volatile("" : "+s"(w_), "+s"(o_)); F.ws = w_; F.out = o_; F.ctl = (unsigned*)(w_ + WS_CTL); int v_ = vcu0, g_ = (int)gridDim.x, b_ = (int)blockIdx.x; asm volatile("" : "+s"(v_), "+s"(g_), "+s"(b_)); F.vcu = v_; F.G = g_; F.bx = b_; } } while (0)
#ifndef DUP_MASK
#define DUP_MASK 0
#endif
#define DUP(k) if ((DUP_MASK >> (k)) & 1)
#define SEAM(k) do { if (IN(k) && IN((k) + 1)) { xcd_barrier(bar, fresh_tid(F.wave0)); DUP(13) xcd_barrier(bar, fresh_tid(F.wave0)); } } while (0)
    if (IN(PH_PRO)) { FRESH(); phase_prologue(F); DUP(15) { __syncthreads(); FRESH(); phase_prologue(F); } }
    SEAM(PH_PRO);
    for (int l = 0; l < DEPTH; ++l) {
        const int pb = 1 + PH_PER_LAYER * l;
        if (IN(pb + K_NORM1)) { FRESH(); phase_normgemm<0>(F, l); }
        SEAM(pb + K_NORM1);
        if (IN(pb + K_CUMSUM)) { FRESH(); phase_cumsum(F); DUP(K_CUMSUM) { __syncthreads(); FRESH(); phase_cumsum(F); } }
        if (IN(pb + K_INPROJ)) { FRESH(); phase_inproj(F, l); DUP(K_INPROJ) { __syncthreads(); FRESH(); phase_inproj(F, l); } }
        SEAM(pb + K_INPROJ);
        if (IN(pb + K_ATTN)) { FRESH(); phase_attn<0>(F, l); }
        SEAM(pb + K_ATTN);
        if (IN(pb + K_YZ)) { FRESH(); phase_yz(F, l); DUP(K_YZ) { __syncthreads(); FRESH(); phase_yz(F, l); } }
        SEAM(pb + K_YZ);
        if (IN(pb + K_WO)) { FRESH(); phase_wo(F, l);  }
        SEAM(pb + K_WO);
        if (IN(pb + K_ROUTER)) { FRESH(); phase_router2(F, l); }
        SEAM(pb + K_ROUTER);
        if (IN(pb + K_GATEUP)) { FRESH(); phase_gateup(F, l); DUP(K_GATEUP) { __syncthreads(); FRESH(); phase_gateup(F, l); } }
#if MOE_BARRIER
        SEAM(pb + K_GATEUP);
#else
        __syncthreads();
#endif
        if (IN(pb + K_DOWN)) { FRESH(); phase_down(F, l); DUP(K_DOWN) { __syncthreads(); FRESH(); phase_down(F, l); } }
        SEAM(pb + K_DOWN);
    }
#ifndef TAIL_VAR
#define TAIL_VAR 0
#endif
#ifndef TAIL_MASK
#define TAIL_MASK 0
#endif
#define TAILP(k, call) do { if ((TAIL_MASK >> (k)) & 1) { xcd_barrier(bar, fresh_tid(F.wave0)); FRESH(); call; } } while (0)
    if (IN(PH_FINAL)) { FRESH(); phase_final(F); DUP(14) { __syncthreads(); FRESH(); phase_final(F, true); } }
    if (multi && TAIL_MASK) { const int l = 1;
        TAILP(15, phase_prologue(F)); TAILP(K_CUMSUM, phase_cumsum(F)); TAILP(K_INPROJ, phase_inproj(F, l)); TAILP(K_ATTN, phase_attn<TAIL_VAR>(F, l));
        TAILP(K_DIFFC, phase_diffc(F, l)); TAILP(K_YZ, phase_yz(F, l)); TAILP(K_WO, phase_wo(F, l, true)); TAILP(K_ROUTER, phase_router2(F, l, true)); TAILP(K_GATEUP, phase_gateup(F, l)); TAILP(K_DOWN, phase_down(F, l));
        TAILP(14, phase_final(F, true)); }
#undef IN
#undef FRESH
#undef SEAM
#undef DUP
}

#ifndef FAST_MASK
#define FAST_MASK 0
#endif
#ifndef ONE_LAUNCH
#define ONE_LAUNCH 0
#endif
extern "C" void kernel_launch(void* const* d_in, const int* in_sizes, int n_in, void* d_out, int out_size, void* d_ws, size_t ws_size, hipStream_t stream) {
    static int grid = 0;
    if (grid == 0) {
        if (n_in != 25 || in_sizes[0] != T * D || out_size != T * D || ws_size < WS_END) { fprintf(stderr, "kernel_launch: unexpected shapes (n_in %d, in0 %d, out %d, ws %zu); nothing launched\n", n_in, n_in > 0 ? in_sizes[0] : -1, out_size, ws_size); grid = -1; return; }
        int dev = 0, cus = 0, per_cu = 0;
        if (hipGetDevice(&dev) != hipSuccess || hipDeviceGetAttribute(&cus, hipDeviceAttributeMultiprocessorCount, dev) != hipSuccess) { grid = -1; return; }
        if (hipFuncSetAttribute((const void*)mega, hipFuncAttributeMaxDynamicSharedMemorySize, LDS_BYTES) != hipSuccess) { fprintf(stderr, "kernel_launch: hipFuncSetAttribute failed\n"); grid = -1; return; }
        if (hipOccupancyMaxActiveBlocksPerMultiprocessor(&per_cu, (const void*)mega, NWAVES * 64, LDS_BYTES) != hipSuccess || per_cu < 1) { fprintf(stderr, "kernel_launch: occupancy query reports %d\n", per_cu); }
        (void)hipGetLastError();
        grid = cus;
    }
    if (grid < 0) return;
    (void)hipMemsetAsync((char*)d_ws + WS_CTL, 0, CTL_ZERO_BYTES, stream);
    Args a{};
    for (int i = 0; i < 25; ++i) a.in[i] = d_in[i];
    a.out = (float*)d_out; a.ws = (unsigned char*)d_ws;
#if ONE_LAUNCH
    a.ph_lo = 0; a.ph_hi = N_PHASES;
    hipLaunchKernelGGL(mega, dim3(grid), dim3(NWAVES * 64), LDS_BYTES, stream, a);
#else
    for (int p = 0; p < N_PHASES; ++p) {
        const int l = (p - 1) / PH_PER_LAYER, k = (p >= 1 && p < PH_FINAL) ? (p - 1) % PH_PER_LAYER : -1;
        const bool heavy = (k == K_INPROJ || k == K_ATTN || k == K_YZ || k == K_WO || k == K_GATEUP || k == K_DOWN);
#if BUILD_ORACLE
        if (heavy && !((FAST_MASK >> k) & 1)) {
            if (k == K_INPROJ) hipLaunchKernelGGL(orc::inproj, dim3(80, 256), dim3(256), 0, stream, a, l);
            else if (k == K_ATTN) { hipLaunchKernelGGL(orc::attn, dim3(32, 32), dim3(256), 0, stream, a, 0); hipLaunchKernelGGL(orc::attn, dim3(32, 16), dim3(256), 0, stream, a, 1); }
            else if (k == K_YZ) hipLaunchKernelGGL(orc::yz, dim3(16, 256), dim3(256), 0, stream, a, l);
            else if (k == K_WO) hipLaunchKernelGGL(orc::wo, dim3(16, 256), dim3(256), 0, stream, a, l);
            else if (k == K_GATEUP) hipLaunchKernelGGL(orc::gateup, dim3(8, HID_ROWS / 64), dim3(256), 0, stream, a, l);
            else hipLaunchKernelGGL(orc::down, dim3(16, HID_ROWS / 64), dim3(256), 0, stream, a, l);
            continue;
        }
#endif
        a.ph_lo = p; a.ph_hi = p + 1;
        hipLaunchKernelGGL(mega, dim3(grid), dim3(NWAVES * 64), LDS_BYTES, stream, a);
    }
#endif
}
```
